# Optimizing an MI355X kernel written in HIP

```python
import math
import jax, jax.numpy as jnp
from jax import lax
import numpy as np

D_MODEL = 2048
BATCH = 4
SEQ = 4096
DEPTH = 1

DA_HEADS = 8
DA_HEAD_DIM = 64
DA_V_DIM = 2 * DA_HEAD_DIM
DA_QK_WIDTH = DA_HEADS * 2 * DA_HEAD_DIM
DA_V_WIDTH = DA_HEADS * DA_V_DIM
ROPE_THETA = 500000.0
ROPE_DIM = DA_HEAD_DIM // 4
Q_BLOCK = 128
RW_HEADS = 16
RW_HEAD_DIM = 64
RW_WIDTH = RW_HEADS * RW_HEAD_DIM
DECAY_LORA = 64
AAA_LORA = 64
GATE_LORA = 160
GN_EPS = 64e-5
N_BRANCH = 2
N_EXPERTS = 16
EXPERT_FF = 1024
CAPACITY_FACTOR = 2
RMS_EPS = 1e-6

DA_COLS = 2 * DA_QK_WIDTH + DA_V_WIDTH
RW_COLS = 3 * RW_WIDTH + 2 * DECAY_LORA + 2 * AAA_LORA + GATE_LORA
GATE_COLS = N_BRANCH * D_MODEL
IN_COLS = DA_COLS + RW_COLS + GATE_COLS
RW_SPLITS = tuple(int(v) for v in np.cumsum(
    [RW_WIDTH, RW_WIDTH, RW_WIDTH, DECAY_LORA, DECAY_LORA, AAA_LORA, AAA_LORA]))

kernel_name = "hybrid_diffattn_rwkv7_ecmoe_encoder"


def rms_norm(x, g, eps=RMS_EPS):
    xf = x.astype(jnp.float32)
    y = xf * lax.rsqrt(jnp.mean(xf * xf, axis=-1, keepdims=True) + eps)
    return (y * g.astype(jnp.float32)).astype(x.dtype)


def rope_tables(T):
    inv = ROPE_THETA ** (-(jnp.arange(0, ROPE_DIM, 2, dtype=jnp.float32) / ROPE_DIM))
    ang = jnp.arange(T, dtype=jnp.float32)[:, None] * inv[None, :]
    return jnp.cos(ang), jnp.sin(ang)


def apply_partial_rope(x, cos, sin):
    c = cos[None, :, None, None, :].astype(x.dtype)
    s = sin[None, :, None, None, :].astype(x.dtype)
    half = ROPE_DIM // 2
    x1 = x[..., :half]
    x2 = x[..., half:ROPE_DIM]
    return jnp.concatenate([x1 * c - x2 * s, x2 * c + x1 * s, x[..., ROPE_DIM:]], axis=-1)


def diff_attention_branch(p, cos, sin, q_norm_g, k_norm_g, lq1, lk1, lq2, lk2, subln_g, lam_init):
    B, T, _ = p.shape
    q = p[..., :DA_QK_WIDTH].reshape(B, T, DA_HEADS, 2, DA_HEAD_DIM)
    k = p[..., DA_QK_WIDTH:2 * DA_QK_WIDTH].reshape(B, T, DA_HEADS, 2, DA_HEAD_DIM)
    v = p[..., 2 * DA_QK_WIDTH:].reshape(B, T, DA_HEADS, DA_V_DIM)
    q = apply_partial_rope(rms_norm(q, q_norm_g), cos, sin)
    k = apply_partial_rope(rms_norm(k, k_norm_g), cos, sin)
    lam = (jnp.exp(jnp.sum(lq1.astype(jnp.float32) * lk1.astype(jnp.float32)))
           - jnp.exp(jnp.sum(lq2.astype(jnp.float32) * lk2.astype(jnp.float32))) + lam_init)
    scale = DA_HEAD_DIM ** -0.5
    qh = q.transpose(0, 2, 3, 1, 4)
    kh = k.transpose(0, 2, 3, 1, 4)
    vh = v.transpose(0, 2, 1, 3)
    nb = T // Q_BLOCK
    qb = qh.reshape(B, DA_HEADS, 2, nb, Q_BLOCK, DA_HEAD_DIM).transpose(3, 0, 1, 2, 4, 5)

    def block(qi):
        s = jnp.einsum('bhsqd,bhskd->bhsqk', qi, kh).astype(jnp.float32) * scale
        pr = jax.nn.softmax(s, axis=-1)
        a = pr[:, :, 0] - lam * pr[:, :, 1]
        return jnp.einsum('bhqk,bhkv->bhqv', a.astype(vh.dtype), vh)

    o = lax.map(block, qb)
    o = o.transpose(1, 0, 3, 2, 4).reshape(B, T, DA_HEADS, DA_V_DIM)
    o = rms_norm(o, subln_g) * (1.0 - lam_init)
    return o.reshape(B, T, DA_V_WIDTH)


def centred_shift(p):
    prev = jnp.pad(p[:, :-1], ((0, 0), (1, 0), (0, 0)))
    nxt = jnp.pad(p[:, 1:], ((0, 0), (0, 1), (0, 0)))
    return 0.5 * (prev + nxt)


def wkv7_scan(r, w, k, v, a, b, reverse):
    B, T, H, N = r.shape
    xs = tuple(t.astype(jnp.float32).transpose(1, 0, 2, 3) for t in (r, w, k, v, a, b))

    def step(S, inp):
        r_t, w_t, k_t, v_t, a_t, b_t = inp
        sa = jnp.einsum('bhvk,bhk->bhv', S, a_t)
        S = S * w_t[:, :, None, :] + sa[..., None] * b_t[:, :, None, :] + v_t[..., None] * k_t[:, :, None, :]
        return S, jnp.einsum('bhvk,bhk->bhv', S, r_t)

    S0 = jnp.zeros((B, H, N, N), jnp.float32)
    _, y = lax.scan(step, S0, xs, reverse=reverse)
    return y.transpose(1, 0, 2, 3)


def rwkv7_branch(p, shift_mu, w0_f, w2_f, w0_b, w2_b, a0_f, a2_f, a0_b, a2_b, g2,
                 k_k, k_a, r_k, ln_x_w, ln_x_b):
    B, T, _ = p.shape
    dt = p.dtype
    p = p + shift_mu * (centred_shift(p) - p)
    r, k, v, wd_f, wd_b, ad_f, ad_b, gd = jnp.split(p, RW_SPLITS, axis=-1)

    def decay(w0, wd, w2):
        wl = (w0 + jnp.tanh(wd) @ w2).astype(jnp.float32)
        return jnp.exp(-jnp.exp(-jax.nn.softplus(-wl) - 0.5))

    dec_f = decay(w0_f, wd_f, w2_f)
    dec_b = decay(w0_b, wd_b, w2_b)
    a_f = jax.nn.sigmoid(a0_f + ad_f @ a2_f)
    a_b = jax.nn.sigmoid(a0_b + ad_b @ a2_b)
    g = jax.nn.sigmoid(gd) @ g2

    hs = lambda t: t.reshape(B, T, RW_HEADS, RW_HEAD_DIM)
    r, k, v, a_f, a_b, dec_f, dec_b = map(hs, (r, k, v, a_f, a_b, dec_f, dec_b))
    kk = (k * k_k.reshape(RW_HEADS, RW_HEAD_DIM)).astype(jnp.float32)
    kk = kk / jnp.maximum(jnp.sqrt(jnp.sum(kk * kk, axis=-1, keepdims=True)), 1e-12)
    k_ah = k_a.reshape(RW_HEADS, RW_HEAD_DIM)
    k_f = k * (1 + (a_f - 1) * k_ah)
    k_b = k * (1 + (a_b - 1) * k_ah)
    y = (wkv7_scan(r, dec_f, k_f, v, -kk, kk * a_f, reverse=False)
         + wkv7_scan(r, dec_b, k_b, v, -kk, kk * a_b, reverse=True))
    mean = jnp.mean(y, axis=-1, keepdims=True)
    var = jnp.mean(jnp.square(y - mean), axis=-1, keepdims=True)
    y = ((y - mean) * lax.rsqrt(var + GN_EPS) * ln_x_w.reshape(RW_HEADS, RW_HEAD_DIM).astype(jnp.float32)
         + ln_x_b.reshape(RW_HEADS, RW_HEAD_DIM).astype(jnp.float32)).astype(dt)
    bonus = jnp.sum(r * (k_f + k_b) * r_k, axis=-1, keepdims=True) * v
    return (y + bonus).reshape(B, T, RW_WIDTH) * g


def expert_choice_ffn(hn, w_router, w_gate_e, w_up_e, w_down_e):
    B, T, D = hn.shape
    cap = CAPACITY_FACTOR * T // N_EXPERTS
    aff = jax.nn.softmax((hn @ w_router).astype(jnp.float32), axis=-1)
    gate, idx = lax.top_k(aff.transpose(0, 2, 1), cap)
    xe = jax.vmap(lambda h, i: h[i])(hn, idx)
    hid = jax.nn.silu(jnp.einsum('becd,edf->becf', xe, w_gate_e)) * jnp.einsum('becd,edf->becf', xe, w_up_e)
    ye = jnp.einsum('becf,efd->becd', hid, w_down_e) * gate[..., None].astype(hn.dtype)
    flat = (jnp.arange(B, dtype=jnp.int32)[:, None, None] * T + idx).reshape(-1)
    out = jnp.zeros((B * T, D), hn.dtype).at[flat].add(ye.reshape(-1, D))
    return out.reshape(B, T, D)


def setup_inputs(seed: int = 0) -> dict:
    key = jax.random.key(seed)
    ks = iter(jax.random.split(key, 40))
    f32 = jnp.float32
    nrm = lambda shape, s: jax.random.normal(next(ks), shape, f32) * s
    gain = lambda shape: 1.0 + 0.1 * jax.random.normal(next(ks), shape, f32)
    L = DEPTH
    return {
        "x": jax.random.normal(next(ks), (BATCH, SEQ, D_MODEL), f32),
        "attn_norm_g": gain((L, D_MODEL)),
        "w_in": nrm((L, D_MODEL, IN_COLS), D_MODEL ** -0.5),
        "q_norm_g": gain((L, DA_HEAD_DIM)),
        "k_norm_g": gain((L, DA_HEAD_DIM)),
        "lambda_q1": nrm((L, DA_HEAD_DIM), 0.1),
        "lambda_k1": nrm((L, DA_HEAD_DIM), 0.1),
        "lambda_q2": nrm((L, DA_HEAD_DIM), 0.1),
        "lambda_k2": nrm((L, DA_HEAD_DIM), 0.1),
        "subln_g": gain((L, DA_V_DIM)),
        "shift_mu": jax.random.uniform(next(ks), (L, RW_COLS), f32),
        "w0_f": jax.random.uniform(next(ks), (L, RW_WIDTH), f32, -5.0, -0.5),
        "w2_f": nrm((L, DECAY_LORA, RW_WIDTH), 0.5 * DECAY_LORA ** -0.5),
        "w0_b": jax.random.uniform(next(ks), (L, RW_WIDTH), f32, -5.0, -0.5),
        "w2_b": nrm((L, DECAY_LORA, RW_WIDTH), 0.5 * DECAY_LORA ** -0.5),
        "a0_f": nrm((L, RW_WIDTH), 0.5),
        "a2_f": nrm((L, AAA_LORA, RW_WIDTH), 0.5 * AAA_LORA ** -0.5),
        "a0_b": nrm((L, RW_WIDTH), 0.5),
        "a2_b": nrm((L, AAA_LORA, RW_WIDTH), 0.5 * AAA_LORA ** -0.5),
        "g2": nrm((L, GATE_LORA, RW_WIDTH), GATE_LORA ** -0.5),
        "k_k": 0.85 + 0.1 * jax.random.normal(next(ks), (L, RW_WIDTH), f32),
        "k_a": gain((L, RW_WIDTH)),
        "r_k": nrm((L, RW_HEADS, RW_HEAD_DIM), 0.1),
        "ln_x_w": gain((L, RW_WIDTH)),
        "ln_x_b": nrm((L, RW_WIDTH), 0.02),
        "w_branch_a": nrm((L, DA_V_WIDTH, D_MODEL), DA_V_WIDTH ** -0.5),
        "w_branch_b": nrm((L, RW_WIDTH, D_MODEL), RW_WIDTH ** -0.5),
        "w_out": nrm((L, D_MODEL, D_MODEL), D_MODEL ** -0.5),
        "ffn_norm_g": gain((L, D_MODEL)),
        "w_router": nrm((L, D_MODEL, N_EXPERTS), D_MODEL ** -0.5),
        "w_gate_e": nrm((L, N_EXPERTS, D_MODEL, EXPERT_FF), D_MODEL ** -0.5),
        "w_up_e": nrm((L, N_EXPERTS, D_MODEL, EXPERT_FF), D_MODEL ** -0.5),
        "w_down_e": nrm((L, N_EXPERTS, EXPERT_FF, D_MODEL), EXPERT_FF ** -0.5),
    }


def reference(x, attn_norm_g, w_in, q_norm_g, k_norm_g, lambda_q1, lambda_k1, lambda_q2, lambda_k2,
              subln_g, shift_mu, w0_f, w2_f, w0_b, w2_b, a0_f, a2_f, a0_b, a2_b, g2, k_k, k_a, r_k,
              ln_x_w, ln_x_b, w_branch_a, w_branch_b, w_out, ffn_norm_g, w_router,
              w_gate_e, w_up_e, w_down_e):
    B, T, _ = x.shape
    cos, sin = rope_tables(T)
    h = x
    for l in range(DEPTH):
        lam_init = 0.8 - 0.6 * math.exp(-0.3 * l)
        hn = rms_norm(h, attn_norm_g[l])
        proj = hn @ w_in[l]
        p_da = proj[..., :DA_COLS]
        p_rw = proj[..., DA_COLS:DA_COLS + RW_COLS]
        p_gate = proj[..., DA_COLS + RW_COLS:]
        y_a = diff_attention_branch(p_da, cos, sin, q_norm_g[l], k_norm_g[l], lambda_q1[l], lambda_k1[l],
                                    lambda_q2[l], lambda_k2[l], subln_g[l], lam_init)
        y_b = rwkv7_branch(p_rw, shift_mu[l], w0_f[l], w2_f[l], w0_b[l], w2_b[l], a0_f[l], a2_f[l],
                           a0_b[l], a2_b[l], g2[l], k_k[l], k_a[l], r_k[l], ln_x_w[l], ln_x_b[l])
        gates = jax.nn.sigmoid(p_gate)
        gate_a = gates[..., :D_MODEL]
        gate_b = gates[..., D_MODEL:]
        merged = gate_a * (y_a @ w_branch_a[l]) + gate_b * (y_b @ w_branch_b[l])
        h = h + merged @ w_out[l]
        h = h + expert_choice_ffn(rms_norm(h, ffn_norm_g[l]), w_router[l], w_gate_e[l], w_up_e[l], w_down_e[l])
    return h
```

```cpp
#include <hip/hip_runtime.h>
#include <hip/hip_cooperative_groups.h>
#include <cstdio>
#include <cstdint>
namespace cg = cooperative_groups;

constexpr int NB = 4, SEQ = 4096, M = NB * SEQ, DM = 2048;
constexpr int DA_COLS = 3072, RW_COLS = 3488, RW_PAD = 3584, GATE_COLS = 4096, IN_COLS = 10656, IN_PAD = 10752;
constexpr int NE = 16, FF = 1024, CAP = 512, NSLOT = NB * NE * CAP;
constexpr float RMS_EPS = 1e-6f, GN_EPS = 64e-5f, LAM_INIT = 0.2f;
constexpr int NWAVES = 8, NTHREADS = 512;

constexpr size_t MiB = 1u << 20;
constexpr size_t WS_SSP = 5 * MiB;
constexpr size_t WS_SELTOK = 128 * 1024;
constexpr size_t WS_SELGATE = 256 * 1024;
constexpr size_t WS_BIAS4 = 512 * 1024;
constexpr size_t WS_SMALL = 576 * 1024;
constexpr int SM_QNG = 0, SM_KNG = 64, SM_LQ1 = 128, SM_LK1 = 192, SM_LQ2 = 256, SM_LK2 = 320, SM_SUBLN = 384, SM_MU = 512, SM_KK = 4096, SM_KA = 5120, SM_RK = 6144,
              SM_LNW = 7168, SM_LNB = 8192, SM_FNG = 9216, SM_WR = 11264, SM_END = 44032;
constexpr size_t WS_BAR = 768 * 1024;
constexpr size_t WS_INRM = 1 * MiB;
constexpr size_t WS_AFF = 1 * MiB;
constexpr size_t WS_ROPE = 7 * MiB;
constexpr size_t WS_BTL1 = 2 * MiB;
constexpr size_t WS_BTL2 = 4 * MiB;
constexpr size_t WS_WAT = 8 * MiB, WS_WBT = 12 * MiB, WS_WOT = 16 * MiB;
constexpr size_t WS_HN = 24 * MiB;
constexpr size_t WS_RKV = 24 * MiB;
constexpr size_t WS_WINT = 88 * MiB;
constexpr size_t WS_PDA = 130 * MiB;
constexpr size_t WS_MERGED = 130 * MiB;
constexpr size_t WS_GATES = 226 * MiB;
constexpr size_t WS_LORA = 354 * MiB;
constexpr size_t WS_YA = 514 * MiB;
constexpr size_t WS_END1 = 546 * MiB;
constexpr size_t WS_W1T = 24 * MiB;
constexpr size_t WS_WDT = 546 * MiB;
constexpr size_t WS_XE = 216 * MiB;
constexpr size_t WS_HN2 = 216 * MiB;
constexpr size_t WS_HID = 344 * MiB;
constexpr size_t WS_NEED = 610 * MiB;
constexpr size_t DO_PRW = 0, DO_LIN = 112 * MiB, DO_YSF = 0, DO_YSB = 32 * MiB, DO_YB = 64 * MiB;

constexpr int MISC_OFF = 143360;
constexpr int LDS_BYTES = 147456;

#define LAS __attribute__((address_space(3)))
typedef unsigned short bf16_t;
typedef unsigned v4u __attribute__((ext_vector_type(4)));
typedef unsigned v2u __attribute__((ext_vector_type(2)));

__device__ __forceinline__ int fresh_tid() { int t = threadIdx.x; asm volatile("" : "+v"(t)); return t; }
__device__ __forceinline__ float bf2f(unsigned short b) { return __builtin_bit_cast(float, (unsigned)b << 16); }
__device__ __forceinline__ float bflo(unsigned w) { return __builtin_bit_cast(float, w << 16); }
__device__ __forceinline__ float bfhi(unsigned w) { return __builtin_bit_cast(float, w & 0xffff0000u); }
__device__ __forceinline__ unsigned f2bf(float f) { unsigned u = __builtin_bit_cast(unsigned, f); return (u + 0x7fffu + ((u >> 16) & 1u)) >> 16; }
typedef float f32x2_t __attribute__((ext_vector_type(2))); typedef __bf16 bf16x2_t __attribute__((ext_vector_type(2)));
__device__ __forceinline__ unsigned pk2(float lo, float hi) { f32x2_t v = {lo, hi}; bf16x2_t b = __builtin_convertvector(v, bf16x2_t); return __builtin_bit_cast(unsigned, b); }
__device__ __forceinline__ float sigmoidf_(float x) { return __builtin_amdgcn_rcpf(1.0f + __expf(-x)); }
__device__ __forceinline__ float wave_sum(float v) {
#pragma unroll
    for (int o = 1; o < 64; o <<= 1) v += __shfl_xor(v, o);
    return v;
}
__device__ __forceinline__ float sum8(float v) { v += __shfl_xor(v, 1); v += __shfl_xor(v, 2); v += __shfl_xor(v, 4); return v; }
__device__ __forceinline__ void unpack8(const v4u& w, float (&f)[8]) {
    f[0] = bflo(w.x); f[1] = bfhi(w.x); f[2] = bflo(w.y); f[3] = bfhi(w.y); f[4] = bflo(w.z); f[5] = bfhi(w.z); f[6] = bflo(w.w); f[7] = bfhi(w.w);
}
__device__ __forceinline__ v4u pack8(const float (&f)[8]) { v4u w; w.x = pk2(f[0], f[1]); w.y = pk2(f[2], f[3]); w.z = pk2(f[4], f[5]); w.w = pk2(f[6], f[7]); return w; }

#define XB_TMO      128
#define XB_XCNT(j)  (256  + 64 * (j))
#define XB_XSUB(j)  (1280 + 64 * (j))
#define XB_XGEN(j)  (2304 + 64 * (j))
#define XB_TOP      3328
#define XB_TOPGEN   3392
#define XCD_BAR_WORDS 3456
#define XB_SPIN_CAP (1u << 18)

__device__ __forceinline__ unsigned xb_ld(unsigned* p)              { return __hip_atomic_load(p, __ATOMIC_RELAXED, __HIP_MEMORY_SCOPE_AGENT); }
__device__ __forceinline__ unsigned xb_add(unsigned* p, unsigned v) { return __hip_atomic_fetch_add(p, v, __ATOMIC_RELAXED, __HIP_MEMORY_SCOPE_AGENT); }
__device__ __forceinline__ unsigned xb_xcc_id() { return (unsigned)__builtin_amdgcn_s_getreg((3 << 11) | 20) & 0xFu; }
#define XB_SPIN(cond, bar) do { unsigned _sp = 0; while (cond) { __builtin_amdgcn_s_sleep(1); \
    if ((++_sp & 255u) == 0u) { if (xb_ld(&(bar)[XB_TMO])) break; if (_sp > XB_SPIN_CAP) { atomicAdd(&(bar)[XB_TMO], 1u); break; } } } } while (0)

struct XcdBarrier {
    unsigned* bar; unsigned x;
    volatile LAS unsigned* st;
};

__device__ __forceinline__ XcdBarrier xcd_barrier_post(unsigned* bar, volatile LAS unsigned* st) {
    XcdBarrier b; b.bar = bar; b.x = xb_xcc_id(); b.st = st;
    if (threadIdx.x == 0) (void)xb_add(&bar[XB_XCNT(b.x)], 1u);
    return b;
}
__device__ __forceinline__ void xcd_barrier_complete(unsigned* bar, unsigned x, unsigned& nloc, unsigned& nx) {
    const unsigned G = gridDim.x * gridDim.y * gridDim.z;
    unsigned sum, cnt, mine, sp = 0u;
    for (;;) {
        sum = 0u; cnt = 0u; mine = 0u;
#pragma unroll
        for (unsigned j = 0; j < 16; ++j) { const unsigned c = xb_ld(&bar[XB_XCNT(j)]); sum += c; cnt += (c > 0u) ? 1u : 0u; mine = (j == x) ? c : mine; }
        if (sum == G) break;
        __builtin_amdgcn_s_sleep(1);
        if ((++sp & 255u) == 0u) { if (xb_ld(&bar[XB_TMO])) break; if (sp > XB_SPIN_CAP) { atomicAdd(&bar[XB_TMO], 1u); break; } }
    }
    nloc = mine > 0u ? mine : 1u; nx = cnt > 0u ? cnt : 1u;
}

__device__ __forceinline__ void xcd_barrier(const XcdBarrier& b) {
    asm volatile("s_waitcnt vmcnt(0)" ::: "memory");
    __syncthreads();
    if (threadIdx.x == 0) {
        unsigned* bar = b.bar;
        __builtin_amdgcn_s_waitcnt(0);
        unsigned nloc = b.st[0], nx = b.st[1];
        if (nloc == 0u) { xcd_barrier_complete(bar, b.x, nloc, nx); b.st[0] = nloc; b.st[1] = nx; }
        const unsigned old = xb_add(&bar[XB_XSUB(b.x)], 1u);
        const unsigned gen = old / nloc;
        if (old + 1u == (gen + 1u) * nloc) {
            __builtin_amdgcn_fence(__ATOMIC_RELEASE, "agent");
            asm volatile("s_waitcnt vmcnt(0)" ::: "memory");
            const unsigned og = xb_add(&bar[XB_TOP], 1u);
            const unsigned tg = og / nx;
            if (og + 1u == (tg + 1u) * nx) xb_add(&bar[XB_TOPGEN], 1u);
            else XB_SPIN(xb_ld(&bar[XB_TOPGEN]) == tg, bar);
            __builtin_amdgcn_fence(__ATOMIC_ACQUIRE, "agent");
            xb_add(&bar[XB_XGEN(b.x)], 1u);
            asm volatile("s_waitcnt vmcnt(0)" ::: "memory");
        } else {
            XB_SPIN(xb_ld(&bar[XB_XGEN(b.x)]) == gen, bar);
            __builtin_amdgcn_fence(__ATOMIC_ACQUIRE, "agent");
            asm volatile("s_waitcnt vmcnt(0)" ::: "memory");
        }
    }
    __syncthreads();
}
namespace pg8 {
#define PG8_LAS __attribute__((address_space(3)))
typedef unsigned short bf16_t;
typedef short bf16x8 __attribute__((ext_vector_type(8)));
typedef float f32x4 __attribute__((ext_vector_type(4)));
typedef unsigned u32x4 __attribute__((ext_vector_type(4)));
constexpr int BM = 256, BK = 64, HALF = 128, HTB = HALF * BK * 2  , STAGE_BYTES = 8 * HTB, NXCD = 8, WGM = 4;

__host__ __device__ __forceinline__ int lds_byte(int r, int c) { const int st = (r >> 4) * 2 + (c >> 5), rr = r & 15, cc = c & 31, ob = rr * 64 + cc * 2; return st * 1024 + (ob ^ (((ob >> 9) & 1) << 5)); }
__host__ __device__ __forceinline__ void stage_rc(int b, int& R, int& C) { const int st = b / 1024, sb = b % 1024, swz = sb ^ (((sb >> 9) & 1) << 5); R = (st >> 1) * 16 + swz / 64; C = (st & 1) * 32 + (swz % 64) / 2; }
__host__ __device__ __forceinline__ int perm32(int rho) { const int n = rho >> 4, i = rho & 15; return 8 * (i >> 2) + 4 * n + (i & 3); }

struct Unit { int pm, pn; };
struct Gemm { const bf16_t* A; const bf16_t* Bt; int lda, ldb, K; };

struct StaticOrder {
    int nM, nN, nwg, G, c;
    __host__ __device__ void init(int M, int N, int G_, int c_) { nM = M / BM; nN = N / BM; nwg = nM * nN; G = G_; c = c_; }
    __host__ __device__ bool next(int i, Unit& u) const {
        const long L = (long)i * G + c; if (L >= nwg) return false;
        int wgid = (int)L; { const int q = nwg / NXCD, r = nwg % NXCD, xcd = wgid % NXCD, off = wgid / NXCD; wgid = (xcd < r ? xcd * (q + 1) : r * (q + 1) + (xcd - r) * q) + off; }
        const int nig = WGM * nN, gid = wgid / nig, fm = gid * WGM, gsz = (nM - fm) < WGM ? (nM - fm) : WGM;
        u.pm = fm + ((wgid % nig) % gsz); u.pn = (wgid % nig) / gsz; return true;
    }
    __device__ __forceinline__ void a_ready(const Unit&) const {}
    __device__ __forceinline__ void done(const Unit&) const {}
};

__device__ __forceinline__ unsigned cvt_pk_bf16(float lo, float hi) { return pk2(lo, hi); }
__device__ __forceinline__ u32x4 pack_bf16x8(const f32x4& v0, const f32x4& v1) { u32x4 w; w.x = cvt_pk_bf16(v0[0], v0[1]); w.y = cvt_pk_bf16(v0[2], v0[3]); w.z = cvt_pk_bf16(v1[0], v1[1]); w.w = cvt_pk_bf16(v1[2], v1[3]); return w; }
__device__ __forceinline__ float sigm(float x) { return __builtin_amdgcn_rcpf(1.0f + __expf(-x)); }
__device__ __forceinline__ f32x4 sigm4(f32x4 v) { return (f32x4){sigm(v[0]), sigm(v[1]), sigm(v[2]), sigm(v[3])}; }
__device__ __forceinline__ void unpk8(const u32x4& w, f32x4& a, f32x4& b) {
    a = (f32x4){__builtin_bit_cast(float, w.x << 16), __builtin_bit_cast(float, w.x & 0xffff0000u), __builtin_bit_cast(float, w.y << 16), __builtin_bit_cast(float, w.y & 0xffff0000u)};
    b = (f32x4){__builtin_bit_cast(float, w.z << 16), __builtin_bit_cast(float, w.z & 0xffff0000u), __builtin_bit_cast(float, w.w << 16), __builtin_bit_cast(float, w.w & 0xffff0000u)};
}

struct EpiProj {
    static constexpr bool PERM = true, AFTER_DRAIN = false;
    bf16_t* pda; bf16_t* prw; bf16_t* gates;
    __device__ __forceinline__ void operator()(const f32x4 (&acc)[2][2][4][2], const Unit& u, int wr, int wc, int fr, int fq) const {
        bf16_t* base; int ldc, colt; bool sg = false;
        if (u.pn < 12) { base = pda; ldc = 3072; colt = u.pn * 256; }
        else if (u.pn < 26) { base = prw; ldc = 3584; colt = (u.pn - 12) * 256; }
        else { base = gates; ldc = 4096; colt = (u.pn - 26) * 256; sg = true; }
        const int row0 = u.pm * BM + wr * 64 + fr, col0 = colt + wc * 32 + 8 * fq;
#pragma unroll
        for (int ai = 0; ai < 2; ++ai)
#pragma unroll
            for (int m = 0; m < 4; ++m) { bf16_t* rowp = base + (size_t)(row0 + ai * HALF + m * 16) * ldc + col0;
#pragma unroll
                for (int bj = 0; bj < 2; ++bj) { f32x4 v0 = acc[ai][bj][m][0], v1 = acc[ai][bj][m][1];
                    if (sg) { v0 = sigm4(v0); v1 = sigm4(v1); }
                    *(u32x4*)(rowp + bj * HALF) = pack_bf16x8(v0, v1); } }
    }
};
template <int KIND> struct EpiLora {
    static constexpr bool PERM = true, AFTER_DRAIN = false;
    bf16_t* out; const float* bias4;
    __device__ __forceinline__ void operator()(const f32x4 (&acc)[2][2][4][2], const Unit& u, int wr, int wc, int fr, int fq) const {
        const int seg = (KIND == 0) ? (u.pn >> 2) : 4, colt = (KIND == 0) ? (u.pn & 3) * 256 : u.pn * 256;
        bf16_t* base = out + (size_t)seg * ((size_t)M * 1024);
        const float* bias = bias4 + (seg & 3) * 1024;
        const int row0 = u.pm * BM + wr * 64 + fr, col0 = colt + wc * 32 + 8 * fq;
        const float sc = (seg < 2) ? -0.60653065971f : 1.0f;
#pragma unroll
        for (int bj = 0; bj < 2; ++bj) {
            f32x4 bv0 = (f32x4){0.f, 0.f, 0.f, 0.f}, bv1 = bv0;
            if (KIND == 0) { bv0 = *(const f32x4*)(bias + col0 + bj * HALF); bv1 = *(const f32x4*)(bias + col0 + bj * HALF + 4); }
#pragma unroll
            for (int ai = 0; ai < 2; ++ai)
#pragma unroll
                for (int m = 0; m < 4; ++m) { bf16_t* rowp = base + (size_t)(row0 + ai * HALF + m * 16) * 1024 + col0;
                    f32x4 v0 = acc[ai][bj][m][0] + bv0, v1 = acc[ai][bj][m][1] + bv1;
                    if (KIND == 0) { v0 = sigm4(v0) * sc; v1 = sigm4(v1) * sc; }
                    *(u32x4*)(rowp + bj * HALF) = pack_bf16x8(v0, v1); }
        }
    }
};
template <int STEP> struct EpiMerge {
    static constexpr bool PERM = true, AFTER_DRAIN = false;
    bf16_t* merged; const bf16_t* gates;
    __device__ __forceinline__ void operator()(const f32x4 (&acc)[2][2][4][2], const Unit& u, int wr, int wc, int fr, int fq) const {
        const int row0 = u.pm * BM + wr * 64 + fr, col0 = u.pn * 256 + wc * 32 + 8 * fq;
#pragma unroll
        for (int ai = 0; ai < 2; ++ai) {
            u32x4 gw[4][2], ow[4][2];
#pragma unroll
            for (int m = 0; m < 4; ++m)
#pragma unroll
                for (int bj = 0; bj < 2; ++bj) { const size_t r = (size_t)(row0 + ai * HALF + m * 16);
                    gw[m][bj] = *(const u32x4*)(gates + r * 4096 + STEP * 2048 + col0 + bj * HALF);
                    if (STEP == 1) ow[m][bj] = *(const u32x4*)(merged + r * 2048 + col0 + bj * HALF); }
#pragma unroll
            for (int m = 0; m < 4; ++m)
#pragma unroll
                for (int bj = 0; bj < 2; ++bj) { const size_t r = (size_t)(row0 + ai * HALF + m * 16);
                    f32x4 g0, g1; unpk8(gw[m][bj], g0, g1);
                    f32x4 v0 = acc[ai][bj][m][0] * g0, v1 = acc[ai][bj][m][1] * g1;
                    if (STEP == 1) { f32x4 o0, o1; unpk8(ow[m][bj], o0, o1); v0 += o0; v1 += o1; }
                    *(u32x4*)(merged + r * 2048 + col0 + bj * HALF) = pack_bf16x8(v0, v1); }
        }
    }
};
struct EpiOut {
    static constexpr bool PERM = false, AFTER_DRAIN = false;
    const float* x; float* out; float* ss;
    __device__ __forceinline__ void operator()(const f32x4 (&acc)[2][2][4][2], const Unit& u, int wr, int wc, int fr, int fq) const {
        const int row0 = u.pm * BM + wr * 64 + fr, col0 = u.pn * 256 + wc * 32 + 4 * fq;
#pragma unroll
        for (int ai = 0; ai < 2; ++ai) {
            f32x4 xv[4][2][2];
#pragma unroll
            for (int m = 0; m < 4; ++m)
#pragma unroll
                for (int bj = 0; bj < 2; ++bj)
#pragma unroll
                    for (int n = 0; n < 2; ++n) xv[m][bj][n] = *(const f32x4*)(x + (size_t)(row0 + ai * HALF + m * 16) * 2048 + col0 + bj * HALF + n * 16);
#pragma unroll
            for (int m = 0; m < 4; ++m) { const size_t r = (size_t)(row0 + ai * HALF + m * 16); float s = 0.f;
#pragma unroll
                for (int bj = 0; bj < 2; ++bj)
#pragma unroll
                    for (int n = 0; n < 2; ++n) { const f32x4 h = xv[m][bj][n] + acc[ai][bj][m][n]; *(f32x4*)(out + r * 2048 + col0 + bj * HALF + n * 16) = h;
                        s += (h[0] * h[0] + h[1] * h[1]) + (h[2] * h[2] + h[3] * h[3]); }
                s += __shfl_xor(s, 16); s += __shfl_xor(s, 32);
                if (fq == 0) ss[r * 32 + u.pn * 4 + wc] = s; }
        }
    }
};
struct EpiMoeUp {
    static constexpr bool PERM = true, AFTER_DRAIN = false;
    bf16_t* hid;
    __device__ __forceinline__ void operator()(const f32x4 (&acc)[2][2][4][2], const Unit& u, int wr, int wc, int fr, int fq) const {
        const int row0 = u.pm * BM + wr * 64 + fr, col0 = (u.pn & 7) * 128 + wc * 32 + 8 * fq;
#pragma unroll
        for (int ai = 0; ai < 2; ++ai)
#pragma unroll
            for (int m = 0; m < 4; ++m) { bf16_t* rowp = hid + (size_t)(row0 + ai * HALF + m * 16) * 1024 + col0;
                const f32x4 g0 = acc[ai][0][m][0], g1 = acc[ai][0][m][1], u0 = acc[ai][1][m][0], u1 = acc[ai][1][m][1];
                const f32x4 v0 = g0 * sigm4(g0) * u0, v1 = g1 * sigm4(g1) * u1;
                *(u32x4*)rowp = pack_bf16x8(v0, v1); }
    }
};
struct EpiMoeDown {
    static constexpr bool PERM = true, AFTER_DRAIN = false;
    bf16_t* ye; const float* selgate;
    __device__ __forceinline__ void operator()(const f32x4 (&acc)[2][2][4][2], const Unit& u, int wr, int wc, int fr, int fq) const {
        const int row0 = u.pm * BM + wr * 64 + fr, col0 = (u.pn & 7) * 256 + wc * 32 + 8 * fq;
#pragma unroll
        for (int ai = 0; ai < 2; ++ai)
#pragma unroll
            for (int m = 0; m < 4; ++m) { const int r = row0 + ai * HALF + m * 16; const int e = r >> 11, b = (r >> 9) & 3, c = r & 511;
                const float g = selgate[(b * 16 + e) * 512 + c];
                bf16_t* rowp = ye + (size_t)r * 2048 + col0;
#pragma unroll
                for (int bj = 0; bj < 2; ++bj) *(u32x4*)(rowp + bj * HALF) = pack_bf16x8(acc[ai][bj][m][0] * g, acc[ai][bj][m][1] * g); }
    }
};
struct ExpertOrder {
    int G, c;
    __device__ __forceinline__ bool next(int i, Unit& u) const {
        const int L = i * G + c; if (L >= 1024) return false;
        const int wgid = (L % NXCD) * (1024 / NXCD) + L / NXCD;
        const int e = wgid >> 6, r = wgid & 63; u.pm = e * 8 + (r & 3) + 4 * ((r >> 5) & 1); u.pn = e * 8 + ((r >> 2) & 7); return true;
    }
    __device__ __forceinline__ void a_ready(const Unit&) const {}
    __device__ __forceinline__ void done(const Unit&) const {}
};

struct ExpertGatherOrder {
    int G, c; const int* seltok;
    __device__ __forceinline__ bool next(int i, Unit& u) const {
        const int L = i * G + c; if (L >= 1024) return false;
        const int wgid = (L % NXCD) * (1024 / NXCD) + L / NXCD;
        const int e = wgid >> 6, r = wgid & 63; u.pm = e * 8 + (r & 3) + 4 * ((r >> 5) & 1); u.pn = e * 8 + ((r >> 2) & 7); return true;
    }
    __device__ __forceinline__ int arow(int r) const { const int e = r >> 11, b = (r >> 9) & 3, cc = r & 511; return b * 4096 + seltok[(b * 16 + e) * 512 + cc]; }
    __device__ __forceinline__ void a_ready(const Unit&) const {}
    __device__ __forceinline__ void done(const Unit&) const {}
};
template <class Epi, class Sched, bool ALIGN_EPI = false, bool SP2 = false>
__device__ __forceinline__ void gemm_phase(PG8_LAS unsigned char* lds, const Gemm g, const Sched& S, const Epi& E) {
    const int tid = fresh_tid(), wid = __builtin_amdgcn_readfirstlane(tid >> 6), lane = tid & 63, wr = wid >> 2, wc = wid & 3, fr = lane & 15, fq = lane >> 4;
    const int K = g.K, nt = K / BK;
    unsigned voffA[2], voffB[2];
#pragma unroll
    for (int i = 0; i < 2; ++i) { int R, C; stage_rc(tid * 16 + i * 8192, R, C); const int Rb = Epi::PERM ? ((R & ~31) + perm32(R & 31)) : R;
        voffA[i] = (unsigned)(R * g.lda + C) * 2u; voffB[i] = (unsigned)(Rb * g.ldb + C) * 2u; }
    const size_t kstep = (size_t)(BK * 2);
    const size_t hsA = (size_t)HALF * g.lda * 2, hsB = (size_t)HALF * g.ldb * 2;
    const size_t tsA = 2 * hsA, tsB = 2 * hsB;
    const unsigned ldsw = (unsigned)wid * 1024u;
    const int aoff = lds_byte(wr * 64 + fr, fq * 8), boff = lds_byte(wc * 32 + fr, fq * 8);
#define PG8_SA(b, h) (((b) * 2 + (h)) * HTB)
#define PG8_SB(b, h) ((4 + (b) * 2 + (h)) * HTB)
#define PG8_STAGE(bufoff, gbase, voff) do { _Pragma("unroll") for (int _i = 0; _i < 2; ++_i) \
        __builtin_amdgcn_global_load_lds((const unsigned*)((const char*)(gbase) + (voff)[_i]), (PG8_LAS unsigned*)(lds + (bufoff) + ldsw + _i * 8192), 16, 0, 0); } while (0)
#define PG8_LDA(dst, b, h) do { _Pragma("unroll") for (int m = 0; m < 4; ++m) _Pragma("unroll") for (int k = 0; k < 2; ++k) dst[m][k] = *(const PG8_LAS bf16x8*)(lds + PG8_SA(b, h) + aoff + m * 2048 + k * 1024); } while (0)
#define PG8_LDB(dst, b, h) do { _Pragma("unroll") for (int n = 0; n < 2; ++n) _Pragma("unroll") for (int k = 0; k < 2; ++k) dst[n][k] = *(const PG8_LAS bf16x8*)(lds + PG8_SB(b, h) + boff + n * 2048 + k * 1024); } while (0)
#define PG8_MMA(ai, bj, At, Bt) do { __builtin_amdgcn_s_setprio(1); _Pragma("unroll") for (int m = 0; m < 4; ++m) _Pragma("unroll") for (int n = 0; n < 2; ++n) _Pragma("unroll") for (int k = 0; k < 2; ++k) \
        acc[ai][bj][m][n] = __builtin_amdgcn_mfma_f32_16x16x32_bf16(Bt[n][k], At[m][k], acc[ai][bj][m][n], 0, 0, 0); __builtin_amdgcn_s_setprio(0); } while (0)
#define PG8_WAIT_V(n) asm volatile("s_waitcnt vmcnt(" #n ")" ::: "memory")
#define PG8_WAIT_L(n) asm volatile("s_waitcnt lgkmcnt(" #n ")" ::: "memory")
#define PG8_BAR __builtin_amdgcn_s_barrier()
#define PG8_SCHED __builtin_amdgcn_sched_barrier(0)
    Unit cur, nxt; int ui = 0;
    if (!S.next(0, cur)) return;
    f32x4 acc[2][2][4][2];
#pragma unroll
    for (int a = 0; a < 2; ++a)
#pragma unroll
        for (int b = 0; b < 2; ++b)
#pragma unroll
            for (int m = 0; m < 4; ++m)
#pragma unroll
                for (int n = 0; n < 2; ++n) acc[a][b][m][n] = (f32x4){0.f, 0.f, 0.f, 0.f};
    bf16x8 At[4][2], B0[2][2], B1[2][2];
    const char* cA = (const char*)g.A + (size_t)cur.pm * tsA; const char* cB = (const char*)g.Bt + (size_t)cur.pn * tsB;
    S.a_ready(cur);
    if constexpr (SP2) {
        PG8_STAGE(PG8_SB(0, 0), cB, voffB); PG8_STAGE(PG8_SB(0, 1), cB + hsB, voffB); PG8_STAGE(PG8_SA(0, 0), cA, voffA); PG8_STAGE(PG8_SA(0, 1), cA + hsA, voffA);
        if (wr == 1) PG8_BAR;
        PG8_WAIT_V(2); PG8_BAR;
        PG8_STAGE(PG8_SB(1, 0), cB + kstep, voffB); PG8_STAGE(PG8_SA(1, 0), cA + kstep, voffA); PG8_STAGE(PG8_SB(1, 1), cB + hsB + kstep, voffB);
        PG8_WAIT_V(6); PG8_BAR;
    } else {
        PG8_STAGE(PG8_SB(0, 0), cB, voffB); PG8_STAGE(PG8_SA(0, 0), cA, voffA); PG8_STAGE(PG8_SB(0, 1), cB + hsB, voffB); PG8_STAGE(PG8_SA(0, 1), cA + hsA, voffA);
        if (wr == 1) PG8_BAR;
        PG8_WAIT_V(4); PG8_BAR;
        PG8_STAGE(PG8_SB(1, 0), cB + kstep, voffB); PG8_STAGE(PG8_SA(1, 0), cA + kstep, voffA); PG8_STAGE(PG8_SB(1, 1), cB + hsB + kstep, voffB);
        PG8_WAIT_V(6); PG8_BAR;
    }
    for (;;) {
        const bool has_next = S.next(ui + 1, nxt);
        const char* nA = has_next ? (const char*)g.A + (size_t)nxt.pm * tsA : cA; const char* nB = has_next ? (const char*)g.Bt + (size_t)nxt.pn * tsB : cB;
#pragma unroll 1
        for (int t = 0; t < nt; t += 2) {
            const bool last = (t == nt - 2);
            const char* a1 = cA + (size_t)(t + 1) * kstep;
            const char* a2 = last ? nA : cA + (size_t)(t + 2) * kstep; const char* b2 = last ? nB : cB + (size_t)(t + 2) * kstep;
            const char* a3 = a2 + kstep; const char* b3 = b2 + kstep;
            if (last && has_next) S.a_ready(nxt);
            if constexpr (SP2) {
            PG8_LDB(B0, 0, 0); PG8_LDB(B1, 0, 1); PG8_SCHED; PG8_LDA(At, 0, 0); PG8_STAGE(PG8_SA(1, 1), a1 + hsA, voffA);
            PG8_WAIT_V(8); PG8_WAIT_L(0); PG8_BAR; PG8_MMA(0, 0, At, B0); PG8_MMA(0, 1, At, B1); PG8_BAR; PG8_SCHED;
            PG8_LDA(At, 0, 1); PG8_STAGE(PG8_SB(0, 0), b2, voffB); PG8_STAGE(PG8_SB(0, 1), b2 + hsB, voffB); PG8_STAGE(PG8_SA(0, 0), a2, voffA);
            PG8_WAIT_V(8); PG8_WAIT_L(0); PG8_BAR; PG8_MMA(1, 0, At, B0); PG8_MMA(1, 1, At, B1); PG8_BAR; PG8_SCHED;
            PG8_LDB(B0, 1, 0); PG8_LDB(B1, 1, 1); PG8_SCHED; PG8_LDA(At, 1, 0); PG8_STAGE(PG8_SA(0, 1), a2 + hsA, voffA);
            PG8_WAIT_V(8); PG8_WAIT_L(0); PG8_BAR; PG8_MMA(0, 0, At, B0); PG8_MMA(0, 1, At, B1); PG8_BAR; PG8_SCHED;
            PG8_LDA(At, 1, 1); PG8_STAGE(PG8_SB(1, 0), b3, voffB); PG8_STAGE(PG8_SB(1, 1), b3 + hsB, voffB); PG8_STAGE(PG8_SA(1, 0), a3, voffA);
            PG8_WAIT_V(8); PG8_WAIT_L(0); PG8_BAR; PG8_MMA(1, 0, At, B0); PG8_MMA(1, 1, At, B1); PG8_BAR; PG8_SCHED;
            } else {
            PG8_LDB(B0, 0, 0); PG8_SCHED; PG8_LDA(At, 0, 0); PG8_STAGE(PG8_SA(1, 1), a1 + hsA, voffA);
            PG8_WAIT_L(8); PG8_BAR; PG8_WAIT_L(0); PG8_MMA(0, 0, At, B0); PG8_BAR; PG8_SCHED;
            PG8_LDB(B1, 0, 1); PG8_STAGE(PG8_SB(0, 0), b2, voffB);
            PG8_BAR; PG8_WAIT_L(0); PG8_MMA(0, 1, At, B1); PG8_BAR;
            PG8_LDA(At, 0, 1); PG8_STAGE(PG8_SA(0, 0), a2, voffA);
            PG8_BAR; PG8_WAIT_L(0); PG8_MMA(1, 0, At, B0); PG8_BAR; PG8_SCHED;
            PG8_STAGE(PG8_SB(0, 1), b2 + hsB, voffB);
            PG8_WAIT_V(6); PG8_BAR; PG8_MMA(1, 1, At, B1); PG8_BAR;
            PG8_LDB(B0, 1, 0); PG8_SCHED; PG8_LDA(At, 1, 0); PG8_STAGE(PG8_SA(0, 1), a2 + hsA, voffA);
            PG8_WAIT_L(8); PG8_BAR; PG8_WAIT_L(0); PG8_MMA(0, 0, At, B0); PG8_BAR; PG8_SCHED;
            PG8_LDB(B1, 1, 1); PG8_STAGE(PG8_SB(1, 0), b3, voffB);
            PG8_BAR; PG8_WAIT_L(0); PG8_MMA(0, 1, At, B1); PG8_BAR;
            PG8_LDA(At, 1, 1); PG8_STAGE(PG8_SA(1, 0), a3, voffA);
            PG8_BAR; PG8_WAIT_L(0); PG8_MMA(1, 0, At, B0); PG8_BAR; PG8_SCHED;
            PG8_STAGE(PG8_SB(1, 1), b3 + hsB, voffB);
            PG8_WAIT_V(6); PG8_BAR; PG8_MMA(1, 1, At, B1); PG8_BAR;
            }
        }
        if constexpr (ALIGN_EPI) { if (wr == 0) PG8_BAR; }
        if constexpr (!Epi::AFTER_DRAIN) { E(acc, cur, wr, wc, fr, fq); S.done(cur); }
        if (!has_next) break;
#pragma unroll
        for (int a = 0; a < 2; ++a)
#pragma unroll
            for (int b = 0; b < 2; ++b)
#pragma unroll
                for (int m = 0; m < 4; ++m)
#pragma unroll
                    for (int n = 0; n < 2; ++n) acc[a][b][m][n] = (f32x4){0.f, 0.f, 0.f, 0.f};
        cur = nxt; cA = nA; cB = nB; ++ui;
        if constexpr (ALIGN_EPI) { if (wr == 1) PG8_BAR; }
    }
    PG8_WAIT_V(0);
    if constexpr (!ALIGN_EPI) { if (wr == 0) PG8_BAR; }
    PG8_BAR;
    if constexpr (Epi::AFTER_DRAIN) { E.fused(acc, cur, wr, wc, fr, fq, lds, wid, lane); S.done(cur); }
#undef PG8_SA
#undef PG8_SB
#undef PG8_STAGE
#undef PG8_LDA
#undef PG8_LDB
#undef PG8_MMA
#undef PG8_WAIT_V
#undef PG8_WAIT_L
#undef PG8_BAR
#undef PG8_SCHED
}

template <class Epi, class Sched, bool ALIGN_EPI = false, bool SP2 = false>
__device__ __forceinline__ void gemm_phase_g(PG8_LAS unsigned char* lds, const Gemm g, const Sched& S, const Epi& E) {
    const int tid = fresh_tid(), wid = __builtin_amdgcn_readfirstlane(tid >> 6), lane = tid & 63, wr = wid >> 2, wc = wid & 3, fr = lane & 15, fq = lane >> 4;
    const int K = g.K, nt = K / BK;
    unsigned voffB[2]; int RAr[2]; unsigned CAb[2];
#pragma unroll
    for (int i = 0; i < 2; ++i) { int R, C; stage_rc(tid * 16 + i * 8192, R, C); const int Rb = Epi::PERM ? ((R & ~31) + perm32(R & 31)) : R;
        RAr[i] = R; CAb[i] = (unsigned)C * 2u; voffB[i] = (unsigned)(Rb * g.ldb + C) * 2u; }
    const size_t kstep = (size_t)(BK * 2);
    const size_t hsA = (size_t)HALF * g.lda * 2, hsB = (size_t)HALF * g.ldb * 2;
    const size_t tsA = 2 * hsA, tsB = 2 * hsB;
    const unsigned ldsw = (unsigned)wid * 1024u;
    const int aoff = lds_byte(wr * 64 + fr, fq * 8), boff = lds_byte(wc * 32 + fr, fq * 8);
#define PG8_SA(b, h) (((b) * 2 + (h)) * HTB)
#define PG8_SB(b, h) ((4 + (b) * 2 + (h)) * HTB)
#define PG8_STAGE(bufoff, gbase, voff) do { _Pragma("unroll") for (int _i = 0; _i < 2; ++_i) \
        __builtin_amdgcn_global_load_lds((const unsigned*)((const char*)(gbase) + (voff)[_i]), (PG8_LAS unsigned*)(lds + (bufoff) + ldsw + _i * 8192), 16, 0, 0); } while (0)
#define PG8_LDA(dst, b, h) do { _Pragma("unroll") for (int m = 0; m < 4; ++m) _Pragma("unroll") for (int k = 0; k < 2; ++k) dst[m][k] = *(const PG8_LAS bf16x8*)(lds + PG8_SA(b, h) + aoff + m * 2048 + k * 1024); } while (0)
#define PG8_LDB(dst, b, h) do { _Pragma("unroll") for (int n = 0; n < 2; ++n) _Pragma("unroll") for (int k = 0; k < 2; ++k) dst[n][k] = *(const PG8_LAS bf16x8*)(lds + PG8_SB(b, h) + boff + n * 2048 + k * 1024); } while (0)
#define PG8_MMA(ai, bj, At, Bt) do { __builtin_amdgcn_s_setprio(1); _Pragma("unroll") for (int m = 0; m < 4; ++m) _Pragma("unroll") for (int n = 0; n < 2; ++n) _Pragma("unroll") for (int k = 0; k < 2; ++k) \
        acc[ai][bj][m][n] = __builtin_amdgcn_mfma_f32_16x16x32_bf16(Bt[n][k], At[m][k], acc[ai][bj][m][n], 0, 0, 0); __builtin_amdgcn_s_setprio(0); } while (0)
#define PG8_WAIT_V(n) asm volatile("s_waitcnt vmcnt(" #n ")" ::: "memory")
#define PG8_WAIT_L(n) asm volatile("s_waitcnt lgkmcnt(" #n ")" ::: "memory")
#define PG8_BAR __builtin_amdgcn_s_barrier()
#define PG8_SCHED __builtin_amdgcn_sched_barrier(0)
    Unit cur, nxt; int ui = 0;
    if (!S.next(0, cur)) return;
    f32x4 acc[2][2][4][2];
#pragma unroll
    for (int a = 0; a < 2; ++a)
#pragma unroll
        for (int b = 0; b < 2; ++b)
#pragma unroll
            for (int m = 0; m < 4; ++m)
#pragma unroll
                for (int n = 0; n < 2; ++n) acc[a][b][m][n] = (f32x4){0.f, 0.f, 0.f, 0.f};
    bf16x8 At[4][2], B0[2][2], B1[2][2];
    unsigned vAll[4][2][2];
#pragma unroll
    for (int q = 0; q < 4; ++q) { Unit uq; const bool ok = S.next(q, uq);
#pragma unroll
        for (int h = 0; h < 2; ++h)
#pragma unroll
            for (int i = 0; i < 2; ++i) vAll[q][h][i] = ok ? (unsigned)S.arow(uq.pm * BM + h * HALF + RAr[i]) * (unsigned)(g.lda * 2) + CAb[i] : 0u; }
#define PG8_PICK(dst, idx) do { _Pragma("unroll") for (int h_ = 0; h_ < 2; ++h_) _Pragma("unroll") for (int i_ = 0; i_ < 2; ++i_) \
        dst[h_][i_] = (idx) == 0 ? vAll[0][h_][i_] : (idx) == 1 ? vAll[1][h_][i_] : (idx) == 2 ? vAll[2][h_][i_] : vAll[3][h_][i_]; } while (0)
    unsigned vA[2][2], vAn[2][2], vS[2][2];
    PG8_PICK(vA, 0);
    const char* A0 = (const char*)g.A; const char* cB = (const char*)g.Bt + (size_t)cur.pn * tsB;
    S.a_ready(cur);
    if constexpr (SP2) {
        PG8_STAGE(PG8_SB(0, 0), cB, voffB); PG8_STAGE(PG8_SB(0, 1), cB + hsB, voffB); PG8_STAGE(PG8_SA(0, 0), A0, vA[0]); PG8_STAGE(PG8_SA(0, 1), A0, vA[1]);
        if (wr == 1) PG8_BAR;
        PG8_WAIT_V(2); PG8_BAR;
        PG8_STAGE(PG8_SB(1, 0), cB + kstep, voffB); PG8_STAGE(PG8_SA(1, 0), A0 + kstep, vA[0]); PG8_STAGE(PG8_SB(1, 1), cB + hsB + kstep, voffB);
        PG8_WAIT_V(6); PG8_BAR;
    } else {
        PG8_STAGE(PG8_SB(0, 0), cB, voffB); PG8_STAGE(PG8_SA(0, 0), A0, vA[0]); PG8_STAGE(PG8_SB(0, 1), cB + hsB, voffB); PG8_STAGE(PG8_SA(0, 1), A0, vA[1]);
        if (wr == 1) PG8_BAR;
        PG8_WAIT_V(4); PG8_BAR;
        PG8_STAGE(PG8_SB(1, 0), cB + kstep, voffB); PG8_STAGE(PG8_SA(1, 0), A0 + kstep, vA[0]); PG8_STAGE(PG8_SB(1, 1), cB + hsB + kstep, voffB);
        PG8_WAIT_V(6); PG8_BAR;
    }
    for (;;) {
        const bool has_next = S.next(ui + 1, nxt);
        const char* nB = has_next ? (const char*)g.Bt + (size_t)nxt.pn * tsB : cB;
        if (has_next) { PG8_PICK(vAn, ui + 1); } else { PG8_PICK(vAn, ui); }
#pragma unroll 1
        for (int t = 0; t < nt; t += 2) {
            const bool last = (t == nt - 2);
            const char* a1 = A0 + (size_t)(t + 1) * kstep;
            const char* a2 = last ? A0 : A0 + (size_t)(t + 2) * kstep; const char* b2 = last ? nB : cB + (size_t)(t + 2) * kstep;
#pragma unroll
            for (int h_ = 0; h_ < 2; ++h_)
#pragma unroll
                for (int i_ = 0; i_ < 2; ++i_) vS[h_][i_] = last ? vAn[h_][i_] : vA[h_][i_];
            const char* a3 = a2 + kstep; const char* b3 = b2 + kstep;
            if (last && has_next) S.a_ready(nxt);
            if constexpr (SP2) {
            PG8_LDB(B0, 0, 0); PG8_LDB(B1, 0, 1); PG8_SCHED; PG8_LDA(At, 0, 0); PG8_STAGE(PG8_SA(1, 1), a1, vA[1]);
            PG8_WAIT_V(8); PG8_WAIT_L(0); PG8_BAR; PG8_MMA(0, 0, At, B0); PG8_MMA(0, 1, At, B1); PG8_BAR; PG8_SCHED;
            PG8_LDA(At, 0, 1); PG8_STAGE(PG8_SB(0, 0), b2, voffB); PG8_STAGE(PG8_SB(0, 1), b2 + hsB, voffB); PG8_STAGE(PG8_SA(0, 0), a2, vS[0]);
            PG8_WAIT_V(8); PG8_WAIT_L(0); PG8_BAR; PG8_MMA(1, 0, At, B0); PG8_MMA(1, 1, At, B1); PG8_BAR; PG8_SCHED;
            PG8_LDB(B0, 1, 0); PG8_LDB(B1, 1, 1); PG8_SCHED; PG8_LDA(At, 1, 0); PG8_STAGE(PG8_SA(0, 1), a2, vS[1]);
            PG8_WAIT_V(8); PG8_WAIT_L(0); PG8_BAR; PG8_MMA(0, 0, At, B0); PG8_MMA(0, 1, At, B1); PG8_BAR; PG8_SCHED;
            PG8_LDA(At, 1, 1); PG8_STAGE(PG8_SB(1, 0), b3, voffB); PG8_STAGE(PG8_SB(1, 1), b3 + hsB, voffB); PG8_STAGE(PG8_SA(1, 0), a3, vS[0]);
            PG8_WAIT_V(8); PG8_WAIT_L(0); PG8_BAR; PG8_MMA(1, 0, At, B0); PG8_MMA(1, 1, At, B1); PG8_BAR; PG8_SCHED;
            } else {
            PG8_LDB(B0, 0, 0); PG8_SCHED; PG8_LDA(At, 0, 0); PG8_STAGE(PG8_SA(1, 1), a1, vA[1]);
            PG8_WAIT_L(8); PG8_BAR; PG8_WAIT_L(0); PG8_MMA(0, 0, At, B0); PG8_BAR; PG8_SCHED;
            PG8_LDB(B1, 0, 1); PG8_STAGE(PG8_SB(0, 0), b2, voffB);
            PG8_BAR; PG8_WAIT_L(0); PG8_MMA(0, 1, At, B1); PG8_BAR;
            PG8_LDA(At, 0, 1); PG8_STAGE(PG8_SA(0, 0), a2, vS[0]);
            PG8_BAR; PG8_WAIT_L(0); PG8_MMA(1, 0, At, B0); PG8_BAR; PG8_SCHED;
            PG8_STAGE(PG8_SB(0, 1), b2 + hsB, voffB);
            PG8_WAIT_V(6); PG8_BAR; PG8_MMA(1, 1, At, B1); PG8_BAR;
            PG8_LDB(B0, 1, 0); PG8_SCHED; PG8_LDA(At, 1, 0); PG8_STAGE(PG8_SA(0, 1), a2, vS[1]);
            PG8_WAIT_L(8); PG8_BAR; PG8_WAIT_L(0); PG8_MMA(0, 0, At, B0); PG8_BAR; PG8_SCHED;
            PG8_LDB(B1, 1, 1); PG8_STAGE(PG8_SB(1, 0), b3, voffB);
            PG8_BAR; PG8_WAIT_L(0); PG8_MMA(0, 1, At, B1); PG8_BAR;
            PG8_LDA(At, 1, 1); PG8_STAGE(PG8_SA(1, 0), a3, vS[0]);
            PG8_BAR; PG8_WAIT_L(0); PG8_MMA(1, 0, At, B0); PG8_BAR; PG8_SCHED;
            PG8_STAGE(PG8_SB(1, 1), b3 + hsB, voffB);
            PG8_WAIT_V(6); PG8_BAR; PG8_MMA(1, 1, At, B1); PG8_BAR;
            }
        }
        if constexpr (ALIGN_EPI) { if (wr == 0) PG8_BAR; }
        if constexpr (!Epi::AFTER_DRAIN) { E(acc, cur, wr, wc, fr, fq); S.done(cur); }
        if (!has_next) break;
#pragma unroll
        for (int a = 0; a < 2; ++a)
#pragma unroll
            for (int b = 0; b < 2; ++b)
#pragma unroll
                for (int m = 0; m < 4; ++m)
#pragma unroll
                    for (int n = 0; n < 2; ++n) acc[a][b][m][n] = (f32x4){0.f, 0.f, 0.f, 0.f};
        cur = nxt; cB = nB; ++ui;
#pragma unroll
        for (int h_ = 0; h_ < 2; ++h_)
#pragma unroll
            for (int i_ = 0; i_ < 2; ++i_) vA[h_][i_] = vAn[h_][i_];
        if constexpr (ALIGN_EPI) { if (wr == 1) PG8_BAR; }
    }
    PG8_WAIT_V(0);
    if constexpr (!ALIGN_EPI) { if (wr == 0) PG8_BAR; }
    PG8_BAR;
    if constexpr (Epi::AFTER_DRAIN) { E.fused(acc, cur, wr, wc, fr, fq, lds, wid, lane); S.done(cur); }
#undef PG8_SA
#undef PG8_SB
#undef PG8_STAGE
#undef PG8_LDA
#undef PG8_LDB
#undef PG8_MMA
#undef PG8_WAIT_V
#undef PG8_WAIT_L
#undef PG8_BAR
#undef PG8_SCHED
#undef PG8_PICK
}


}

namespace attn {
using bf16x8 = __attribute__((ext_vector_type(8))) short;
using s16x4  = __attribute__((ext_vector_type(4))) short;
using f32x16 = __attribute__((ext_vector_type(16))) float;
using u32x4  = __attribute__((ext_vector_type(4))) unsigned;
constexpr int QBLK = 32, KVBLK = 64, LDQ = 3072;
constexpr float SCALE = 0.125f, QSCALE = 0.125f * 1.4426950408889634f;
constexpr size_t SHM_V = KVBLK * 128 * 2, SHM_K = KVBLK * 128 * 2, SHM_ATTN = 2 * SHM_V + 2 * SHM_K + 8 * 64 * 4;
#define KSWZ(row, colB) ((row) * 256 + ((colB) ^ (((row) & 7) << 4)))
#define SBAR() __builtin_amdgcn_sched_barrier(0)
__device__ __forceinline__ int crow(int r, int hi) { return (r & 3) + 8 * (r >> 2) + 4 * hi; }
__device__ __forceinline__ unsigned cvtpk(float lo, float hi) { return pk2(lo, hi); }
__device__ __forceinline__ bf16x8 ld8(const bf16_t* p) { return *reinterpret_cast<const bf16x8*>(p); }

__device__ __forceinline__ void partialSM(f32x16& p0, f32x16& p1) {
  for (int r = 0; r < 16; ++r) p0[r] = __builtin_amdgcn_exp2f(p0[r]);
}
__device__ __forceinline__ void finishSM(f32x16& p0, f32x16& p1, float& l_reg, bf16x8& pa0, bf16x8& pa1, bf16x8& pa2, bf16x8& pa3) {
  for (int r = 0; r < 16; ++r) p1[r] = __builtin_amdgcn_exp2f(p1[r]);
  float ps = 0; for (int r = 0; r < 16; ++r) ps += p0[r]; for (int r = 0; r < 16; ++r) ps += p1[r];
  l_reg += ps;
#define PK4(P, BASE, OUT) do { unsigned a0 = cvtpk(P[BASE + 0], P[BASE + 1]), a1 = cvtpk(P[BASE + 2], P[BASE + 3]);   \
    unsigned b0 = cvtpk(P[BASE + 4], P[BASE + 5]), b1 = cvtpk(P[BASE + 6], P[BASE + 7]);                              \
    auto r0 = __builtin_amdgcn_permlane32_swap(a0, b0, false, false); auto r1 = __builtin_amdgcn_permlane32_swap(a1, b1, false, false); \
    u32x4 w = {r0[0], r1[0], r0[1], r1[1]}; OUT = *reinterpret_cast<bf16x8*>(&w); } while (0)
  PK4(p0, 0, pa0); PK4(p0, 8, pa1); PK4(p1, 0, pa2); PK4(p1, 8, pa3);
#undef PK4
}
__device__ __forceinline__ void qkt(f32x16& p0, f32x16& p1, const bf16_t* Ks, const bf16x8* qr, int r32, int hi, int sub) {
  p0 = f32x16{}; p1 = f32x16{};
#pragma unroll
  for (int d0 = 0; d0 < 4; ++d0) { int cb = (sub * 64 + d0 * 16 + hi * 8) * 2;
    bf16x8 b0 = *reinterpret_cast<const bf16x8*>((const char*)Ks + KSWZ(r32, cb));
    bf16x8 b1 = *reinterpret_cast<const bf16x8*>((const char*)Ks + KSWZ(32 + r32, cb));
    p0 = __builtin_amdgcn_mfma_f32_32x32x16_bf16(b0, qr[d0], p0, 0, 0, 0);
    p1 = __builtin_amdgcn_mfma_f32_32x32x16_bf16(b1, qr[d0], p1, 0, 0, 0); }
}
__device__ __forceinline__ int v_st(int k, int c) { const int kk = (k & ~0xC) | ((k & 4) << 1) | ((k & 8) >> 1); return ((kk >> 3) * 4 + (c >> 5)) * 512 + ((kk & 7) * 32 + (c & 31)) * 2; }
__device__ __forceinline__ int v_rd_base(int lane) { return ((lane & 3) << 3) | (((lane >> 2) & 3) << 6) | (((lane >> 4) & 1) << 5) | (((lane >> 5) & 1) << 8); }
constexpr int v_rd_off(int d0, int ks, int half) { return d0 * 512 + ks * 4096 + half * 2048; }
template <int OFF> __device__ __forceinline__ s16x4 tr_read(int vb) {
  s16x4 r; asm volatile("ds_read_b64_tr_b16 %0, %1 offset:%2" : "=&v"(r) : "v"(vb), "i"(OFF) : "memory"); return r;
}
template <int D0> __device__ __forceinline__ void pv_one(f32x16& od, int vb, bf16x8 pa0, bf16x8 pa1, bf16x8 pa2, bf16x8 pa3) {
  const s16x4 l0 = tr_read<v_rd_off(D0, 0, 0)>(vb), h0 = tr_read<v_rd_off(D0, 0, 1)>(vb), l1 = tr_read<v_rd_off(D0, 1, 0)>(vb), h1 = tr_read<v_rd_off(D0, 1, 1)>(vb);
  const s16x4 l2 = tr_read<v_rd_off(D0, 2, 0)>(vb), h2 = tr_read<v_rd_off(D0, 2, 1)>(vb), l3 = tr_read<v_rd_off(D0, 3, 0)>(vb), h3 = tr_read<v_rd_off(D0, 3, 1)>(vb);
  asm volatile("s_waitcnt lgkmcnt(0)" ::: "memory"); SBAR();
#define PK(L, H) (bf16x8){L[0], L[1], L[2], L[3], H[0], H[1], H[2], H[3]}
  od = __builtin_amdgcn_mfma_f32_32x32x16_bf16(pa0, PK(l0, h0), od, 0, 0, 0);
  od = __builtin_amdgcn_mfma_f32_32x32x16_bf16(pa1, PK(l1, h1), od, 0, 0, 0);
  od = __builtin_amdgcn_mfma_f32_32x32x16_bf16(pa2, PK(l2, h2), od, 0, 0, 0);
  od = __builtin_amdgcn_mfma_f32_32x32x16_bf16(pa3, PK(l3, h3), od, 0, 0, 0);
#undef PK
}
__device__ __forceinline__ void pv_d0(f32x16* o, int vb, bf16x8 pa0, bf16x8 pa1, bf16x8 pa2, bf16x8 pa3) {
  pv_one<0>(o[0], vb, pa0, pa1, pa2, pa3); pv_one<1>(o[1], vb, pa0, pa1, pa2, pa3); pv_one<2>(o[2], vb, pa0, pa1, pa2, pa3); pv_one<3>(o[3], vb, pa0, pa1, pa2, pa3);
}

__device__ __forceinline__ void attn_unit(const bf16_t* Qb, const bf16_t* Kh, const bf16_t* Vh, bf16_t* Ya, float lam, const float* subln_g, int seq, char* lds) {
  const int tid = fresh_tid(), wid = __builtin_amdgcn_readfirstlane(tid >> 6), lane = tid & 63, r32 = lane & 31, hi = lane >> 5, sub = wid >> 2, wq = wid & 3;
  bf16_t* V_lds = (bf16_t*)lds; bf16_t* K_lds = (bf16_t*)(lds + 2 * SHM_V);
  float* ws = (float*)(lds + 2 * SHM_V + 2 * SHM_K) + wid * 64; float* li_l = ws;
  float l_reg = 0; f32x16 o[4] = {}; bf16x8 qr[4];
  const bf16_t* Qw = Qb + (long)(wq * QBLK + r32) * LDQ + sub * 64 + hi * 8;
#pragma unroll
  for (int d0 = 0; d0 < 4; ++d0) qr[d0] = ld8(Qw + d0 * 16);
  const int sr = tid >> 4, sc = (tid & 15) * 8, vst0 = v_st(sr, sc), vst1 = v_st(32 + sr, sc);
  const int vb0 = (int)(uintptr_t)V_lds + v_rd_base(lane);
  struct { bf16x8 vs0, vs1, ks0, ks1; } sr_[2];
#define SLOAD(i, k0) do { sr_[i].vs0 = ld8(&Vh[(long)((k0) + sr) * LDQ + sc]); sr_[i].vs1 = ld8(&Vh[(long)((k0) + 32 + sr) * LDQ + sc]); \
    sr_[i].ks0 = ld8(&Kh[(long)((k0) + sr) * LDQ + sc]); sr_[i].ks1 = ld8(&Kh[(long)((k0) + 32 + sr) * LDQ + sc]); } while (0)
#define SWRITE(b, i) do { *(bf16x8*)((char*)V_lds + (b) * SHM_V + vst0) = sr_[i].vs0;          \
    *(bf16x8*)((char*)V_lds + (b) * SHM_V + vst1) = sr_[i].vs1; int kc = sc * 2;               \
    *(bf16x8*)((char*)K_lds + (b) * SHM_K + KSWZ(sr, kc)) = sr_[i].ks0;                       \
    *(bf16x8*)((char*)K_lds + (b) * SHM_K + KSWZ(32 + sr, kc)) = sr_[i].ks1; } while (0)
#define SWAIT() asm volatile("s_waitcnt vmcnt(4)" ::: "memory")
  f32x16 pA0, pA1, pB0, pB1; bf16x8 pa0, pa1, pa2, pa3; const int NT = seq / KVBLK;
  constexpr int SE = 0, SO = 1;
  SLOAD(SE, 0); asm volatile("s_waitcnt vmcnt(0)" ::: "memory"); SWRITE(0, SE); __syncthreads();
  qkt(pA0, pA1, K_lds, qr, r32, hi, sub); partialSM(pA0, pA1);
  SLOAD(SO, KVBLK); if (2 < NT) SLOAD(SE, 2 * KVBLK);
  SWAIT(); SWRITE(1, SO); __syncthreads();
  for (int j = 1; j + 1 < NT; j += 2) {
    SBAR(); qkt(pB0, pB1, (bf16_t*)((char*)K_lds + SHM_K), qr, r32, hi, sub);
    finishSM(pA0, pA1, l_reg, pa0, pa1, pa2, pa3); SBAR();
    SLOAD(SO, (j + 2) * KVBLK); SBAR();
    pv_d0(o, vb0, pa0, pa1, pa2, pa3); partialSM(pB0, pB1);
    __syncthreads(); SWAIT(); SWRITE(0, SE); __syncthreads();
    SBAR(); qkt(pA0, pA1, K_lds, qr, r32, hi, sub);
    finishSM(pB0, pB1, l_reg, pa0, pa1, pa2, pa3); SBAR();
    if (j + 3 < NT) SLOAD(SE, (j + 3) * KVBLK); SBAR();
    pv_d0(o, vb0 + (int)SHM_V, pa0, pa1, pa2, pa3); partialSM(pA0, pA1);
    __syncthreads(); SWAIT(); SWRITE(1, SO); __syncthreads();
  }
  SBAR(); qkt(pB0, pB1, (bf16_t*)((char*)K_lds + SHM_K), qr, r32, hi, sub);
  finishSM(pA0, pA1, l_reg, pa0, pa1, pa2, pa3); SBAR();
  pv_d0(o, vb0, pa0, pa1, pa2, pa3); partialSM(pB0, pB1);
  __syncthreads();
  finishSM(pB0, pB1, l_reg, pa0, pa1, pa2, pa3); SBAR();
  pv_d0(o, vb0 + (int)SHM_V, pa0, pa1, pa2, pa3);
  { auto rr = __builtin_amdgcn_permlane32_swap(__float_as_uint(l_reg), __float_as_uint(l_reg), false, false); l_reg = __uint_as_float(rr[0]) + __uint_as_float(rr[1]); }
  if (hi == 0) li_l[r32] = l_reg; asm volatile("s_waitcnt lgkmcnt(0)" ::: "memory");
  float rli[16];
#pragma unroll
  for (int r = 0; r < 16; ++r) rli[r] = __builtin_amdgcn_rcpf(li_l[crow(r, hi)]);
  __syncthreads();
  float* xo = (float*)lds;
  if (sub == 1) {
#pragma unroll
    for (int r = 0; r < 16; ++r) { const int orow = wq * 32 + crow(r, hi);
#pragma unroll
      for (int d0 = 0; d0 < 4; ++d0) xo[orow * 128 + d0 * 32 + r32] = o[d0][r] * rli[r]; }
  }
  __syncthreads();
  if (sub == 0) {
    float gv[4];
#pragma unroll
    for (int d0 = 0; d0 < 4; ++d0) gv[d0] = subln_g[d0 * 32 + r32] * (1.0f - LAM_INIT);
#pragma unroll
    for (int r = 0; r < 16; ++r) { const int orow = wq * 32 + crow(r, hi); float v[4]; float ssq = 0.f;
#pragma unroll
      for (int d0 = 0; d0 < 4; ++d0) { v[d0] = o[d0][r] * rli[r] - lam * xo[orow * 128 + d0 * 32 + r32]; ssq += v[d0] * v[d0]; }
      ssq += __shfl_xor(ssq, 1); ssq += __shfl_xor(ssq, 2); ssq += __shfl_xor(ssq, 4); ssq += __shfl_xor(ssq, 8); ssq += __shfl_xor(ssq, 16);
      const float sc_ = 1.0f / sqrtf(ssq * (1.0f / 128.0f) + RMS_EPS);
#pragma unroll
      for (int d0 = 0; d0 < 4; ++d0) Ya[(long)orow * 1024 + d0 * 32 + r32] = (bf16_t)f2bf(v[d0] * sc_ * gv[d0]); }
  }
  __syncthreads();
#undef SLOAD
#undef SWRITE
#undef SWAIT
}
#undef KSWZ
#undef SBAR
}

struct Args {
    const float* in[33];
    float* out; unsigned char* ws;
    int ph_lo, ph_hi;
};
enum { I_X = 0, I_ANG, I_WIN, I_QNG, I_KNG, I_LQ1, I_LK1, I_LQ2, I_LK2, I_SUBLN, I_MU, I_W0F, I_W2F, I_W0B, I_W2B, I_A0F, I_A2F, I_A0B, I_A2B, I_G2, I_KK, I_KA, I_RK,
       I_LNW, I_LNB, I_WBA, I_WBB, I_WOUT, I_FNG, I_WR, I_WG, I_WU, I_WD };

__device__ __forceinline__ void tr_item(const float* W, int ldw, int k0, int n0, bf16_t* dst, int ldd, LAS float* scr, int lane) {
    float tv[32];
    const float* src = W + (size_t)(k0 + (lane >> 5)) * ldw + n0 + (lane & 31);
#pragma unroll
    for (int i = 0; i < 32; ++i) tv[i] = src[(size_t)(2 * i) * ldw];
#pragma unroll
    for (int i = 0; i < 32; ++i) scr[(2 * i + (lane >> 5)) * 33 + (lane & 31)] = tv[i];
    asm volatile("s_waitcnt lgkmcnt(0)" ::: "memory");
    const int c = lane & 7;
#pragma unroll
    for (int j = 0; j < 4; ++j) { const int n = (lane >> 3) + 8 * j; const LAS float* s = scr + (8 * c) * 33 + n;
        v4u o; o.x = pk2(s[0 * 33], s[1 * 33]); o.y = pk2(s[2 * 33], s[3 * 33]); o.z = pk2(s[4 * 33], s[5 * 33]); o.w = pk2(s[6 * 33], s[7 * 33]);
        *(v4u*)(dst + (size_t)n * ldd + 8 * c) = o; }
    asm volatile("s_waitcnt lgkmcnt(0)" ::: "memory");
}

__device__ __forceinline__ void p0_prologue(const Args& a, LAS unsigned char* lds, int gw, int NGW, int wave, int lane) {
    unsigned char* ws = a.ws;
    LAS float* scr = (LAS float*)(lds + wave * 16384);
    bf16_t* WinT = (bf16_t*)(ws + WS_WINT);
    bf16_t* WaT = (bf16_t*)(ws + WS_WAT); bf16_t* WbT = (bf16_t*)(ws + WS_WBT); bf16_t* WoT = (bf16_t*)(ws + WS_WOT);
    constexpr int I_IN = 32 * 333, I_A = 16 * 64, I_B = 16 * 64, I_O = 32 * 64, NITEMS = I_IN + I_A + I_B + I_O;
    for (int it = gw; it < NITEMS; it += NGW) {
        int r = it;
        if (r < I_IN) { const int kb = r / 333, nb = r % 333, n0 = nb * 32, drow = (n0 < 6560) ? n0 : n0 + 96;
            tr_item(a.in[I_WIN], IN_COLS, kb * 64, n0, WinT + (size_t)drow * 2048 + kb * 64, 2048, scr, lane); continue; } r -= I_IN;
        if (r < I_A) { const int kb = r / 64, nb = r % 64; tr_item(a.in[I_WBA], 2048, kb * 64, nb * 32, WaT + (size_t)(nb * 32) * 1024 + kb * 64, 1024, scr, lane); continue; } r -= I_A;
        if (r < I_B) { const int kb = r / 64, nb = r % 64; tr_item(a.in[I_WBB], 2048, kb * 64, nb * 32, WbT + (size_t)(nb * 32) * 1024 + kb * 64, 1024, scr, lane); continue; } r -= I_B;
        { const int kb = r / 64, nb = r % 64; tr_item(a.in[I_WOUT], 2048, kb * 64, nb * 32, WoT + (size_t)(nb * 32) * 2048 + kb * 64, 2048, scr, lane); }
    }
    { const int gt = gw * 64 + lane, NT_ = NGW * 64;
      v4u z = {0u, 0u, 0u, 0u};
      for (int i = gt; i < 24576; i += NT_) ((v4u*)(WinT + (size_t)6560 * 2048))[i] = z;
      { const float invf[8] = {1.000000000e+00f, 1.939227432e-01f, 3.760603070e-02f, 7.292664610e-03f, 1.414213562e-03f, 2.742481884e-04f, 5.318296098e-05f, 1.031338616e-05f};
        for (int i = gt; i < SEQ * 8; i += NT_) { float iv = invf[0];
#pragma unroll
            for (int j = 1; j < 8; ++j) iv = ((i & 7) == j) ? invf[j] : iv;
            float sv, cv; sincosf((float)(i >> 3) * iv, &sv, &cv); ((float2*)(ws + WS_ROPE))[i] = make_float2(cv, sv); } }
      { float* sm = (float*)(ws + WS_SMALL);
#define CPY(OFF, IDX, N) for (int i = gt; i < (N); i += NT_) sm[(OFF) + i] = a.in[IDX][i];
        CPY(SM_QNG, I_QNG, 64) CPY(SM_KNG, I_KNG, 64) CPY(SM_LQ1, I_LQ1, 64) CPY(SM_LK1, I_LK1, 64) CPY(SM_LQ2, I_LQ2, 64) CPY(SM_LK2, I_LK2, 64) CPY(SM_SUBLN, I_SUBLN, 128)
        CPY(SM_MU, I_MU, 3488) CPY(SM_KK, I_KK, 1024) CPY(SM_KA, I_KA, 1024) CPY(SM_RK, I_RK, 1024) CPY(SM_LNW, I_LNW, 1024) CPY(SM_LNB, I_LNB, 1024) CPY(SM_FNG, I_FNG, 2048) CPY(SM_WR, I_WR, 32768)
#undef CPY
      }
      for (int i = gt; i < 4096; i += NT_) { const int seg = i >> 10, c = i & 1023; ((float*)(ws + WS_BIAS4))[i] = (seg == 0) ? a.in[I_W0F][c] : (seg == 1) ? a.in[I_W0B][c] : (seg == 2) ? a.in[I_A0F][c] : a.in[I_A0B][c]; }
      bf16_t* B1 = (bf16_t*)(ws + WS_BTL1); bf16_t* B2 = (bf16_t*)(ws + WS_BTL2);
      for (int i = gt; i < 4096 * 32; i += NT_) { const int n = i >> 5, kc = (i & 31) * 8, seg = n >> 10, c = n & 1023;
          const float* w2 = (seg == 0) ? a.in[I_W2F] : (seg == 1) ? a.in[I_W2B] : (seg == 2) ? a.in[I_A2F] : a.in[I_A2B];
          float f[8];
#pragma unroll
          for (int j = 0; j < 8; ++j) { const int k = kc + j - 64 * seg; f[j] = (k >= 0 && k < 64) ? w2[(size_t)k * 1024 + c] : 0.f; }
          *(v4u*)(B1 + (size_t)n * 256 + kc) = pack8(f); }
      for (int i = gt; i < 1024 * 32; i += NT_) { const int n = i >> 5, kc = (i & 31) * 8; float f[8];
#pragma unroll
          for (int j = 0; j < 8; ++j) { const int k = kc + j; f[j] = (k < 160) ? a.in[I_G2][(size_t)k * 1024 + n] : 0.f; }
          *(v4u*)(B2 + (size_t)n * 256 + kc) = pack8(f); }
    }
    bf16_t* HN = (bf16_t*)(ws + WS_HN); const float* x = a.in[I_X]; const float* g = a.in[I_ANG];
    for (int m = gw; m < M; m += NGW) {
        const float4* xr = (const float4*)(x + (size_t)m * DM) + lane; float4 v[8]; float s = 0.f;
#pragma unroll
        for (int j = 0; j < 8; ++j) { v[j] = xr[64 * j]; s += (v[j].x * v[j].x + v[j].y * v[j].y) + (v[j].z * v[j].z + v[j].w * v[j].w); }
        const float rs = 1.0f / sqrtf(wave_sum(s) * (1.0f / DM) + RMS_EPS);
        v2u* o = (v2u*)(HN + (size_t)m * DM) + lane;
#pragma unroll
        for (int j = 0; j < 8; ++j) { const float4 gg = ((const float4*)g)[64 * j + lane]; v2u w; w.x = pk2(v[j].x * rs * gg.x, v[j].y * rs * gg.y); w.y = pk2(v[j].z * rs * gg.z, v[j].w * rs * gg.w); o[64 * j] = w; }
    }
}

__device__ __forceinline__ void p2_prep(const Args& a, int gw, int NGW, int lane, bool dummy = false) {
    unsigned char* ws = a.ws;
    bf16_t* PDA = (bf16_t*)(ws + WS_PDA); const bf16_t* PRW = (const bf16_t*)((unsigned char*)a.out + DO_PRW);
    bf16_t* RKV = (bf16_t*)(ws + WS_RKV); bf16_t* LIN = (bf16_t*)((unsigned char*)a.out + DO_LIN);
    const float* sm = (const float*)(ws + WS_SMALL); const float* mu = sm + SM_MU;
    const int sub8 = lane & 7;
    float gq[8], gk[8];
#pragma unroll
    for (int j = 0; j < 8; ++j) { gq[j] = sm[SM_QNG + sub8 * 8 + j]; gk[j] = sm[SM_KNG + sub8 * 8 + j]; }
    for (int m = gw; m < M; m += NGW) {
        const int t = m & (SEQ - 1);
        const float2 csv = ((const float2*)(ws + WS_ROPE))[t * 8 + sub8]; const float cv = csv.x, sv = csv.y;
        float cs[8], sn[8];
#pragma unroll
        for (int j = 0; j < 8; ++j) { cs[j] = __shfl(cv, j); sn[j] = __shfl(sv, j); }
#pragma unroll
        for (int it = 0; it < 4; ++it) {
            const int v = it * 8 + (lane >> 3);
            bf16_t* p = PDA + (size_t)m * 3072 + (v < 16 ? 0 : 1024) + (v & 15) * 64 + sub8 * 8;
            const v4u w = *(const v4u*)p; float f[8]; unpack8(w, f);
            float s = 0.f;
#pragma unroll
            for (int j = 0; j < 8; ++j) s += f[j] * f[j];
            s = sum8(s); const float rs = 1.0f / sqrtf(s * (1.0f / 64.0f) + RMS_EPS);
            float y[8], oth[8];
#pragma unroll
            for (int j = 0; j < 8; ++j) { y[j] = f[j] * rs * (v < 16 ? gq[j] : gk[j]); }
#pragma unroll
            for (int j = 0; j < 8; ++j) oth[j] = __shfl_xor(y[j], 1);
            float o[8];
#pragma unroll
            for (int j = 0; j < 8; ++j) o[j] = (sub8 == 0) ? (y[j] * cs[j] - oth[j] * sn[j]) : (sub8 == 1) ? (y[j] * cs[j] + oth[j] * sn[j]) : y[j];
            if (v < 16) {
#pragma unroll
                for (int j = 0; j < 8; ++j) o[j] *= 0.125f * 1.4426950408889634f; }
            *(v4u*)(dummy ? (bf16_t*)(ws + WS_LORA) + (p - PDA) : p) = pack8(o);
        }
        const bool hp = t > 0, hn_ = t < SEQ - 1;
        const bf16_t* pr = PRW + (size_t)m * RW_PAD;
#pragma unroll
        for (int it = 0; it < 7; ++it) {
            const int v = it * 64 + lane; if (it == 6 && v >= 436) continue;
            const v4u wc = *(const v4u*)(pr + v * 8);
            v4u wp = {0u, 0u, 0u, 0u}, wn = {0u, 0u, 0u, 0u};
            if (hp) wp = *(const v4u*)(pr - RW_PAD + v * 8);
            if (hn_) wn = *(const v4u*)(pr + RW_PAD + v * 8);
            float c[8], pv[8], nx[8]; unpack8(wc, c); unpack8(wp, pv); unpack8(wn, nx);
            const float4 m0 = *(const float4*)(mu + v * 8), m1 = *(const float4*)(mu + v * 8 + 4);
            const float mm[8] = {m0.x, m0.y, m0.z, m0.w, m1.x, m1.y, m1.z, m1.w};
            float xs[8];
#pragma unroll
            for (int j = 0; j < 8; ++j) xs[j] = c[j] + mm[j] * (0.5f * (pv[j] + nx[j]) - c[j]);
            if (v < 384) { const v4u pw = pack8(xs); *(v4u*)(RKV + (size_t)m * 3072 + v * 8) = pw;
                if (it == 2 || it == 3) {
                    float kr[8]; unpack8(pw, kr); float ssq = 0.f;
#pragma unroll
                    for (int j = 0; j < 8; ++j) { const float kkv = kr[j] * sm[SM_KK + (v - 128) * 8 + j]; ssq += kkv * kkv; }
                    ssq = sum8(ssq);
                    if ((lane & 7) == 0) ((float*)(ws + WS_INRM))[(size_t)m * 16 + ((v - 128) >> 3)] = 1.0f / fmaxf(sqrtf(ssq), 1e-12f); } }
            else if (v < 400) {
#pragma unroll
                for (int j = 0; j < 8; ++j) xs[j] = 1.0f - 2.0f * __builtin_amdgcn_rcpf(1.0f + __expf(2.0f * xs[j]));
                *(v4u*)(LIN + (size_t)m * 512 + (v - 384) * 8) = pack8(xs); }
            else if (v < 416) { *(v4u*)(LIN + (size_t)m * 512 + (v - 384) * 8) = pack8(xs); }
            else {
#pragma unroll
                for (int j = 0; j < 8; ++j) xs[j] = sigmoidf_(xs[j]);
                *(v4u*)(LIN + (size_t)m * 512 + 256 + (v - 416) * 8) = pack8(xs); }
        }
        if (lane < 12) { v4u z = {0u, 0u, 0u, 0u}; *(v4u*)(LIN + (size_t)m * 512 + 416 + lane * 8) = z; }
    }
}

__device__ __forceinline__ void p6_rwpost(const Args& a, int gw, int NGW, int lane) {
    unsigned char* ws = a.ws;
    const bf16_t* RKV = (const bf16_t*)(ws + WS_RKV); const bf16_t* LO = (const bf16_t*)(ws + WS_LORA);
    const bf16_t* YSF = (const bf16_t*)((unsigned char*)a.out + DO_YSF); const bf16_t* YSB = (const bf16_t*)((unsigned char*)a.out + DO_YSB);
    bf16_t* YB = (bf16_t*)((unsigned char*)a.out + DO_YB);
    const size_t SEG = (size_t)M * 1024; const float* sm = (const float*)(ws + WS_SMALL);
    for (int it = gw; it < 2 * M; it += NGW) {
        const int m = it >> 1, col = (it & 1) * 512 + lane * 8;
        float yf[8], ybk[8], r[8], k[8], v[8], af[8], ab[8], g[8];
        unpack8(*(const v4u*)(YSF + (size_t)m * 1024 + col), yf); unpack8(*(const v4u*)(YSB + (size_t)m * 1024 + col), ybk);
        unpack8(*(const v4u*)(RKV + (size_t)m * 3072 + col), r); unpack8(*(const v4u*)(RKV + (size_t)m * 3072 + 1024 + col), k); unpack8(*(const v4u*)(RKV + (size_t)m * 3072 + 2048 + col), v);
        unpack8(*(const v4u*)(LO + 2 * SEG + (size_t)m * 1024 + col), af); unpack8(*(const v4u*)(LO + 3 * SEG + (size_t)m * 1024 + col), ab); unpack8(*(const v4u*)(LO + 4 * SEG + (size_t)m * 1024 + col), g);
        float y[8]; float s = 0.f;
#pragma unroll
        for (int j = 0; j < 8; ++j) { y[j] = yf[j] + ybk[j]; s += y[j]; }
        const float mean = sum8(s) * (1.0f / 64.0f); float q = 0.f;
#pragma unroll
        for (int j = 0; j < 8; ++j) { y[j] -= mean; q += y[j] * y[j]; }
        const float rstd = 1.0f / sqrtf(sum8(q) * (1.0f / 64.0f) + GN_EPS);
        float bs = 0.f;
#pragma unroll
        for (int j = 0; j < 8; ++j) { const float kfb = k[j] * (2.0f + (af[j] + ab[j] - 2.0f) * sm[SM_KA + col + j]); bs += r[j] * kfb * sm[SM_RK + col + j]; }
        bs = sum8(bs);
        float o[8];
#pragma unroll
        for (int j = 0; j < 8; ++j) o[j] = (y[j] * rstd * sm[SM_LNW + col + j] + sm[SM_LNB + col + j] + bs * v[j]) * g[j];
        *(v4u*)(YB + (size_t)m * 1024 + col) = pack8(o);
    }
}

__device__ __forceinline__ void expert_convert(const Args& a, LAS unsigned char* lds, int gw, int NGW, int wave, int lane, int lo, int hi) {
    unsigned char* ws = a.ws;
    LAS float* scr = (LAS float*)(lds + wave * 16384);
    bf16_t* W1T = (bf16_t*)(ws + WS_W1T); bf16_t* WDT = (bf16_t*)(ws + WS_WDT);
    for (int it = lo + gw; it < hi; it += NGW) {
        const int which = it >> 14, r = it & 16383, e = r >> 10, q = r & 1023;
        if (which < 2) { const int kb = q >> 5, nb = q & 31, n0 = nb * 32;
            const float* W = (which == 0 ? a.in[I_WG] : a.in[I_WU]) + (size_t)e * 2048 * 1024;
            const int drow = (n0 >> 7) * 256 + which * 128 + (n0 & 127);
            tr_item(W, 1024, kb * 64, n0, W1T + ((size_t)e * 2048 + drow) * 2048 + kb * 64, 2048, scr, lane); }
        else { const int kb = q >> 6, nb = q & 63;
            const float* W = a.in[I_WD] + (size_t)e * 1024 * 2048;
            tr_item(W, 2048, kb * 64, nb * 32, WDT + ((size_t)e * 2048 + nb * 32) * 1024 + kb * 64, 1024, scr, lane); }
    }
}
__device__ __forceinline__ void p9_router(const Args& a, LAS unsigned char* lds, int gw, int NGW, int wave, int lane) {
    unsigned char* ws = a.ws;
    expert_convert(a, lds, gw, NGW, wave, lane, 0, 2 * 16384);
    __syncthreads();
    LAS float* wrT = (LAS float*)lds;
    { const float4* wr4 = (const float4*)((const float*)(ws + WS_SMALL) + SM_WR);
      for (int idx = fresh_tid(); idx < 2048 * 4; idx += NTHREADS) { const int d = idx >> 2, q = idx & 3; const float4 w4 = wr4[idx];
          wrT[(4 * q + 0) * 2048 + d] = w4.x; wrT[(4 * q + 1) * 2048 + d] = w4.y; wrT[(4 * q + 2) * 2048 + d] = w4.z; wrT[(4 * q + 3) * 2048 + d] = w4.w; } }
    __syncthreads();
    const float* h = a.out; const float* ss = (const float*)(ws + WS_SSP); const float* g = (const float*)(ws + WS_SMALL) + SM_FNG;
    float* aff = (float*)(ws + WS_AFF); bf16_t* hn2 = (bf16_t*)(ws + WS_HN2);
    for (int mp = gw; mp < M / 2; mp += NGW) {
        const int m0 = 2 * mp;
        const float rs0 = 1.0f / sqrtf(wave_sum(lane < 32 ? ss[(size_t)m0 * 32 + lane] : 0.f) * (1.0f / DM) + RMS_EPS);
        const float rs1 = 1.0f / sqrtf(wave_sum(lane < 32 ? ss[(size_t)(m0 + 1) * 32 + lane] : 0.f) * (1.0f / DM) + RMS_EPS);
        float acc0[16], acc1[16];
#pragma unroll
        for (int e = 0; e < 16; ++e) { acc0[e] = 0.f; acc1[e] = 0.f; }
#pragma unroll 2
        for (int j = 0; j < 8; ++j) { const int d = j * 256 + lane * 4;
            const float4 gv = *(const float4*)(g + d), h0 = *(const float4*)(h + (size_t)m0 * DM + d), h1 = *(const float4*)(h + (size_t)(m0 + 1) * DM + d);
            const float x0[4] = {h0.x * rs0 * gv.x, h0.y * rs0 * gv.y, h0.z * rs0 * gv.z, h0.w * rs0 * gv.w};
            const float x1[4] = {h1.x * rs1 * gv.x, h1.y * rs1 * gv.y, h1.z * rs1 * gv.z, h1.w * rs1 * gv.w};
            { v2u w0, w1; w0.x = pk2(x0[0], x0[1]); w0.y = pk2(x0[2], x0[3]); w1.x = pk2(x1[0], x1[1]); w1.y = pk2(x1[2], x1[3]);
              *(v2u*)(hn2 + (size_t)m0 * DM + d) = w0; *(v2u*)(hn2 + (size_t)(m0 + 1) * DM + d) = w1; }
#pragma unroll
            for (int e = 0; e < 16; ++e) { const pg8::f32x4 w4 = *(const LAS pg8::f32x4*)(wrT + e * 2048 + d);
                acc0[e] += x0[0] * w4.x + x0[1] * w4.y + x0[2] * w4.z + x0[3] * w4.w;
                acc1[e] += x1[0] * w4.x + x1[1] * w4.y + x1[2] * w4.z + x1[3] * w4.w; } }
#pragma unroll
        for (int t2 = 0; t2 < 2; ++t2) {
            float mx = -1e30f, lg[16];
#pragma unroll
            for (int e = 0; e < 16; ++e) { lg[e] = wave_sum(t2 ? acc1[e] : acc0[e]); mx = fmaxf(mx, lg[e]); }
            float den = 0.f;
#pragma unroll
            for (int e = 0; e < 16; ++e) { lg[e] = __expf(lg[e] - mx); den += lg[e]; }
            float mine = lg[0];
#pragma unroll
            for (int e = 1; e < 16; ++e) mine = (lane == e) ? lg[e] : mine;
            const int m = m0 + t2;
            if (lane < 16) aff[((size_t)(m >> 12) * 16 + lane) * SEQ + (m & (SEQ - 1))] = mine / den;
        }
    }
}

__device__ __forceinline__ void p10_topk(const Args& a, unsigned char* ldsg) {
    const int bx = blockIdx.x; if (bx >= NB * NE) return;
    LAS unsigned char* L = (LAS unsigned char*)ldsg;
    const int tid = fresh_tid(), lane = tid & 63, w = tid >> 6;
    unsigned char* ws = a.ws;
    const float* aff = (const float*)(ws + WS_AFF) + (size_t)bx * SEQ;
    LAS unsigned* hist = (LAS unsigned*)L;
    LAS unsigned* ctl = hist + 256;
    LAS unsigned* wtot = hist + 272;
    unsigned v[8];
    { const v4u a0 = *(const v4u*)(aff + tid * 8), a1 = *(const v4u*)(aff + tid * 8 + 4); v[0] = a0.x; v[1] = a0.y; v[2] = a0.z; v[3] = a0.w; v[4] = a1.x; v[5] = a1.y; v[6] = a1.z; v[7] = a1.w; }
    unsigned prefix = 0u, mask = 0u, remaining = CAP;
#pragma unroll 1
    for (int pass = 0; pass < 4; ++pass) {
        const int shift = 24 - 8 * pass;
        if (tid < 256) hist[tid] = 0u;
        __syncthreads();
#pragma unroll
        for (int q = 0; q < 8; ++q) if ((v[q] & mask) == prefix) __hip_atomic_fetch_add((unsigned*)&hist[(v[q] >> shift) & 255u], 1u, __ATOMIC_RELAXED, __HIP_MEMORY_SCOPE_WORKGROUP);
        __syncthreads();
        if (w == 0) {
            const v4u hb = *(const LAS v4u*)(hist + 4 * lane);
            const unsigned own = hb.x + hb.y + hb.z + hb.w;
            unsigned suf = own;
#pragma unroll
            for (int o = 1; o < 64; o <<= 1) { const unsigned t = __shfl_down(suf, o); suf += (lane + o < 64) ? t : 0u; }
            const unsigned above = suf - own;
            if (above < remaining && remaining <= suf) {
                unsigned c3 = above, d, rem;
                if (remaining <= c3 + hb.w) { d = 3; rem = remaining - c3; }
                else { c3 += hb.w; if (remaining <= c3 + hb.z) { d = 2; rem = remaining - c3; }
                    else { c3 += hb.z; if (remaining <= c3 + hb.y) { d = 1; rem = remaining - c3; } else { c3 += hb.y; d = 0; rem = remaining - c3; } } }
                ctl[0] = 4u * lane + d; ctl[1] = rem;
            }
        }
        __syncthreads();
        prefix |= ctl[0] << shift; mask |= 255u << shift; remaining = ctl[1];
        __syncthreads();
    }
    const unsigned thr = prefix;
    unsigned ceq = 0u, cgt = 0u;
#pragma unroll
    for (int q = 0; q < 8; ++q) { ceq += (v[q] == thr) ? 1u : 0u; cgt += (v[q] > thr) ? 1u : 0u; }
    unsigned inc = ceq;
#pragma unroll
    for (int o = 1; o < 64; o <<= 1) { const unsigned t = __shfl_up(inc, o); inc += (lane >= o) ? t : 0u; }
    if (lane == 63) wtot[w] = inc;
    __syncthreads();
    unsigned eqbase = inc - ceq;
#pragma unroll
    for (int q = 0; q < 8; ++q) eqbase += (q < w) ? wtot[q] : 0u;
    __syncthreads();
    unsigned selmask = 0u, nsel = 0u, er = eqbase;
#pragma unroll
    for (int q = 0; q < 8; ++q) { bool s = v[q] > thr; if (v[q] == thr) { s = er < remaining; ++er; } selmask |= s ? (1u << q) : 0u; nsel += s ? 1u : 0u; }
    inc = nsel;
#pragma unroll
    for (int o = 1; o < 64; o <<= 1) { const unsigned t = __shfl_up(inc, o); inc += (lane >= o) ? t : 0u; }
    if (lane == 63) wtot[w] = inc;
    __syncthreads();
    unsigned pos = inc - nsel;
#pragma unroll
    for (int q = 0; q < 8; ++q) pos += (q < w) ? wtot[q] : 0u;
    int* seltok = (int*)(ws + WS_SELTOK) + bx * CAP; float* selgate = (float*)(ws + WS_SELGATE) + bx * CAP;
#pragma unroll
    for (int q = 0; q < 8; ++q) if (selmask & (1u << q)) { if (pos < (unsigned)CAP) { seltok[pos] = tid * 8 + q; selgate[pos] = __uint_as_float(v[q]); } ++pos; }
    (void)cgt;
}

__device__ __forceinline__ void p11_gather(const Args& a, int gw, int NGW, int lane) {
    unsigned char* ws = a.ws;
    const float* h = a.out; const float* ss = (const float*)(ws + WS_SSP); const float* g = (const float*)(ws + WS_SMALL) + SM_FNG;
    const int* seltok = (const int*)(ws + WS_SELTOK); bf16_t* XE = (bf16_t*)(ws + WS_XE);
    for (int r = gw; r < NSLOT; r += NGW) {
        const int e = r >> 11, b = (r >> 9) & 3, c = r & 511;
        const int tok = seltok[(b * 16 + e) * CAP + c]; const size_t m = (size_t)b * SEQ + tok;
        const float rs = 1.0f / sqrtf(wave_sum(lane < 32 ? ss[m * 32 + lane] : 0.f) * (1.0f / DM) + RMS_EPS);
        const float4* hr = (const float4*)(h + m * DM) + lane; v2u* o = (v2u*)(XE + (size_t)r * DM) + lane;
#pragma unroll
        for (int j = 0; j < 8; ++j) { const float4 hv = hr[64 * j], gg = ((const float4*)g)[64 * j + lane];
            v2u w; w.x = pk2(hv.x * rs * gg.x, hv.y * rs * gg.y); w.y = pk2(hv.z * rs * gg.z, hv.w * rs * gg.w); o[64 * j] = w; }
    }
}

__device__ __forceinline__ void p14_combine(const Args& a, unsigned char* lds, int wave, int lane) {
    unsigned char* ws = a.ws;
    const int G = gridDim.x, bx = blockIdx.x, tid = fresh_tid();
    const int per = M / G;
    const int m0 = bx * per, b = m0 >> 12, t0 = m0 & (SEQ - 1);
    int* inv = (int*)lds;
    for (int i = tid; i < per * 16; i += NTHREADS) inv[i] = -1;
    __syncthreads();
    const int* seltok = (const int*)(ws + WS_SELTOK) + b * 16 * CAP;
    for (int i = tid; i < 16 * CAP; i += NTHREADS) { const int e = i >> 9, c = i & 511; const int tok = seltok[i]; const int tl = tok - t0;
        if (tl >= 0 && tl < per) inv[tl * 16 + e] = e * 2048 + b * 512 + c; }
    __syncthreads();
    const bf16_t* YE = (const bf16_t*)(ws + WS_XE);
    float* out = a.out;
    for (int tl = wave; tl < per; tl += NWAVES) {
        const size_t m = (size_t)m0 + tl;
        float4* orow = (float4*)(out + m * DM) + lane;
        float4 acc[8];
#pragma unroll
        for (int j = 0; j < 8; ++j) acc[j] = orow[64 * j];
        int sl[16]; int ns = 0;
#pragma unroll
        for (int e = 0; e < 16; ++e) { const int s_ = inv[tl * 16 + e]; if (s_ >= 0) { _Pragma("unroll") for (int q = 0; q < 16; ++q) if (q == ns) sl[q] = s_; ++ns; } }
        for (int q = 0; q < ns; q += 2) { int s0 = sl[0], s1 = sl[0];
#pragma unroll
            for (int z = 0; z < 16; ++z) { if (z == q) s0 = sl[z]; if (z == q + 1) s1 = sl[z]; }
            const bool two = q + 1 < ns;
            const v2u* y0 = (const v2u*)(YE + (size_t)s0 * DM) + lane; const v2u* y1 = (const v2u*)(YE + (size_t)(two ? s1 : s0) * DM) + lane;
            v2u w0[8], w1[8];
#pragma unroll
            for (int j = 0; j < 8; ++j) { w0[j] = y0[64 * j]; w1[j] = y1[64 * j]; }
#pragma unroll
            for (int j = 0; j < 8; ++j) { acc[j].x += bflo(w0[j].x); acc[j].y += bfhi(w0[j].x); acc[j].z += bflo(w0[j].y); acc[j].w += bfhi(w0[j].y);
                if (two) { acc[j].x += bflo(w1[j].x); acc[j].y += bfhi(w1[j].x); acc[j].z += bflo(w1[j].y); acc[j].w += bfhi(w1[j].y); } } }
#pragma unroll
        for (int j = 0; j < 8; ++j) orow[64 * j] = acc[j];
    }
}


namespace scan {
typedef short bf16x8 __attribute__((ext_vector_type(8)));
typedef float f32x4 __attribute__((ext_vector_type(4)));
constexpr int TS = 72, TILE_B = 64 * TS * 2;
enum { SL_ATR = 0, SL_BTR = 1, SL_KTR = 2, SL_RTR = 3, SL_ATC = 4, SL_BBT = 5, SL_KBT = 6, SL_VT = 7, SL_XAR = 8, SL_XAC = 9, SL_TTA = 10, SL_NKA = 11, SL_NBRT = 12, SL_G = 13, SL_SB = 14,
       SL_XBR = 0, SL_XBC = 1, SL_TTB = 2, SL_AP = 8, SL_APT = 9, SL_RPT = 4, SL_HT = 11, SL_PSIT = 10, SL_WB = 12 };
constexpr int OFF_PL = 15 * TILE_B, OFF_TOT = OFF_PL + 256;
#define TILE(s) (L + (s) * TILE_B)
__device__ __forceinline__ bf16x8 frag(const LAS unsigned char* tile, int row0, int k0, int lane) {
    return *(const LAS bf16x8*)(tile + ((row0 + (lane & 15)) * TS + k0 + 8 * (lane >> 4)) * 2);
}
__device__ __forceinline__ void mma(f32x4& acc, const LAS unsigned char* A, int arow0, const LAS unsigned char* B, int brow0, int lane) {
    acc = __builtin_amdgcn_mfma_f32_16x16x32_bf16(frag(A, arow0, 0, lane), frag(B, brow0, 0, lane), acc, 0, 0, 0);
    acc = __builtin_amdgcn_mfma_f32_16x16x32_bf16(frag(A, arow0, 32, lane), frag(B, brow0, 32, lane), acc, 0, 0, 0);
}
__device__ __forceinline__ void st4(LAS unsigned char* tile, int brow, int acol0, const f32x4& v) {
    v2u w; w.x = pg8::cvt_pk_bf16(v[0], v[1]); w.y = pg8::cvt_pk_bf16(v[2], v[3]); *(LAS v2u*)(tile + (brow * TS + acol0) * 2) = w;
}
__device__ __forceinline__ f32x4 ld4(const LAS unsigned char* tile, int brow, int acol0) {
    const v2u w = *(const LAS v2u*)(tile + (brow * TS + acol0) * 2); return (f32x4){bflo(w.x), bfhi(w.x), bflo(w.y), bfhi(w.y)};
}
struct Fr { bf16x8 k0, k1; };
__device__ __forceinline__ Fr ldf(const LAS unsigned char* tile, int row0, int lane) { Fr f; f.k0 = frag(tile, row0, 0, lane); f.k1 = frag(tile, row0, 32, lane); return f; }
__device__ __forceinline__ void mmf(f32x4& acc, const Fr& A, const Fr& B) {
    acc = __builtin_amdgcn_mfma_f32_16x16x32_bf16(A.k0, B.k0, acc, 0, 0, 0); acc = __builtin_amdgcn_mfma_f32_16x16x32_bf16(A.k1, B.k1, acc, 0, 0, 0);
}
#define ZERO4 ((f32x4){0.f, 0.f, 0.f, 0.f})
#define LWAIT() asm volatile("s_waitcnt lgkmcnt(0)" ::: "memory")

__device__ __forceinline__ void scan_phase(const Args& a, unsigned char* ldsg) {
    const int bx = blockIdx.x; if (bx >= 128) return;
    LAS unsigned char* L = (LAS unsigned char*)ldsg;
    const int tid = fresh_tid(), lane = tid & 63, w = __builtin_amdgcn_readfirstlane(tid >> 6);
    const int dir = bx >> 6, b = (bx >> 4) & 3, hh = bx & 15;
    unsigned char* ws = a.ws;
    const bf16_t* RKV = (const bf16_t*)(ws + WS_RKV) + hh * 64 + lane;
    const bf16_t* LW = (const bf16_t*)(ws + WS_LORA) + (size_t)dir * ((size_t)M * 1024) + hh * 64 + lane;
    const bf16_t* AL = (const bf16_t*)(ws + WS_LORA) + (size_t)(2 + dir) * ((size_t)M * 1024) + hh * 64 + lane;
    bf16_t* YS = (bf16_t*)((unsigned char*)a.out + (dir ? DO_YSB : DO_YSF));
    const float kkc = ((const float*)(ws + WS_SMALL))[SM_KK + hh * 64 + lane], kac = ((const float*)(ws + WS_SMALL))[SM_KA + hh * 64 + lane];
    const int g4 = lane >> 4, l15 = lane & 15;
    const int ta = w >> 1, tb0 = (w & 1) * 2;
    const int a0 = ta * 16 + 4 * g4;
    unsigned short rw[8][5]; float inr[8];
    const float* INRM = (const float*)(ws + WS_INRM) + hh;
#define RAW_LOAD(chunk) do { _Pragma("unroll") for (int j = 0; j < 8; ++j) { const int s_ = (chunk) * 64 + w * 8 + j; const int t_ = dir ? (SEQ - 1 - s_) : s_; const size_t m_ = (size_t)b * SEQ + t_; \
        rw[j][0] = RKV[m_ * 3072]; rw[j][1] = RKV[m_ * 3072 + 1024]; rw[j][2] = RKV[m_ * 3072 + 2048]; rw[j][3] = LW[m_ * 1024]; rw[j][4] = AL[m_ * 1024]; inr[j] = INRM[m_ * 16]; } } while (0)
    RAW_LOAD(0);
    f32x4 accS[4];
#pragma unroll
    for (int q = 0; q < 4; ++q) accS[q] = (f32x4){0.f, 0.f, 0.f, 0.f};
    for (int u = tid; u < TILE_B / 16; u += NTHREADS) ((LAS v4u*)TILE(SL_SB))[u] = (v4u){0u, 0u, 0u, 0u};
#pragma unroll 1
    for (int c = 0; c < SEQ / 64; ++c) {
        float cl[8];
        {
            float run = 0.f;
#pragma unroll
            for (int j = 0; j < 8; ++j) { run += bf2f(rw[j][3]); cl[j] = run; }
            ((LAS float*)(L + OFF_TOT))[w * 64 + lane] = run;
        }
        __syncthreads();
        {
            float off = 0.f, tot = 0.f;
#pragma unroll
            for (int q = 0; q < 8; ++q) { const float t_ = ((const LAS float*)(L + OFF_TOT))[q * 64 + lane]; off += (q < w) ? t_ : 0.f; tot += t_; }
            const float pLt = __expf(tot);
            if (w == 0) ((LAS float*)(L + OFF_PL))[lane] = pLt;
            float pprev = __expf(off);
            unsigned atc[4], bbt[4], kbt[4], vt[4];
#pragma unroll
            for (int j = 0; j < 8; ++j) {
                const float r = bf2f(rw[j][0]), k = bf2f(rw[j][1]), al = bf2f(rw[j][4]);
                const float p = __expf(cl[j] + off), em = __builtin_amdgcn_rcpf(p), eL = pLt * em;
                const float kk = k * kkc * inr[j], kdv = k * (1.0f + (al - 1.0f) * kac), bbj = kk * al;
                const float at = -kk * pprev; pprev = p;
                const int s = w * 8 + j;
                const unsigned w01 = pg8::cvt_pk_bf16(at, bbj * em), w23 = pg8::cvt_pk_bf16(kdv * em, r * p);
                *(LAS unsigned short*)(TILE(SL_ATR) + (s * TS + lane) * 2) = (unsigned short)w01;
                *(LAS unsigned short*)(TILE(SL_BTR) + (s * TS + lane) * 2) = (unsigned short)(w01 >> 16);
                *(LAS unsigned short*)(TILE(SL_KTR) + (s * TS + lane) * 2) = (unsigned short)w23;
                *(LAS unsigned short*)(TILE(SL_RTR) + (s * TS + lane) * 2) = (unsigned short)(w23 >> 16);
                const float bbv = bbj * eL, kbv = kdv * eL;
                if (j & 1) { atc[j >> 1] |= (w01 << 16); bbt[j >> 1] = pg8::cvt_pk_bf16(__uint_as_float(bbt[j >> 1]), bbv); kbt[j >> 1] = pg8::cvt_pk_bf16(__uint_as_float(kbt[j >> 1]), kbv); vt[j >> 1] |= ((unsigned)rw[j][2] << 16); }
                else { atc[j >> 1] = w01 & 0xffffu; bbt[j >> 1] = __float_as_uint(bbv); kbt[j >> 1] = __float_as_uint(kbv); vt[j >> 1] = rw[j][2]; }
            }
            *(LAS v4u*)(TILE(SL_ATC) + (lane * TS + w * 8) * 2) = (v4u){atc[0], atc[1], atc[2], atc[3]};
            *(LAS v4u*)(TILE(SL_BBT) + (lane * TS + w * 8) * 2) = (v4u){bbt[0], bbt[1], bbt[2], bbt[3]};
            *(LAS v4u*)(TILE(SL_KBT) + (lane * TS + w * 8) * 2) = (v4u){kbt[0], kbt[1], kbt[2], kbt[3]};
            *(LAS v4u*)(TILE(SL_VT) + (lane * TS + w * 8) * 2) = (v4u){vt[0], vt[1], vt[2], vt[3]};
        }
        if (c + 1 < SEQ / 64) RAW_LOAD(c + 1);
        __syncthreads();
        f32x4 accT[2], accH[2];
        {
            const Fr aAT = ldf(TILE(SL_ATR), ta * 16, lane), aBT = ldf(TILE(SL_BTR), ta * 16, lane), aKT = ldf(TILE(SL_KTR), ta * 16, lane);
            Fr bBT[2], bKT[2], bAT[2], bRT[2];
#pragma unroll
            for (int q = 0; q < 2; ++q) { bBT[q] = ldf(TILE(SL_BTR), (tb0 + q) * 16, lane); bKT[q] = ldf(TILE(SL_KTR), (tb0 + q) * 16, lane); bAT[q] = ldf(TILE(SL_ATR), (tb0 + q) * 16, lane); bRT[q] = ldf(TILE(SL_RTR), (tb0 + q) * 16, lane); }
            f32x4 d1[2], d2[2], d3[2], d4[2];
#pragma unroll
            for (int q = 0; q < 2; ++q) { d1[q] = ZERO4; d2[q] = ZERO4; d3[q] = ZERO4; d4[q] = ZERO4; accH[q] = ZERO4;
                mmf(d1[q], aAT, bBT[q]);
                mmf(d3[q], aAT, bKT[q]);
                mmf(d2[q], aBT, bAT[q]);
                mmf(d4[q], aBT, bRT[q]);
                mmf(accH[q], aKT, bRT[q]); }
#pragma unroll
            for (int q = 0; q < 2; ++q) { const int bcol = (tb0 + q) * 16 + l15;
#pragma unroll
                for (int e = 0; e < 4; ++e) { const bool lt = bcol < a0 + e, gt = a0 + e < bcol, ge = a0 + e <= bcol;
                    d1[q][e] = lt ? d1[q][e] : 0.f; d3[q][e] = lt ? d3[q][e] : 0.f;
                    d2[q][e] = gt ? d2[q][e] : 0.f; d4[q][e] = ge ? d4[q][e] : 0.f; accH[q][e] = ge ? accH[q][e] : 0.f; }
                st4(TILE(SL_XAR), bcol, a0, d1[q]); st4(TILE(SL_NKA), bcol, a0, d3[q]); st4(TILE(SL_XAC), bcol, a0, d2[q]); st4(TILE(SL_NBRT), bcol, a0, d4[q]);
#pragma unroll
                for (int e = 0; e < 4; ++e) d2[q][e] += (a0 + e == bcol) ? 1.0f : 0.f;
                accT[q] = d2[q]; st4(TILE(SL_TTA), bcol, a0, d2[q]); }
        }
        __syncthreads();
#pragma unroll
        for (int r = 0; r <= 5; ++r) {
            LAS unsigned char* Xr = (r & 1) ? TILE(SL_XBR) : TILE(SL_XAR); LAS unsigned char* Xc = (r & 1) ? TILE(SL_XBC) : TILE(SL_XAC);
            LAS unsigned char* Xr2 = (r & 1) ? TILE(SL_XAR) : TILE(SL_XBR); LAS unsigned char* Xc2 = (r & 1) ? TILE(SL_XAC) : TILE(SL_XBC);
            LAS unsigned char* TTr = ((r - 1) & 1) ? TILE(SL_TTB) : TILE(SL_TTA); LAS unsigned char* TTw = (r & 1) ? TILE(SL_TTB) : TILE(SL_TTA);
            const Fr aXr = ldf(Xr, ta * 16, lane); Fr aXc, bTT[2], bXc[2], bXr[2];
            if (r < 5) aXc = ldf(Xc, ta * 16, lane);
#pragma unroll
            for (int q = 0; q < 2; ++q) { if (r >= 1) bTT[q] = ldf(TTr, (tb0 + q) * 16, lane); if (r < 5) { bXc[q] = ldf(Xc, (tb0 + q) * 16, lane); bXr[q] = ldf(Xr, (tb0 + q) * 16, lane); } }
            f32x4 x1[2], x2[2];
#pragma unroll
            for (int q = 0; q < 2; ++q) {
                if (r >= 1) mmf(accT[q], aXr, bTT[q]);
                if (r < 5) { x1[q] = ZERO4; x2[q] = ZERO4; mmf(x1[q], aXr, bXc[q]);
                             mmf(x2[q], aXc, bXr[q]); } }
#pragma unroll
            for (int q = 0; q < 2; ++q) { const int bcol = (tb0 + q) * 16 + l15;
                if (r >= 1) st4(TTw, bcol, a0, accT[q]);
                if (r < 5) { st4(Xc2, bcol, a0, x1[q]); st4(Xr2, bcol, a0, x2[q]); } }
            __syncthreads();
        }
        {
            const Fr aATC = ldf(TILE(SL_ATC), ta * 16, lane), aTT = ldf(TILE(SL_TTB), ta * 16, lane); Fr bTT[2], bATC[2], bNKA[2];
#pragma unroll
            for (int q = 0; q < 2; ++q) { bTT[q] = ldf(TILE(SL_TTB), (tb0 + q) * 16, lane); bATC[q] = ldf(TILE(SL_ATC), (tb0 + q) * 16, lane); bNKA[q] = ldf(TILE(SL_NKA), (tb0 + q) * 16, lane); }
            f32x4 e1[2], e2[2], e3[2];
#pragma unroll
            for (int q = 0; q < 2; ++q) { e1[q] = ZERO4; e2[q] = ZERO4; e3[q] = ZERO4;
                mmf(e1[q], aATC, bTT[q]);
                mmf(e2[q], aTT, bATC[q]);
                mmf(e3[q], aTT, bNKA[q]); }
#pragma unroll
            for (int q = 0; q < 2; ++q) { const int bcol = (tb0 + q) * 16 + l15; st4(TILE(SL_APT), bcol, a0, e1[q]); st4(TILE(SL_AP), bcol, a0, e2[q]); st4(TILE(SL_G), bcol, a0, e3[q]); }
        }
        __syncthreads();
        {
            const Fr aAP = ldf(TILE(SL_AP), ta * 16, lane), aG = ldf(TILE(SL_G), ta * 16, lane); Fr bNB[2], bBB[2]; f32x4 rp[2], ps[2];
#pragma unroll
            for (int q = 0; q < 2; ++q) { const int bcol = (tb0 + q) * 16 + l15; bNB[q] = ldf(TILE(SL_NBRT), (tb0 + q) * 16, lane); bBB[q] = ldf(TILE(SL_BBT), (tb0 + q) * 16, lane);
                rp[q] = ld4(TILE(SL_RTR), bcol, a0); ps[q] = ld4(TILE(SL_KBT), bcol, a0); }
#pragma unroll
            for (int q = 0; q < 2; ++q) { mmf(rp[q], aAP, bNB[q]);
                mmf(accH[q], aG, bNB[q]);
                mmf(ps[q], aG, bBB[q]); }
#pragma unroll
            for (int q = 0; q < 2; ++q) { const int bcol = (tb0 + q) * 16 + l15;
                st4(TILE(SL_RPT), bcol, a0, rp[q]); st4(TILE(SL_HT), bcol, a0, accH[q]); st4(TILE(SL_PSIT), bcol, a0, ps[q]); }
        }
        __syncthreads();
        if (w < 4) {
            const int vrow = w * 16 + l15;
            const Fr fS = ldf(TILE(SL_SB), w * 16, lane), fV = ldf(TILE(SL_VT), w * 16, lane);
            f32x4 wv[4], yv[4];
            {
                Fr fAPT[4];
#pragma unroll
                for (int q = 0; q < 4; ++q) fAPT[q] = ldf(TILE(SL_APT), q * 16, lane);
#pragma unroll
                for (int q = 0; q < 4; ++q) { wv[q] = ZERO4; mmf(wv[q], fAPT[q], fS); }
#pragma unroll
                for (int q = 0; q < 4; ++q) st4(TILE(SL_WB), vrow, q * 16 + 4 * g4, wv[q]);
            }
            {
                Fr fRPT[4], fHT[4];
#pragma unroll
                for (int q = 0; q < 4; ++q) { fRPT[q] = ldf(TILE(SL_RPT), q * 16, lane); fHT[q] = ldf(TILE(SL_HT), q * 16, lane); }
#pragma unroll
                for (int q = 0; q < 4; ++q) { yv[q] = ZERO4; mmf(yv[q], fS, fRPT[q]); mmf(yv[q], fV, fHT[q]); }
#pragma unroll
                for (int q = 0; q < 4; ++q) { const int s_ = c * 64 + q * 16 + l15; const int t_ = dir ? (SEQ - 1 - s_) : s_;
                    v2u o; o.x = pg8::cvt_pk_bf16(yv[q][0], yv[q][1]); o.y = pg8::cvt_pk_bf16(yv[q][2], yv[q][3]);
                    *(v2u*)(YS + ((size_t)b * SEQ + t_) * 1024 + hh * 64 + w * 16 + 4 * g4) = o; }
            }
            {
                Fr fPS[4];
#pragma unroll
                for (int q = 0; q < 4; ++q) fPS[q] = ldf(TILE(SL_PSIT), q * 16, lane);
#pragma unroll
                for (int q = 0; q < 4; ++q) { const f32x4 pl = *(const LAS f32x4*)(L + OFF_PL + (q * 16 + 4 * g4) * 4); accS[q] = accS[q] * pl; mmf(accS[q], fPS[q], fV); }
                LWAIT();
                const Fr fW = ldf(TILE(SL_WB), w * 16, lane); Fr fBB[4];
#pragma unroll
                for (int q = 0; q < 4; ++q) fBB[q] = ldf(TILE(SL_BBT), q * 16, lane);
#pragma unroll
                for (int q = 0; q < 4; ++q) { mmf(accS[q], fBB[q], fW); st4(TILE(SL_SB), vrow, q * 16 + 4 * g4, accS[q]); }
            }
        }
    }
#undef RAW_LOAD
}
#undef TILE
#undef LWAIT
}
__global__ void __launch_bounds__(NTHREADS, 2) mega_fwd(Args a) {
    extern __shared__ __attribute__((aligned(16))) unsigned char lds[];
    cg::grid_group grid = cg::this_grid();
    const int G = gridDim.x, bx = blockIdx.x;
    const int vcu = (G % 8 == 0) ? (bx % 8) * (G / 8) + bx / 8 : bx;
    const int NGW = G * NWAVES;
#define WIDS() const int tid = fresh_tid(), lane = tid & 63, wave = __builtin_amdgcn_readfirstlane(tid >> 6), gw = vcu * NWAVES + wave; (void)lane; (void)gw
    unsigned char* ws = a.ws;
    LAS unsigned char* lds3 = (LAS unsigned char*)lds;
    const int lo = a.ph_lo, hi = a.ph_hi;
#ifndef ONLY
#define ONLY -1
#endif
#define IN(k) (lo <= (k) && (k) < hi && (ONLY < 0 || ONLY == (k)))
#ifndef DUPMASK
#define DUPMASK 0
#endif
#ifndef USE_CG
#define USE_CG 0
#endif
#define GRIDBAR(k) do { if (USE_CG || a.ph_hi > 1000) grid.sync(); else xcd_barrier(bar); } while (0)
#define SEAM(k) do { if (IN(k) && IN((k) + 1)) GRIDBAR(k); } while (0)
#define PH_BEGIN(k) if (IN(k)) for (int rep_ = 0; rep_ <= ((DUPMASK >> (k)) & 1); ++rep_) { if (rep_) GRIDBAR(1);
#define PH_END(k) } SEAM(k);
    for (int u = fresh_tid(); u < 64; u += NTHREADS) ((LAS unsigned*)(lds3 + MISC_OFF))[u] = 0u;
    __syncthreads();
    XcdBarrier bar = xcd_barrier_post((unsigned*)(ws + WS_BAR), (volatile LAS unsigned*)(lds3 + MISC_OFF) + 8);

    PH_BEGIN(0) { WIDS(); p0_prologue(a, lds3, gw, NGW, wave, lane); } PH_END(0)
    PH_BEGIN(1) {
        pg8::Gemm g{(const bf16_t*)(ws + WS_HN), (const bf16_t*)(ws + WS_WINT), DM, DM, DM}; pg8::StaticOrder S; S.init(M, IN_PAD, G, bx);
        pg8::EpiProj E{(bf16_t*)(ws + WS_PDA), (bf16_t*)((unsigned char*)a.out + DO_PRW), (bf16_t*)(ws + WS_GATES)};
        pg8::gemm_phase<pg8::EpiProj, pg8::StaticOrder, true, true>(lds3, g, S, E);
        if (G == 256 && bx >= 128) { WIDS(); expert_convert(a, lds3, (bx - 128) * NWAVES + wave, 128 * NWAVES, wave, lane, 2 * 16384, 3 * 16384); }
        else if (G != 256) { WIDS(); expert_convert(a, lds3, gw, NGW, wave, lane, 2 * 16384, 3 * 16384); }
    } PH_END(1)
    PH_BEGIN(2) { WIDS(); p2_prep(a, gw, NGW, lane); } PH_END(2)
    PH_BEGIN(3) {
        const bf16_t* LIN = (const bf16_t*)((unsigned char*)a.out + DO_LIN);
        { pg8::Gemm g{LIN, (const bf16_t*)(ws + WS_BTL1), 512, 256, 256}; pg8::StaticOrder S; S.init(M, 4096, G, bx);
          pg8::EpiLora<0> E{(bf16_t*)(ws + WS_LORA), (const float*)(ws + WS_BIAS4)};
          pg8::gemm_phase<pg8::EpiLora<0>, pg8::StaticOrder, true, true>(lds3, g, S, E); }
        { pg8::Gemm g{LIN + 256, (const bf16_t*)(ws + WS_BTL2), 512, 256, 256}; pg8::StaticOrder S; S.init(M, 1024, G, bx);
          pg8::EpiLora<1> E{(bf16_t*)(ws + WS_LORA), nullptr};
          pg8::gemm_phase<pg8::EpiLora<1>, pg8::StaticOrder, true, true>(lds3, g, S, E); }
    } PH_END(3)
    PH_BEGIN(4) { WIDS();
        const float* sm = (const float*)(ws + WS_SMALL); const float d1 = wave_sum(sm[SM_LQ1 + lane] * sm[SM_LK1 + lane]), d2 = wave_sum(sm[SM_LQ2 + lane] * sm[SM_LK2 + lane]);
        const float lam = __expf(d1) - __expf(d2) + LAM_INIT;
        const bf16_t* PDA = (const bf16_t*)(ws + WS_PDA); bf16_t* YA = (bf16_t*)(ws + WS_YA);
        if (G == 256) {
            int u0, nu;
            if (bx < 128) { scan::scan_phase(a, lds); __syncthreads(); const int i = (bx & 7) * 16 + (bx >> 3); u0 = 768 + 2 * i; nu = 2; }
            else { const int k = bx - 128, i = (k & 7) * 16 + (k >> 3); u0 = 6 * i; nu = 6; }
            for (int q = 0; q < nu; ++q) { const int u = u0 + q; const int bh = u >> 5, qb = u & 31, b = bh >> 3, h = bh & 7;
                const size_t row0 = (size_t)b * SEQ;
                attn::attn_unit(PDA + (row0 + qb * 128) * 3072 + h * 128, PDA + row0 * 3072 + 1024 + h * 128, PDA + row0 * 3072 + 2048 + h * 128,
                                YA + (row0 + qb * 128) * 1024 + h * 128, lam, sm + SM_SUBLN, SEQ, (char*)lds); }
        } else {
        const int upb = 1024 / G;
        for (int i = 0; i < upb; ++i) { const int u = vcu * upb + i; const int bh = u >> 5, qb = u & 31, b = bh >> 3, h = bh & 7;
            const size_t row0 = (size_t)b * SEQ;
            attn::attn_unit(PDA + (row0 + qb * 128) * 3072 + h * 128, PDA + row0 * 3072 + 1024 + h * 128, PDA + row0 * 3072 + 2048 + h * 128,
                            YA + (row0 + qb * 128) * 1024 + h * 128, lam, sm + SM_SUBLN, SEQ, (char*)lds); }
        }
    } PH_END(4)
    if (G != 256) { PH_BEGIN(5) { scan::scan_phase(a, lds); } PH_END(5) }
    PH_BEGIN(6) { WIDS(); p6_rwpost(a, gw, NGW, lane); } PH_END(6)
    PH_BEGIN(7) {
        bf16_t* MG = (bf16_t*)(ws + WS_MERGED); const bf16_t* GT = (const bf16_t*)(ws + WS_GATES);
        { pg8::Gemm g{(const bf16_t*)(ws + WS_YA), (const bf16_t*)(ws + WS_WAT), 1024, 1024, 1024}; pg8::StaticOrder S; S.init(M, DM, G, bx);
          pg8::EpiMerge<0> E{MG, GT}; pg8::gemm_phase<pg8::EpiMerge<0>, pg8::StaticOrder, true, true>(lds3, g, S, E); }
        { pg8::Gemm g{(const bf16_t*)((unsigned char*)a.out + DO_YB), (const bf16_t*)(ws + WS_WBT), 1024, 1024, 1024}; pg8::StaticOrder S; S.init(M, DM, G, bx);
          pg8::EpiMerge<1> E{MG, GT}; pg8::gemm_phase<pg8::EpiMerge<1>, pg8::StaticOrder, true, true>(lds3, g, S, E); }
    } PH_END(7)
    PH_BEGIN(8) {
        pg8::Gemm g{(const bf16_t*)(ws + WS_MERGED), (const bf16_t*)(ws + WS_WOT), DM, DM, DM}; pg8::StaticOrder S; S.init(M, DM, G, bx);
        pg8::EpiOut E{a.in[I_X], a.out, (float*)(ws + WS_SSP)};
        pg8::gemm_phase<pg8::EpiOut, pg8::StaticOrder, true, true>(lds3, g, S, E);
    } PH_END(8)
    PH_BEGIN(9) { WIDS(); p9_router(a, lds3, gw, NGW, wave, lane); } PH_END(9)
    PH_BEGIN(10) { p10_topk(a, lds); } PH_END(10)
    if (G != 256) { PH_BEGIN(11) { WIDS(); p11_gather(a, gw, NGW, lane); } PH_END(11) }
    PH_BEGIN(12) {
        pg8::EpiMoeUp E{(bf16_t*)(ws + WS_HID)};
        if (G == 256) {
            pg8::Gemm g{(const bf16_t*)(ws + WS_HN2), (const bf16_t*)(ws + WS_W1T), DM, DM, DM}; pg8::ExpertGatherOrder S{G, bx, (const int*)(ws + WS_SELTOK)};
            pg8::gemm_phase_g<pg8::EpiMoeUp, pg8::ExpertGatherOrder, true, true>(lds3, g, S, E);
        } else {
            pg8::Gemm g{(const bf16_t*)(ws + WS_XE), (const bf16_t*)(ws + WS_W1T), DM, DM, DM}; pg8::ExpertOrder S{G, bx};
            pg8::gemm_phase<pg8::EpiMoeUp, pg8::ExpertOrder, true, true>(lds3, g, S, E);
        }
    } PH_END(12)
    PH_BEGIN(13) {
        pg8::Gemm g{(const bf16_t*)(ws + WS_HID), (const bf16_t*)(ws + WS_WDT), FF, FF, FF}; pg8::ExpertOrder S{G, bx};
        pg8::EpiMoeDown E{(bf16_t*)(ws + WS_XE), (const float*)(ws + WS_SELGATE)};
        pg8::gemm_phase<pg8::EpiMoeDown, pg8::ExpertOrder, true, true>(lds3, g, S, E);
    } PH_END(13)
    PH_BEGIN(14) { WIDS(); p14_combine(a, lds, wave, lane); } }
#undef IN
#undef SEAM
}

constexpr int NPHASES = 15;
#ifndef MK_SPLIT
#define MK_SPLIT 0
#endif
extern "C" void kernel_launch(void* const* d_in, const int* in_sizes, int n_in, void* d_out, int out_size, void* d_ws, size_t ws_size, hipStream_t stream) {
    static int grid = 0;
    if (grid == 0) {
        if (n_in != 33 || in_sizes[0] != M * DM || out_size != M * DM || ws_size < WS_NEED) {
            fprintf(stderr, "kernel_launch: unexpected shapes: n_in %d in0 %d out %d ws %zu (need %zu)\n", n_in, n_in > 0 ? in_sizes[0] : -1, out_size, ws_size, (size_t)WS_NEED); grid = -1; return; }
        int dev = 0, cus = 0, per_cu = 0;
        if (hipGetDevice(&dev) != hipSuccess || hipDeviceGetAttribute(&cus, hipDeviceAttributeMultiprocessorCount, dev) != hipSuccess) { grid = -1; return; }
        if (hipFuncSetAttribute((const void*)mega_fwd, hipFuncAttributeMaxDynamicSharedMemorySize, LDS_BYTES) != hipSuccess) { fprintf(stderr, "kernel_launch: hipFuncSetAttribute failed\n"); grid = -1; return; }
        if (hipOccupancyMaxActiveBlocksPerMultiprocessor(&per_cu, (const void*)mega_fwd, NTHREADS, LDS_BYTES) != hipSuccess || per_cu < 1) { fprintf(stderr, "kernel_launch: occupancy query says %d\n", per_cu); (void)hipGetLastError(); per_cu = 1; }
        grid = cus;
        if (grid != 256) fprintf(stderr, "kernel_launch: note: %d CUs (tuned for 256)\n", grid);
    }
    if (grid < 0) return;
    if (hipMemsetAsync((char*)d_ws + WS_BAR, 0, 16384, stream) != hipSuccess) { fprintf(stderr, "kernel_launch: memset failed\n"); return; }
    Args a{};
    for (int i = 0; i < 33; ++i) a.in[i] = (const float*)d_in[i];
    a.out = (float*)d_out; a.ws = (unsigned char*)d_ws;
#if MK_SPLIT
    for (int p = 0; p < NPHASES; ++p) { a.ph_lo = p; a.ph_hi = p + 1; void* args[] = {&a};
        hipError_t e = hipLaunchCooperativeKernel((const void*)mega_fwd, dim3(grid), dim3(NTHREADS), args, LDS_BYTES, stream);
        if (e != hipSuccess) { fprintf(stderr, "kernel_launch: launch of phase %d failed: %s\n", p, hipGetErrorString(e)); return; } }
#else
    a.ph_lo = 0; a.ph_hi = NPHASES; void* args[] = {&a};
    hipError_t e = hipLaunchCooperativeKernel((const void*)mega_fwd, dim3(grid), dim3(NTHREADS), args, LDS_BYTES, stream);
    if (e != hipSuccess) fprintf(stderr, "kernel_launch: cooperative launch failed: %s (grid %d)\n", hipGetErrorString(e), grid);
#endif
}
```

```cpp
#include <hip/hip_runtime.h>
#include <hip/hip_cooperative_groups.h>
#include <cstdio>
#include <cstdint>
namespace cg = cooperative_groups;

constexpr int NB = 4, SEQ = 4096, M = NB * SEQ, DM = 2048;
constexpr int DA_COLS = 3072, RW_COLS = 3488, RW_PAD = 3584, GATE_COLS = 4096, IN_COLS = 10656, IN_PAD = 10752;
constexpr int NE = 16, FF = 1024, CAP = 512, NSLOT = NB * NE * CAP;
constexpr float RMS_EPS = 1e-6f, GN_EPS = 64e-5f, LAM_INIT = 0.2f;
constexpr int NWAVES = 8, NTHREADS = 512;

constexpr size_t MiB = 1u << 20;
constexpr size_t WS_SSP = 5 * MiB;
constexpr size_t WS_SELTOK = 128 * 1024;
constexpr size_t WS_SELGATE = 256 * 1024;
constexpr size_t WS_BIAS4 = 512 * 1024;
constexpr size_t WS_SMALL = 576 * 1024;
constexpr int SM_QNG = 0, SM_KNG = 64, SM_LQ1 = 128, SM_LK1 = 192, SM_LQ2 = 256, SM_LK2 = 320, SM_SUBLN = 384, SM_MU = 512, SM_KK = 4096, SM_KA = 5120, SM_RK = 6144,
              SM_LNW = 7168, SM_LNB = 8192, SM_FNG = 9216, SM_WR = 11264, SM_END = 44032;
constexpr size_t WS_BAR = 768 * 1024;
constexpr size_t WS_INRM = 1 * MiB;
constexpr size_t WS_AFF = 1 * MiB;
constexpr size_t WS_ROPE = 7 * MiB;
constexpr size_t WS_BTL1 = 2 * MiB;
constexpr size_t WS_BTL2 = 4 * MiB;
constexpr size_t WS_WAT = 8 * MiB, WS_WBT = 12 * MiB, WS_WOT = 16 * MiB;
constexpr size_t WS_HN = 24 * MiB;
constexpr size_t WS_RKV = 24 * MiB;
constexpr size_t WS_WINT = 88 * MiB;
constexpr size_t WS_PDA = 130 * MiB;
constexpr size_t WS_MERGED = 130 * MiB;
constexpr size_t WS_GATES = 226 * MiB;
constexpr size_t WS_LORA = 354 * MiB;
constexpr size_t WS_YA = 514 * MiB;
constexpr size_t WS_END1 = 546 * MiB;
constexpr size_t WS_W1T = 24 * MiB;
constexpr size_t WS_WDT = 546 * MiB;
constexpr size_t WS_XE = 216 * MiB;
constexpr size_t WS_HN2 = 216 * MiB;
constexpr size_t WS_HID = 344 * MiB;
constexpr size_t WS_NEED = 610 * MiB;
constexpr size_t DO_PRW = 0, DO_LIN = 112 * MiB, DO_YSF = 0, DO_YSB = 32 * MiB, DO_YAB = 64 * MiB;

constexpr int MISC_OFF = 143360;
constexpr int LDS_BYTES = 147456;

#define LAS __attribute__((address_space(3)))
typedef unsigned short bf16_t;
typedef unsigned v4u __attribute__((ext_vector_type(4)));
typedef unsigned v2u __attribute__((ext_vector_type(2)));

__device__ __forceinline__ int fresh_tid() { int t = threadIdx.x; asm volatile("" : "+v"(t)); return t; }
__device__ __forceinline__ float bf2f(unsigned short b) { return __builtin_bit_cast(float, (unsigned)b << 16); }
__device__ __forceinline__ float bflo(unsigned w) { return __builtin_bit_cast(float, w << 16); }
__device__ __forceinline__ float bfhi(unsigned w) { return __builtin_bit_cast(float, w & 0xffff0000u); }
__device__ __forceinline__ unsigned f2bf(float f) { unsigned u = __builtin_bit_cast(unsigned, f); return (u + 0x7fffu + ((u >> 16) & 1u)) >> 16; }
typedef float f32x2_t __attribute__((ext_vector_type(2))); typedef __bf16 bf16x2_t __attribute__((ext_vector_type(2)));
__device__ __forceinline__ unsigned pk2(float lo, float hi) { f32x2_t v = {lo, hi}; bf16x2_t b = __builtin_convertvector(v, bf16x2_t); return __builtin_bit_cast(unsigned, b); }
__device__ __forceinline__ float sigmoidf_(float x) { return __builtin_amdgcn_rcpf(1.0f + __expf(-x)); }
__device__ __forceinline__ float wave_sum(float v) {
#pragma unroll
    for (int o = 1; o < 64; o <<= 1) v += __shfl_xor(v, o);
    return v;
}
__device__ __forceinline__ float sum8(float v) { v += __shfl_xor(v, 1); v += __shfl_xor(v, 2); v += __shfl_xor(v, 4); return v; }
__device__ __forceinline__ void unpack8(const v4u& w, float (&f)[8]) {
    f[0] = bflo(w.x); f[1] = bfhi(w.x); f[2] = bflo(w.y); f[3] = bfhi(w.y); f[4] = bflo(w.z); f[5] = bfhi(w.z); f[6] = bflo(w.w); f[7] = bfhi(w.w);
}
__device__ __forceinline__ v4u pack8(const float (&f)[8]) { v4u w; w.x = pk2(f[0], f[1]); w.y = pk2(f[2], f[3]); w.z = pk2(f[4], f[5]); w.w = pk2(f[6], f[7]); return w; }

#define XB_TMO      128
#define XB_XCNT(j)  (256  + 64 * (j))
#define XB_XSUB(j)  (1280 + 64 * (j))
#define XB_XGEN(j)  (2304 + 64 * (j))
#define XB_TOP      3328
#define XB_TOPGEN   3392
#define XCD_BAR_WORDS 3456
#define XB_SPIN_CAP (1u << 18)

__device__ __forceinline__ unsigned xb_ld(unsigned* p)              { return __hip_atomic_load(p, __ATOMIC_RELAXED, __HIP_MEMORY_SCOPE_AGENT); }
__device__ __forceinline__ unsigned xb_add(unsigned* p, unsigned v) { return __hip_atomic_fetch_add(p, v, __ATOMIC_RELAXED, __HIP_MEMORY_SCOPE_AGENT); }
__device__ __forceinline__ unsigned xb_xcc_id() { return (unsigned)__builtin_amdgcn_s_getreg((3 << 11) | 20) & 0xFu; }
#define XB_SPIN(cond, bar) do { unsigned _sp = 0; while (cond) { __builtin_amdgcn_s_sleep(1); \
    if ((++_sp & 255u) == 0u) { if (xb_ld(&(bar)[XB_TMO])) break; if (_sp > XB_SPIN_CAP) { atomicAdd(&(bar)[XB_TMO], 1u); break; } } } } while (0)

struct XcdBarrier {
    unsigned* bar; unsigned x;
    volatile LAS unsigned* st;
};

__device__ __forceinline__ XcdBarrier xcd_barrier_post(unsigned* bar, volatile LAS unsigned* st) {
    XcdBarrier b; b.bar = bar; b.x = xb_xcc_id(); b.st = st;
    if (threadIdx.x == 0) (void)xb_add(&bar[XB_XCNT(b.x)], 1u);
    return b;
}
__device__ __forceinline__ void xcd_barrier_complete(unsigned* bar, unsigned x, unsigned& nloc, unsigned& nx) {
    const unsigned G = gridDim.x * gridDim.y * gridDim.z;
    unsigned sum, cnt, mine, sp = 0u;
    for (;;) {
        sum = 0u; cnt = 0u; mine = 0u;
#pragma unroll
        for (unsigned j = 0; j < 16; ++j) { const unsigned c = xb_ld(&bar[XB_XCNT(j)]); sum += c; cnt += (c > 0u) ? 1u : 0u; mine = (j == x) ? c : mine; }
        if (sum == G) break;
        __builtin_amdgcn_s_sleep(1);
        if ((++sp & 255u) == 0u) { if (xb_ld(&bar[XB_TMO])) break; if (sp > XB_SPIN_CAP) { atomicAdd(&bar[XB_TMO], 1u); break; } }
    }
    nloc = mine > 0u ? mine : 1u; nx = cnt > 0u ? cnt : 1u;
}

__device__ __forceinline__ void xcd_barrier(const XcdBarrier& b) {
    asm volatile("s_waitcnt vmcnt(0)" ::: "memory");
    __syncthreads();
    if (threadIdx.x == 0) {
        unsigned* bar = b.bar;
        __builtin_amdgcn_s_waitcnt(0);
        unsigned nloc = b.st[0], nx = b.st[1];
        if (nloc == 0u) { xcd_barrier_complete(bar, b.x, nloc, nx); b.st[0] = nloc; b.st[1] = nx; }
        const unsigned old = xb_add(&bar[XB_XSUB(b.x)], 1u);
        const unsigned gen = old / nloc;
        if (old + 1u == (gen + 1u) * nloc) {
            __builtin_amdgcn_fence(__ATOMIC_RELEASE, "agent");
            asm volatile("s_waitcnt vmcnt(0)" ::: "memory");
            const unsigned og = xb_add(&bar[XB_TOP], 1u);
            const unsigned tg = og / nx;
            if (og + 1u == (tg + 1u) * nx) xb_add(&bar[XB_TOPGEN], 1u);
            else XB_SPIN(xb_ld(&bar[XB_TOPGEN]) == tg, bar);
            __builtin_amdgcn_fence(__ATOMIC_ACQUIRE, "agent");
            xb_add(&bar[XB_XGEN(b.x)], 1u);
            asm volatile("s_waitcnt vmcnt(0)" ::: "memory");
        } else {
            XB_SPIN(xb_ld(&bar[XB_XGEN(b.x)]) == gen, bar);
            __builtin_amdgcn_fence(__ATOMIC_ACQUIRE, "agent");
            asm volatile("s_waitcnt vmcnt(0)" ::: "memory");
        }
    }
    __syncthreads();
}
namespace pg8 {
#define PG8_LAS __attribute__((address_space(3)))
typedef unsigned short bf16_t;
typedef short bf16x8 __attribute__((ext_vector_type(8)));
typedef float f32x4 __attribute__((ext_vector_type(4)));
typedef unsigned u32x4 __attribute__((ext_vector_type(4)));
constexpr int BM = 256, BK = 64, HALF = 128, HTB = HALF * BK * 2  , STAGE_BYTES = 8 * HTB, NXCD = 8, WGM = 4;

__host__ __device__ __forceinline__ int lds_byte(int r, int c) { const int st = (r >> 4) * 2 + (c >> 5), rr = r & 15, cc = c & 31, ob = rr * 64 + cc * 2; return st * 1024 + (ob ^ (((ob >> 9) & 1) << 5)); }
__host__ __device__ __forceinline__ void stage_rc(int b, int& R, int& C) { const int st = b / 1024, sb = b % 1024, swz = sb ^ (((sb >> 9) & 1) << 5); R = (st >> 1) * 16 + swz / 64; C = (st & 1) * 32 + (swz % 64) / 2; }
__host__ __device__ __forceinline__ int perm32(int rho) { const int n = rho >> 4, i = rho & 15; return 8 * (i >> 2) + 4 * n + (i & 3); }

struct Unit { int pm, pn; };
struct Gemm { const bf16_t* A; const bf16_t* Bt; int lda, ldb, K; };

struct StaticOrder {
    int nM, nN, nwg, G, c;
    __host__ __device__ void init(int M, int N, int G_, int c_) { nM = M / BM; nN = N / BM; nwg = nM * nN; G = G_; c = c_; }
    __host__ __device__ bool next(int i, Unit& u) const {
        const long L = (long)i * G + c; if (L >= nwg) return false;
        int wgid = (int)L; { const int q = nwg / NXCD, r = nwg % NXCD, xcd = wgid % NXCD, off = wgid / NXCD; wgid = (xcd < r ? xcd * (q + 1) : r * (q + 1) + (xcd - r) * q) + off; }
        const int nig = WGM * nN, gid = wgid / nig, fm = gid * WGM, gsz = (nM - fm) < WGM ? (nM - fm) : WGM;
        u.pm = fm + ((wgid % nig) % gsz); u.pn = (wgid % nig) / gsz; return true;
    }
    __device__ __forceinline__ void a_ready(const Unit&) const {}
    __device__ __forceinline__ void done(const Unit&) const {}
};

__device__ __forceinline__ unsigned cvt_pk_bf16(float lo, float hi) { return pk2(lo, hi); }
__device__ __forceinline__ u32x4 pack_bf16x8(const f32x4& v0, const f32x4& v1) { u32x4 w; w.x = cvt_pk_bf16(v0[0], v0[1]); w.y = cvt_pk_bf16(v0[2], v0[3]); w.z = cvt_pk_bf16(v1[0], v1[1]); w.w = cvt_pk_bf16(v1[2], v1[3]); return w; }
__device__ __forceinline__ float sigm(float x) { return __builtin_amdgcn_rcpf(1.0f + __expf(-x)); }
__device__ __forceinline__ f32x4 sigm4(f32x4 v) { return (f32x4){sigm(v[0]), sigm(v[1]), sigm(v[2]), sigm(v[3])}; }
__device__ __forceinline__ void unpk8(const u32x4& w, f32x4& a, f32x4& b) {
    a = (f32x4){__builtin_bit_cast(float, w.x << 16), __builtin_bit_cast(float, w.x & 0xffff0000u), __builtin_bit_cast(float, w.y << 16), __builtin_bit_cast(float, w.y & 0xffff0000u)};
    b = (f32x4){__builtin_bit_cast(float, w.z << 16), __builtin_bit_cast(float, w.z & 0xffff0000u), __builtin_bit_cast(float, w.w << 16), __builtin_bit_cast(float, w.w & 0xffff0000u)};
}

struct EpiProj {
    static constexpr bool PERM = true, AFTER_DRAIN = false, HAS_MID = false;
    bf16_t* pda; bf16_t* prw; bf16_t* gates;
    __device__ __forceinline__ void operator()(const f32x4 (&acc)[2][2][4][2], const Unit& u, int wr, int wc, int fr, int fq) const {
        const int row0 = u.pm * BM + wr * 64 + fr;
        if (u.pn >= 26) {
            const int col0 = (u.pn - 26) * 128 + wc * 32 + 8 * fq;
#pragma unroll
            for (int ai = 0; ai < 2; ++ai)
#pragma unroll
                for (int m = 0; m < 4; ++m) { bf16_t* rowp = gates + (size_t)(row0 + ai * HALF + m * 16) * 4096 + col0;
                    f32x4 rt[2], gb[2];
#pragma unroll
                    for (int n = 0; n < 2; ++n)
#pragma unroll
                        for (int e = 0; e < 4; ++e) { const float ea = __expf(-acc[ai][0][m][n][e]), eb = __expf(-acc[ai][1][m][n][e]);
                            gb[n][e] = __builtin_amdgcn_rcpf(1.0f + eb); rt[n][e] = (1.0f + eb) * __builtin_amdgcn_rcpf(1.0f + ea); }
                    *(u32x4*)rowp = pack_bf16x8(rt[0], rt[1]); *(u32x4*)(rowp + 2048) = pack_bf16x8(gb[0], gb[1]); }
            return;
        }
        bf16_t* base; int ldc, colt;
        if (u.pn < 12) { base = pda; ldc = 3072; colt = u.pn * 256; }
        else { base = prw; ldc = 3584; colt = (u.pn - 12) * 256; }
        const int col0 = colt + wc * 32 + 8 * fq;
#pragma unroll
        for (int ai = 0; ai < 2; ++ai)
#pragma unroll
            for (int m = 0; m < 4; ++m) { bf16_t* rowp = base + (size_t)(row0 + ai * HALF + m * 16) * ldc + col0;
#pragma unroll
                for (int bj = 0; bj < 2; ++bj) *(u32x4*)(rowp + bj * HALF) = pack_bf16x8(acc[ai][bj][m][0], acc[ai][bj][m][1]); }
    }
};
template <int KIND> struct EpiLora {
    static constexpr bool PERM = true, AFTER_DRAIN = false, HAS_MID = false;
    bf16_t* out; const float* bias4;
    __device__ __forceinline__ void operator()(const f32x4 (&acc)[2][2][4][2], const Unit& u, int wr, int wc, int fr, int fq) const {
        const int seg = (KIND == 0) ? (u.pn >> 2) : 4, colt = (KIND == 0) ? (u.pn & 3) * 256 : u.pn * 256;
        bf16_t* base = out + (size_t)seg * ((size_t)M * 1024);
        const float* bias = bias4 + (seg & 3) * 1024;
        const int row0 = u.pm * BM + wr * 64 + fr, col0 = colt + wc * 32 + 8 * fq;
        const float sc = (seg < 2) ? -0.60653065971f : 1.0f;
#pragma unroll
        for (int bj = 0; bj < 2; ++bj) {
            f32x4 bv0 = (f32x4){0.f, 0.f, 0.f, 0.f}, bv1 = bv0;
            if (KIND == 0) { bv0 = *(const f32x4*)(bias + col0 + bj * HALF); bv1 = *(const f32x4*)(bias + col0 + bj * HALF + 4); }
#pragma unroll
            for (int ai = 0; ai < 2; ++ai)
#pragma unroll
                for (int m = 0; m < 4; ++m) { bf16_t* rowp = base + (size_t)(row0 + ai * HALF + m * 16) * 1024 + col0;
                    f32x4 v0 = acc[ai][bj][m][0] + bv0, v1 = acc[ai][bj][m][1] + bv1;
                    if (KIND == 0) { v0 = sigm4(v0) * sc; v1 = sigm4(v1) * sc; }
                    *(u32x4*)(rowp + bj * HALF) = pack_bf16x8(v0, v1); }
        }
    }
};
struct EpiMergeF {
    static constexpr bool PERM = true, AFTER_DRAIN = false, HAS_MID = true;
    bf16_t* merged; const bf16_t* gates;
    template <int HALFSEL> __device__ __forceinline__ void scale(f32x4 (&acc)[2][2][4][2], const Unit& u, int wr, int wc, int fr, int fq, bool store) const {
        int row0 = u.pm * BM + wr * 64 + fr, col0 = u.pn * 256 + wc * 32 + 8 * fq;
        asm volatile("" : "+v"(row0), "+v"(col0));
#pragma unroll
        for (int ai = 0; ai < 2; ++ai)
#pragma unroll
            for (int mh = 0; mh < 2; ++mh) {
                u32x4 gw[2][2];
#pragma unroll
                for (int mm = 0; mm < 2; ++mm)
#pragma unroll
                    for (int bj = 0; bj < 2; ++bj) gw[mm][bj] = *(const u32x4*)(gates + (size_t)(row0 + ai * HALF + (2 * mh + mm) * 16) * 4096 + HALFSEL * 2048 + col0 + bj * HALF);
#pragma unroll
                for (int mm = 0; mm < 2; ++mm)
#pragma unroll
                    for (int bj = 0; bj < 2; ++bj) { const int m = 2 * mh + mm; f32x4 g0, g1; unpk8(gw[mm][bj], g0, g1);
                        acc[ai][bj][m][0] *= g0; acc[ai][bj][m][1] *= g1;
                        if (store) *(u32x4*)(merged + (size_t)(row0 + ai * HALF + m * 16) * 2048 + col0 + bj * HALF) = pack_bf16x8(acc[ai][bj][m][0], acc[ai][bj][m][1]); }
                asm volatile("" ::: "memory");
            }
    }
    __device__ __forceinline__ void mid(f32x4 (&acc)[2][2][4][2], const Unit& u, int wr, int wc, int fr, int fq) const { scale<0>(acc, u, wr, wc, fr, fq, false); }
    __device__ __forceinline__ void operator()(const f32x4 (&acc)[2][2][4][2], const Unit& u, int wr, int wc, int fr, int fq) const {
        f32x4 (&ac)[2][2][4][2] = const_cast<f32x4 (&)[2][2][4][2]>(acc); scale<1>(ac, u, wr, wc, fr, fq, true); }
};
struct EpiOut {
    static constexpr bool PERM = false, AFTER_DRAIN = false, HAS_MID = false;
    const float* x; float* out; float* ss;
    __device__ __forceinline__ void operator()(const f32x4 (&acc)[2][2][4][2], const Unit& u, int wr, int wc, int fr, int fq) const {
        const int row0 = u.pm * BM + wr * 64 + fr, col0 = u.pn * 256 + wc * 32 + 4 * fq;
#pragma unroll
        for (int ai = 0; ai < 2; ++ai) {
            f32x4 xv[4][2][2];
#pragma unroll
            for (int m = 0; m < 4; ++m)
#pragma unroll
                for (int bj = 0; bj < 2; ++bj)
#pragma unroll
                    for (int n = 0; n < 2; ++n) xv[m][bj][n] = *(const f32x4*)(x + (size_t)(row0 + ai * HALF + m * 16) * 2048 + col0 + bj * HALF + n * 16);
#pragma unroll
            for (int m = 0; m < 4; ++m) { const size_t r = (size_t)(row0 + ai * HALF + m * 16); float s = 0.f;
#pragma unroll
                for (int bj = 0; bj < 2; ++bj)
#pragma unroll
                    for (int n = 0; n < 2; ++n) { const f32x4 h = xv[m][bj][n] + acc[ai][bj][m][n]; *(f32x4*)(out + r * 2048 + col0 + bj * HALF + n * 16) = h;
                        s += (h[0] * h[0] + h[1] * h[1]) + (h[2] * h[2] + h[3] * h[3]); }
                s += __shfl_xor(s, 16); s += __shfl_xor(s, 32);
                if (fq == 0) ss[r * 32 + u.pn * 4 + wc] = s; }
        }
    }
};
struct EpiMoeUp {
    static constexpr bool PERM = true, AFTER_DRAIN = false, HAS_MID = false;
    bf16_t* hid;
    __device__ __forceinline__ void operator()(const f32x4 (&acc)[2][2][4][2], const Unit& u, int wr, int wc, int fr, int fq) const {
        const int row0 = u.pm * BM + wr * 64 + fr, col0 = (u.pn & 7) * 128 + wc * 32 + 8 * fq;
#pragma unroll
        for (int ai = 0; ai < 2; ++ai)
#pragma unroll
            for (int m = 0; m < 4; ++m) { bf16_t* rowp = hid + (size_t)(row0 + ai * HALF + m * 16) * 1024 + col0;
                const f32x4 g0 = acc[ai][0][m][0], g1 = acc[ai][0][m][1], u0 = acc[ai][1][m][0], u1 = acc[ai][1][m][1];
                const f32x4 v0 = g0 * sigm4(g0) * u0, v1 = g1 * sigm4(g1) * u1;
                *(u32x4*)rowp = pack_bf16x8(v0, v1); }
    }
};
struct EpiMoeDown {
    static constexpr bool PERM = true, AFTER_DRAIN = false, HAS_MID = false;
    bf16_t* ye; const float* selgate;
    __device__ __forceinline__ void operator()(const f32x4 (&acc)[2][2][4][2], const Unit& u, int wr, int wc, int fr, int fq) const {
        const int row0 = u.pm * BM + wr * 64 + fr, col0 = (u.pn & 7) * 256 + wc * 32 + 8 * fq;
#pragma unroll
        for (int ai = 0; ai < 2; ++ai)
#pragma unroll
            for (int m = 0; m < 4; ++m) { const int r = row0 + ai * HALF + m * 16; const int e = r >> 11, b = (r >> 9) & 3, c = r & 511;
                const float g = selgate[(b * 16 + e) * 512 + c];
                bf16_t* rowp = ye + (size_t)r * 2048 + col0;
#pragma unroll
                for (int bj = 0; bj < 2; ++bj) *(u32x4*)(rowp + bj * HALF) = pack_bf16x8(acc[ai][bj][m][0] * g, acc[ai][bj][m][1] * g); }
    }
};
struct ExpertOrder {
    int G, c;
    __device__ __forceinline__ bool next(int i, Unit& u) const {
        const int L = i * G + c; if (L >= 1024) return false;
        const int wgid = (L % NXCD) * (1024 / NXCD) + L / NXCD;
        const int e = wgid >> 6, r = wgid & 63; u.pm = e * 8 + (r & 3) + 4 * ((r >> 5) & 1); u.pn = e * 8 + ((r >> 2) & 7); return true;
    }
    __device__ __forceinline__ void a_ready(const Unit&) const {}
    __device__ __forceinline__ void done(const Unit&) const {}
};

struct ExpertGatherOrder {
    int G, c; const int* seltok;
    __device__ __forceinline__ bool next(int i, Unit& u) const {
        const int L = i * G + c; if (L >= 1024) return false;
        const int wgid = (L % NXCD) * (1024 / NXCD) + L / NXCD;
        const int e = wgid >> 6, r = wgid & 63; u.pm = e * 8 + (r & 3) + 4 * ((r >> 5) & 1); u.pn = e * 8 + ((r >> 2) & 7); return true;
    }
    __device__ __forceinline__ int arow(int r) const { const int e = r >> 11, b = (r >> 9) & 3, cc = r & 511; return b * 4096 + seltok[(b * 16 + e) * 512 + cc]; }
    __device__ __forceinline__ void a_ready(const Unit&) const {}
    __device__ __forceinline__ void done(const Unit&) const {}
};
template <class Epi, class Sched, bool ALIGN_EPI = false, bool SP2 = false>
__device__ __forceinline__ void gemm_phase(PG8_LAS unsigned char* lds, const Gemm g, const Sched& S, const Epi& E) {
    const int tid = fresh_tid(), wid = __builtin_amdgcn_readfirstlane(tid >> 6), lane = tid & 63, wr = wid >> 2, wc = wid & 3, fr = lane & 15, fq = lane >> 4;
    const int K = g.K, nt = K / BK;
    unsigned voffA[2], voffB[2];
#pragma unroll
    for (int i = 0; i < 2; ++i) { int R, C; stage_rc(tid * 16 + i * 8192, R, C); const int Rb = Epi::PERM ? ((R & ~31) + perm32(R & 31)) : R;
        voffA[i] = (unsigned)(R * g.lda + C) * 2u; voffB[i] = (unsigned)(Rb * g.ldb + C) * 2u; }
    const size_t kstep = (size_t)(BK * 2);
    const size_t hsA = (size_t)HALF * g.lda * 2, hsB = (size_t)HALF * g.ldb * 2;
    const size_t tsA = 2 * hsA, tsB = 2 * hsB;
    const unsigned ldsw = (unsigned)wid * 1024u;
    const int aoff = lds_byte(wr * 64 + fr, fq * 8), boff = lds_byte(wc * 32 + fr, fq * 8);
#define PG8_SA(b, h) (((b) * 2 + (h)) * HTB)
#define PG8_SB(b, h) ((4 + (b) * 2 + (h)) * HTB)
#define PG8_STAGE(bufoff, gbase, voff) do { _Pragma("unroll") for (int _i = 0; _i < 2; ++_i) \
        __builtin_amdgcn_global_load_lds((const unsigned*)((const char*)(gbase) + (voff)[_i]), (PG8_LAS unsigned*)(lds + (bufoff) + ldsw + _i * 8192), 16, 0, 0); } while (0)
#define PG8_LDA(dst, b, h) do { _Pragma("unroll") for (int m = 0; m < 4; ++m) _Pragma("unroll") for (int k = 0; k < 2; ++k) dst[m][k] = *(const PG8_LAS bf16x8*)(lds + PG8_SA(b, h) + aoff + m * 2048 + k * 1024); } while (0)
#define PG8_LDB(dst, b, h) do { _Pragma("unroll") for (int n = 0; n < 2; ++n) _Pragma("unroll") for (int k = 0; k < 2; ++k) dst[n][k] = *(const PG8_LAS bf16x8*)(lds + PG8_SB(b, h) + boff + n * 2048 + k * 1024); } while (0)
#define PG8_MMA(ai, bj, At, Bt) do { __builtin_amdgcn_s_setprio(1); _Pragma("unroll") for (int m = 0; m < 4; ++m) _Pragma("unroll") for (int n = 0; n < 2; ++n) _Pragma("unroll") for (int k = 0; k < 2; ++k) \
        acc[ai][bj][m][n] = __builtin_amdgcn_mfma_f32_16x16x32_bf16(Bt[n][k], At[m][k], acc[ai][bj][m][n], 0, 0, 0); __builtin_amdgcn_s_setprio(0); } while (0)
#define PG8_WAIT_V(n) asm volatile("s_waitcnt vmcnt(" #n ")" ::: "memory")
#define PG8_WAIT_L(n) asm volatile("s_waitcnt lgkmcnt(" #n ")" ::: "memory")
#define PG8_BAR __builtin_amdgcn_s_barrier()
#define PG8_SCHED __builtin_amdgcn_sched_barrier(0)
    Unit cur, nxt; int ui = 0;
    if (!S.next(0, cur)) return;
    f32x4 acc[2][2][4][2];
#pragma unroll
    for (int a = 0; a < 2; ++a)
#pragma unroll
        for (int b = 0; b < 2; ++b)
#pragma unroll
            for (int m = 0; m < 4; ++m)
#pragma unroll
                for (int n = 0; n < 2; ++n) acc[a][b][m][n] = (f32x4){0.f, 0.f, 0.f, 0.f};
    bf16x8 At[4][2], B0[2][2], B1[2][2];
    const char* cA = (const char*)g.A + (size_t)cur.pm * tsA; const char* cB = (const char*)g.Bt + (size_t)cur.pn * tsB;
    S.a_ready(cur);
    if constexpr (SP2) {
        PG8_STAGE(PG8_SB(0, 0), cB, voffB); PG8_STAGE(PG8_SB(0, 1), cB + hsB, voffB); PG8_STAGE(PG8_SA(0, 0), cA, voffA); PG8_STAGE(PG8_SA(0, 1), cA + hsA, voffA);
        if (wr == 1) PG8_BAR;
        PG8_WAIT_V(2); PG8_BAR;
        PG8_STAGE(PG8_SB(1, 0), cB + kstep, voffB); PG8_STAGE(PG8_SA(1, 0), cA + kstep, voffA); PG8_STAGE(PG8_SB(1, 1), cB + hsB + kstep, voffB);
        PG8_WAIT_V(6); PG8_BAR;
    } else {
        PG8_STAGE(PG8_SB(0, 0), cB, voffB); PG8_STAGE(PG8_SA(0, 0), cA, voffA); PG8_STAGE(PG8_SB(0, 1), cB + hsB, voffB); PG8_STAGE(PG8_SA(0, 1), cA + hsA, voffA);
        if (wr == 1) PG8_BAR;
        PG8_WAIT_V(4); PG8_BAR;
        PG8_STAGE(PG8_SB(1, 0), cB + kstep, voffB); PG8_STAGE(PG8_SA(1, 0), cA + kstep, voffA); PG8_STAGE(PG8_SB(1, 1), cB + hsB + kstep, voffB);
        PG8_WAIT_V(6); PG8_BAR;
    }
    for (;;) {
        const bool has_next = S.next(ui + 1, nxt);
        const char* nA = has_next ? (const char*)g.A + (size_t)nxt.pm * tsA : cA; const char* nB = has_next ? (const char*)g.Bt + (size_t)nxt.pn * tsB : cB;
#pragma unroll 1
        for (int t = 0; t < nt; t += 2) {
            const bool last = (t == nt - 2);
            const char* a1 = cA + (size_t)(t + 1) * kstep;
            const char* a2 = last ? nA : cA + (size_t)(t + 2) * kstep; const char* b2 = last ? nB : cB + (size_t)(t + 2) * kstep;
            const char* a3 = a2 + kstep; const char* b3 = b2 + kstep;
            if (last && has_next) S.a_ready(nxt);
            if constexpr (Epi::HAS_MID) { if (t == nt / 2) E.mid(acc, cur, wr, wc, fr, fq); }
            if constexpr (SP2) {
            PG8_LDB(B0, 0, 0); PG8_LDB(B1, 0, 1); PG8_SCHED; PG8_LDA(At, 0, 0); PG8_STAGE(PG8_SA(1, 1), a1 + hsA, voffA);
            PG8_WAIT_V(8); PG8_WAIT_L(0); PG8_BAR; PG8_MMA(0, 0, At, B0); PG8_MMA(0, 1, At, B1); PG8_BAR; PG8_SCHED;
            PG8_LDA(At, 0, 1); PG8_STAGE(PG8_SB(0, 0), b2, voffB); PG8_STAGE(PG8_SB(0, 1), b2 + hsB, voffB); PG8_STAGE(PG8_SA(0, 0), a2, voffA);
            PG8_WAIT_V(8); PG8_WAIT_L(0); PG8_BAR; PG8_MMA(1, 0, At, B0); PG8_MMA(1, 1, At, B1); PG8_BAR; PG8_SCHED;
            PG8_LDB(B0, 1, 0); PG8_LDB(B1, 1, 1); PG8_SCHED; PG8_LDA(At, 1, 0); PG8_STAGE(PG8_SA(0, 1), a2 + hsA, voffA);
            PG8_WAIT_V(8); PG8_WAIT_L(0); PG8_BAR; PG8_MMA(0, 0, At, B0); PG8_MMA(0, 1, At, B1); PG8_BAR; PG8_SCHED;
            PG8_LDA(At, 1, 1); PG8_STAGE(PG8_SB(1, 0), b3, voffB); PG8_STAGE(PG8_SB(1, 1), b3 + hsB, voffB); PG8_STAGE(PG8_SA(1, 0), a3, voffA);
            PG8_WAIT_V(8); PG8_WAIT_L(0); PG8_BAR; PG8_MMA(1, 0, At, B0); PG8_MMA(1, 1, At, B1); PG8_BAR; PG8_SCHED;
            } else {
            PG8_LDB(B0, 0, 0); PG8_SCHED; PG8_LDA(At, 0, 0); PG8_STAGE(PG8_SA(1, 1), a1 + hsA, voffA);
            PG8_WAIT_L(8); PG8_BAR; PG8_WAIT_L(0); PG8_MMA(0, 0, At, B0); PG8_BAR; PG8_SCHED;
            PG8_LDB(B1, 0, 1); PG8_STAGE(PG8_SB(0, 0), b2, voffB);
            PG8_BAR; PG8_WAIT_L(0); PG8_MMA(0, 1, At, B1); PG8_BAR;
            PG8_LDA(At, 0, 1); PG8_STAGE(PG8_SA(0, 0), a2, voffA);
            PG8_BAR; PG8_WAIT_L(0); PG8_MMA(1, 0, At, B0); PG8_BAR; PG8_SCHED;
            PG8_STAGE(PG8_SB(0, 1), b2 + hsB, voffB);
            PG8_WAIT_V(6); PG8_BAR; PG8_MMA(1, 1, At, B1); PG8_BAR;
            PG8_LDB(B0, 1, 0); PG8_SCHED; PG8_LDA(At, 1, 0); PG8_STAGE(PG8_SA(0, 1), a2 + hsA, voffA);
            PG8_WAIT_L(8); PG8_BAR; PG8_WAIT_L(0); PG8_MMA(0, 0, At, B0); PG8_BAR; PG8_SCHED;
            PG8_LDB(B1, 1, 1); PG8_STAGE(PG8_SB(1, 0), b3, voffB);
            PG8_BAR; PG8_WAIT_L(0); PG8_MMA(0, 1, At, B1); PG8_BAR;
            PG8_LDA(At, 1, 1); PG8_STAGE(PG8_SA(1, 0), a3, voffA);
            PG8_BAR; PG8_WAIT_L(0); PG8_MMA(1, 0, At, B0); PG8_BAR; PG8_SCHED;
            PG8_STAGE(PG8_SB(1, 1), b3 + hsB, voffB);
            PG8_WAIT_V(6); PG8_BAR; PG8_MMA(1, 1, At, B1); PG8_BAR;
            }
        }
        if constexpr (ALIGN_EPI) { if (wr == 0) PG8_BAR; }
        if constexpr (!Epi::AFTER_DRAIN) { E(acc, cur, wr, wc, fr, fq); S.done(cur); }
        if (!has_next) break;
#pragma unroll
        for (int a = 0; a < 2; ++a)
#pragma unroll
            for (int b = 0; b < 2; ++b)
#pragma unroll
                for (int m = 0; m < 4; ++m)
#pragma unroll
                    for (int n = 0; n < 2; ++n) acc[a][b][m][n] = (f32x4){0.f, 0.f, 0.f, 0.f};
        cur = nxt; cA = nA; cB = nB; ++ui;
        if constexpr (ALIGN_EPI) { if (wr == 1) PG8_BAR; }
    }
    PG8_WAIT_V(0);
    if constexpr (!ALIGN_EPI) { if (wr == 0) PG8_BAR; }
    PG8_BAR;
    if constexpr (Epi::AFTER_DRAIN) { E.fused(acc, cur, wr, wc, fr, fq, lds, wid, lane); S.done(cur); }
#undef PG8_SA
#undef PG8_SB
#undef PG8_STAGE
#undef PG8_LDA
#undef PG8_LDB
#undef PG8_MMA
#undef PG8_WAIT_V
#undef PG8_WAIT_L
#undef PG8_BAR
#undef PG8_SCHED
}

template <class Epi, class Sched, bool ALIGN_EPI = false, bool SP2 = false>
__device__ __forceinline__ void gemm_phase_g(PG8_LAS unsigned char* lds, const Gemm g, const Sched& S, const Epi& E) {
    const int tid = fresh_tid(), wid = __builtin_amdgcn_readfirstlane(tid >> 6), lane = tid & 63, wr = wid >> 2, wc = wid & 3, fr = lane & 15, fq = lane >> 4;
    const int K = g.K, nt = K / BK;
    unsigned voffB[2]; int RAr[2]; unsigned CAb[2];
#pragma unroll
    for (int i = 0; i < 2; ++i) { int R, C; stage_rc(tid * 16 + i * 8192, R, C); const int Rb = Epi::PERM ? ((R & ~31) + perm32(R & 31)) : R;
        RAr[i] = R; CAb[i] = (unsigned)C * 2u; voffB[i] = (unsigned)(Rb * g.ldb + C) * 2u; }
    const size_t kstep = (size_t)(BK * 2);
    const size_t hsA = (size_t)HALF * g.lda * 2, hsB = (size_t)HALF * g.ldb * 2;
    const size_t tsA = 2 * hsA, tsB = 2 * hsB;
    const unsigned ldsw = (unsigned)wid * 1024u;
    const int aoff = lds_byte(wr * 64 + fr, fq * 8), boff = lds_byte(wc * 32 + fr, fq * 8);
#define PG8_SA(b, h) (((b) * 2 + (h)) * HTB)
#define PG8_SB(b, h) ((4 + (b) * 2 + (h)) * HTB)
#define PG8_STAGE(bufoff, gbase, voff) do { _Pragma("unroll") for (int _i = 0; _i < 2; ++_i) \
        __builtin_amdgcn_global_load_lds((const unsigned*)((const char*)(gbase) + (voff)[_i]), (PG8_LAS unsigned*)(lds + (bufoff) + ldsw + _i * 8192), 16, 0, 0); } while (0)
#define PG8_LDA(dst, b, h) do { _Pragma("unroll") for (int m = 0; m < 4; ++m) _Pragma("unroll") for (int k = 0; k < 2; ++k) dst[m][k] = *(const PG8_LAS bf16x8*)(lds + PG8_SA(b, h) + aoff + m * 2048 + k * 1024); } while (0)
#define PG8_LDB(dst, b, h) do { _Pragma("unroll") for (int n = 0; n < 2; ++n) _Pragma("unroll") for (int k = 0; k < 2; ++k) dst[n][k] = *(const PG8_LAS bf16x8*)(lds + PG8_SB(b, h) + boff + n * 2048 + k * 1024); } while (0)
#define PG8_MMA(ai, bj, At, Bt) do { __builtin_amdgcn_s_setprio(1); _Pragma("unroll") for (int m = 0; m < 4; ++m) _Pragma("unroll") for (int n = 0; n < 2; ++n) _Pragma("unroll") for (int k = 0; k < 2; ++k) \
        acc[ai][bj][m][n] = __builtin_amdgcn_mfma_f32_16x16x32_bf16(Bt[n][k], At[m][k], acc[ai][bj][m][n], 0, 0, 0); __builtin_amdgcn_s_setprio(0); } while (0)
#define PG8_WAIT_V(n) asm volatile("s_waitcnt vmcnt(" #n ")" ::: "memory")
#define PG8_WAIT_L(n) asm volatile("s_waitcnt lgkmcnt(" #n ")" ::: "memory")
#define PG8_BAR __builtin_amdgcn_s_barrier()
#define PG8_SCHED __builtin_amdgcn_sched_barrier(0)
    Unit cur, nxt; int ui = 0;
    if (!S.next(0, cur)) return;
    f32x4 acc[2][2][4][2];
#pragma unroll
    for (int a = 0; a < 2; ++a)
#pragma unroll
        for (int b = 0; b < 2; ++b)
#pragma unroll
            for (int m = 0; m < 4; ++m)
#pragma unroll
                for (int n = 0; n < 2; ++n) acc[a][b][m][n] = (f32x4){0.f, 0.f, 0.f, 0.f};
    bf16x8 At[4][2], B0[2][2], B1[2][2];
    unsigned vAll[4][2][2];
#pragma unroll
    for (int q = 0; q < 4; ++q) { Unit uq; const bool ok = S.next(q, uq);
#pragma unroll
        for (int h = 0; h < 2; ++h)
#pragma unroll
            for (int i = 0; i < 2; ++i) vAll[q][h][i] = ok ? (unsigned)S.arow(uq.pm * BM + h * HALF + RAr[i]) * (unsigned)(g.lda * 2) + CAb[i] : 0u; }
#define PG8_PICK(dst, idx) do { _Pragma("unroll") for (int h_ = 0; h_ < 2; ++h_) _Pragma("unroll") for (int i_ = 0; i_ < 2; ++i_) \
        dst[h_][i_] = (idx) == 0 ? vAll[0][h_][i_] : (idx) == 1 ? vAll[1][h_][i_] : (idx) == 2 ? vAll[2][h_][i_] : vAll[3][h_][i_]; } while (0)
    unsigned vA[2][2], vAn[2][2], vS[2][2];
    PG8_PICK(vA, 0);
    const char* A0 = (const char*)g.A; const char* cB = (const char*)g.Bt + (size_t)cur.pn * tsB;
    S.a_ready(cur);
    if constexpr (SP2) {
        PG8_STAGE(PG8_SB(0, 0), cB, voffB); PG8_STAGE(PG8_SB(0, 1), cB + hsB, voffB); PG8_STAGE(PG8_SA(0, 0), A0, vA[0]); PG8_STAGE(PG8_SA(0, 1), A0, vA[1]);
        if (wr == 1) PG8_BAR;
        PG8_WAIT_V(2); PG8_BAR;
        PG8_STAGE(PG8_SB(1, 0), cB + kstep, voffB); PG8_STAGE(PG8_SA(1, 0), A0 + kstep, vA[0]); PG8_STAGE(PG8_SB(1, 1), cB + hsB + kstep, voffB);
        PG8_WAIT_V(6); PG8_BAR;
    } else {
        PG8_STAGE(PG8_SB(0, 0), cB, voffB); PG8_STAGE(PG8_SA(0, 0), A0, vA[0]); PG8_STAGE(PG8_SB(0, 1), cB + hsB, voffB); PG8_STAGE(PG8_SA(0, 1), A0, vA[1]);
        if (wr == 1) PG8_BAR;
        PG8_WAIT_V(4); PG8_BAR;
        PG8_STAGE(PG8_SB(1, 0), cB + kstep, voffB); PG8_STAGE(PG8_SA(1, 0), A0 + kstep, vA[0]); PG8_STAGE(PG8_SB(1, 1), cB + hsB + kstep, voffB);
        PG8_WAIT_V(6); PG8_BAR;
    }
    for (;;) {
        const bool has_next = S.next(ui + 1, nxt);
        const char* nB = has_next ? (const char*)g.Bt + (size_t)nxt.pn * tsB : cB;
        if (has_next) { PG8_PICK(vAn, ui + 1); } else { PG8_PICK(vAn, ui); }
#pragma unroll 1
        for (int t = 0; t < nt; t += 2) {
            const bool last = (t == nt - 2);
            const char* a1 = A0 + (size_t)(t + 1) * kstep;
            const char* a2 = last ? A0 : A0 + (size_t)(t + 2) * kstep; const char* b2 = last ? nB : cB + (size_t)(t + 2) * kstep;
#pragma unroll
            for (int h_ = 0; h_ < 2; ++h_)
#pragma unroll
                for (int i_ = 0; i_ < 2; ++i_) vS[h_][i_] = last ? vAn[h_][i_] : vA[h_][i_];
            const char* a3 = a2 + kstep; const char* b3 = b2 + kstep;
            if (last && has_next) S.a_ready(nxt);
            if constexpr (Epi::HAS_MID) { if (t == nt / 2) E.mid(acc, cur, wr, wc, fr, fq); }
            if constexpr (SP2) {
            PG8_LDB(B0, 0, 0); PG8_LDB(B1, 0, 1); PG8_SCHED; PG8_LDA(At, 0, 0); PG8_STAGE(PG8_SA(1, 1), a1, vA[1]);
            PG8_WAIT_V(8); PG8_WAIT_L(0); PG8_BAR; PG8_MMA(0, 0, At, B0); PG8_MMA(0, 1, At, B1); PG8_BAR; PG8_SCHED;
            PG8_LDA(At, 0, 1); PG8_STAGE(PG8_SB(0, 0), b2, voffB); PG8_STAGE(PG8_SB(0, 1), b2 + hsB, voffB); PG8_STAGE(PG8_SA(0, 0), a2, vS[0]);
            PG8_WAIT_V(8); PG8_WAIT_L(0); PG8_BAR; PG8_MMA(1, 0, At, B0); PG8_MMA(1, 1, At, B1); PG8_BAR; PG8_SCHED;
            PG8_LDB(B0, 1, 0); PG8_LDB(B1, 1, 1); PG8_SCHED; PG8_LDA(At, 1, 0); PG8_STAGE(PG8_SA(0, 1), a2, vS[1]);
            PG8_WAIT_V(8); PG8_WAIT_L(0); PG8_BAR; PG8_MMA(0, 0, At, B0); PG8_MMA(0, 1, At, B1); PG8_BAR; PG8_SCHED;
            PG8_LDA(At, 1, 1); PG8_STAGE(PG8_SB(1, 0), b3, voffB); PG8_STAGE(PG8_SB(1, 1), b3 + hsB, voffB); PG8_STAGE(PG8_SA(1, 0), a3, vS[0]);
            PG8_WAIT_V(8); PG8_WAIT_L(0); PG8_BAR; PG8_MMA(1, 0, At, B0); PG8_MMA(1, 1, At, B1); PG8_BAR; PG8_SCHED;
            } else {
            PG8_LDB(B0, 0, 0); PG8_SCHED; PG8_LDA(At, 0, 0); PG8_STAGE(PG8_SA(1, 1), a1, vA[1]);
            PG8_WAIT_L(8); PG8_BAR; PG8_WAIT_L(0); PG8_MMA(0, 0, At, B0); PG8_BAR; PG8_SCHED;
            PG8_LDB(B1, 0, 1); PG8_STAGE(PG8_SB(0, 0), b2, voffB);
            PG8_BAR; PG8_WAIT_L(0); PG8_MMA(0, 1, At, B1); PG8_BAR;
            PG8_LDA(At, 0, 1); PG8_STAGE(PG8_SA(0, 0), a2, vS[0]);
            PG8_BAR; PG8_WAIT_L(0); PG8_MMA(1, 0, At, B0); PG8_BAR; PG8_SCHED;
            PG8_STAGE(PG8_SB(0, 1), b2 + hsB, voffB);
            PG8_WAIT_V(6); PG8_BAR; PG8_MMA(1, 1, At, B1); PG8_BAR;
            PG8_LDB(B0, 1, 0); PG8_SCHED; PG8_LDA(At, 1, 0); PG8_STAGE(PG8_SA(0, 1), a2, vS[1]);
            PG8_WAIT_L(8); PG8_BAR; PG8_WAIT_L(0); PG8_MMA(0, 0, At, B0); PG8_BAR; PG8_SCHED;
            PG8_LDB(B1, 1, 1); PG8_STAGE(PG8_SB(1, 0), b3, voffB);
            PG8_BAR; PG8_WAIT_L(0); PG8_MMA(0, 1, At, B1); PG8_BAR;
            PG8_LDA(At, 1, 1); PG8_STAGE(PG8_SA(1, 0), a3, vS[0]);
            PG8_BAR; PG8_WAIT_L(0); PG8_MMA(1, 0, At, B0); PG8_BAR; PG8_SCHED;
            PG8_STAGE(PG8_SB(1, 1), b3 + hsB, voffB);
            PG8_WAIT_V(6); PG8_BAR; PG8_MMA(1, 1, At, B1); PG8_BAR;
            }
        }
        if constexpr (ALIGN_EPI) { if (wr == 0) PG8_BAR; }
        if constexpr (!Epi::AFTER_DRAIN) { E(acc, cur, wr, wc, fr, fq); S.done(cur); }
        if (!has_next) break;
#pragma unroll
        for (int a = 0; a < 2; ++a)
#pragma unroll
            for (int b = 0; b < 2; ++b)
#pragma unroll
                for (int m = 0; m < 4; ++m)
#pragma unroll
                    for (int n = 0; n < 2; ++n) acc[a][b][m][n] = (f32x4){0.f, 0.f, 0.f, 0.f};
        cur = nxt; cB = nB; ++ui;
#pragma unroll
        for (int h_ = 0; h_ < 2; ++h_)
#pragma unroll
            for (int i_ = 0; i_ < 2; ++i_) vA[h_][i_] = vAn[h_][i_];
        if constexpr (ALIGN_EPI) { if (wr == 1) PG8_BAR; }
    }
    PG8_WAIT_V(0);
    if constexpr (!ALIGN_EPI) { if (wr == 0) PG8_BAR; }
    PG8_BAR;
    if constexpr (Epi::AFTER_DRAIN) { E.fused(acc, cur, wr, wc, fr, fq, lds, wid, lane); S.done(cur); }
#undef PG8_SA
#undef PG8_SB
#undef PG8_STAGE
#undef PG8_LDA
#undef PG8_LDB
#undef PG8_MMA
#undef PG8_WAIT_V
#undef PG8_WAIT_L
#undef PG8_BAR
#undef PG8_SCHED
#undef PG8_PICK
}


}

namespace attn {
using bf16x8 = __attribute__((ext_vector_type(8))) short;
using s16x4  = __attribute__((ext_vector_type(4))) short;
using f32x16 = __attribute__((ext_vector_type(16))) float;
using u32x4  = __attribute__((ext_vector_type(4))) unsigned;
constexpr int QBLK = 32, KVBLK = 64, LDQ = 3072;
constexpr float SCALE = 0.125f, QSCALE = 0.125f * 1.4426950408889634f;
constexpr size_t SHM_V = KVBLK * 128 * 2, SHM_K = KVBLK * 128 * 2, SHM_ATTN = 2 * SHM_V + 2 * SHM_K + 8 * 64 * 4;
#define KSWZ(row, colB) ((row) * 256 + ((colB) ^ (((row) & 7) << 4)))
#define SBAR() __builtin_amdgcn_sched_barrier(0)
__device__ __forceinline__ int crow(int r, int hi) { return (r & 3) + 8 * (r >> 2) + 4 * hi; }
__device__ __forceinline__ unsigned cvtpk(float lo, float hi) { return pk2(lo, hi); }
__device__ __forceinline__ bf16x8 ld8(const bf16_t* p) { return *reinterpret_cast<const bf16x8*>(p); }

__device__ __forceinline__ void partialSM(f32x16& p0, f32x16& p1) {
  for (int r = 0; r < 16; ++r) p0[r] = __builtin_amdgcn_exp2f(p0[r]);
}
__device__ __forceinline__ void finishSM(f32x16& p0, f32x16& p1, float& l_reg, bf16x8& pa0, bf16x8& pa1, bf16x8& pa2, bf16x8& pa3) {
  for (int r = 0; r < 16; ++r) p1[r] = __builtin_amdgcn_exp2f(p1[r]);
  float ps = 0; for (int r = 0; r < 16; ++r) ps += p0[r]; for (int r = 0; r < 16; ++r) ps += p1[r];
  l_reg += ps;
#define PK4(P, BASE, OUT) do { unsigned a0 = cvtpk(P[BASE + 0], P[BASE + 1]), a1 = cvtpk(P[BASE + 2], P[BASE + 3]);   \
    unsigned b0 = cvtpk(P[BASE + 4], P[BASE + 5]), b1 = cvtpk(P[BASE + 6], P[BASE + 7]);                              \
    auto r0 = __builtin_amdgcn_permlane32_swap(a0, b0, false, false); auto r1 = __builtin_amdgcn_permlane32_swap(a1, b1, false, false); \
    u32x4 w = {r0[0], r1[0], r0[1], r1[1]}; OUT = *reinterpret_cast<bf16x8*>(&w); } while (0)
  PK4(p0, 0, pa0); PK4(p0, 8, pa1); PK4(p1, 0, pa2); PK4(p1, 8, pa3);
#undef PK4
}
__device__ __forceinline__ void qkt(f32x16& p0, f32x16& p1, const bf16_t* Ks, const bf16x8* qr, int r32, int hi, int sub) {
  p0 = f32x16{}; p1 = f32x16{};
#pragma unroll
  for (int d0 = 0; d0 < 4; ++d0) { int cb = (sub * 64 + d0 * 16 + hi * 8) * 2;
    bf16x8 b0 = *reinterpret_cast<const bf16x8*>((const char*)Ks + KSWZ(r32, cb));
    bf16x8 b1 = *reinterpret_cast<const bf16x8*>((const char*)Ks + KSWZ(32 + r32, cb));
    p0 = __builtin_amdgcn_mfma_f32_32x32x16_bf16(b0, qr[d0], p0, 0, 0, 0);
    p1 = __builtin_amdgcn_mfma_f32_32x32x16_bf16(b1, qr[d0], p1, 0, 0, 0); }
}
__device__ __forceinline__ int v_st(int k, int c) { const int kk = (k & ~0xC) | ((k & 4) << 1) | ((k & 8) >> 1); return ((kk >> 3) * 4 + (c >> 5)) * 512 + ((kk & 7) * 32 + (c & 31)) * 2; }
__device__ __forceinline__ int v_rd_base(int lane) { return ((lane & 3) << 3) | (((lane >> 2) & 3) << 6) | (((lane >> 4) & 1) << 5) | (((lane >> 5) & 1) << 8); }
constexpr int v_rd_off(int d0, int ks, int half) { return d0 * 512 + ks * 4096 + half * 2048; }
template <int OFF> __device__ __forceinline__ s16x4 tr_read(int vb) {
  s16x4 r; asm volatile("ds_read_b64_tr_b16 %0, %1 offset:%2" : "=&v"(r) : "v"(vb), "i"(OFF) : "memory"); return r;
}
template <int D0> __device__ __forceinline__ void pv_one(f32x16& od, int vb, bf16x8 pa0, bf16x8 pa1, bf16x8 pa2, bf16x8 pa3) {
  const s16x4 l0 = tr_read<v_rd_off(D0, 0, 0)>(vb), h0 = tr_read<v_rd_off(D0, 0, 1)>(vb), l1 = tr_read<v_rd_off(D0, 1, 0)>(vb), h1 = tr_read<v_rd_off(D0, 1, 1)>(vb);
  const s16x4 l2 = tr_read<v_rd_off(D0, 2, 0)>(vb), h2 = tr_read<v_rd_off(D0, 2, 1)>(vb), l3 = tr_read<v_rd_off(D0, 3, 0)>(vb), h3 = tr_read<v_rd_off(D0, 3, 1)>(vb);
  asm volatile("s_waitcnt lgkmcnt(0)" ::: "memory"); SBAR();
#define PK(L, H) (bf16x8){L[0], L[1], L[2], L[3], H[0], H[1], H[2], H[3]}
  od = __builtin_amdgcn_mfma_f32_32x32x16_bf16(pa0, PK(l0, h0), od, 0, 0, 0);
  od = __builtin_amdgcn_mfma_f32_32x32x16_bf16(pa1, PK(l1, h1), od, 0, 0, 0);
  od = __builtin_amdgcn_mfma_f32_32x32x16_bf16(pa2, PK(l2, h2), od, 0, 0, 0);
  od = __builtin_amdgcn_mfma_f32_32x32x16_bf16(pa3, PK(l3, h3), od, 0, 0, 0);
#undef PK
}
__device__ __forceinline__ void pv_d0(f32x16* o, int vb, bf16x8 pa0, bf16x8 pa1, bf16x8 pa2, bf16x8 pa3) {
  pv_one<0>(o[0], vb, pa0, pa1, pa2, pa3); pv_one<1>(o[1], vb, pa0, pa1, pa2, pa3); pv_one<2>(o[2], vb, pa0, pa1, pa2, pa3); pv_one<3>(o[3], vb, pa0, pa1, pa2, pa3);
}

__device__ __forceinline__ void attn_unit(const bf16_t* Qb, const bf16_t* Kh, const bf16_t* Vh, bf16_t* Ya, float lam, const float* subln_g, int seq, char* lds) {
  const int tid = fresh_tid(), wid = __builtin_amdgcn_readfirstlane(tid >> 6), lane = tid & 63, r32 = lane & 31, hi = lane >> 5, sub = wid >> 2, wq = wid & 3;
  bf16_t* V_lds = (bf16_t*)lds; bf16_t* K_lds = (bf16_t*)(lds + 2 * SHM_V);
  float* ws = (float*)(lds + 2 * SHM_V + 2 * SHM_K) + wid * 64; float* li_l = ws;
  float l_reg = 0; f32x16 o[4] = {}; bf16x8 qr[4];
  const bf16_t* Qw = Qb + (long)(wq * QBLK + r32) * LDQ + sub * 64 + hi * 8;
#pragma unroll
  for (int d0 = 0; d0 < 4; ++d0) qr[d0] = ld8(Qw + d0 * 16);
  const int sr = tid >> 4, sc = (tid & 15) * 8, vst0 = v_st(sr, sc), vst1 = v_st(32 + sr, sc);
  const int vb0 = (int)(uintptr_t)V_lds + v_rd_base(lane);
  struct { bf16x8 vs0, vs1, ks0, ks1; } sr_[2];
#define SLOAD(i, k0) do { sr_[i].vs0 = ld8(&Vh[(long)((k0) + sr) * LDQ + sc]); sr_[i].vs1 = ld8(&Vh[(long)((k0) + 32 + sr) * LDQ + sc]); \
    sr_[i].ks0 = ld8(&Kh[(long)((k0) + sr) * LDQ + sc]); sr_[i].ks1 = ld8(&Kh[(long)((k0) + 32 + sr) * LDQ + sc]); } while (0)
#define SWRITE(b, i) do { *(bf16x8*)((char*)V_lds + (b) * SHM_V + vst0) = sr_[i].vs0;          \
    *(bf16x8*)((char*)V_lds + (b) * SHM_V + vst1) = sr_[i].vs1; int kc = sc * 2;               \
    *(bf16x8*)((char*)K_lds + (b) * SHM_K + KSWZ(sr, kc)) = sr_[i].ks0;                       \
    *(bf16x8*)((char*)K_lds + (b) * SHM_K + KSWZ(32 + sr, kc)) = sr_[i].ks1; } while (0)
#define SWAIT() asm volatile("s_waitcnt vmcnt(4)" ::: "memory")
  f32x16 pA0, pA1, pB0, pB1; bf16x8 pa0, pa1, pa2, pa3; const int NT = seq / KVBLK;
  constexpr int SE = 0, SO = 1;
  SLOAD(SE, 0); asm volatile("s_waitcnt vmcnt(0)" ::: "memory"); SWRITE(0, SE); __syncthreads();
  qkt(pA0, pA1, K_lds, qr, r32, hi, sub); partialSM(pA0, pA1);
  SLOAD(SO, KVBLK); if (2 < NT) SLOAD(SE, 2 * KVBLK);
  SWAIT(); SWRITE(1, SO); __syncthreads();
  for (int j = 1; j + 1 < NT; j += 2) {
    SBAR(); qkt(pB0, pB1, (bf16_t*)((char*)K_lds + SHM_K), qr, r32, hi, sub);
    finishSM(pA0, pA1, l_reg, pa0, pa1, pa2, pa3); SBAR();
    SLOAD(SO, (j + 2) * KVBLK); SBAR();
    pv_d0(o, vb0, pa0, pa1, pa2, pa3); partialSM(pB0, pB1);
    __syncthreads(); SWAIT(); SWRITE(0, SE); __syncthreads();
    SBAR(); qkt(pA0, pA1, K_lds, qr, r32, hi, sub);
    finishSM(pB0, pB1, l_reg, pa0, pa1, pa2, pa3); SBAR();
    if (j + 3 < NT) SLOAD(SE, (j + 3) * KVBLK); SBAR();
    pv_d0(o, vb0 + (int)SHM_V, pa0, pa1, pa2, pa3); partialSM(pA0, pA1);
    __syncthreads(); SWAIT(); SWRITE(1, SO); __syncthreads();
  }
  SBAR(); qkt(pB0, pB1, (bf16_t*)((char*)K_lds + SHM_K), qr, r32, hi, sub);
  finishSM(pA0, pA1, l_reg, pa0, pa1, pa2, pa3); SBAR();
  pv_d0(o, vb0, pa0, pa1, pa2, pa3); partialSM(pB0, pB1);
  __syncthreads();
  finishSM(pB0, pB1, l_reg, pa0, pa1, pa2, pa3); SBAR();
  pv_d0(o, vb0 + (int)SHM_V, pa0, pa1, pa2, pa3);
  { auto rr = __builtin_amdgcn_permlane32_swap(__float_as_uint(l_reg), __float_as_uint(l_reg), false, false); l_reg = __uint_as_float(rr[0]) + __uint_as_float(rr[1]); }
  if (hi == 0) li_l[r32] = l_reg; asm volatile("s_waitcnt lgkmcnt(0)" ::: "memory");
  float rli[16];
#pragma unroll
  for (int r = 0; r < 16; ++r) rli[r] = __builtin_amdgcn_rcpf(li_l[crow(r, hi)]);
  __syncthreads();
  float* xo = (float*)lds;
  if (sub == 1) {
#pragma unroll
    for (int r = 0; r < 16; ++r) { const int orow = wq * 32 + crow(r, hi);
#pragma unroll
      for (int d0 = 0; d0 < 4; ++d0) xo[orow * 128 + d0 * 32 + r32] = o[d0][r] * rli[r]; }
  }
  __syncthreads();
  if (sub == 0) {
    float gv[4];
#pragma unroll
    for (int d0 = 0; d0 < 4; ++d0) gv[d0] = subln_g[d0 * 32 + r32] * (1.0f - LAM_INIT);
#pragma unroll
    for (int r = 0; r < 16; ++r) { const int orow = wq * 32 + crow(r, hi); float v[4]; float ssq = 0.f;
#pragma unroll
      for (int d0 = 0; d0 < 4; ++d0) { v[d0] = o[d0][r] * rli[r] - lam * xo[orow * 128 + d0 * 32 + r32]; ssq += v[d0] * v[d0]; }
      ssq += __shfl_xor(ssq, 1); ssq += __shfl_xor(ssq, 2); ssq += __shfl_xor(ssq, 4); ssq += __shfl_xor(ssq, 8); ssq += __shfl_xor(ssq, 16);
      const float sc_ = 1.0f / sqrtf(ssq * (1.0f / 128.0f) + RMS_EPS);
#pragma unroll
      for (int d0 = 0; d0 < 4; ++d0) Ya[(long)orow * 2048 + d0 * 32 + r32] = (bf16_t)f2bf(v[d0] * sc_ * gv[d0]); }
  }
  __syncthreads();
#undef SLOAD
#undef SWRITE
#undef SWAIT
}
#undef KSWZ
#undef SBAR
}

struct Args {
    const float* in[33];
    float* out; unsigned char* ws;
    int ph_lo, ph_hi;
};
enum { I_X = 0, I_ANG, I_WIN, I_QNG, I_KNG, I_LQ1, I_LK1, I_LQ2, I_LK2, I_SUBLN, I_MU, I_W0F, I_W2F, I_W0B, I_W2B, I_A0F, I_A2F, I_A0B, I_A2B, I_G2, I_KK, I_KA, I_RK,
       I_LNW, I_LNB, I_WBA, I_WBB, I_WOUT, I_FNG, I_WR, I_WG, I_WU, I_WD };

__device__ __forceinline__ void tr_item(const float* W, int ldw, int k0, int n0, bf16_t* dst, int ldd, LAS float* scr, int lane) {
    float tv[32];
    const float* src = W + (size_t)(k0 + (lane >> 5)) * ldw + n0 + (lane & 31);
#pragma unroll
    for (int i = 0; i < 32; ++i) tv[i] = src[(size_t)(2 * i) * ldw];
#pragma unroll
    for (int i = 0; i < 32; ++i) scr[(2 * i + (lane >> 5)) * 33 + (lane & 31)] = tv[i];
    asm volatile("s_waitcnt lgkmcnt(0)" ::: "memory");
    const int c = lane & 7;
#pragma unroll
    for (int j = 0; j < 4; ++j) { const int n = (lane >> 3) + 8 * j; const LAS float* s = scr + (8 * c) * 33 + n;
        v4u o; o.x = pk2(s[0 * 33], s[1 * 33]); o.y = pk2(s[2 * 33], s[3 * 33]); o.z = pk2(s[4 * 33], s[5 * 33]); o.w = pk2(s[6 * 33], s[7 * 33]);
        *(v4u*)(dst + (size_t)n * ldd + 8 * c) = o; }
    asm volatile("s_waitcnt lgkmcnt(0)" ::: "memory");
}

__device__ __forceinline__ void p0_prologue(const Args& a, LAS unsigned char* lds, int gw, int NGW, int wave, int lane) {
    unsigned char* ws = a.ws;
    LAS float* scr = (LAS float*)(lds + wave * 16384);
    bf16_t* WinT = (bf16_t*)(ws + WS_WINT);
    bf16_t* WaT = (bf16_t*)(ws + WS_WAT); bf16_t* WoT = (bf16_t*)(ws + WS_WOT);
    constexpr int I_IN = 32 * 333, I_A = 16 * 64, I_B = 16 * 64, I_O = 32 * 64, NITEMS = I_IN + I_A + I_B + I_O;
    for (int it = gw; it < NITEMS; it += NGW) {
        int r = it;
        if (r < I_IN) { const int kb = r / 333, nb = r % 333, n0 = nb * 32; int drow = n0;
            if (n0 >= 6560) { const int c = n0 - 6560, which = c >> 11, cc = c & 2047; drow = 6656 + (cc >> 7) * 256 + which * 128 + (cc & 127); }
            tr_item(a.in[I_WIN], IN_COLS, kb * 64, n0, WinT + (size_t)drow * 2048 + kb * 64, 2048, scr, lane); continue; } r -= I_IN;
        if (r < I_A) { const int kb = r / 64, nb = r % 64; tr_item(a.in[I_WBA], 2048, kb * 64, nb * 32, WaT + (size_t)(nb * 32) * 2048 + kb * 64, 2048, scr, lane); continue; } r -= I_A;
        if (r < I_B) { const int kb = r / 64, nb = r % 64; tr_item(a.in[I_WBB], 2048, kb * 64, nb * 32, WaT + (size_t)(nb * 32) * 2048 + 1024 + kb * 64, 2048, scr, lane); continue; } r -= I_B;
        { const int kb = r / 64, nb = r % 64; tr_item(a.in[I_WOUT], 2048, kb * 64, nb * 32, WoT + (size_t)(nb * 32) * 2048 + kb * 64, 2048, scr, lane); }
    }
    { const int gt = gw * 64 + lane, NT_ = NGW * 64;
      v4u z = {0u, 0u, 0u, 0u};
      for (int i = gt; i < 24576; i += NT_) ((v4u*)(WinT + (size_t)6560 * 2048))[i] = z;
      { const float invf[8] = {1.000000000e+00f, 1.939227432e-01f, 3.760603070e-02f, 7.292664610e-03f, 1.414213562e-03f, 2.742481884e-04f, 5.318296098e-05f, 1.031338616e-05f};
        for (int i = gt; i < SEQ * 8; i += NT_) { float iv = invf[0];
#pragma unroll
            for (int j = 1; j < 8; ++j) iv = ((i & 7) == j) ? invf[j] : iv;
            float sv, cv; sincosf((float)(i >> 3) * iv, &sv, &cv); ((float2*)(ws + WS_ROPE))[i] = make_float2(cv, sv); } }
      { float* sm = (float*)(ws + WS_SMALL);
#define CPY(OFF, IDX, N) for (int i = gt; i < (N); i += NT_) sm[(OFF) + i] = a.in[IDX][i];
        CPY(SM_QNG, I_QNG, 64) CPY(SM_KNG, I_KNG, 64) CPY(SM_LQ1, I_LQ1, 64) CPY(SM_LK1, I_LK1, 64) CPY(SM_LQ2, I_LQ2, 64) CPY(SM_LK2, I_LK2, 64) CPY(SM_SUBLN, I_SUBLN, 128)
        CPY(SM_MU, I_MU, 3488) CPY(SM_KK, I_KK, 1024) CPY(SM_KA, I_KA, 1024) CPY(SM_RK, I_RK, 1024) CPY(SM_LNW, I_LNW, 1024) CPY(SM_LNB, I_LNB, 1024) CPY(SM_FNG, I_FNG, 2048) CPY(SM_WR, I_WR, 32768)
#undef CPY
      }
      for (int i = gt; i < 4096; i += NT_) { const int seg = i >> 10, c = i & 1023; ((float*)(ws + WS_BIAS4))[i] = (seg == 0) ? a.in[I_W0F][c] : (seg == 1) ? a.in[I_W0B][c] : (seg == 2) ? a.in[I_A0F][c] : a.in[I_A0B][c]; }
      bf16_t* B1 = (bf16_t*)(ws + WS_BTL1); bf16_t* B2 = (bf16_t*)(ws + WS_BTL2);
      for (int i = gt; i < 4096 * 32; i += NT_) { const int n = i >> 5, kc = (i & 31) * 8, seg = n >> 10, c = n & 1023;
          const float* w2 = (seg == 0) ? a.in[I_W2F] : (seg == 1) ? a.in[I_W2B] : (seg == 2) ? a.in[I_A2F] : a.in[I_A2B];
          float f[8];
#pragma unroll
          for (int j = 0; j < 8; ++j) { const int k = kc + j - 64 * seg; f[j] = (k >= 0 && k < 64) ? w2[(size_t)k * 1024 + c] : 0.f; }
          *(v4u*)(B1 + (size_t)n * 256 + kc) = pack8(f); }
      for (int i = gt; i < 1024 * 32; i += NT_) { const int n = i >> 5, kc = (i & 31) * 8; float f[8];
#pragma unroll
          for (int j = 0; j < 8; ++j) { const int k = kc + j; f[j] = (k < 160) ? a.in[I_G2][(size_t)k * 1024 + n] : 0.f; }
          *(v4u*)(B2 + (size_t)n * 256 + kc) = pack8(f); }
    }
    bf16_t* HN = (bf16_t*)(ws + WS_HN); const float* x = a.in[I_X]; const float* g = a.in[I_ANG];
    for (int m = gw; m < M; m += NGW) {
        const float4* xr = (const float4*)(x + (size_t)m * DM) + lane; float4 v[8]; float s = 0.f;
#pragma unroll
        for (int j = 0; j < 8; ++j) { v[j] = xr[64 * j]; s += (v[j].x * v[j].x + v[j].y * v[j].y) + (v[j].z * v[j].z + v[j].w * v[j].w); }
        const float rs = 1.0f / sqrtf(wave_sum(s) * (1.0f / DM) + RMS_EPS);
        v2u* o = (v2u*)(HN + (size_t)m * DM) + lane;
#pragma unroll
        for (int j = 0; j < 8; ++j) { const float4 gg = ((const float4*)g)[64 * j + lane]; v2u w; w.x = pk2(v[j].x * rs * gg.x, v[j].y * rs * gg.y); w.y = pk2(v[j].z * rs * gg.z, v[j].w * rs * gg.w); o[64 * j] = w; }
    }
}

__device__ __forceinline__ void p2_prep(const Args& a, int gw, int NGW, int lane, bool dummy = false) {
    unsigned char* ws = a.ws;
    bf16_t* PDA = (bf16_t*)(ws + WS_PDA); const bf16_t* PRW = (const bf16_t*)((unsigned char*)a.out + DO_PRW);
    bf16_t* RKV = (bf16_t*)(ws + WS_RKV); bf16_t* LIN = (bf16_t*)((unsigned char*)a.out + DO_LIN);
    const float* sm = (const float*)(ws + WS_SMALL); const float* mu = sm + SM_MU;
    const int sub8 = lane & 7;
    float gq[8], gk[8];
#pragma unroll
    for (int j = 0; j < 8; ++j) { gq[j] = sm[SM_QNG + sub8 * 8 + j]; gk[j] = sm[SM_KNG + sub8 * 8 + j]; }
    for (int m = gw; m < M; m += NGW) {
        const int t = m & (SEQ - 1);
        const float2 csv = ((const float2*)(ws + WS_ROPE))[t * 8 + sub8]; const float cv = csv.x, sv = csv.y;
        float cs[8], sn[8];
#pragma unroll
        for (int j = 0; j < 8; ++j) { cs[j] = __shfl(cv, j); sn[j] = __shfl(sv, j); }
#pragma unroll
        for (int it = 0; it < 4; ++it) {
            const int v = it * 8 + (lane >> 3);
            bf16_t* p = PDA + (size_t)m * 3072 + (v < 16 ? 0 : 1024) + (v & 15) * 64 + sub8 * 8;
            const v4u w = *(const v4u*)p; float f[8]; unpack8(w, f);
            float s = 0.f;
#pragma unroll
            for (int j = 0; j < 8; ++j) s += f[j] * f[j];
            s = sum8(s); const float rs = 1.0f / sqrtf(s * (1.0f / 64.0f) + RMS_EPS);
            float y[8], oth[8];
#pragma unroll
            for (int j = 0; j < 8; ++j) { y[j] = f[j] * rs * (v < 16 ? gq[j] : gk[j]); }
#pragma unroll
            for (int j = 0; j < 8; ++j) oth[j] = __shfl_xor(y[j], 1);
            float o[8];
#pragma unroll
            for (int j = 0; j < 8; ++j) o[j] = (sub8 == 0) ? (y[j] * cs[j] - oth[j] * sn[j]) : (sub8 == 1) ? (y[j] * cs[j] + oth[j] * sn[j]) : y[j];
            if (v < 16) {
#pragma unroll
                for (int j = 0; j < 8; ++j) o[j] *= 0.125f * 1.4426950408889634f; }
            *(v4u*)(dummy ? (bf16_t*)(ws + WS_LORA) + (p - PDA) : p) = pack8(o);
        }
        const bool hp = t > 0, hn_ = t < SEQ - 1;
        const bf16_t* pr = PRW + (size_t)m * RW_PAD;
#pragma unroll
        for (int it = 0; it < 7; ++it) {
            const int v = it * 64 + lane; if (it == 6 && v >= 436) continue;
            const v4u wc = *(const v4u*)(pr + v * 8);
            v4u wp = {0u, 0u, 0u, 0u}, wn = {0u, 0u, 0u, 0u};
            if (hp) wp = *(const v4u*)(pr - RW_PAD + v * 8);
            if (hn_) wn = *(const v4u*)(pr + RW_PAD + v * 8);
            float c[8], pv[8], nx[8]; unpack8(wc, c); unpack8(wp, pv); unpack8(wn, nx);
            const float4 m0 = *(const float4*)(mu + v * 8), m1 = *(const float4*)(mu + v * 8 + 4);
            const float mm[8] = {m0.x, m0.y, m0.z, m0.w, m1.x, m1.y, m1.z, m1.w};
            float xs[8];
#pragma unroll
            for (int j = 0; j < 8; ++j) xs[j] = c[j] + mm[j] * (0.5f * (pv[j] + nx[j]) - c[j]);
            if (v < 384) { const v4u pw = pack8(xs); *(v4u*)(RKV + (size_t)m * 3072 + v * 8) = pw;
                if (it == 2 || it == 3) {
                    float kr[8]; unpack8(pw, kr); float ssq = 0.f;
#pragma unroll
                    for (int j = 0; j < 8; ++j) { const float kkv = kr[j] * sm[SM_KK + (v - 128) * 8 + j]; ssq += kkv * kkv; }
                    ssq = sum8(ssq);
                    if ((lane & 7) == 0) ((float*)(ws + WS_INRM))[(size_t)m * 16 + ((v - 128) >> 3)] = 1.0f / fmaxf(sqrtf(ssq), 1e-12f); } }
            else if (v < 400) {
#pragma unroll
                for (int j = 0; j < 8; ++j) xs[j] = 1.0f - 2.0f * __builtin_amdgcn_rcpf(1.0f + __expf(2.0f * xs[j]));
                *(v4u*)(LIN + (size_t)m * 512 + (v - 384) * 8) = pack8(xs); }
            else if (v < 416) { *(v4u*)(LIN + (size_t)m * 512 + (v - 384) * 8) = pack8(xs); }
            else {
#pragma unroll
                for (int j = 0; j < 8; ++j) xs[j] = sigmoidf_(xs[j]);
                *(v4u*)(LIN + (size_t)m * 512 + 256 + (v - 416) * 8) = pack8(xs); }
        }
        if (lane < 12) { v4u z = {0u, 0u, 0u, 0u}; *(v4u*)(LIN + (size_t)m * 512 + 416 + lane * 8) = z; }
    }
}

__device__ __forceinline__ void p6_rwpost(const Args& a, int gw, int NGW, int lane) {
    unsigned char* ws = a.ws;
    const bf16_t* RKV = (const bf16_t*)(ws + WS_RKV); const bf16_t* LO = (const bf16_t*)(ws + WS_LORA);
    const bf16_t* YSF = (const bf16_t*)((unsigned char*)a.out + DO_YSF); const bf16_t* YSB = (const bf16_t*)((unsigned char*)a.out + DO_YSB);
    bf16_t* YB = (bf16_t*)((unsigned char*)a.out + DO_YAB) + 1024;
    const size_t SEG = (size_t)M * 1024; const float* sm = (const float*)(ws + WS_SMALL);
    for (int it = gw; it < 2 * M; it += NGW) {
        const int m = it >> 1, col = (it & 1) * 512 + lane * 8;
        float yf[8], ybk[8], r[8], k[8], v[8], af[8], ab[8], g[8];
        unpack8(*(const v4u*)(YSF + (size_t)m * 1024 + col), yf); unpack8(*(const v4u*)(YSB + (size_t)m * 1024 + col), ybk);
        unpack8(*(const v4u*)(RKV + (size_t)m * 3072 + col), r); unpack8(*(const v4u*)(RKV + (size_t)m * 3072 + 1024 + col), k); unpack8(*(const v4u*)(RKV + (size_t)m * 3072 + 2048 + col), v);
        unpack8(*(const v4u*)(LO + 2 * SEG + (size_t)m * 1024 + col), af); unpack8(*(const v4u*)(LO + 3 * SEG + (size_t)m * 1024 + col), ab); unpack8(*(const v4u*)(LO + 4 * SEG + (size_t)m * 1024 + col), g);
        float y[8]; float s = 0.f;
#pragma unroll
        for (int j = 0; j < 8; ++j) { y[j] = yf[j] + ybk[j]; s += y[j]; }
        const float mean = sum8(s) * (1.0f / 64.0f); float q = 0.f;
#pragma unroll
        for (int j = 0; j < 8; ++j) { y[j] -= mean; q += y[j] * y[j]; }
        const float rstd = 1.0f / sqrtf(sum8(q) * (1.0f / 64.0f) + GN_EPS);
        float bs = 0.f;
#pragma unroll
        for (int j = 0; j < 8; ++j) { const float kfb = k[j] * (2.0f + (af[j] + ab[j] - 2.0f) * sm[SM_KA + col + j]); bs += r[j] * kfb * sm[SM_RK + col + j]; }
        bs = sum8(bs);
        float o[8];
#pragma unroll
        for (int j = 0; j < 8; ++j) o[j] = (y[j] * rstd * sm[SM_LNW + col + j] + sm[SM_LNB + col + j] + bs * v[j]) * g[j];
        *(v4u*)(YB + (size_t)m * 2048 + col) = pack8(o);
    }
}

__device__ __forceinline__ void expert_convert(const Args& a, LAS unsigned char* lds, int gw, int NGW, int wave, int lane, int lo, int hi) {
    unsigned char* ws = a.ws;
    LAS float* scr = (LAS float*)(lds + wave * 16384);
    bf16_t* W1T = (bf16_t*)(ws + WS_W1T); bf16_t* WDT = (bf16_t*)(ws + WS_WDT);
    for (int it = lo + gw; it < hi; it += NGW) {
        const int which = it >> 14, r = it & 16383, e = r >> 10, q = r & 1023;
        if (which < 2) { const int kb = q >> 5, nb = q & 31, n0 = nb * 32;
            const float* W = (which == 0 ? a.in[I_WG] : a.in[I_WU]) + (size_t)e * 2048 * 1024;
            const int drow = (n0 >> 7) * 256 + which * 128 + (n0 & 127);
            tr_item(W, 1024, kb * 64, n0, W1T + ((size_t)e * 2048 + drow) * 2048 + kb * 64, 2048, scr, lane); }
        else { const int kb = q >> 6, nb = q & 63;
            const float* W = a.in[I_WD] + (size_t)e * 1024 * 2048;
            tr_item(W, 2048, kb * 64, nb * 32, WDT + ((size_t)e * 2048 + nb * 32) * 1024 + kb * 64, 1024, scr, lane); }
    }
}
__device__ __forceinline__ void p9_router(const Args& a, LAS unsigned char* lds, int gw, int NGW, int wave, int lane) {
    unsigned char* ws = a.ws;
    expert_convert(a, lds, gw, NGW, wave, lane, 0, 2 * 16384);
    __syncthreads();
    LAS float* wrT = (LAS float*)lds;
    { const float4* wr4 = (const float4*)((const float*)(ws + WS_SMALL) + SM_WR);
      for (int idx = fresh_tid(); idx < 2048 * 4; idx += NTHREADS) { const int d = idx >> 2, q = idx & 3; const float4 w4 = wr4[idx];
          wrT[(4 * q + 0) * 2048 + d] = w4.x; wrT[(4 * q + 1) * 2048 + d] = w4.y; wrT[(4 * q + 2) * 2048 + d] = w4.z; wrT[(4 * q + 3) * 2048 + d] = w4.w; } }
    __syncthreads();
    const float* h = a.out; const float* ss = (const float*)(ws + WS_SSP); const float* g = (const float*)(ws + WS_SMALL) + SM_FNG;
    float* aff = (float*)(ws + WS_AFF); bf16_t* hn2 = (bf16_t*)(ws + WS_HN2);
    for (int mp = gw; mp < M / 2; mp += NGW) {
        const int m0 = 2 * mp;
        const float rs0 = 1.0f / sqrtf(wave_sum(lane < 32 ? ss[(size_t)m0 * 32 + lane] : 0.f) * (1.0f / DM) + RMS_EPS);
        const float rs1 = 1.0f / sqrtf(wave_sum(lane < 32 ? ss[(size_t)(m0 + 1) * 32 + lane] : 0.f) * (1.0f / DM) + RMS_EPS);
        float acc0[16], acc1[16];
#pragma unroll
        for (int e = 0; e < 16; ++e) { acc0[e] = 0.f; acc1[e] = 0.f; }
#pragma unroll 2
        for (int j = 0; j < 8; ++j) { const int d = j * 256 + lane * 4;
            const float4 gv = *(const float4*)(g + d), h0 = *(const float4*)(h + (size_t)m0 * DM + d), h1 = *(const float4*)(h + (size_t)(m0 + 1) * DM + d);
            const float x0[4] = {h0.x * rs0 * gv.x, h0.y * rs0 * gv.y, h0.z * rs0 * gv.z, h0.w * rs0 * gv.w};
            const float x1[4] = {h1.x * rs1 * gv.x, h1.y * rs1 * gv.y, h1.z * rs1 * gv.z, h1.w * rs1 * gv.w};
            { v2u w0, w1; w0.x = pk2(x0[0], x0[1]); w0.y = pk2(x0[2], x0[3]); w1.x = pk2(x1[0], x1[1]); w1.y = pk2(x1[2], x1[3]);
              *(v2u*)(hn2 + (size_t)m0 * DM + d) = w0; *(v2u*)(hn2 + (size_t)(m0 + 1) * DM + d) = w1; }
#pragma unroll
            for (int e = 0; e < 16; ++e) { const pg8::f32x4 w4 = *(const LAS pg8::f32x4*)(wrT + e * 2048 + d);
                acc0[e] += x0[0] * w4.x + x0[1] * w4.y + x0[2] * w4.z + x0[3] * w4.w;
                acc1[e] += x1[0] * w4.x + x1[1] * w4.y + x1[2] * w4.z + x1[3] * w4.w; } }
#pragma unroll
        for (int t2 = 0; t2 < 2; ++t2) {
            float mx = -1e30f, lg[16];
#pragma unroll
            for (int e = 0; e < 16; ++e) { lg[e] = wave_sum(t2 ? acc1[e] : acc0[e]); mx = fmaxf(mx, lg[e]); }
            float den = 0.f;
#pragma unroll
            for (int e = 0; e < 16; ++e) { lg[e] = __expf(lg[e] - mx); den += lg[e]; }
            float mine = lg[0];
#pragma unroll
            for (int e = 1; e < 16; ++e) mine = (lane == e) ? lg[e] : mine;
            const int m = m0 + t2;
            if (lane < 16) aff[((size_t)(m >> 12) * 16 + lane) * SEQ + (m & (SEQ - 1))] = mine / den;
        }
    }
}

__device__ __forceinline__ void p10_topk(const Args& a, unsigned char* ldsg) {
    const int bx = blockIdx.x; if (bx >= NB * NE) return;
    LAS unsigned char* L = (LAS unsigned char*)ldsg;
    const int tid = fresh_tid(), lane = tid & 63, w = tid >> 6;
    unsigned char* ws = a.ws;
    const float* aff = (const float*)(ws + WS_AFF) + (size_t)bx * SEQ;
    LAS unsigned* hist = (LAS unsigned*)L;
    LAS unsigned* ctl = hist + 256;
    LAS unsigned* wtot = hist + 272;
    unsigned v[8];
    { const v4u a0 = *(const v4u*)(aff + tid * 8), a1 = *(const v4u*)(aff + tid * 8 + 4); v[0] = a0.x; v[1] = a0.y; v[2] = a0.z; v[3] = a0.w; v[4] = a1.x; v[5] = a1.y; v[6] = a1.z; v[7] = a1.w; }
    unsigned prefix = 0u, mask = 0u, remaining = CAP;
#pragma unroll 1
    for (int pass = 0; pass < 4; ++pass) {
        const int shift = 24 - 8 * pass;
        if (tid < 256) hist[tid] = 0u;
        __syncthreads();
#pragma unroll
        for (int q = 0; q < 8; ++q) if ((v[q] & mask) == prefix) __hip_atomic_fetch_add((unsigned*)&hist[(v[q] >> shift) & 255u], 1u, __ATOMIC_RELAXED, __HIP_MEMORY_SCOPE_WORKGROUP);
        __syncthreads();
        if (w == 0) {
            const v4u hb = *(const LAS v4u*)(hist + 4 * lane);
            const unsigned own = hb.x + hb.y + hb.z + hb.w;
            unsigned suf = own;
#pragma unroll
            for (int o = 1; o < 64; o <<= 1) { const unsigned t = __shfl_down(suf, o); suf += (lane + o < 64) ? t : 0u; }
            const unsigned above = suf - own;
            if (above < remaining && remaining <= suf) {
                unsigned c3 = above, d, rem;
                if (remaining <= c3 + hb.w) { d = 3; rem = remaining - c3; }
                else { c3 += hb.w; if (remaining <= c3 + hb.z) { d = 2; rem = remaining - c3; }
                    else { c3 += hb.z; if (remaining <= c3 + hb.y) { d = 1; rem = remaining - c3; } else { c3 += hb.y; d = 0; rem = remaining - c3; } } }
                ctl[0] = 4u * lane + d; ctl[1] = rem;
            }
        }
        __syncthreads();
        prefix |= ctl[0] << shift; mask |= 255u << shift; remaining = ctl[1];
        __syncthreads();
    }
    const unsigned thr = prefix;
    unsigned ceq = 0u, cgt = 0u;
#pragma unroll
    for (int q = 0; q < 8; ++q) { ceq += (v[q] == thr) ? 1u : 0u; cgt += (v[q] > thr) ? 1u : 0u; }
    unsigned inc = ceq;
#pragma unroll
    for (int o = 1; o < 64; o <<= 1) { const unsigned t = __shfl_up(inc, o); inc += (lane >= o) ? t : 0u; }
    if (lane == 63) wtot[w] = inc;
    __syncthreads();
    unsigned eqbase = inc - ceq;
#pragma unroll
    for (int q = 0; q < 8; ++q) eqbase += (q < w) ? wtot[q] : 0u;
    __syncthreads();
    unsigned selmask = 0u, nsel = 0u, er = eqbase;
#pragma unroll
    for (int q = 0; q < 8; ++q) { bool s = v[q] > thr; if (v[q] == thr) { s = er < remaining; ++er; } selmask |= s ? (1u << q) : 0u; nsel += s ? 1u : 0u; }
    inc = nsel;
#pragma unroll
    for (int o = 1; o < 64; o <<= 1) { const unsigned t = __shfl_up(inc, o); inc += (lane >= o) ? t : 0u; }
    if (lane == 63) wtot[w] = inc;
    __syncthreads();
    unsigned pos = inc - nsel;
#pragma unroll
    for (int q = 0; q < 8; ++q) pos += (q < w) ? wtot[q] : 0u;
    int* seltok = (int*)(ws + WS_SELTOK) + bx * CAP; float* selgate = (float*)(ws + WS_SELGATE) + bx * CAP;
#pragma unroll
    for (int q = 0; q < 8; ++q) if (selmask & (1u << q)) { if (pos < (unsigned)CAP) { seltok[pos] = tid * 8 + q; selgate[pos] = __uint_as_float(v[q]); } ++pos; }
    (void)cgt;
}

__device__ __forceinline__ void p11_gather(const Args& a, int gw, int NGW, int lane) {
    unsigned char* ws = a.ws;
    const float* h = a.out; const float* ss = (const float*)(ws + WS_SSP); const float* g = (const float*)(ws + WS_SMALL) + SM_FNG;
    const int* seltok = (const int*)(ws + WS_SELTOK); bf16_t* XE = (bf16_t*)(ws + WS_XE);
    for (int r = gw; r < NSLOT; r += NGW) {
        const int e = r >> 11, b = (r >> 9) & 3, c = r & 511;
        const int tok = seltok[(b * 16 + e) * CAP + c]; const size_t m = (size_t)b * SEQ + tok;
        const float rs = 1.0f / sqrtf(wave_sum(lane < 32 ? ss[m * 32 + lane] : 0.f) * (1.0f / DM) + RMS_EPS);
        const float4* hr = (const float4*)(h + m * DM) + lane; v2u* o = (v2u*)(XE + (size_t)r * DM) + lane;
#pragma unroll
        for (int j = 0; j < 8; ++j) { const float4 hv = hr[64 * j], gg = ((const float4*)g)[64 * j + lane];
            v2u w; w.x = pk2(hv.x * rs * gg.x, hv.y * rs * gg.y); w.y = pk2(hv.z * rs * gg.z, hv.w * rs * gg.w); o[64 * j] = w; }
    }
}

__device__ __forceinline__ void p14_combine(const Args& a, unsigned char* lds, int wave, int lane) {
    unsigned char* ws = a.ws;
    const int G = gridDim.x, bx = blockIdx.x, tid = fresh_tid();
    const int per = M / G;
    const int m0 = bx * per, b = m0 >> 12, t0 = m0 & (SEQ - 1);
    int* inv = (int*)lds;
    for (int i = tid; i < per * 16; i += NTHREADS) inv[i] = -1;
    __syncthreads();
    const int* seltok = (const int*)(ws + WS_SELTOK) + b * 16 * CAP;
    for (int i = tid; i < 16 * CAP; i += NTHREADS) { const int e = i >> 9, c = i & 511; const int tok = seltok[i]; const int tl = tok - t0;
        if (tl >= 0 && tl < per) inv[tl * 16 + e] = e * 2048 + b * 512 + c; }
    __syncthreads();
    const bf16_t* YE = (const bf16_t*)(ws + WS_XE);
    float* out = a.out;
    for (int tl = wave; tl < per; tl += NWAVES) {
        const size_t m = (size_t)m0 + tl;
        float4* orow = (float4*)(out + m * DM) + lane;
        float4 acc[8];
#pragma unroll
        for (int j = 0; j < 8; ++j) acc[j] = orow[64 * j];
        int sl[16]; int ns = 0;
#pragma unroll
        for (int e = 0; e < 16; ++e) { const int s_ = inv[tl * 16 + e]; if (s_ >= 0) { _Pragma("unroll") for (int q = 0; q < 16; ++q) if (q == ns) sl[q] = s_; ++ns; } }
        for (int q = 0; q < ns; q += 2) { int s0 = sl[0], s1 = sl[0];
#pragma unroll
            for (int z = 0; z < 16; ++z) { if (z == q) s0 = sl[z]; if (z == q + 1) s1 = sl[z]; }
            const bool two = q + 1 < ns;
            const v2u* y0 = (const v2u*)(YE + (size_t)s0 * DM) + lane; const v2u* y1 = (const v2u*)(YE + (size_t)(two ? s1 : s0) * DM) + lane;
            v2u w0[8], w1[8];
#pragma unroll
            for (int j = 0; j < 8; ++j) { w0[j] = y0[64 * j]; w1[j] = y1[64 * j]; }
#pragma unroll
            for (int j = 0; j < 8; ++j) { acc[j].x += bflo(w0[j].x); acc[j].y += bfhi(w0[j].x); acc[j].z += bflo(w0[j].y); acc[j].w += bfhi(w0[j].y);
                if (two) { acc[j].x += bflo(w1[j].x); acc[j].y += bfhi(w1[j].x); acc[j].z += bflo(w1[j].y); acc[j].w += bfhi(w1[j].y); } } }
#pragma unroll
        for (int j = 0; j < 8; ++j) orow[64 * j] = acc[j];
    }
}


namespace scan {
typedef short bf16x8 __attribute__((ext_vector_type(8)));
typedef float f32x4 __attribute__((ext_vector_type(4)));
constexpr int TS = 72, TILE_B = 64 * TS * 2;
enum { SL_ATR = 0, SL_BTR = 1, SL_KTR = 2, SL_RTR = 3, SL_ATC = 4, SL_BBT = 5, SL_KBT = 6, SL_VT = 7, SL_XAR = 8, SL_XAC = 9, SL_TTA = 10, SL_NKA = 11, SL_NBRT = 12, SL_G = 13, SL_SB = 14,
       SL_XBR = 0, SL_XBC = 1, SL_TTB = 2, SL_AP = 8, SL_APT = 9, SL_RPT = 4, SL_HT = 11, SL_PSIT = 10, SL_WB = 12 };
constexpr int OFF_PL = 15 * TILE_B, OFF_TOT = OFF_PL + 256;
#define TILE(s) (L + (s) * TILE_B)
__device__ __forceinline__ bf16x8 frag(const LAS unsigned char* tile, int row0, int k0, int lane) {
    return *(const LAS bf16x8*)(tile + ((row0 + (lane & 15)) * TS + k0 + 8 * (lane >> 4)) * 2);
}
__device__ __forceinline__ void mma(f32x4& acc, const LAS unsigned char* A, int arow0, const LAS unsigned char* B, int brow0, int lane) {
    acc = __builtin_amdgcn_mfma_f32_16x16x32_bf16(frag(A, arow0, 0, lane), frag(B, brow0, 0, lane), acc, 0, 0, 0);
    acc = __builtin_amdgcn_mfma_f32_16x16x32_bf16(frag(A, arow0, 32, lane), frag(B, brow0, 32, lane), acc, 0, 0, 0);
}
__device__ __forceinline__ void st4(LAS unsigned char* tile, int brow, int acol0, const f32x4& v) {
    v2u w; w.x = pg8::cvt_pk_bf16(v[0], v[1]); w.y = pg8::cvt_pk_bf16(v[2], v[3]); *(LAS v2u*)(tile + (brow * TS + acol0) * 2) = w;
}
__device__ __forceinline__ f32x4 ld4(const LAS unsigned char* tile, int brow, int acol0) {
    const v2u w = *(const LAS v2u*)(tile + (brow * TS + acol0) * 2); return (f32x4){bflo(w.x), bfhi(w.x), bflo(w.y), bfhi(w.y)};
}
struct Fr { bf16x8 k0, k1; };
__device__ __forceinline__ Fr ldf(const LAS unsigned char* tile, int row0, int lane) { Fr f; f.k0 = frag(tile, row0, 0, lane); f.k1 = frag(tile, row0, 32, lane); return f; }
__device__ __forceinline__ void mmf(f32x4& acc, const Fr& A, const Fr& B) {
    acc = __builtin_amdgcn_mfma_f32_16x16x32_bf16(A.k0, B.k0, acc, 0, 0, 0); acc = __builtin_amdgcn_mfma_f32_16x16x32_bf16(A.k1, B.k1, acc, 0, 0, 0);
}
#define ZERO4 ((f32x4){0.f, 0.f, 0.f, 0.f})
#define LWAIT() asm volatile("s_waitcnt lgkmcnt(0)" ::: "memory")

__device__ __forceinline__ void scan_phase(const Args& a, unsigned char* ldsg) {
    const int bx = blockIdx.x; if (bx >= 128) return;
    LAS unsigned char* L = (LAS unsigned char*)ldsg;
    const int tid = fresh_tid(), lane = tid & 63, w = __builtin_amdgcn_readfirstlane(tid >> 6);
    const int dir = bx >> 6, b = (bx >> 4) & 3, hh = bx & 15;
    unsigned char* ws = a.ws;
    const bf16_t* RKV = (const bf16_t*)(ws + WS_RKV) + hh * 64 + lane;
    const bf16_t* LW = (const bf16_t*)(ws + WS_LORA) + (size_t)dir * ((size_t)M * 1024) + hh * 64 + lane;
    const bf16_t* AL = (const bf16_t*)(ws + WS_LORA) + (size_t)(2 + dir) * ((size_t)M * 1024) + hh * 64 + lane;
    bf16_t* YS = (bf16_t*)((unsigned char*)a.out + (dir ? DO_YSB : DO_YSF));
    const float kkc = ((const float*)(ws + WS_SMALL))[SM_KK + hh * 64 + lane], kac = ((const float*)(ws + WS_SMALL))[SM_KA + hh * 64 + lane];
    const int g4 = lane >> 4, l15 = lane & 15;
    const int ta = w >> 1, tb0 = (w & 1) * 2;
    const int a0 = ta * 16 + 4 * g4;
    unsigned short rw[8][5]; float inr[8];
    const float* INRM = (const float*)(ws + WS_INRM) + hh;
#define RAW_LOAD(chunk) do { _Pragma("unroll") for (int j = 0; j < 8; ++j) { const int s_ = (chunk) * 64 + w * 8 + j; const int t_ = dir ? (SEQ - 1 - s_) : s_; const size_t m_ = (size_t)b * SEQ + t_; \
        rw[j][0] = RKV[m_ * 3072]; rw[j][1] = RKV[m_ * 3072 + 1024]; rw[j][2] = RKV[m_ * 3072 + 2048]; rw[j][3] = LW[m_ * 1024]; rw[j][4] = AL[m_ * 1024]; inr[j] = INRM[m_ * 16]; } } while (0)
    RAW_LOAD(0);
    f32x4 accS[4];
#pragma unroll
    for (int q = 0; q < 4; ++q) accS[q] = (f32x4){0.f, 0.f, 0.f, 0.f};
    for (int u = tid; u < TILE_B / 16; u += NTHREADS) ((LAS v4u*)TILE(SL_SB))[u] = (v4u){0u, 0u, 0u, 0u};
#pragma unroll 1
    for (int c = 0; c < SEQ / 64; ++c) {
        float cl[8];
        {
            float run = 0.f;
#pragma unroll
            for (int j = 0; j < 8; ++j) { run += bf2f(rw[j][3]); cl[j] = run; }
            ((LAS float*)(L + OFF_TOT))[w * 64 + lane] = run;
        }
        __syncthreads();
        {
            float off = 0.f, tot = 0.f;
#pragma unroll
            for (int q = 0; q < 8; ++q) { const float t_ = ((const LAS float*)(L + OFF_TOT))[q * 64 + lane]; off += (q < w) ? t_ : 0.f; tot += t_; }
            const float pLt = __expf(tot);
            if (w == 0) ((LAS float*)(L + OFF_PL))[lane] = pLt;
            float pprev = __expf(off);
            unsigned atc[4], bbt[4], kbt[4], vt[4];
#pragma unroll
            for (int j = 0; j < 8; ++j) {
                const float r = bf2f(rw[j][0]), k = bf2f(rw[j][1]), al = bf2f(rw[j][4]);
                const float p = __expf(cl[j] + off), em = __builtin_amdgcn_rcpf(p), eL = pLt * em;
                const float kk = k * kkc * inr[j], kdv = k * (1.0f + (al - 1.0f) * kac), bbj = kk * al;
                const float at = -kk * pprev; pprev = p;
                const int s = w * 8 + j;
                const unsigned w01 = pg8::cvt_pk_bf16(at, bbj * em), w23 = pg8::cvt_pk_bf16(kdv * em, r * p);
                *(LAS unsigned short*)(TILE(SL_ATR) + (s * TS + lane) * 2) = (unsigned short)w01;
                *(LAS unsigned short*)(TILE(SL_BTR) + (s * TS + lane) * 2) = (unsigned short)(w01 >> 16);
                *(LAS unsigned short*)(TILE(SL_KTR) + (s * TS + lane) * 2) = (unsigned short)w23;
                *(LAS unsigned short*)(TILE(SL_RTR) + (s * TS + lane) * 2) = (unsigned short)(w23 >> 16);
                const float bbv = bbj * eL, kbv = kdv * eL;
                if (j & 1) { atc[j >> 1] |= (w01 << 16); bbt[j >> 1] = pg8::cvt_pk_bf16(__uint_as_float(bbt[j >> 1]), bbv); kbt[j >> 1] = pg8::cvt_pk_bf16(__uint_as_float(kbt[j >> 1]), kbv); vt[j >> 1] |= ((unsigned)rw[j][2] << 16); }
                else { atc[j >> 1] = w01 & 0xffffu; bbt[j >> 1] = __float_as_uint(bbv); kbt[j >> 1] = __float_as_uint(kbv); vt[j >> 1] = rw[j][2]; }
            }
            *(LAS v4u*)(TILE(SL_ATC) + (lane * TS + w * 8) * 2) = (v4u){atc[0], atc[1], atc[2], atc[3]};
            *(LAS v4u*)(TILE(SL_BBT) + (lane * TS + w * 8) * 2) = (v4u){bbt[0], bbt[1], bbt[2], bbt[3]};
            *(LAS v4u*)(TILE(SL_KBT) + (lane * TS + w * 8) * 2) = (v4u){kbt[0], kbt[1], kbt[2], kbt[3]};
            *(LAS v4u*)(TILE(SL_VT) + (lane * TS + w * 8) * 2) = (v4u){vt[0], vt[1], vt[2], vt[3]};
        }
        if (c + 1 < SEQ / 64) RAW_LOAD(c + 1);
        __syncthreads();
        f32x4 accT[2], accH[2];
        {
            const Fr aAT = ldf(TILE(SL_ATR), ta * 16, lane), aBT = ldf(TILE(SL_BTR), ta * 16, lane), aKT = ldf(TILE(SL_KTR), ta * 16, lane);
            Fr bBT[2], bKT[2], bAT[2], bRT[2];
#pragma unroll
            for (int q = 0; q < 2; ++q) { bBT[q] = ldf(TILE(SL_BTR), (tb0 + q) * 16, lane); bKT[q] = ldf(TILE(SL_KTR), (tb0 + q) * 16, lane); bAT[q] = ldf(TILE(SL_ATR), (tb0 + q) * 16, lane); bRT[q] = ldf(TILE(SL_RTR), (tb0 + q) * 16, lane); }
            f32x4 d1[2], d2[2], d3[2], d4[2];
#pragma unroll
            for (int q = 0; q < 2; ++q) { d1[q] = ZERO4; d2[q] = ZERO4; d3[q] = ZERO4; d4[q] = ZERO4; accH[q] = ZERO4;
                mmf(d1[q], aAT, bBT[q]);
                mmf(d3[q], aAT, bKT[q]);
                mmf(d2[q], aBT, bAT[q]);
                mmf(d4[q], aBT, bRT[q]);
                mmf(accH[q], aKT, bRT[q]); }
#pragma unroll
            for (int q = 0; q < 2; ++q) { const int bcol = (tb0 + q) * 16 + l15;
#pragma unroll
                for (int e = 0; e < 4; ++e) { const bool lt = bcol < a0 + e, gt = a0 + e < bcol, ge = a0 + e <= bcol;
                    d1[q][e] = lt ? d1[q][e] : 0.f; d3[q][e] = lt ? d3[q][e] : 0.f;
                    d2[q][e] = gt ? d2[q][e] : 0.f; d4[q][e] = ge ? d4[q][e] : 0.f; accH[q][e] = ge ? accH[q][e] : 0.f; }
                st4(TILE(SL_XAR), bcol, a0, d1[q]); st4(TILE(SL_NKA), bcol, a0, d3[q]); st4(TILE(SL_XAC), bcol, a0, d2[q]); st4(TILE(SL_NBRT), bcol, a0, d4[q]);
#pragma unroll
                for (int e = 0; e < 4; ++e) d2[q][e] += (a0 + e == bcol) ? 1.0f : 0.f;
                accT[q] = d2[q]; st4(TILE(SL_TTA), bcol, a0, d2[q]); }
        }
        __syncthreads();
#pragma unroll
        for (int r = 0; r <= 5; ++r) {
            LAS unsigned char* Xr = (r & 1) ? TILE(SL_XBR) : TILE(SL_XAR); LAS unsigned char* Xc = (r & 1) ? TILE(SL_XBC) : TILE(SL_XAC);
            LAS unsigned char* Xr2 = (r & 1) ? TILE(SL_XAR) : TILE(SL_XBR); LAS unsigned char* Xc2 = (r & 1) ? TILE(SL_XAC) : TILE(SL_XBC);
            LAS unsigned char* TTr = ((r - 1) & 1) ? TILE(SL_TTB) : TILE(SL_TTA); LAS unsigned char* TTw = (r & 1) ? TILE(SL_TTB) : TILE(SL_TTA);
            const Fr aXr = ldf(Xr, ta * 16, lane); Fr aXc, bTT[2], bXc[2], bXr[2];
            if (r < 5) aXc = ldf(Xc, ta * 16, lane);
#pragma unroll
            for (int q = 0; q < 2; ++q) { if (r >= 1) bTT[q] = ldf(TTr, (tb0 + q) * 16, lane); if (r < 5) { bXc[q] = ldf(Xc, (tb0 + q) * 16, lane); bXr[q] = ldf(Xr, (tb0 + q) * 16, lane); } }
            f32x4 x1[2], x2[2];
#pragma unroll
            for (int q = 0; q < 2; ++q) {
                if (r >= 1) mmf(accT[q], aXr, bTT[q]);
                if (r < 5) { x1[q] = ZERO4; x2[q] = ZERO4; mmf(x1[q], aXr, bXc[q]);
                             mmf(x2[q], aXc, bXr[q]); } }
#pragma unroll
            for (int q = 0; q < 2; ++q) { const int bcol = (tb0 + q) * 16 + l15;
                if (r >= 1) st4(TTw, bcol, a0, accT[q]);
                if (r < 5) { st4(Xc2, bcol, a0, x1[q]); st4(Xr2, bcol, a0, x2[q]); } }
            __syncthreads();
        }
        {
            const Fr aATC = ldf(TILE(SL_ATC), ta * 16, lane), aTT = ldf(TILE(SL_TTB), ta * 16, lane); Fr bTT[2], bATC[2], bNKA[2];
#pragma unroll
            for (int q = 0; q < 2; ++q) { bTT[q] = ldf(TILE(SL_TTB), (tb0 + q) * 16, lane); bATC[q] = ldf(TILE(SL_ATC), (tb0 + q) * 16, lane); bNKA[q] = ldf(TILE(SL_NKA), (tb0 + q) * 16, lane); }
            f32x4 e1[2], e2[2], e3[2];
#pragma unroll
            for (int q = 0; q < 2; ++q) { e1[q] = ZERO4; e2[q] = ZERO4; e3[q] = ZERO4;
                mmf(e1[q], aATC, bTT[q]);
                mmf(e2[q], aTT, bATC[q]);
                mmf(e3[q], aTT, bNKA[q]); }
#pragma unroll
            for (int q = 0; q < 2; ++q) { const int bcol = (tb0 + q) * 16 + l15; st4(TILE(SL_APT), bcol, a0, e1[q]); st4(TILE(SL_AP), bcol, a0, e2[q]); st4(TILE(SL_G), bcol, a0, e3[q]); }
        }
        __syncthreads();
        {
            const Fr aAP = ldf(TILE(SL_AP), ta * 16, lane), aG = ldf(TILE(SL_G), ta * 16, lane); Fr bNB[2], bBB[2]; f32x4 rp[2], ps[2];
#pragma unroll
            for (int q = 0; q < 2; ++q) { const int bcol = (tb0 + q) * 16 + l15; bNB[q] = ldf(TILE(SL_NBRT), (tb0 + q) * 16, lane); bBB[q] = ldf(TILE(SL_BBT), (tb0 + q) * 16, lane);
                rp[q] = ld4(TILE(SL_RTR), bcol, a0); ps[q] = ld4(TILE(SL_KBT), bcol, a0); }
#pragma unroll
            for (int q = 0; q < 2; ++q) { mmf(rp[q], aAP, bNB[q]);
                mmf(accH[q], aG, bNB[q]);
                mmf(ps[q], aG, bBB[q]); }
#pragma unroll
            for (int q = 0; q < 2; ++q) { const int bcol = (tb0 + q) * 16 + l15;
                st4(TILE(SL_RPT), bcol, a0, rp[q]); st4(TILE(SL_HT), bcol, a0, accH[q]); st4(TILE(SL_PSIT), bcol, a0, ps[q]); }
        }
        __syncthreads();
        if (w < 4) {
            const int vrow = w * 16 + l15;
            const Fr fS = ldf(TILE(SL_SB), w * 16, lane), fV = ldf(TILE(SL_VT), w * 16, lane);
            f32x4 wv[4], yv[4];
            {
                Fr fAPT[4];
#pragma unroll
                for (int q = 0; q < 4; ++q) fAPT[q] = ldf(TILE(SL_APT), q * 16, lane);
#pragma unroll
                for (int q = 0; q < 4; ++q) { wv[q] = ZERO4; mmf(wv[q], fAPT[q], fS); }
#pragma unroll
                for (int q = 0; q < 4; ++q) st4(TILE(SL_WB), vrow, q * 16 + 4 * g4, wv[q]);
            }
            {
                Fr fRPT[4], fHT[4];
#pragma unroll
                for (int q = 0; q < 4; ++q) { fRPT[q] = ldf(TILE(SL_RPT), q * 16, lane); fHT[q] = ldf(TILE(SL_HT), q * 16, lane); }
#pragma unroll
                for (int q = 0; q < 4; ++q) { yv[q] = ZERO4; mmf(yv[q], fS, fRPT[q]); mmf(yv[q], fV, fHT[q]); }
#pragma unroll
                for (int q = 0; q < 4; ++q) { const int s_ = c * 64 + q * 16 + l15; const int t_ = dir ? (SEQ - 1 - s_) : s_;
                    v2u o; o.x = pg8::cvt_pk_bf16(yv[q][0], yv[q][1]); o.y = pg8::cvt_pk_bf16(yv[q][2], yv[q][3]);
                    *(v2u*)(YS + ((size_t)b * SEQ + t_) * 1024 + hh * 64 + w * 16 + 4 * g4) = o; }
            }
            {
                Fr fPS[4];
#pragma unroll
                for (int q = 0; q < 4; ++q) fPS[q] = ldf(TILE(SL_PSIT), q * 16, lane);
#pragma unroll
                for (int q = 0; q < 4; ++q) { const f32x4 pl = *(const LAS f32x4*)(L + OFF_PL + (q * 16 + 4 * g4) * 4); accS[q] = accS[q] * pl; mmf(accS[q], fPS[q], fV); }
                LWAIT();
                const Fr fW = ldf(TILE(SL_WB), w * 16, lane); Fr fBB[4];
#pragma unroll
                for (int q = 0; q < 4; ++q) fBB[q] = ldf(TILE(SL_BBT), q * 16, lane);
#pragma unroll
                for (int q = 0; q < 4; ++q) { mmf(accS[q], fBB[q], fW); st4(TILE(SL_SB), vrow, q * 16 + 4 * g4, accS[q]); }
            }
        }
    }
#undef RAW_LOAD
}
#undef TILE
#undef LWAIT
}
__global__ void __launch_bounds__(NTHREADS, 2) mega_fwd(Args a) {
    extern __shared__ __attribute__((aligned(16))) unsigned char lds[];
    cg::grid_group grid = cg::this_grid();
    const int G = gridDim.x, bx = blockIdx.x;
    const int vcu = (G % 8 == 0) ? (bx % 8) * (G / 8) + bx / 8 : bx;
    const int NGW = G * NWAVES;
#define WIDS() const int tid = fresh_tid(), lane = tid & 63, wave = __builtin_amdgcn_readfirstlane(tid >> 6), gw = vcu * NWAVES + wave; (void)lane; (void)gw
    unsigned char* ws = a.ws;
    LAS unsigned char* lds3 = (LAS unsigned char*)lds;
    const int lo = a.ph_lo, hi = a.ph_hi;
#ifndef ONLY
#define ONLY -1
#endif
#define IN(k) (lo <= (k) && (k) < hi && (ONLY < 0 || ONLY == (k)))
#ifndef DUPMASK
#define DUPMASK 0
#endif
#ifndef USE_CG
#define USE_CG 0
#endif
#define GRIDBAR(k) do { if (USE_CG || a.ph_hi > 1000) grid.sync(); else xcd_barrier(bar); } while (0)
#define SEAM(k) do { if (IN(k) && IN((k) + 1)) GRIDBAR(k); } while (0)
#define PH_BEGIN(k) if (IN(k)) for (int rep_ = 0; rep_ <= ((DUPMASK >> (k)) & 1); ++rep_) { if (rep_) GRIDBAR(1);
#define PH_END(k) } SEAM(k);
    for (int u = fresh_tid(); u < 64; u += NTHREADS) ((LAS unsigned*)(lds3 + MISC_OFF))[u] = 0u;
    __syncthreads();
    XcdBarrier bar = xcd_barrier_post((unsigned*)(ws + WS_BAR), (volatile LAS unsigned*)(lds3 + MISC_OFF) + 8);

    PH_BEGIN(0) { WIDS(); p0_prologue(a, lds3, gw, NGW, wave, lane); } PH_END(0)
    PH_BEGIN(1) {
        pg8::Gemm g{(const bf16_t*)(ws + WS_HN), (const bf16_t*)(ws + WS_WINT), DM, DM, DM}; pg8::StaticOrder S; S.init(M, IN_PAD, G, bx);
        pg8::EpiProj E{(bf16_t*)(ws + WS_PDA), (bf16_t*)((unsigned char*)a.out + DO_PRW), (bf16_t*)(ws + WS_GATES)};
        pg8::gemm_phase<pg8::EpiProj, pg8::StaticOrder, true, true>(lds3, g, S, E);
        if (G == 256 && bx >= 128) { WIDS(); expert_convert(a, lds3, (bx - 128) * NWAVES + wave, 128 * NWAVES, wave, lane, 2 * 16384, 3 * 16384); }
        else if (G != 256) { WIDS(); expert_convert(a, lds3, gw, NGW, wave, lane, 2 * 16384, 3 * 16384); }
    } PH_END(1)
    PH_BEGIN(2) { WIDS(); p2_prep(a, gw, NGW, lane); } PH_END(2)
    PH_BEGIN(3) {
        const bf16_t* LIN = (const bf16_t*)((unsigned char*)a.out + DO_LIN);
        { pg8::Gemm g{LIN, (const bf16_t*)(ws + WS_BTL1), 512, 256, 256}; pg8::StaticOrder S; S.init(M, 4096, G, bx);
          pg8::EpiLora<0> E{(bf16_t*)(ws + WS_LORA), (const float*)(ws + WS_BIAS4)};
          pg8::gemm_phase<pg8::EpiLora<0>, pg8::StaticOrder, true, true>(lds3, g, S, E); }
        { pg8::Gemm g{LIN + 256, (const bf16_t*)(ws + WS_BTL2), 512, 256, 256}; pg8::StaticOrder S; S.init(M, 1024, G, bx);
          pg8::EpiLora<1> E{(bf16_t*)(ws + WS_LORA), nullptr};
          pg8::gemm_phase<pg8::EpiLora<1>, pg8::StaticOrder, true, true>(lds3, g, S, E); }
    } PH_END(3)
    PH_BEGIN(4) { WIDS();
        const float* sm = (const float*)(ws + WS_SMALL); const float d1 = wave_sum(sm[SM_LQ1 + lane] * sm[SM_LK1 + lane]), d2 = wave_sum(sm[SM_LQ2 + lane] * sm[SM_LK2 + lane]);
        const float lam = __expf(d1) - __expf(d2) + LAM_INIT;
        const bf16_t* PDA = (const bf16_t*)(ws + WS_PDA); bf16_t* YA = (bf16_t*)((unsigned char*)a.out + DO_YAB);
        if (G == 256) {
            int u0, nu;
            if (bx < 128) { scan::scan_phase(a, lds); __syncthreads(); const int i = (bx & 7) * 16 + (bx >> 3); u0 = 768 + 2 * i; nu = 2; }
            else { const int k = bx - 128, i = (k & 7) * 16 + (k >> 3); u0 = 6 * i; nu = 6; }
            for (int q = 0; q < nu; ++q) { const int u = u0 + q; const int bh = u >> 5, qb = u & 31, b = bh >> 3, h = bh & 7;
                const size_t row0 = (size_t)b * SEQ;
                attn::attn_unit(PDA + (row0 + qb * 128) * 3072 + h * 128, PDA + row0 * 3072 + 1024 + h * 128, PDA + row0 * 3072 + 2048 + h * 128,
                                YA + (row0 + qb * 128) * 2048 + h * 128, lam, sm + SM_SUBLN, SEQ, (char*)lds); }
        } else {
        const int upb = 1024 / G;
        for (int i = 0; i < upb; ++i) { const int u = vcu * upb + i; const int bh = u >> 5, qb = u & 31, b = bh >> 3, h = bh & 7;
            const size_t row0 = (size_t)b * SEQ;
            attn::attn_unit(PDA + (row0 + qb * 128) * 3072 + h * 128, PDA + row0 * 3072 + 1024 + h * 128, PDA + row0 * 3072 + 2048 + h * 128,
                            YA + (row0 + qb * 128) * 2048 + h * 128, lam, sm + SM_SUBLN, SEQ, (char*)lds); }
        }
    } PH_END(4)
    if (G != 256) { PH_BEGIN(5) { scan::scan_phase(a, lds); } PH_END(5) }
    PH_BEGIN(6) { WIDS(); p6_rwpost(a, gw, NGW, lane); } PH_END(6)
    PH_BEGIN(7) {
        bf16_t* MG = (bf16_t*)(ws + WS_MERGED); const bf16_t* GT = (const bf16_t*)(ws + WS_GATES);
        { pg8::Gemm g{(const bf16_t*)((unsigned char*)a.out + DO_YAB), (const bf16_t*)(ws + WS_WAT), DM, DM, DM}; pg8::StaticOrder S; S.init(M, DM, G, bx);
          pg8::EpiMergeF E{MG, GT}; pg8::gemm_phase<pg8::EpiMergeF, pg8::StaticOrder, true, true>(lds3, g, S, E); }
    } PH_END(7)
    PH_BEGIN(8) {
        pg8::Gemm g{(const bf16_t*)(ws + WS_MERGED), (const bf16_t*)(ws + WS_WOT), DM, DM, DM}; pg8::StaticOrder S; S.init(M, DM, G, bx);
        pg8::EpiOut E{a.in[I_X], a.out, (float*)(ws + WS_SSP)};
        pg8::gemm_phase<pg8::EpiOut, pg8::StaticOrder, true, true>(lds3, g, S, E);
    } PH_END(8)
    PH_BEGIN(9) { WIDS(); p9_router(a, lds3, gw, NGW, wave, lane); } PH_END(9)
    PH_BEGIN(10) { p10_topk(a, lds); } PH_END(10)
    if (G != 256) { PH_BEGIN(11) { WIDS(); p11_gather(a, gw, NGW, lane); } PH_END(11) }
    PH_BEGIN(12) {
        pg8::EpiMoeUp E{(bf16_t*)(ws + WS_HID)};
        if (G == 256) {
            pg8::Gemm g{(const bf16_t*)(ws + WS_HN2), (const bf16_t*)(ws + WS_W1T), DM, DM, DM}; pg8::ExpertGatherOrder S{G, bx, (const int*)(ws + WS_SELTOK)};
            pg8::gemm_phase_g<pg8::EpiMoeUp, pg8::ExpertGatherOrder, true, true>(lds3, g, S, E);
        } else {
            pg8::Gemm g{(const bf16_t*)(ws + WS_XE), (const bf16_t*)(ws + WS_W1T), DM, DM, DM}; pg8::ExpertOrder S{G, bx};
            pg8::gemm_phase<pg8::EpiMoeUp, pg8::ExpertOrder, true, true>(lds3, g, S, E);
        }
    } PH_END(12)
    PH_BEGIN(13) {
        pg8::Gemm g{(const bf16_t*)(ws + WS_HID), (const bf16_t*)(ws + WS_WDT), FF, FF, FF}; pg8::ExpertOrder S{G, bx};
        pg8::EpiMoeDown E{(bf16_t*)(ws + WS_XE), (const float*)(ws + WS_SELGATE)};
        pg8::gemm_phase<pg8::EpiMoeDown, pg8::ExpertOrder, true, true>(lds3, g, S, E);
    } PH_END(13)
    PH_BEGIN(14) { WIDS(); p14_combine(a, lds, wave, lane); } }
#undef IN
#undef SEAM
}

constexpr int NPHASES = 15;
#ifndef MK_SPLIT
#define MK_SPLIT 0
#endif
extern "C" void kernel_launch(void* const* d_in, const int* in_sizes, int n_in, void* d_out, int out_size, void* d_ws, size_t ws_size, hipStream_t stream) {
    static int grid = 0;
    if (grid == 0) {
        if (n_in != 33 || in_sizes[0] != M * DM || out_size != M * DM || ws_size < WS_NEED) {
            fprintf(stderr, "kernel_launch: unexpected shapes: n_in %d in0 %d out %d ws %zu (need %zu)\n", n_in, n_in > 0 ? in_sizes[0] : -1, out_size, ws_size, (size_t)WS_NEED); grid = -1; return; }
        int dev = 0, cus = 0, per_cu = 0;
        if (hipGetDevice(&dev) != hipSuccess || hipDeviceGetAttribute(&cus, hipDeviceAttributeMultiprocessorCount, dev) != hipSuccess) { grid = -1; return; }
        if (hipFuncSetAttribute((const void*)mega_fwd, hipFuncAttributeMaxDynamicSharedMemorySize, LDS_BYTES) != hipSuccess) { fprintf(stderr, "kernel_launch: hipFuncSetAttribute failed\n"); grid = -1; return; }
        if (hipOccupancyMaxActiveBlocksPerMultiprocessor(&per_cu, (const void*)mega_fwd, NTHREADS, LDS_BYTES) != hipSuccess || per_cu < 1) { fprintf(stderr, "kernel_launch: occupancy query says %d\n", per_cu); (void)hipGetLastError(); per_cu = 1; }
        grid = cus;
        if (grid != 256) fprintf(stderr, "kernel_launch: note: %d CUs (tuned for 256)\n", grid);
    }
    if (grid < 0) return;
    if (hipMemsetAsync((char*)d_ws + WS_BAR, 0, 16384, stream) != hipSuccess) { fprintf(stderr, "kernel_launch: memset failed\n"); return; }
    Args a{};
    for (int i = 0; i < 33; ++i) a.in[i] = (const float*)d_in[i];
    a.out = (float*)d_out; a.ws = (unsigned char*)d_ws;
#if MK_SPLIT
    for (int p = 0; p < NPHASES; ++p) { a.ph_lo = p; a.ph_hi = p + 1; void* args[] = {&a};
        hipError_t e = hipLaunchCooperativeKernel((const void*)mega_fwd, dim3(grid), dim3(NTHREADS), args, LDS_BYTES, stream);
        if (e != hipSuccess) { fprintf(stderr, "kernel_launch: launch of phase %d failed: %s\n", p, hipGetErrorString(e)); return; } }
#else
    a.ph_lo = 0; a.ph_hi = NPHASES; void* args[] = {&a};
    hipError_t e = hipLaunchCooperativeKernel((const void*)mega_fwd, dim3(grid), dim3(NTHREADS), args, LDS_BYTES, stream);
    if (e != hipSuccess) fprintf(stderr, "kernel_launch: cooperative launch failed: %s (grid %d)\n", hipGetErrorString(e), grid);
#endif
}
```

```cpp
#include <hip/hip_runtime.h>
#include <hip/hip_cooperative_groups.h>
#include <cstdio>
#include <cstdint>
namespace cg = cooperative_groups;

constexpr int NB = 4, SEQ = 4096, M = NB * SEQ, DM = 2048;
constexpr int DA_COLS = 3072, RW_COLS = 3488, RW_PAD = 3584, GATE_COLS = 4096, IN_COLS = 10656, IN_PAD = 10752;
constexpr int NE = 16, FF = 1024, CAP = 512, NSLOT = NB * NE * CAP;
constexpr float RMS_EPS = 1e-6f, GN_EPS = 64e-5f, LAM_INIT = 0.2f;
constexpr int NWAVES = 8, NTHREADS = 512;

constexpr size_t MiB = 1u << 20;
constexpr size_t WS_SSP = 5 * MiB;
constexpr size_t WS_SELTOK = 128 * 1024;
constexpr size_t WS_SELGATE = 256 * 1024;
constexpr size_t WS_BIAS4 = 512 * 1024;
constexpr size_t WS_SMALL = 576 * 1024;
constexpr int SM_QNG = 0, SM_KNG = 64, SM_LQ1 = 128, SM_LK1 = 192, SM_LQ2 = 256, SM_LK2 = 320, SM_SUBLN = 384, SM_MU = 512, SM_KK = 4096, SM_KA = 5120, SM_RK = 6144,
              SM_LNW = 7168, SM_LNB = 8192, SM_FNG = 9216, SM_WR = 11264, SM_END = 44032;
constexpr size_t WS_BAR = 768 * 1024;
constexpr size_t WS_INRM = 1 * MiB;
constexpr size_t WS_AFF = 1 * MiB;
constexpr size_t WS_ROPE = 7 * MiB;
constexpr size_t WS_BTL1 = 2 * MiB;
constexpr size_t WS_BTL2 = 4 * MiB;
constexpr size_t WS_WAT = 8 * MiB, WS_WBT = 12 * MiB, WS_WOT = 16 * MiB;
constexpr size_t WS_HN = 24 * MiB;
constexpr size_t WS_RKV = 24 * MiB;
constexpr size_t WS_WINT = 88 * MiB;
constexpr size_t WS_PDA = 130 * MiB;
constexpr size_t WS_MERGED = 130 * MiB;
constexpr size_t WS_GATES = 226 * MiB;
constexpr size_t WS_LORA = 354 * MiB;
constexpr size_t WS_YA = 514 * MiB;
constexpr size_t WS_END1 = 546 * MiB;
constexpr size_t WS_W1T = 24 * MiB;
constexpr size_t WS_WDT = 546 * MiB;
constexpr size_t WS_XE = 216 * MiB;
constexpr size_t WS_HN2 = 216 * MiB;
constexpr size_t WS_HID = 344 * MiB;
constexpr size_t WS_NEED = 610 * MiB;
constexpr size_t DO_PRW = 0, DO_LIN = 112 * MiB, DO_YSF = 0, DO_YSB = 32 * MiB, DO_YAB = 64 * MiB;

constexpr int MISC_OFF = 143360;
constexpr int LDS_BYTES = 147456;

#define LAS __attribute__((address_space(3)))
typedef unsigned short bf16_t;
typedef unsigned v4u __attribute__((ext_vector_type(4)));
typedef unsigned v2u __attribute__((ext_vector_type(2)));

__device__ __forceinline__ int fresh_tid() { int t = threadIdx.x; asm volatile("" : "+v"(t)); return t; }
__device__ __forceinline__ float bf2f(unsigned short b) { return __builtin_bit_cast(float, (unsigned)b << 16); }
__device__ __forceinline__ float bflo(unsigned w) { return __builtin_bit_cast(float, w << 16); }
__device__ __forceinline__ float bfhi(unsigned w) { return __builtin_bit_cast(float, w & 0xffff0000u); }
__device__ __forceinline__ unsigned f2bf(float f) { unsigned u = __builtin_bit_cast(unsigned, f); return (u + 0x7fffu + ((u >> 16) & 1u)) >> 16; }
typedef float f32x2_t __attribute__((ext_vector_type(2))); typedef __bf16 bf16x2_t __attribute__((ext_vector_type(2)));
__device__ __forceinline__ unsigned pk2(float lo, float hi) { f32x2_t v = {lo, hi}; bf16x2_t b = __builtin_convertvector(v, bf16x2_t); return __builtin_bit_cast(unsigned, b); }
__device__ __forceinline__ float sigmoidf_(float x) { return __builtin_amdgcn_rcpf(1.0f + __expf(-x)); }
__device__ __forceinline__ float wave_sum(float v) {
#pragma unroll
    for (int o = 1; o < 64; o <<= 1) v += __shfl_xor(v, o);
    return v;
}
__device__ __forceinline__ float sum8(float v) { v += __shfl_xor(v, 1); v += __shfl_xor(v, 2); v += __shfl_xor(v, 4); return v; }
__device__ __forceinline__ void unpack8(const v4u& w, float (&f)[8]) {
    f[0] = bflo(w.x); f[1] = bfhi(w.x); f[2] = bflo(w.y); f[3] = bfhi(w.y); f[4] = bflo(w.z); f[5] = bfhi(w.z); f[6] = bflo(w.w); f[7] = bfhi(w.w);
}
__device__ __forceinline__ v4u pack8(const float (&f)[8]) { v4u w; w.x = pk2(f[0], f[1]); w.y = pk2(f[2], f[3]); w.z = pk2(f[4], f[5]); w.w = pk2(f[6], f[7]); return w; }

#define XB_TMO      128
#define XB_XCNT(j)  (256  + 64 * (j))
#define XB_XSUB(j)  (1280 + 64 * (j))
#define XB_XGEN(j)  (2304 + 64 * (j))
#define XB_TOP      3328
#define XB_TOPGEN   3392
#define XCD_BAR_WORDS 3456
#define XB_SPIN_CAP (1u << 18)

__device__ __forceinline__ unsigned xb_ld(unsigned* p)              { return __hip_atomic_load(p, __ATOMIC_RELAXED, __HIP_MEMORY_SCOPE_AGENT); }
__device__ __forceinline__ unsigned xb_add(unsigned* p, unsigned v) { return __hip_atomic_fetch_add(p, v, __ATOMIC_RELAXED, __HIP_MEMORY_SCOPE_AGENT); }
__device__ __forceinline__ unsigned xb_xcc_id() { return (unsigned)__builtin_amdgcn_s_getreg((3 << 11) | 20) & 0xFu; }
#define XB_SPIN(cond, bar) do { unsigned _sp = 0; while (cond) { __builtin_amdgcn_s_sleep(1); \
    if ((++_sp & 255u) == 0u) { if (xb_ld(&(bar)[XB_TMO])) break; if (_sp > XB_SPIN_CAP) { atomicAdd(&(bar)[XB_TMO], 1u); break; } } } } while (0)

struct XcdBarrier {
    unsigned* bar; unsigned x;
    volatile LAS unsigned* st;
};

__device__ __forceinline__ XcdBarrier xcd_barrier_post(unsigned* bar, volatile LAS unsigned* st) {
    XcdBarrier b; b.bar = bar; b.x = xb_xcc_id(); b.st = st;
    if (threadIdx.x == 0) (void)xb_add(&bar[XB_XCNT(b.x)], 1u);
    return b;
}
__device__ __forceinline__ void xcd_barrier_complete(unsigned* bar, unsigned x, unsigned& nloc, unsigned& nx) {
    const unsigned G = gridDim.x * gridDim.y * gridDim.z;
    unsigned sum, cnt, mine, sp = 0u;
    for (;;) {
        sum = 0u; cnt = 0u; mine = 0u;
#pragma unroll
        for (unsigned j = 0; j < 16; ++j) { const unsigned c = xb_ld(&bar[XB_XCNT(j)]); sum += c; cnt += (c > 0u) ? 1u : 0u; mine = (j == x) ? c : mine; }
        if (sum == G) break;
        __builtin_amdgcn_s_sleep(1);
        if ((++sp & 255u) == 0u) { if (xb_ld(&bar[XB_TMO])) break; if (sp > XB_SPIN_CAP) { atomicAdd(&bar[XB_TMO], 1u); break; } }
    }
    nloc = mine > 0u ? mine : 1u; nx = cnt > 0u ? cnt : 1u;
}

__device__ __forceinline__ void xcd_barrier(const XcdBarrier& b) {
    asm volatile("s_waitcnt vmcnt(0)" ::: "memory");
    __syncthreads();
    if (threadIdx.x == 0) {
        unsigned* bar = b.bar;
        __builtin_amdgcn_s_waitcnt(0);
        unsigned nloc = b.st[0], nx = b.st[1];
        if (nloc == 0u) { xcd_barrier_complete(bar, b.x, nloc, nx); b.st[0] = nloc; b.st[1] = nx; }
        const unsigned old = xb_add(&bar[XB_XSUB(b.x)], 1u);
        const unsigned gen = old / nloc;
        if (old + 1u == (gen + 1u) * nloc) {
            __builtin_amdgcn_fence(__ATOMIC_RELEASE, "agent");
            asm volatile("s_waitcnt vmcnt(0)" ::: "memory");
            const unsigned og = xb_add(&bar[XB_TOP], 1u);
            const unsigned tg = og / nx;
            if (og + 1u == (tg + 1u) * nx) xb_add(&bar[XB_TOPGEN], 1u);
            else XB_SPIN(xb_ld(&bar[XB_TOPGEN]) == tg, bar);
            __builtin_amdgcn_fence(__ATOMIC_ACQUIRE, "agent");
            xb_add(&bar[XB_XGEN(b.x)], 1u);
            asm volatile("s_waitcnt vmcnt(0)" ::: "memory");
        } else {
            XB_SPIN(xb_ld(&bar[XB_XGEN(b.x)]) == gen, bar);
            __builtin_amdgcn_fence(__ATOMIC_ACQUIRE, "agent");
            asm volatile("s_waitcnt vmcnt(0)" ::: "memory");
        }
    }
    __syncthreads();
}
namespace pg8 {
#define PG8_LAS __attribute__((address_space(3)))
typedef unsigned short bf16_t;
typedef short bf16x8 __attribute__((ext_vector_type(8)));
typedef float f32x4 __attribute__((ext_vector_type(4)));
typedef unsigned u32x4 __attribute__((ext_vector_type(4)));
constexpr int BM = 256, BK = 64, HALF = 128, HTB = HALF * BK * 2  , STAGE_BYTES = 8 * HTB, NXCD = 8, WGM = 4;

__host__ __device__ __forceinline__ int lds_byte(int r, int c) { const int st = (r >> 4) * 2 + (c >> 5), rr = r & 15, cc = c & 31, ob = rr * 64 + cc * 2; return st * 1024 + (ob ^ (((ob >> 9) & 1) << 5)); }
__host__ __device__ __forceinline__ void stage_rc(int b, int& R, int& C) { const int st = b / 1024, sb = b % 1024, swz = sb ^ (((sb >> 9) & 1) << 5); R = (st >> 1) * 16 + swz / 64; C = (st & 1) * 32 + (swz % 64) / 2; }
__host__ __device__ __forceinline__ int perm32(int rho) { const int n = rho >> 4, i = rho & 15; return 8 * (i >> 2) + 4 * n + (i & 3); }

struct Unit { int pm, pn; };
struct Gemm { const bf16_t* A; const bf16_t* Bt; int lda, ldb, K; };

struct StaticOrder {
    int nM, nN, nwg, G, c;
    __host__ __device__ void init(int M, int N, int G_, int c_) { nM = M / BM; nN = N / BM; nwg = nM * nN; G = G_; c = c_; }
    __host__ __device__ bool next(int i, Unit& u) const {
        const long L = (long)i * G + c; if (L >= nwg) return false;
        int wgid = (int)L; { const int q = nwg / NXCD, r = nwg % NXCD, xcd = wgid % NXCD, off = wgid / NXCD; wgid = (xcd < r ? xcd * (q + 1) : r * (q + 1) + (xcd - r) * q) + off; }
        const int nig = WGM * nN, gid = wgid / nig, fm = gid * WGM, gsz = (nM - fm) < WGM ? (nM - fm) : WGM;
        u.pm = fm + ((wgid % nig) % gsz); u.pn = (wgid % nig) / gsz; return true;
    }
    __device__ __forceinline__ void a_ready(const Unit&) const {}
    __device__ __forceinline__ void done(const Unit&) const {}
};

__device__ __forceinline__ unsigned cvt_pk_bf16(float lo, float hi) { return pk2(lo, hi); }
__device__ __forceinline__ u32x4 pack_bf16x8(const f32x4& v0, const f32x4& v1) { u32x4 w; w.x = cvt_pk_bf16(v0[0], v0[1]); w.y = cvt_pk_bf16(v0[2], v0[3]); w.z = cvt_pk_bf16(v1[0], v1[1]); w.w = cvt_pk_bf16(v1[2], v1[3]); return w; }
__device__ __forceinline__ float sigm(float x) { return __builtin_amdgcn_rcpf(1.0f + __expf(-x)); }
__device__ __forceinline__ f32x4 sigm4(f32x4 v) { return (f32x4){sigm(v[0]), sigm(v[1]), sigm(v[2]), sigm(v[3])}; }
__device__ __forceinline__ void unpk8(const u32x4& w, f32x4& a, f32x4& b) {
    a = (f32x4){__builtin_bit_cast(float, w.x << 16), __builtin_bit_cast(float, w.x & 0xffff0000u), __builtin_bit_cast(float, w.y << 16), __builtin_bit_cast(float, w.y & 0xffff0000u)};
    b = (f32x4){__builtin_bit_cast(float, w.z << 16), __builtin_bit_cast(float, w.z & 0xffff0000u), __builtin_bit_cast(float, w.w << 16), __builtin_bit_cast(float, w.w & 0xffff0000u)};
}

struct EpiProj {
    static constexpr bool PERM = true, AFTER_DRAIN = false, HAS_MID = false;
    bf16_t* pda; bf16_t* prw; bf16_t* gates;
    __device__ __forceinline__ void operator()(const f32x4 (&acc)[2][2][4][2], const Unit& u, int wr, int wc, int fr, int fq) const {
        const int row0 = u.pm * BM + wr * 64 + fr;
        if (u.pn >= 26) {
            const int col0 = (u.pn - 26) * 128 + wc * 32 + 8 * fq;
#pragma unroll
            for (int ai = 0; ai < 2; ++ai)
#pragma unroll
                for (int m = 0; m < 4; ++m) { bf16_t* rowp = gates + (size_t)(row0 + ai * HALF + m * 16) * 4096 + col0;
                    f32x4 rt[2], gb[2];
#pragma unroll
                    for (int n = 0; n < 2; ++n)
#pragma unroll
                        for (int e = 0; e < 4; ++e) { const float ea = __expf(-acc[ai][0][m][n][e]), eb = __expf(-acc[ai][1][m][n][e]);
                            gb[n][e] = __builtin_amdgcn_rcpf(1.0f + eb); rt[n][e] = (1.0f + eb) * __builtin_amdgcn_rcpf(1.0f + ea); }
                    *(u32x4*)rowp = pack_bf16x8(rt[0], rt[1]); *(u32x4*)(rowp + 2048) = pack_bf16x8(gb[0], gb[1]); }
            return;
        }
        bf16_t* base; int ldc, colt;
        if (u.pn < 12) { base = pda; ldc = 3072; colt = u.pn * 256; }
        else { base = prw; ldc = 3584; colt = (u.pn - 12) * 256; }
        const int col0 = colt + wc * 32 + 8 * fq;
#pragma unroll
        for (int ai = 0; ai < 2; ++ai)
#pragma unroll
            for (int m = 0; m < 4; ++m) { bf16_t* rowp = base + (size_t)(row0 + ai * HALF + m * 16) * ldc + col0;
#pragma unroll
                for (int bj = 0; bj < 2; ++bj) *(u32x4*)(rowp + bj * HALF) = pack_bf16x8(acc[ai][bj][m][0], acc[ai][bj][m][1]); }
    }
};
template <int KIND> struct EpiLora {
    static constexpr bool PERM = true, AFTER_DRAIN = false, HAS_MID = false;
    bf16_t* out; const float* bias4;
    __device__ __forceinline__ void operator()(const f32x4 (&acc)[2][2][4][2], const Unit& u, int wr, int wc, int fr, int fq) const {
        const int seg = (KIND == 0) ? (u.pn >> 2) : 4, colt = (KIND == 0) ? (u.pn & 3) * 256 : u.pn * 256;
        bf16_t* base = out + (size_t)seg * ((size_t)M * 1024);
        const float* bias = bias4 + (seg & 3) * 1024;
        const int row0 = u.pm * BM + wr * 64 + fr, col0 = colt + wc * 32 + 8 * fq;
        const float sc = (seg < 2) ? -0.60653065971f : 1.0f;
#pragma unroll
        for (int bj = 0; bj < 2; ++bj) {
            f32x4 bv0 = (f32x4){0.f, 0.f, 0.f, 0.f}, bv1 = bv0;
            if (KIND == 0) { bv0 = *(const f32x4*)(bias + col0 + bj * HALF); bv1 = *(const f32x4*)(bias + col0 + bj * HALF + 4); }
#pragma unroll
            for (int ai = 0; ai < 2; ++ai)
#pragma unroll
                for (int m = 0; m < 4; ++m) { bf16_t* rowp = base + (size_t)(row0 + ai * HALF + m * 16) * 1024 + col0;
                    f32x4 v0 = acc[ai][bj][m][0] + bv0, v1 = acc[ai][bj][m][1] + bv1;
                    if (KIND == 0) { v0 = sigm4(v0) * sc; v1 = sigm4(v1) * sc; }
                    *(u32x4*)(rowp + bj * HALF) = pack_bf16x8(v0, v1); }
        }
    }
};
struct EpiMergeF {
    static constexpr bool PERM = true, AFTER_DRAIN = false, HAS_MID = true;
    bf16_t* merged; const bf16_t* gates;
    template <int HALFSEL> __device__ __forceinline__ void scale(f32x4 (&acc)[2][2][4][2], const Unit& u, int wr, int wc, int fr, int fq, bool store) const {
        int row0 = u.pm * BM + wr * 64 + fr, col0 = u.pn * 256 + wc * 32 + 8 * fq;
        asm volatile("" : "+v"(row0), "+v"(col0));
#pragma unroll
        for (int ai = 0; ai < 2; ++ai)
#pragma unroll
            for (int mh = 0; mh < 2; ++mh) {
                u32x4 gw[2][2];
#pragma unroll
                for (int mm = 0; mm < 2; ++mm)
#pragma unroll
                    for (int bj = 0; bj < 2; ++bj) gw[mm][bj] = *(const u32x4*)(gates + (size_t)(row0 + ai * HALF + (2 * mh + mm) * 16) * 4096 + HALFSEL * 2048 + col0 + bj * HALF);
#pragma unroll
                for (int mm = 0; mm < 2; ++mm)
#pragma unroll
                    for (int bj = 0; bj < 2; ++bj) { const int m = 2 * mh + mm; f32x4 g0, g1; unpk8(gw[mm][bj], g0, g1);
                        acc[ai][bj][m][0] *= g0; acc[ai][bj][m][1] *= g1;
                        if (store) *(u32x4*)(merged + (size_t)(row0 + ai * HALF + m * 16) * 2048 + col0 + bj * HALF) = pack_bf16x8(acc[ai][bj][m][0], acc[ai][bj][m][1]); }
                asm volatile("" ::: "memory");
            }
    }
    __device__ __forceinline__ void mid(f32x4 (&acc)[2][2][4][2], const Unit& u, int wr, int wc, int fr, int fq) const { scale<0>(acc, u, wr, wc, fr, fq, false); }
    __device__ __forceinline__ void operator()(const f32x4 (&acc)[2][2][4][2], const Unit& u, int wr, int wc, int fr, int fq) const {
        f32x4 (&ac)[2][2][4][2] = const_cast<f32x4 (&)[2][2][4][2]>(acc); scale<1>(ac, u, wr, wc, fr, fq, true); }
};
struct EpiOut {
    static constexpr bool PERM = false, AFTER_DRAIN = false, HAS_MID = false;
    const float* x; float* out; float* ss;
    __device__ __forceinline__ void operator()(const f32x4 (&acc)[2][2][4][2], const Unit& u, int wr, int wc, int fr, int fq) const {
        const int row0 = u.pm * BM + wr * 64 + fr, col0 = u.pn * 256 + wc * 32 + 4 * fq;
#pragma unroll
        for (int ai = 0; ai < 2; ++ai) {
            f32x4 xv[4][2][2];
#pragma unroll
            for (int m = 0; m < 4; ++m)
#pragma unroll
                for (int bj = 0; bj < 2; ++bj)
#pragma unroll
                    for (int n = 0; n < 2; ++n) xv[m][bj][n] = *(const f32x4*)(x + (size_t)(row0 + ai * HALF + m * 16) * 2048 + col0 + bj * HALF + n * 16);
#pragma unroll
            for (int m = 0; m < 4; ++m) { const size_t r = (size_t)(row0 + ai * HALF + m * 16); float s = 0.f;
#pragma unroll
                for (int bj = 0; bj < 2; ++bj)
#pragma unroll
                    for (int n = 0; n < 2; ++n) { const f32x4 h = xv[m][bj][n] + acc[ai][bj][m][n]; *(f32x4*)(out + r * 2048 + col0 + bj * HALF + n * 16) = h;
                        s += (h[0] * h[0] + h[1] * h[1]) + (h[2] * h[2] + h[3] * h[3]); }
                s += __shfl_xor(s, 16); s += __shfl_xor(s, 32);
                if (fq == 0) ss[r * 32 + u.pn * 4 + wc] = s; }
        }
    }
};
struct EpiMoeUp {
    static constexpr bool PERM = true, AFTER_DRAIN = false, HAS_MID = false;
    bf16_t* hid;
    __device__ __forceinline__ void operator()(const f32x4 (&acc)[2][2][4][2], const Unit& u, int wr, int wc, int fr, int fq) const {
        const int row0 = u.pm * BM + wr * 64 + fr, col0 = (u.pn & 7) * 128 + wc * 32 + 8 * fq;
#pragma unroll
        for (int ai = 0; ai < 2; ++ai)
#pragma unroll
            for (int m = 0; m < 4; ++m) { bf16_t* rowp = hid + (size_t)(row0 + ai * HALF + m * 16) * 1024 + col0;
                const f32x4 g0 = acc[ai][0][m][0], g1 = acc[ai][0][m][1], u0 = acc[ai][1][m][0], u1 = acc[ai][1][m][1];
                const f32x4 v0 = g0 * sigm4(g0) * u0, v1 = g1 * sigm4(g1) * u1;
                *(u32x4*)rowp = pack_bf16x8(v0, v1); }
    }
};
struct EpiMoeDown {
    static constexpr bool PERM = true, AFTER_DRAIN = false, HAS_MID = false;
    bf16_t* ye; const float* selgate;
    __device__ __forceinline__ void operator()(const f32x4 (&acc)[2][2][4][2], const Unit& u, int wr, int wc, int fr, int fq) const {
        const int row0 = u.pm * BM + wr * 64 + fr, col0 = (u.pn & 7) * 256 + wc * 32 + 8 * fq;
#pragma unroll
        for (int ai = 0; ai < 2; ++ai)
#pragma unroll
            for (int m = 0; m < 4; ++m) { const int r = row0 + ai * HALF + m * 16; const int e = r >> 11, b = (r >> 9) & 3, c = r & 511;
                const float g = selgate[(b * 16 + e) * 512 + c];
                bf16_t* rowp = ye + (size_t)r * 2048 + col0;
#pragma unroll
                for (int bj = 0; bj < 2; ++bj) *(u32x4*)(rowp + bj * HALF) = pack_bf16x8(acc[ai][bj][m][0] * g, acc[ai][bj][m][1] * g); }
    }
};
struct ExpertOrder {
    int G, c;
    __device__ __forceinline__ bool next(int i, Unit& u) const {
        const int L = i * G + c; if (L >= 1024) return false;
        const int wgid = (L % NXCD) * (1024 / NXCD) + L / NXCD;
        const int e = wgid >> 6, r = wgid & 63; u.pm = e * 8 + (r & 3) + 4 * ((r >> 5) & 1); u.pn = e * 8 + ((r >> 2) & 7); return true;
    }
    __device__ __forceinline__ void a_ready(const Unit&) const {}
    __device__ __forceinline__ void done(const Unit&) const {}
};

struct ExpertGatherOrder {
    int G, c; const int* seltok;
    __device__ __forceinline__ bool next(int i, Unit& u) const {
        const int L = i * G + c; if (L >= 1024) return false;
        const int wgid = (L % NXCD) * (1024 / NXCD) + L / NXCD;
        const int e = wgid >> 6, r = wgid & 63; u.pm = e * 8 + (r & 3) + 4 * ((r >> 5) & 1); u.pn = e * 8 + ((r >> 2) & 7); return true;
    }
    __device__ __forceinline__ int arow(int r) const { const int e = r >> 11, b = (r >> 9) & 3, cc = r & 511; return b * 4096 + seltok[(b * 16 + e) * 512 + cc]; }
    __device__ __forceinline__ void a_ready(const Unit&) const {}
    __device__ __forceinline__ void done(const Unit&) const {}
};
template <class Epi, class Sched, bool ALIGN_EPI = false, bool SP2 = false>
__device__ __forceinline__ void gemm_phase(PG8_LAS unsigned char* lds, const Gemm g, const Sched& S, const Epi& E) {
    const int tid = fresh_tid(), wid = __builtin_amdgcn_readfirstlane(tid >> 6), lane = tid & 63, wr = wid >> 2, wc = wid & 3, fr = lane & 15, fq = lane >> 4;
    const int K = g.K, nt = K / BK;
    unsigned voffA[2], voffB[2];
#pragma unroll
    for (int i = 0; i < 2; ++i) { int R, C; stage_rc(tid * 16 + i * 8192, R, C); const int Rb = Epi::PERM ? ((R & ~31) + perm32(R & 31)) : R;
        voffA[i] = (unsigned)(R * g.lda + C) * 2u; voffB[i] = (unsigned)(Rb * g.ldb + C) * 2u; }
    const size_t kstep = (size_t)(BK * 2);
    const size_t hsA = (size_t)HALF * g.lda * 2, hsB = (size_t)HALF * g.ldb * 2;
    const size_t tsA = 2 * hsA, tsB = 2 * hsB;
    const unsigned ldsw = (unsigned)wid * 1024u;
    const int aoff = lds_byte(wr * 64 + fr, fq * 8), boff = lds_byte(wc * 32 + fr, fq * 8);
#define PG8_SA(b, h) (((b) * 2 + (h)) * HTB)
#define PG8_SB(b, h) ((4 + (b) * 2 + (h)) * HTB)
#define PG8_STAGE(bufoff, gbase, voff) do { _Pragma("unroll") for (int _i = 0; _i < 2; ++_i) \
        __builtin_amdgcn_global_load_lds((const unsigned*)((const char*)(gbase) + (voff)[_i]), (PG8_LAS unsigned*)(lds + (bufoff) + ldsw + _i * 8192), 16, 0, 0); } while (0)
#define PG8_LDA(dst, b, h) do { _Pragma("unroll") for (int m = 0; m < 4; ++m) _Pragma("unroll") for (int k = 0; k < 2; ++k) dst[m][k] = *(const PG8_LAS bf16x8*)(lds + PG8_SA(b, h) + aoff + m * 2048 + k * 1024); } while (0)
#define PG8_LDB(dst, b, h) do { _Pragma("unroll") for (int n = 0; n < 2; ++n) _Pragma("unroll") for (int k = 0; k < 2; ++k) dst[n][k] = *(const PG8_LAS bf16x8*)(lds + PG8_SB(b, h) + boff + n * 2048 + k * 1024); } while (0)
#define PG8_MMA(ai, bj, At, Bt) do { __builtin_amdgcn_s_setprio(1); _Pragma("unroll") for (int m = 0; m < 4; ++m) _Pragma("unroll") for (int n = 0; n < 2; ++n) _Pragma("unroll") for (int k = 0; k < 2; ++k) \
        acc[ai][bj][m][n] = __builtin_amdgcn_mfma_f32_16x16x32_bf16(Bt[n][k], At[m][k], acc[ai][bj][m][n], 0, 0, 0); __builtin_amdgcn_s_setprio(0); } while (0)
#define PG8_WAIT_V(n) asm volatile("s_waitcnt vmcnt(" #n ")" ::: "memory")
#define PG8_WAIT_L(n) asm volatile("s_waitcnt lgkmcnt(" #n ")" ::: "memory")
#define PG8_BAR __builtin_amdgcn_s_barrier()
#define PG8_SCHED __builtin_amdgcn_sched_barrier(0)
    Unit cur, nxt; int ui = 0;
    if (!S.next(0, cur)) return;
    f32x4 acc[2][2][4][2];
#pragma unroll
    for (int a = 0; a < 2; ++a)
#pragma unroll
        for (int b = 0; b < 2; ++b)
#pragma unroll
            for (int m = 0; m < 4; ++m)
#pragma unroll
                for (int n = 0; n < 2; ++n) acc[a][b][m][n] = (f32x4){0.f, 0.f, 0.f, 0.f};
    bf16x8 At[4][2], B0[2][2], B1[2][2];
    const char* cA = (const char*)g.A + (size_t)cur.pm * tsA; const char* cB = (const char*)g.Bt + (size_t)cur.pn * tsB;
    S.a_ready(cur);
    if constexpr (SP2) {
        PG8_STAGE(PG8_SB(0, 0), cB, voffB); PG8_STAGE(PG8_SB(0, 1), cB + hsB, voffB); PG8_STAGE(PG8_SA(0, 0), cA, voffA); PG8_STAGE(PG8_SA(0, 1), cA + hsA, voffA);
        if (wr == 1) PG8_BAR;
        PG8_WAIT_V(2); PG8_BAR;
        PG8_STAGE(PG8_SB(1, 0), cB + kstep, voffB); PG8_STAGE(PG8_SA(1, 0), cA + kstep, voffA); PG8_STAGE(PG8_SB(1, 1), cB + hsB + kstep, voffB);
        PG8_WAIT_V(6); PG8_BAR;
    } else {
        PG8_STAGE(PG8_SB(0, 0), cB, voffB); PG8_STAGE(PG8_SA(0, 0), cA, voffA); PG8_STAGE(PG8_SB(0, 1), cB + hsB, voffB); PG8_STAGE(PG8_SA(0, 1), cA + hsA, voffA);
        if (wr == 1) PG8_BAR;
        PG8_WAIT_V(4); PG8_BAR;
        PG8_STAGE(PG8_SB(1, 0), cB + kstep, voffB); PG8_STAGE(PG8_SA(1, 0), cA + kstep, voffA); PG8_STAGE(PG8_SB(1, 1), cB + hsB + kstep, voffB);
        PG8_WAIT_V(6); PG8_BAR;
    }
    for (;;) {
        const bool has_next = S.next(ui + 1, nxt);
        const char* nA = has_next ? (const char*)g.A + (size_t)nxt.pm * tsA : cA; const char* nB = has_next ? (const char*)g.Bt + (size_t)nxt.pn * tsB : cB;
#pragma unroll 1
        for (int t = 0; t < nt; t += 2) {
            const bool last = (t == nt - 2);
            const char* a1 = cA + (size_t)(t + 1) * kstep;
            const char* a2 = last ? nA : cA + (size_t)(t + 2) * kstep; const char* b2 = last ? nB : cB + (size_t)(t + 2) * kstep;
            const char* a3 = a2 + kstep; const char* b3 = b2 + kstep;
            if (last && has_next) S.a_ready(nxt);
            if constexpr (Epi::HAS_MID) { if (t == nt / 2) E.mid(acc, cur, wr, wc, fr, fq); }
            if constexpr (SP2) {
            PG8_LDB(B0, 0, 0); PG8_LDB(B1, 0, 1); PG8_SCHED; PG8_LDA(At, 0, 0); PG8_STAGE(PG8_SA(1, 1), a1 + hsA, voffA);
            PG8_WAIT_V(8); PG8_WAIT_L(0); PG8_BAR; PG8_MMA(0, 0, At, B0); PG8_MMA(0, 1, At, B1); PG8_BAR; PG8_SCHED;
            PG8_LDA(At, 0, 1); PG8_STAGE(PG8_SB(0, 0), b2, voffB); PG8_STAGE(PG8_SB(0, 1), b2 + hsB, voffB); PG8_STAGE(PG8_SA(0, 0), a2, voffA);
            PG8_WAIT_V(8); PG8_WAIT_L(0); PG8_BAR; PG8_MMA(1, 0, At, B0); PG8_MMA(1, 1, At, B1); PG8_BAR; PG8_SCHED;
            PG8_LDB(B0, 1, 0); PG8_LDB(B1, 1, 1); PG8_SCHED; PG8_LDA(At, 1, 0); PG8_STAGE(PG8_SA(0, 1), a2 + hsA, voffA);
            PG8_WAIT_V(8); PG8_WAIT_L(0); PG8_BAR; PG8_MMA(0, 0, At, B0); PG8_MMA(0, 1, At, B1); PG8_BAR; PG8_SCHED;
            PG8_LDA(At, 1, 1); PG8_STAGE(PG8_SB(1, 0), b3, voffB); PG8_STAGE(PG8_SB(1, 1), b3 + hsB, voffB); PG8_STAGE(PG8_SA(1, 0), a3, voffA);
            PG8_WAIT_V(8); PG8_WAIT_L(0); PG8_BAR; PG8_MMA(1, 0, At, B0); PG8_MMA(1, 1, At, B1); PG8_BAR; PG8_SCHED;
            } else {
            PG8_LDB(B0, 0, 0); PG8_SCHED; PG8_LDA(At, 0, 0); PG8_STAGE(PG8_SA(1, 1), a1 + hsA, voffA);
            PG8_WAIT_L(8); PG8_BAR; PG8_WAIT_L(0); PG8_MMA(0, 0, At, B0); PG8_BAR; PG8_SCHED;
            PG8_LDB(B1, 0, 1); PG8_STAGE(PG8_SB(0, 0), b2, voffB);
            PG8_BAR; PG8_WAIT_L(0); PG8_MMA(0, 1, At, B1); PG8_BAR;
            PG8_LDA(At, 0, 1); PG8_STAGE(PG8_SA(0, 0), a2, voffA);
            PG8_BAR; PG8_WAIT_L(0); PG8_MMA(1, 0, At, B0); PG8_BAR; PG8_SCHED;
            PG8_STAGE(PG8_SB(0, 1), b2 + hsB, voffB);
            PG8_WAIT_V(6); PG8_BAR; PG8_MMA(1, 1, At, B1); PG8_BAR;
            PG8_LDB(B0, 1, 0); PG8_SCHED; PG8_LDA(At, 1, 0); PG8_STAGE(PG8_SA(0, 1), a2 + hsA, voffA);
            PG8_WAIT_L(8); PG8_BAR; PG8_WAIT_L(0); PG8_MMA(0, 0, At, B0); PG8_BAR; PG8_SCHED;
            PG8_LDB(B1, 1, 1); PG8_STAGE(PG8_SB(1, 0), b3, voffB);
            PG8_BAR; PG8_WAIT_L(0); PG8_MMA(0, 1, At, B1); PG8_BAR;
            PG8_LDA(At, 1, 1); PG8_STAGE(PG8_SA(1, 0), a3, voffA);
            PG8_BAR; PG8_WAIT_L(0); PG8_MMA(1, 0, At, B0); PG8_BAR; PG8_SCHED;
            PG8_STAGE(PG8_SB(1, 1), b3 + hsB, voffB);
            PG8_WAIT_V(6); PG8_BAR; PG8_MMA(1, 1, At, B1); PG8_BAR;
            }
        }
        if constexpr (ALIGN_EPI) { if (wr == 0) PG8_BAR; }
        if constexpr (!Epi::AFTER_DRAIN) { E(acc, cur, wr, wc, fr, fq); S.done(cur); }
        if (!has_next) break;
#pragma unroll
        for (int a = 0; a < 2; ++a)
#pragma unroll
            for (int b = 0; b < 2; ++b)
#pragma unroll
                for (int m = 0; m < 4; ++m)
#pragma unroll
                    for (int n = 0; n < 2; ++n) acc[a][b][m][n] = (f32x4){0.f, 0.f, 0.f, 0.f};
        cur = nxt; cA = nA; cB = nB; ++ui;
        if constexpr (ALIGN_EPI) { if (wr == 1) PG8_BAR; }
    }
    PG8_WAIT_V(0);
    if constexpr (!ALIGN_EPI) { if (wr == 0) PG8_BAR; }
    PG8_BAR;
    if constexpr (Epi::AFTER_DRAIN) { E.fused(acc, cur, wr, wc, fr, fq, lds, wid, lane); S.done(cur); }
#undef PG8_SA
#undef PG8_SB
#undef PG8_STAGE
#undef PG8_LDA
#undef PG8_LDB
#undef PG8_MMA
#undef PG8_WAIT_V
#undef PG8_WAIT_L
#undef PG8_BAR
#undef PG8_SCHED
}

template <class Epi, class Sched, bool ALIGN_EPI = false, bool SP2 = false>
__device__ __forceinline__ void gemm_phase_g(PG8_LAS unsigned char* lds, const Gemm g, const Sched& S, const Epi& E) {
    const int tid = fresh_tid(), wid = __builtin_amdgcn_readfirstlane(tid >> 6), lane = tid & 63, wr = wid >> 2, wc = wid & 3, fr = lane & 15, fq = lane >> 4;
    const int K = g.K, nt = K / BK;
    unsigned voffB[2]; int RAr[2]; unsigned CAb[2];
#pragma unroll
    for (int i = 0; i < 2; ++i) { int R, C; stage_rc(tid * 16 + i * 8192, R, C); const int Rb = Epi::PERM ? ((R & ~31) + perm32(R & 31)) : R;
        RAr[i] = R; CAb[i] = (unsigned)C * 2u; voffB[i] = (unsigned)(Rb * g.ldb + C) * 2u; }
    const size_t kstep = (size_t)(BK * 2);
    const size_t hsA = (size_t)HALF * g.lda * 2, hsB = (size_t)HALF * g.ldb * 2;
    const size_t tsA = 2 * hsA, tsB = 2 * hsB;
    const unsigned ldsw = (unsigned)wid * 1024u;
    const int aoff = lds_byte(wr * 64 + fr, fq * 8), boff = lds_byte(wc * 32 + fr, fq * 8);
#define PG8_SA(b, h) (((b) * 2 + (h)) * HTB)
#define PG8_SB(b, h) ((4 + (b) * 2 + (h)) * HTB)
#define PG8_STAGE(bufoff, gbase, voff) do { _Pragma("unroll") for (int _i = 0; _i < 2; ++_i) \
        __builtin_amdgcn_global_load_lds((const unsigned*)((const char*)(gbase) + (voff)[_i]), (PG8_LAS unsigned*)(lds + (bufoff) + ldsw + _i * 8192), 16, 0, 0); } while (0)
#define PG8_LDA(dst, b, h) do { _Pragma("unroll") for (int m = 0; m < 4; ++m) _Pragma("unroll") for (int k = 0; k < 2; ++k) dst[m][k] = *(const PG8_LAS bf16x8*)(lds + PG8_SA(b, h) + aoff + m * 2048 + k * 1024); } while (0)
#define PG8_LDB(dst, b, h) do { _Pragma("unroll") for (int n = 0; n < 2; ++n) _Pragma("unroll") for (int k = 0; k < 2; ++k) dst[n][k] = *(const PG8_LAS bf16x8*)(lds + PG8_SB(b, h) + boff + n * 2048 + k * 1024); } while (0)
#define PG8_MMA(ai, bj, At, Bt) do { __builtin_amdgcn_s_setprio(1); _Pragma("unroll") for (int m = 0; m < 4; ++m) _Pragma("unroll") for (int n = 0; n < 2; ++n) _Pragma("unroll") for (int k = 0; k < 2; ++k) \
        acc[ai][bj][m][n] = __builtin_amdgcn_mfma_f32_16x16x32_bf16(Bt[n][k], At[m][k], acc[ai][bj][m][n], 0, 0, 0); __builtin_amdgcn_s_setprio(0); } while (0)
#define PG8_WAIT_V(n) asm volatile("s_waitcnt vmcnt(" #n ")" ::: "memory")
#define PG8_WAIT_L(n) asm volatile("s_waitcnt lgkmcnt(" #n ")" ::: "memory")
#define PG8_BAR __builtin_amdgcn_s_barrier()
#define PG8_SCHED __builtin_amdgcn_sched_barrier(0)
    Unit cur, nxt; int ui = 0;
    if (!S.next(0, cur)) return;
    f32x4 acc[2][2][4][2];
#pragma unroll
    for (int a = 0; a < 2; ++a)
#pragma unroll
        for (int b = 0; b < 2; ++b)
#pragma unroll
            for (int m = 0; m < 4; ++m)
#pragma unroll
                for (int n = 0; n < 2; ++n) acc[a][b][m][n] = (f32x4){0.f, 0.f, 0.f, 0.f};
    bf16x8 At[4][2], B0[2][2], B1[2][2];
    unsigned vAll[4][2][2];
#pragma unroll
    for (int q = 0; q < 4; ++q) { Unit uq; const bool ok = S.next(q, uq);
#pragma unroll
        for (int h = 0; h < 2; ++h)
#pragma unroll
            for (int i = 0; i < 2; ++i) vAll[q][h][i] = ok ? (unsigned)S.arow(uq.pm * BM + h * HALF + RAr[i]) * (unsigned)(g.lda * 2) + CAb[i] : 0u; }
#define PG8_PICK(dst, idx) do { _Pragma("unroll") for (int h_ = 0; h_ < 2; ++h_) _Pragma("unroll") for (int i_ = 0; i_ < 2; ++i_) \
        dst[h_][i_] = (idx) == 0 ? vAll[0][h_][i_] : (idx) == 1 ? vAll[1][h_][i_] : (idx) == 2 ? vAll[2][h_][i_] : vAll[3][h_][i_]; } while (0)
    unsigned vA[2][2], vAn[2][2], vS[2][2];
    PG8_PICK(vA, 0);
    const char* A0 = (const char*)g.A; const char* cB = (const char*)g.Bt + (size_t)cur.pn * tsB;
    S.a_ready(cur);
    if constexpr (SP2) {
        PG8_STAGE(PG8_SB(0, 0), cB, voffB); PG8_STAGE(PG8_SB(0, 1), cB + hsB, voffB); PG8_STAGE(PG8_SA(0, 0), A0, vA[0]); PG8_STAGE(PG8_SA(0, 1), A0, vA[1]);
        if (wr == 1) PG8_BAR;
        PG8_WAIT_V(2); PG8_BAR;
        PG8_STAGE(PG8_SB(1, 0), cB + kstep, voffB); PG8_STAGE(PG8_SA(1, 0), A0 + kstep, vA[0]); PG8_STAGE(PG8_SB(1, 1), cB + hsB + kstep, voffB);
        PG8_WAIT_V(6); PG8_BAR;
    } else {
        PG8_STAGE(PG8_SB(0, 0), cB, voffB); PG8_STAGE(PG8_SA(0, 0), A0, vA[0]); PG8_STAGE(PG8_SB(0, 1), cB + hsB, voffB); PG8_STAGE(PG8_SA(0, 1), A0, vA[1]);
        if (wr == 1) PG8_BAR;
        PG8_WAIT_V(4); PG8_BAR;
        PG8_STAGE(PG8_SB(1, 0), cB + kstep, voffB); PG8_STAGE(PG8_SA(1, 0), A0 + kstep, vA[0]); PG8_STAGE(PG8_SB(1, 1), cB + hsB + kstep, voffB);
        PG8_WAIT_V(6); PG8_BAR;
    }
    for (;;) {
        const bool has_next = S.next(ui + 1, nxt);
        const char* nB = has_next ? (const char*)g.Bt + (size_t)nxt.pn * tsB : cB;
        if (has_next) { PG8_PICK(vAn, ui + 1); } else { PG8_PICK(vAn, ui); }
#pragma unroll 1
        for (int t = 0; t < nt; t += 2) {
            const bool last = (t == nt - 2);
            const char* a1 = A0 + (size_t)(t + 1) * kstep;
            const char* a2 = last ? A0 : A0 + (size_t)(t + 2) * kstep; const char* b2 = last ? nB : cB + (size_t)(t + 2) * kstep;
#pragma unroll
            for (int h_ = 0; h_ < 2; ++h_)
#pragma unroll
                for (int i_ = 0; i_ < 2; ++i_) vS[h_][i_] = last ? vAn[h_][i_] : vA[h_][i_];
            const char* a3 = a2 + kstep; const char* b3 = b2 + kstep;
            if (last && has_next) S.a_ready(nxt);
            if constexpr (Epi::HAS_MID) { if (t == nt / 2) E.mid(acc, cur, wr, wc, fr, fq); }
            if constexpr (SP2) {
            PG8_LDB(B0, 0, 0); PG8_LDB(B1, 0, 1); PG8_SCHED; PG8_LDA(At, 0, 0); PG8_STAGE(PG8_SA(1, 1), a1, vA[1]);
            PG8_WAIT_V(8); PG8_WAIT_L(0); PG8_BAR; PG8_MMA(0, 0, At, B0); PG8_MMA(0, 1, At, B1); PG8_BAR; PG8_SCHED;
            PG8_LDA(At, 0, 1); PG8_STAGE(PG8_SB(0, 0), b2, voffB); PG8_STAGE(PG8_SB(0, 1), b2 + hsB, voffB); PG8_STAGE(PG8_SA(0, 0), a2, vS[0]);
            PG8_WAIT_V(8); PG8_WAIT_L(0); PG8_BAR; PG8_MMA(1, 0, At, B0); PG8_MMA(1, 1, At, B1); PG8_BAR; PG8_SCHED;
            PG8_LDB(B0, 1, 0); PG8_LDB(B1, 1, 1); PG8_SCHED; PG8_LDA(At, 1, 0); PG8_STAGE(PG8_SA(0, 1), a2, vS[1]);
            PG8_WAIT_V(8); PG8_WAIT_L(0); PG8_BAR; PG8_MMA(0, 0, At, B0); PG8_MMA(0, 1, At, B1); PG8_BAR; PG8_SCHED;
            PG8_LDA(At, 1, 1); PG8_STAGE(PG8_SB(1, 0), b3, voffB); PG8_STAGE(PG8_SB(1, 1), b3 + hsB, voffB); PG8_STAGE(PG8_SA(1, 0), a3, vS[0]);
            PG8_WAIT_V(8); PG8_WAIT_L(0); PG8_BAR; PG8_MMA(1, 0, At, B0); PG8_MMA(1, 1, At, B1); PG8_BAR; PG8_SCHED;
            } else {
            PG8_LDB(B0, 0, 0); PG8_SCHED; PG8_LDA(At, 0, 0); PG8_STAGE(PG8_SA(1, 1), a1, vA[1]);
            PG8_WAIT_L(8); PG8_BAR; PG8_WAIT_L(0); PG8_MMA(0, 0, At, B0); PG8_BAR; PG8_SCHED;
            PG8_LDB(B1, 0, 1); PG8_STAGE(PG8_SB(0, 0), b2, voffB);
            PG8_BAR; PG8_WAIT_L(0); PG8_MMA(0, 1, At, B1); PG8_BAR;
            PG8_LDA(At, 0, 1); PG8_STAGE(PG8_SA(0, 0), a2, vS[0]);
            PG8_BAR; PG8_WAIT_L(0); PG8_MMA(1, 0, At, B0); PG8_BAR; PG8_SCHED;
            PG8_STAGE(PG8_SB(0, 1), b2 + hsB, voffB);
            PG8_WAIT_V(6); PG8_BAR; PG8_MMA(1, 1, At, B1); PG8_BAR;
            PG8_LDB(B0, 1, 0); PG8_SCHED; PG8_LDA(At, 1, 0); PG8_STAGE(PG8_SA(0, 1), a2, vS[1]);
            PG8_WAIT_L(8); PG8_BAR; PG8_WAIT_L(0); PG8_MMA(0, 0, At, B0); PG8_BAR; PG8_SCHED;
            PG8_LDB(B1, 1, 1); PG8_STAGE(PG8_SB(1, 0), b3, voffB);
            PG8_BAR; PG8_WAIT_L(0); PG8_MMA(0, 1, At, B1); PG8_BAR;
            PG8_LDA(At, 1, 1); PG8_STAGE(PG8_SA(1, 0), a3, vS[0]);
            PG8_BAR; PG8_WAIT_L(0); PG8_MMA(1, 0, At, B0); PG8_BAR; PG8_SCHED;
            PG8_STAGE(PG8_SB(1, 1), b3 + hsB, voffB);
            PG8_WAIT_V(6); PG8_BAR; PG8_MMA(1, 1, At, B1); PG8_BAR;
            }
        }
        if constexpr (ALIGN_EPI) { if (wr == 0) PG8_BAR; }
        if constexpr (!Epi::AFTER_DRAIN) { E(acc, cur, wr, wc, fr, fq); S.done(cur); }
        if (!has_next) break;
#pragma unroll
        for (int a = 0; a < 2; ++a)
#pragma unroll
            for (int b = 0; b < 2; ++b)
#pragma unroll
                for (int m = 0; m < 4; ++m)
#pragma unroll
                    for (int n = 0; n < 2; ++n) acc[a][b][m][n] = (f32x4){0.f, 0.f, 0.f, 0.f};
        cur = nxt; cB = nB; ++ui;
#pragma unroll
        for (int h_ = 0; h_ < 2; ++h_)
#pragma unroll
            for (int i_ = 0; i_ < 2; ++i_) vA[h_][i_] = vAn[h_][i_];
        if constexpr (ALIGN_EPI) { if (wr == 1) PG8_BAR; }
    }
    PG8_WAIT_V(0);
    if constexpr (!ALIGN_EPI) { if (wr == 0) PG8_BAR; }
    PG8_BAR;
    if constexpr (Epi::AFTER_DRAIN) { E.fused(acc, cur, wr, wc, fr, fq, lds, wid, lane); S.done(cur); }
#undef PG8_SA
#undef PG8_SB
#undef PG8_STAGE
#undef PG8_LDA
#undef PG8_LDB
#undef PG8_MMA
#undef PG8_WAIT_V
#undef PG8_WAIT_L
#undef PG8_BAR
#undef PG8_SCHED
#undef PG8_PICK
}


}

namespace attn {
using bf16x8 = __attribute__((ext_vector_type(8))) short;
using s16x4  = __attribute__((ext_vector_type(4))) short;
using f32x16 = __attribute__((ext_vector_type(16))) float;
using u32x4  = __attribute__((ext_vector_type(4))) unsigned;
constexpr int QBLK = 32, KVBLK = 64, LDQ = 3072;
constexpr float SCALE = 0.125f, QSCALE = 0.125f * 1.4426950408889634f;
constexpr size_t SHM_V = KVBLK * 128 * 2, SHM_K = KVBLK * 128 * 2, SHM_ATTN = 2 * SHM_V + 2 * SHM_K + 8 * 64 * 4;
#define KSWZ(row, colB) ((row) * 256 + ((colB) ^ (((row) & 7) << 4)))
#define SBAR() __builtin_amdgcn_sched_barrier(0)
__device__ __forceinline__ int crow(int r, int hi) { return (r & 3) + 8 * (r >> 2) + 4 * hi; }
__device__ __forceinline__ unsigned cvtpk(float lo, float hi) { return pk2(lo, hi); }
__device__ __forceinline__ bf16x8 ld8(const bf16_t* p) { return *reinterpret_cast<const bf16x8*>(p); }

__device__ __forceinline__ void partialSM(f32x16& p0, f32x16& p1) {
  for (int r = 0; r < 16; ++r) p0[r] = __builtin_amdgcn_exp2f(p0[r]);
}
__device__ __forceinline__ void finishSM(f32x16& p0, f32x16& p1, float& l_reg, bf16x8& pa0, bf16x8& pa1, bf16x8& pa2, bf16x8& pa3) {
  for (int r = 0; r < 16; ++r) p1[r] = __builtin_amdgcn_exp2f(p1[r]);
  float ps = 0; for (int r = 0; r < 16; ++r) ps += p0[r]; for (int r = 0; r < 16; ++r) ps += p1[r];
  l_reg += ps;
#define PK4(P, BASE, OUT) do { unsigned a0 = cvtpk(P[BASE + 0], P[BASE + 1]), a1 = cvtpk(P[BASE + 2], P[BASE + 3]);   \
    unsigned b0 = cvtpk(P[BASE + 4], P[BASE + 5]), b1 = cvtpk(P[BASE + 6], P[BASE + 7]);                              \
    auto r0 = __builtin_amdgcn_permlane32_swap(a0, b0, false, false); auto r1 = __builtin_amdgcn_permlane32_swap(a1, b1, false, false); \
    u32x4 w = {r0[0], r1[0], r0[1], r1[1]}; OUT = *reinterpret_cast<bf16x8*>(&w); } while (0)
  PK4(p0, 0, pa0); PK4(p0, 8, pa1); PK4(p1, 0, pa2); PK4(p1, 8, pa3);
#undef PK4
}
__device__ __forceinline__ void qkt(f32x16& p0, f32x16& p1, const bf16_t* Ks, const bf16x8* qr, int r32, int hi, int sub) {
  p0 = f32x16{}; p1 = f32x16{};
#pragma unroll
  for (int d0 = 0; d0 < 4; ++d0) { int cb = (sub * 64 + d0 * 16 + hi * 8) * 2;
    bf16x8 b0 = *reinterpret_cast<const bf16x8*>((const char*)Ks + KSWZ(r32, cb));
    bf16x8 b1 = *reinterpret_cast<const bf16x8*>((const char*)Ks + KSWZ(32 + r32, cb));
    p0 = __builtin_amdgcn_mfma_f32_32x32x16_bf16(b0, qr[d0], p0, 0, 0, 0);
    p1 = __builtin_amdgcn_mfma_f32_32x32x16_bf16(b1, qr[d0], p1, 0, 0, 0); }
}
__device__ __forceinline__ int v_st(int k, int c) { const int kk = (k & ~0xC) | ((k & 4) << 1) | ((k & 8) >> 1); return ((kk >> 3) * 4 + (c >> 5)) * 512 + ((kk & 7) * 32 + (c & 31)) * 2; }
__device__ __forceinline__ int v_rd_base(int lane) { return ((lane & 3) << 3) | (((lane >> 2) & 3) << 6) | (((lane >> 4) & 1) << 5) | (((lane >> 5) & 1) << 8); }
constexpr int v_rd_off(int d0, int ks, int half) { return d0 * 512 + ks * 4096 + half * 2048; }
template <int OFF> __device__ __forceinline__ s16x4 tr_read(int vb) {
  s16x4 r; asm volatile("ds_read_b64_tr_b16 %0, %1 offset:%2" : "=&v"(r) : "v"(vb), "i"(OFF) : "memory"); return r;
}
template <int D0> __device__ __forceinline__ void pv_one(f32x16& od, int vb, bf16x8 pa0, bf16x8 pa1, bf16x8 pa2, bf16x8 pa3) {
  const s16x4 l0 = tr_read<v_rd_off(D0, 0, 0)>(vb), h0 = tr_read<v_rd_off(D0, 0, 1)>(vb), l1 = tr_read<v_rd_off(D0, 1, 0)>(vb), h1 = tr_read<v_rd_off(D0, 1, 1)>(vb);
  const s16x4 l2 = tr_read<v_rd_off(D0, 2, 0)>(vb), h2 = tr_read<v_rd_off(D0, 2, 1)>(vb), l3 = tr_read<v_rd_off(D0, 3, 0)>(vb), h3 = tr_read<v_rd_off(D0, 3, 1)>(vb);
  asm volatile("s_waitcnt lgkmcnt(0)" ::: "memory"); SBAR();
#define PK(L, H) (bf16x8){L[0], L[1], L[2], L[3], H[0], H[1], H[2], H[3]}
  od = __builtin_amdgcn_mfma_f32_32x32x16_bf16(pa0, PK(l0, h0), od, 0, 0, 0);
  od = __builtin_amdgcn_mfma_f32_32x32x16_bf16(pa1, PK(l1, h1), od, 0, 0, 0);
  od = __builtin_amdgcn_mfma_f32_32x32x16_bf16(pa2, PK(l2, h2), od, 0, 0, 0);
  od = __builtin_amdgcn_mfma_f32_32x32x16_bf16(pa3, PK(l3, h3), od, 0, 0, 0);
#undef PK
}
__device__ __forceinline__ void pv_d0(f32x16* o, int vb, bf16x8 pa0, bf16x8 pa1, bf16x8 pa2, bf16x8 pa3) {
  pv_one<0>(o[0], vb, pa0, pa1, pa2, pa3); pv_one<1>(o[1], vb, pa0, pa1, pa2, pa3); pv_one<2>(o[2], vb, pa0, pa1, pa2, pa3); pv_one<3>(o[3], vb, pa0, pa1, pa2, pa3);
}

__device__ __forceinline__ void attn_unit(const bf16_t* Qb, const bf16_t* Kh, const bf16_t* Vh, bf16_t* Ya, float lam, const float* subln_g, int seq, char* lds) {
  const int tid = fresh_tid(), wid = __builtin_amdgcn_readfirstlane(tid >> 6), lane = tid & 63, r32 = lane & 31, hi = lane >> 5, sub = wid >> 2, wq = wid & 3;
  bf16_t* V_lds = (bf16_t*)lds; bf16_t* K_lds = (bf16_t*)(lds + 2 * SHM_V);
  float* ws = (float*)(lds + 2 * SHM_V + 2 * SHM_K) + wid * 64; float* li_l = ws;
  float l_reg = 0; f32x16 o[4] = {}; bf16x8 qr[4];
  const bf16_t* Qw = Qb + (long)(wq * QBLK + r32) * LDQ + sub * 64 + hi * 8;
#pragma unroll
  for (int d0 = 0; d0 < 4; ++d0) qr[d0] = ld8(Qw + d0 * 16);
  const int sr = tid >> 4, sc = (tid & 15) * 8, vst0 = v_st(sr, sc), vst1 = v_st(32 + sr, sc);
  const int vb0 = (int)(uintptr_t)V_lds + v_rd_base(lane);
  struct { bf16x8 vs0, vs1, ks0, ks1; } sr_[2];
#define SLOAD(i, k0) do { sr_[i].vs0 = ld8(&Vh[(long)((k0) + sr) * LDQ + sc]); sr_[i].vs1 = ld8(&Vh[(long)((k0) + 32 + sr) * LDQ + sc]); \
    sr_[i].ks0 = ld8(&Kh[(long)((k0) + sr) * LDQ + sc]); sr_[i].ks1 = ld8(&Kh[(long)((k0) + 32 + sr) * LDQ + sc]); } while (0)
#define SWRITE(b, i) do { *(bf16x8*)((char*)V_lds + (b) * SHM_V + vst0) = sr_[i].vs0;          \
    *(bf16x8*)((char*)V_lds + (b) * SHM_V + vst1) = sr_[i].vs1; int kc = sc * 2;               \
    *(bf16x8*)((char*)K_lds + (b) * SHM_K + KSWZ(sr, kc)) = sr_[i].ks0;                       \
    *(bf16x8*)((char*)K_lds + (b) * SHM_K + KSWZ(32 + sr, kc)) = sr_[i].ks1; } while (0)
#define SWAIT() asm volatile("s_waitcnt vmcnt(4)" ::: "memory")
  f32x16 pA0, pA1, pB0, pB1; bf16x8 pa0, pa1, pa2, pa3; const int NT = seq / KVBLK;
  constexpr int SE = 0, SO = 1;
  SLOAD(SE, 0); asm volatile("s_waitcnt vmcnt(0)" ::: "memory"); SWRITE(0, SE); __syncthreads();
  qkt(pA0, pA1, K_lds, qr, r32, hi, sub); partialSM(pA0, pA1);
  SLOAD(SO, KVBLK); if (2 < NT) SLOAD(SE, 2 * KVBLK);
  SWAIT(); SWRITE(1, SO); __syncthreads();
  for (int j = 1; j + 1 < NT; j += 2) {
    SBAR(); qkt(pB0, pB1, (bf16_t*)((char*)K_lds + SHM_K), qr, r32, hi, sub);
    finishSM(pA0, pA1, l_reg, pa0, pa1, pa2, pa3); SBAR();
    SLOAD(SO, (j + 2) * KVBLK); SBAR();
    pv_d0(o, vb0, pa0, pa1, pa2, pa3); partialSM(pB0, pB1);
    __syncthreads(); SWAIT(); SWRITE(0, SE); __syncthreads();
    SBAR(); qkt(pA0, pA1, K_lds, qr, r32, hi, sub);
    finishSM(pB0, pB1, l_reg, pa0, pa1, pa2, pa3); SBAR();
    if (j + 3 < NT) SLOAD(SE, (j + 3) * KVBLK); SBAR();
    pv_d0(o, vb0 + (int)SHM_V, pa0, pa1, pa2, pa3); partialSM(pA0, pA1);
    __syncthreads(); SWAIT(); SWRITE(1, SO); __syncthreads();
  }
  SBAR(); qkt(pB0, pB1, (bf16_t*)((char*)K_lds + SHM_K), qr, r32, hi, sub);
  finishSM(pA0, pA1, l_reg, pa0, pa1, pa2, pa3); SBAR();
  pv_d0(o, vb0, pa0, pa1, pa2, pa3); partialSM(pB0, pB1);
  __syncthreads();
  finishSM(pB0, pB1, l_reg, pa0, pa1, pa2, pa3); SBAR();
  pv_d0(o, vb0 + (int)SHM_V, pa0, pa1, pa2, pa3);
  { auto rr = __builtin_amdgcn_permlane32_swap(__float_as_uint(l_reg), __float_as_uint(l_reg), false, false); l_reg = __uint_as_float(rr[0]) + __uint_as_float(rr[1]); }
  if (hi == 0) li_l[r32] = l_reg; asm volatile("s_waitcnt lgkmcnt(0)" ::: "memory");
  float rli[16];
#pragma unroll
  for (int r = 0; r < 16; ++r) rli[r] = __builtin_amdgcn_rcpf(li_l[crow(r, hi)]);
  __syncthreads();
  float* xo = (float*)lds;
  if (sub == 1) {
#pragma unroll
    for (int r = 0; r < 16; ++r) { const int orow = wq * 32 + crow(r, hi);
#pragma unroll
      for (int d0 = 0; d0 < 4; ++d0) xo[orow * 128 + d0 * 32 + r32] = o[d0][r] * rli[r]; }
  }
  __syncthreads();
  if (sub == 0) {
    float gv[4];
#pragma unroll
    for (int d0 = 0; d0 < 4; ++d0) gv[d0] = subln_g[d0 * 32 + r32] * (1.0f - LAM_INIT);
#pragma unroll
    for (int r = 0; r < 16; ++r) { const int orow = wq * 32 + crow(r, hi); float v[4]; float ssq = 0.f;
#pragma unroll
      for (int d0 = 0; d0 < 4; ++d0) { v[d0] = o[d0][r] * rli[r] - lam * xo[orow * 128 + d0 * 32 + r32]; ssq += v[d0] * v[d0]; }
      ssq += __shfl_xor(ssq, 1); ssq += __shfl_xor(ssq, 2); ssq += __shfl_xor(ssq, 4); ssq += __shfl_xor(ssq, 8); ssq += __shfl_xor(ssq, 16);
      const float sc_ = 1.0f / sqrtf(ssq * (1.0f / 128.0f) + RMS_EPS);
#pragma unroll
      for (int d0 = 0; d0 < 4; ++d0) Ya[(long)orow * 2048 + d0 * 32 + r32] = (bf16_t)f2bf(v[d0] * sc_ * gv[d0]); }
  }
  __syncthreads();
#undef SLOAD
#undef SWRITE
#undef SWAIT
}
#undef KSWZ
#undef SBAR
}

struct Args {
    const float* in[33];
    float* out; unsigned char* ws;
    int ph_lo, ph_hi;
};
enum { I_X = 0, I_ANG, I_WIN, I_QNG, I_KNG, I_LQ1, I_LK1, I_LQ2, I_LK2, I_SUBLN, I_MU, I_W0F, I_W2F, I_W0B, I_W2B, I_A0F, I_A2F, I_A0B, I_A2B, I_G2, I_KK, I_KA, I_RK,
       I_LNW, I_LNB, I_WBA, I_WBB, I_WOUT, I_FNG, I_WR, I_WG, I_WU, I_WD };

__device__ __forceinline__ void tr_item(const float* W, int ldw, int k0, int n0, bf16_t* dst, int ldd, LAS float* scr, int lane) {
    float tv[32];
    const float* src = W + (size_t)(k0 + (lane >> 5)) * ldw + n0 + (lane & 31);
#pragma unroll
    for (int i = 0; i < 32; ++i) tv[i] = src[(size_t)(2 * i) * ldw];
#pragma unroll
    for (int i = 0; i < 32; ++i) scr[(2 * i + (lane >> 5)) * 33 + (lane & 31)] = tv[i];
    asm volatile("s_waitcnt lgkmcnt(0)" ::: "memory");
    const int c = lane & 7;
#pragma unroll
    for (int j = 0; j < 4; ++j) { const int n = (lane >> 3) + 8 * j; const LAS float* s = scr + (8 * c) * 33 + n;
        v4u o; o.x = pk2(s[0 * 33], s[1 * 33]); o.y = pk2(s[2 * 33], s[3 * 33]); o.z = pk2(s[4 * 33], s[5 * 33]); o.w = pk2(s[6 * 33], s[7 * 33]);
        *(v4u*)(dst + (size_t)n * ldd + 8 * c) = o; }
    asm volatile("s_waitcnt lgkmcnt(0)" ::: "memory");
}

__device__ __forceinline__ void p0_prologue(const Args& a, LAS unsigned char* lds, int gw, int NGW, int wave, int lane) {
    unsigned char* ws = a.ws;
    LAS float* scr = (LAS float*)(lds + wave * 16384);
    bf16_t* WinT = (bf16_t*)(ws + WS_WINT);
    bf16_t* WaT = (bf16_t*)(ws + WS_WAT); bf16_t* WoT = (bf16_t*)(ws + WS_WOT);
    constexpr int I_IN = 32 * 333, I_A = 16 * 64, I_B = 16 * 64, I_O = 32 * 64, NITEMS = I_IN + I_A + I_B + I_O;
    for (int it = gw; it < NITEMS; it += NGW) {
        int r = it;
        if (r < I_IN) { const int kb = r / 333, nb = r % 333, n0 = nb * 32; int drow = n0;
            if (n0 >= 6560) { const int c = n0 - 6560, which = c >> 11, cc = c & 2047; drow = 6656 + (cc >> 7) * 256 + which * 128 + (cc & 127); }
            tr_item(a.in[I_WIN], IN_COLS, kb * 64, n0, WinT + (size_t)drow * 2048 + kb * 64, 2048, scr, lane); continue; } r -= I_IN;
        if (r < I_A) { const int kb = r / 64, nb = r % 64; tr_item(a.in[I_WBA], 2048, kb * 64, nb * 32, WaT + (size_t)(nb * 32) * 2048 + kb * 64, 2048, scr, lane); continue; } r -= I_A;
        if (r < I_B) { const int kb = r / 64, nb = r % 64; tr_item(a.in[I_WBB], 2048, kb * 64, nb * 32, WaT + (size_t)(nb * 32) * 2048 + 1024 + kb * 64, 2048, scr, lane); continue; } r -= I_B;
        { const int kb = r / 64, nb = r % 64; tr_item(a.in[I_WOUT], 2048, kb * 64, nb * 32, WoT + (size_t)(nb * 32) * 2048 + kb * 64, 2048, scr, lane); }
    }
    { const int gt = gw * 64 + lane, NT_ = NGW * 64;
      v4u z = {0u, 0u, 0u, 0u};
      for (int i = gt; i < 24576; i += NT_) ((v4u*)(WinT + (size_t)6560 * 2048))[i] = z;
      { const float invf[8] = {1.000000000e+00f, 1.939227432e-01f, 3.760603070e-02f, 7.292664610e-03f, 1.414213562e-03f, 2.742481884e-04f, 5.318296098e-05f, 1.031338616e-05f};
        for (int i = gt; i < SEQ * 8; i += NT_) { float iv = invf[0];
#pragma unroll
            for (int j = 1; j < 8; ++j) iv = ((i & 7) == j) ? invf[j] : iv;
            float sv, cv; sincosf((float)(i >> 3) * iv, &sv, &cv); ((float2*)(ws + WS_ROPE))[i] = make_float2(cv, sv); } }
      { float* sm = (float*)(ws + WS_SMALL);
#define CPY(OFF, IDX, N) for (int i = gt; i < (N); i += NT_) sm[(OFF) + i] = a.in[IDX][i];
        CPY(SM_QNG, I_QNG, 64) CPY(SM_KNG, I_KNG, 64) CPY(SM_LQ1, I_LQ1, 64) CPY(SM_LK1, I_LK1, 64) CPY(SM_LQ2, I_LQ2, 64) CPY(SM_LK2, I_LK2, 64) CPY(SM_SUBLN, I_SUBLN, 128)
        CPY(SM_MU, I_MU, 3488) CPY(SM_KK, I_KK, 1024) CPY(SM_KA, I_KA, 1024) CPY(SM_RK, I_RK, 1024) CPY(SM_LNW, I_LNW, 1024) CPY(SM_LNB, I_LNB, 1024) CPY(SM_FNG, I_FNG, 2048) CPY(SM_WR, I_WR, 32768)
#undef CPY
      }
      for (int i = gt; i < 4096; i += NT_) { const int seg = i >> 10, c = i & 1023; ((float*)(ws + WS_BIAS4))[i] = (seg == 0) ? a.in[I_W0F][c] : (seg == 1) ? a.in[I_W0B][c] : (seg == 2) ? a.in[I_A0F][c] : a.in[I_A0B][c]; }
      bf16_t* B1 = (bf16_t*)(ws + WS_BTL1); bf16_t* B2 = (bf16_t*)(ws + WS_BTL2);
      for (int i = gt; i < 4096 * 32; i += NT_) { const int n = i >> 5, kc = (i & 31) * 8, seg = n >> 10, c = n & 1023;
          const float* w2 = (seg == 0) ? a.in[I_W2F] : (seg == 1) ? a.in[I_W2B] : (seg == 2) ? a.in[I_A2F] : a.in[I_A2B];
          float f[8];
#pragma unroll
          for (int j = 0; j < 8; ++j) { const int k = kc + j - 64 * seg; f[j] = (k >= 0 && k < 64) ? w2[(size_t)k * 1024 + c] : 0.f; }
          *(v4u*)(B1 + (size_t)n * 256 + kc) = pack8(f); }
      for (int i = gt; i < 1024 * 32; i += NT_) { const int n = i >> 5, kc = (i & 31) * 8; float f[8];
#pragma unroll
          for (int j = 0; j < 8; ++j) { const int k = kc + j; f[j] = (k < 160) ? a.in[I_G2][(size_t)k * 1024 + n] : 0.f; }
          *(v4u*)(B2 + (size_t)n * 256 + kc) = pack8(f); }
    }
    bf16_t* HN = (bf16_t*)(ws + WS_HN); const float* x = a.in[I_X]; const float* g = a.in[I_ANG];
    for (int m = gw; m < M; m += NGW) {
        const float4* xr = (const float4*)(x + (size_t)m * DM) + lane; float4 v[8]; float s = 0.f;
#pragma unroll
        for (int j = 0; j < 8; ++j) { v[j] = xr[64 * j]; s += (v[j].x * v[j].x + v[j].y * v[j].y) + (v[j].z * v[j].z + v[j].w * v[j].w); }
        const float rs = 1.0f / sqrtf(wave_sum(s) * (1.0f / DM) + RMS_EPS);
        v2u* o = (v2u*)(HN + (size_t)m * DM) + lane;
#pragma unroll
        for (int j = 0; j < 8; ++j) { const float4 gg = ((const float4*)g)[64 * j + lane]; v2u w; w.x = pk2(v[j].x * rs * gg.x, v[j].y * rs * gg.y); w.y = pk2(v[j].z * rs * gg.z, v[j].w * rs * gg.w); o[64 * j] = w; }
    }
}

__device__ __forceinline__ void p2_prep(const Args& a, int gw, int NGW, int lane, bool dummy = false) {
    unsigned char* ws = a.ws;
    bf16_t* PDA = (bf16_t*)(ws + WS_PDA); const bf16_t* PRW = (const bf16_t*)((unsigned char*)a.out + DO_PRW);
    bf16_t* RKV = (bf16_t*)(ws + WS_RKV); bf16_t* LIN = (bf16_t*)((unsigned char*)a.out + DO_LIN);
    const float* sm = (const float*)(ws + WS_SMALL); const float* mu = sm + SM_MU;
    const int sub8 = lane & 7;
    float gq[8], gk[8];
#pragma unroll
    for (int j = 0; j < 8; ++j) { gq[j] = sm[SM_QNG + sub8 * 8 + j]; gk[j] = sm[SM_KNG + sub8 * 8 + j]; }
    for (int m = gw; m < M; m += NGW) {
        const int t = m & (SEQ - 1);
        const float2 csv = ((const float2*)(ws + WS_ROPE))[t * 8 + sub8]; const float cv = csv.x, sv = csv.y;
        float cs[8], sn[8];
#pragma unroll
        for (int j = 0; j < 8; ++j) { cs[j] = __shfl(cv, j); sn[j] = __shfl(sv, j); }
#pragma unroll
        for (int it = 0; it < 4; ++it) {
            const int v = it * 8 + (lane >> 3);
            bf16_t* p = PDA + (size_t)m * 3072 + (v < 16 ? 0 : 1024) + (v & 15) * 64 + sub8 * 8;
            const v4u w = *(const v4u*)p; float f[8]; unpack8(w, f);
            float s = 0.f;
#pragma unroll
            for (int j = 0; j < 8; ++j) s += f[j] * f[j];
            s = sum8(s); const float rs = 1.0f / sqrtf(s * (1.0f / 64.0f) + RMS_EPS);
            float y[8], oth[8];
#pragma unroll
            for (int j = 0; j < 8; ++j) { y[j] = f[j] * rs * (v < 16 ? gq[j] : gk[j]); }
#pragma unroll
            for (int j = 0; j < 8; ++j) oth[j] = __shfl_xor(y[j], 1);
            float o[8];
#pragma unroll
            for (int j = 0; j < 8; ++j) o[j] = (sub8 == 0) ? (y[j] * cs[j] - oth[j] * sn[j]) : (sub8 == 1) ? (y[j] * cs[j] + oth[j] * sn[j]) : y[j];
            if (v < 16) {
#pragma unroll
                for (int j = 0; j < 8; ++j) o[j] *= 0.125f * 1.4426950408889634f; }
            *(v4u*)(dummy ? (bf16_t*)(ws + WS_LORA) + (p - PDA) : p) = pack8(o);
        }
        const bool hp = t > 0, hn_ = t < SEQ - 1;
        const bf16_t* pr = PRW + (size_t)m * RW_PAD;
#pragma unroll
        for (int it = 0; it < 7; ++it) {
            const int v = it * 64 + lane; if (it == 6 && v >= 436) continue;
            const v4u wc = *(const v4u*)(pr + v * 8);
            v4u wp = {0u, 0u, 0u, 0u}, wn = {0u, 0u, 0u, 0u};
            if (hp) wp = *(const v4u*)(pr - RW_PAD + v * 8);
            if (hn_) wn = *(const v4u*)(pr + RW_PAD + v * 8);
            float c[8], pv[8], nx[8]; unpack8(wc, c); unpack8(wp, pv); unpack8(wn, nx);
            const float4 m0 = *(const float4*)(mu + v * 8), m1 = *(const float4*)(mu + v * 8 + 4);
            const float mm[8] = {m0.x, m0.y, m0.z, m0.w, m1.x, m1.y, m1.z, m1.w};
            float xs[8];
#pragma unroll
            for (int j = 0; j < 8; ++j) xs[j] = c[j] + mm[j] * (0.5f * (pv[j] + nx[j]) - c[j]);
            if (v < 384) { const v4u pw = pack8(xs); *(v4u*)(RKV + (size_t)m * 3072 + v * 8) = pw;
                if (it == 2 || it == 3) {
                    float kr[8]; unpack8(pw, kr); float ssq = 0.f;
#pragma unroll
                    for (int j = 0; j < 8; ++j) { const float kkv = kr[j] * sm[SM_KK + (v - 128) * 8 + j]; ssq += kkv * kkv; }
                    ssq = sum8(ssq);
                    if ((lane & 7) == 0) ((float*)(ws + WS_INRM))[(size_t)m * 16 + ((v - 128) >> 3)] = 1.0f / fmaxf(sqrtf(ssq), 1e-12f); } }
            else if (v < 400) {
#pragma unroll
                for (int j = 0; j < 8; ++j) xs[j] = 1.0f - 2.0f * __builtin_amdgcn_rcpf(1.0f + __expf(2.0f * xs[j]));
                *(v4u*)(LIN + (size_t)m * 512 + (v - 384) * 8) = pack8(xs); }
            else if (v < 416) { *(v4u*)(LIN + (size_t)m * 512 + (v - 384) * 8) = pack8(xs); }
            else {
#pragma unroll
                for (int j = 0; j < 8; ++j) xs[j] = sigmoidf_(xs[j]);
                *(v4u*)(LIN + (size_t)m * 512 + 256 + (v - 416) * 8) = pack8(xs); }
        }
        if (lane < 12) { v4u z = {0u, 0u, 0u, 0u}; *(v4u*)(LIN + (size_t)m * 512 + 416 + lane * 8) = z; }
    }
}

__device__ __forceinline__ void p6_rwpost(const Args& a, int gw, int NGW, int lane) {
    unsigned char* ws = a.ws;
    const bf16_t* RKV = (const bf16_t*)(ws + WS_RKV); const bf16_t* LO = (const bf16_t*)(ws + WS_LORA);
    const bf16_t* YSF = (const bf16_t*)((unsigned char*)a.out + DO_YSF); const bf16_t* YSB = (const bf16_t*)((unsigned char*)a.out + DO_YSB);
    bf16_t* YB = (bf16_t*)((unsigned char*)a.out + DO_YAB) + 1024;
    const size_t SEG = (size_t)M * 1024; const float* sm = (const float*)(ws + WS_SMALL);
    for (int it = gw; it < 2 * M; it += NGW) {
        const int m = it >> 1, col = (it & 1) * 512 + lane * 8;
        float yf[8], ybk[8], r[8], k[8], v[8], af[8], ab[8], g[8];
        unpack8(*(const v4u*)(YSF + (size_t)m * 1024 + col), yf); unpack8(*(const v4u*)(YSB + (size_t)m * 1024 + col), ybk);
        unpack8(*(const v4u*)(RKV + (size_t)m * 3072 + col), r); unpack8(*(const v4u*)(RKV + (size_t)m * 3072 + 1024 + col), k); unpack8(*(const v4u*)(RKV + (size_t)m * 3072 + 2048 + col), v);
        unpack8(*(const v4u*)(LO + 2 * SEG + (size_t)m * 1024 + col), af); unpack8(*(const v4u*)(LO + 3 * SEG + (size_t)m * 1024 + col), ab); unpack8(*(const v4u*)(LO + 4 * SEG + (size_t)m * 1024 + col), g);
        float y[8]; float s = 0.f;
#pragma unroll
        for (int j = 0; j < 8; ++j) { y[j] = yf[j] + ybk[j]; s += y[j]; }
        const float mean = sum8(s) * (1.0f / 64.0f); float q = 0.f;
#pragma unroll
        for (int j = 0; j < 8; ++j) { y[j] -= mean; q += y[j] * y[j]; }
        const float rstd = 1.0f / sqrtf(sum8(q) * (1.0f / 64.0f) + GN_EPS);
        float bs = 0.f;
#pragma unroll
        for (int j = 0; j < 8; ++j) { const float kfb = k[j] * (2.0f + (af[j] + ab[j] - 2.0f) * sm[SM_KA + col + j]); bs += r[j] * kfb * sm[SM_RK + col + j]; }
        bs = sum8(bs);
        float o[8];
#pragma unroll
        for (int j = 0; j < 8; ++j) o[j] = (y[j] * rstd * sm[SM_LNW + col + j] + sm[SM_LNB + col + j] + bs * v[j]) * g[j];
        *(v4u*)(YB + (size_t)m * 2048 + col) = pack8(o);
    }
}

__device__ __forceinline__ void expert_convert(const Args& a, LAS unsigned char* lds, int gw, int NGW, int wave, int lane, int lo, int hi) {
    unsigned char* ws = a.ws;
    LAS float* scr = (LAS float*)(lds + wave * 16384);
    bf16_t* W1T = (bf16_t*)(ws + WS_W1T); bf16_t* WDT = (bf16_t*)(ws + WS_WDT);
    for (int it = lo + gw; it < hi; it += NGW) {
        const int which = it >> 14, r = it & 16383, e = r >> 10, q = r & 1023;
        if (which < 2) { const int kb = q >> 5, nb = q & 31, n0 = nb * 32;
            const float* W = (which == 0 ? a.in[I_WG] : a.in[I_WU]) + (size_t)e * 2048 * 1024;
            const int drow = (n0 >> 7) * 256 + which * 128 + (n0 & 127);
            tr_item(W, 1024, kb * 64, n0, W1T + ((size_t)e * 2048 + drow) * 2048 + kb * 64, 2048, scr, lane); }
        else { const int kb = q >> 6, nb = q & 63;
            const float* W = a.in[I_WD] + (size_t)e * 1024 * 2048;
            tr_item(W, 2048, kb * 64, nb * 32, WDT + ((size_t)e * 2048 + nb * 32) * 1024 + kb * 64, 1024, scr, lane); }
    }
}
__device__ __forceinline__ void p9_router(const Args& a, LAS unsigned char* lds, int gw, int NGW, int wave, int lane) {
    unsigned char* ws = a.ws;
    expert_convert(a, lds, gw, NGW, wave, lane, 0, 2 * 16384);
    __syncthreads();
    LAS float* wrT = (LAS float*)lds;
    { const float4* wr4 = (const float4*)((const float*)(ws + WS_SMALL) + SM_WR);
      for (int idx = fresh_tid(); idx < 2048 * 4; idx += NTHREADS) { const int d = idx >> 2, q = idx & 3; const float4 w4 = wr4[idx];
          wrT[(4 * q + 0) * 2048 + d] = w4.x; wrT[(4 * q + 1) * 2048 + d] = w4.y; wrT[(4 * q + 2) * 2048 + d] = w4.z; wrT[(4 * q + 3) * 2048 + d] = w4.w; } }
    __syncthreads();
    const float* h = a.out; const float* ss = (const float*)(ws + WS_SSP); const float* g = (const float*)(ws + WS_SMALL) + SM_FNG;
    float* aff = (float*)(ws + WS_AFF); bf16_t* hn2 = (bf16_t*)(ws + WS_HN2);
    for (int mp = gw; mp < M / 2; mp += NGW) {
        const int m0 = 2 * mp;
        const float rs0 = 1.0f / sqrtf(wave_sum(lane < 32 ? ss[(size_t)m0 * 32 + lane] : 0.f) * (1.0f / DM) + RMS_EPS);
        const float rs1 = 1.0f / sqrtf(wave_sum(lane < 32 ? ss[(size_t)(m0 + 1) * 32 + lane] : 0.f) * (1.0f / DM) + RMS_EPS);
        float acc0[16], acc1[16];
#pragma unroll
        for (int e = 0; e < 16; ++e) { acc0[e] = 0.f; acc1[e] = 0.f; }
#pragma unroll 2
        for (int j = 0; j < 8; ++j) { const int d = j * 256 + lane * 4;
            const float4 gv = *(const float4*)(g + d), h0 = *(const float4*)(h + (size_t)m0 * DM + d), h1 = *(const float4*)(h + (size_t)(m0 + 1) * DM + d);
            const float x0[4] = {h0.x * rs0 * gv.x, h0.y * rs0 * gv.y, h0.z * rs0 * gv.z, h0.w * rs0 * gv.w};
            const float x1[4] = {h1.x * rs1 * gv.x, h1.y * rs1 * gv.y, h1.z * rs1 * gv.z, h1.w * rs1 * gv.w};
            { v2u w0, w1; w0.x = pk2(x0[0], x0[1]); w0.y = pk2(x0[2], x0[3]); w1.x = pk2(x1[0], x1[1]); w1.y = pk2(x1[2], x1[3]);
              *(v2u*)(hn2 + (size_t)m0 * DM + d) = w0; *(v2u*)(hn2 + (size_t)(m0 + 1) * DM + d) = w1; }
#pragma unroll
            for (int e = 0; e < 16; ++e) { const pg8::f32x4 w4 = *(const LAS pg8::f32x4*)(wrT + e * 2048 + d);
                acc0[e] += x0[0] * w4.x + x0[1] * w4.y + x0[2] * w4.z + x0[3] * w4.w;
                acc1[e] += x1[0] * w4.x + x1[1] * w4.y + x1[2] * w4.z + x1[3] * w4.w; } }
#pragma unroll
        for (int t2 = 0; t2 < 2; ++t2) {
            float mx = -1e30f, lg[16];
#pragma unroll
            for (int e = 0; e < 16; ++e) { lg[e] = wave_sum(t2 ? acc1[e] : acc0[e]); mx = fmaxf(mx, lg[e]); }
            float den = 0.f;
#pragma unroll
            for (int e = 0; e < 16; ++e) { lg[e] = __expf(lg[e] - mx); den += lg[e]; }
            float mine = lg[0];
#pragma unroll
            for (int e = 1; e < 16; ++e) mine = (lane == e) ? lg[e] : mine;
            const int m = m0 + t2;
            if (lane < 16) aff[((size_t)(m >> 12) * 16 + lane) * SEQ + (m & (SEQ - 1))] = mine / den;
        }
    }
}

__device__ __forceinline__ void p10_topk(const Args& a, unsigned char* ldsg) {
    const int bx = blockIdx.x; if (bx >= NB * NE) return;
    LAS unsigned char* L = (LAS unsigned char*)ldsg;
    const int tid = fresh_tid(), lane = tid & 63, w = tid >> 6;
    unsigned char* ws = a.ws;
    const float* aff = (const float*)(ws + WS_AFF) + (size_t)bx * SEQ;
    LAS unsigned* hist = (LAS unsigned*)L;
    LAS unsigned* ctl = hist + 256;
    LAS unsigned* wtot = hist + 272;
    unsigned v[8];
    { const v4u a0 = *(const v4u*)(aff + tid * 8), a1 = *(const v4u*)(aff + tid * 8 + 4); v[0] = a0.x; v[1] = a0.y; v[2] = a0.z; v[3] = a0.w; v[4] = a1.x; v[5] = a1.y; v[6] = a1.z; v[7] = a1.w; }
    unsigned prefix = 0u, mask = 0u, remaining = CAP;
#pragma unroll 1
    for (int pass = 0; pass < 4; ++pass) {
        const int shift = 24 - 8 * pass;
        if (tid < 256) hist[tid] = 0u;
        __syncthreads();
#pragma unroll
        for (int q = 0; q < 8; ++q) if ((v[q] & mask) == prefix) __hip_atomic_fetch_add((unsigned*)&hist[(v[q] >> shift) & 255u], 1u, __ATOMIC_RELAXED, __HIP_MEMORY_SCOPE_WORKGROUP);
        __syncthreads();
        if (w == 0) {
            const v4u hb = *(const LAS v4u*)(hist + 4 * lane);
            const unsigned own = hb.x + hb.y + hb.z + hb.w;
            unsigned suf = own;
#pragma unroll
            for (int o = 1; o < 64; o <<= 1) { const unsigned t = __shfl_down(suf, o); suf += (lane + o < 64) ? t : 0u; }
            const unsigned above = suf - own;
            if (above < remaining && remaining <= suf) {
                unsigned c3 = above, d, rem;
                if (remaining <= c3 + hb.w) { d = 3; rem = remaining - c3; }
                else { c3 += hb.w; if (remaining <= c3 + hb.z) { d = 2; rem = remaining - c3; }
                    else { c3 += hb.z; if (remaining <= c3 + hb.y) { d = 1; rem = remaining - c3; } else { c3 += hb.y; d = 0; rem = remaining - c3; } } }
                ctl[0] = 4u * lane + d; ctl[1] = rem;
            }
        }
        __syncthreads();
        prefix |= ctl[0] << shift; mask |= 255u << shift; remaining = ctl[1];
        __syncthreads();
    }
    const unsigned thr = prefix;
    unsigned ceq = 0u, cgt = 0u;
#pragma unroll
    for (int q = 0; q < 8; ++q) { ceq += (v[q] == thr) ? 1u : 0u; cgt += (v[q] > thr) ? 1u : 0u; }
    unsigned inc = ceq;
#pragma unroll
    for (int o = 1; o < 64; o <<= 1) { const unsigned t = __shfl_up(inc, o); inc += (lane >= o) ? t : 0u; }
    if (lane == 63) wtot[w] = inc;
    __syncthreads();
    unsigned eqbase = inc - ceq;
#pragma unroll
    for (int q = 0; q < 8; ++q) eqbase += (q < w) ? wtot[q] : 0u;
    __syncthreads();
    unsigned selmask = 0u, nsel = 0u, er = eqbase;
#pragma unroll
    for (int q = 0; q < 8; ++q) { bool s = v[q] > thr; if (v[q] == thr) { s = er < remaining; ++er; } selmask |= s ? (1u << q) : 0u; nsel += s ? 1u : 0u; }
    inc = nsel;
#pragma unroll
    for (int o = 1; o < 64; o <<= 1) { const unsigned t = __shfl_up(inc, o); inc += (lane >= o) ? t : 0u; }
    if (lane == 63) wtot[w] = inc;
    __syncthreads();
    unsigned pos = inc - nsel;
#pragma unroll
    for (int q = 0; q < 8; ++q) pos += (q < w) ? wtot[q] : 0u;
    int* seltok = (int*)(ws + WS_SELTOK) + bx * CAP; float* selgate = (float*)(ws + WS_SELGATE) + bx * CAP;
#pragma unroll
    for (int q = 0; q < 8; ++q) if (selmask & (1u << q)) { if (pos < (unsigned)CAP) { seltok[pos] = tid * 8 + q; selgate[pos] = __uint_as_float(v[q]); } ++pos; }
    (void)cgt;
}

__device__ __forceinline__ void p11_gather(const Args& a, int gw, int NGW, int lane) {
    unsigned char* ws = a.ws;
    const float* h = a.out; const float* ss = (const float*)(ws + WS_SSP); const float* g = (const float*)(ws + WS_SMALL) + SM_FNG;
    const int* seltok = (const int*)(ws + WS_SELTOK); bf16_t* XE = (bf16_t*)(ws + WS_XE);
    for (int r = gw; r < NSLOT; r += NGW) {
        const int e = r >> 11, b = (r >> 9) & 3, c = r & 511;
        const int tok = seltok[(b * 16 + e) * CAP + c]; const size_t m = (size_t)b * SEQ + tok;
        const float rs = 1.0f / sqrtf(wave_sum(lane < 32 ? ss[m * 32 + lane] : 0.f) * (1.0f / DM) + RMS_EPS);
        const float4* hr = (const float4*)(h + m * DM) + lane; v2u* o = (v2u*)(XE + (size_t)r * DM) + lane;
#pragma unroll
        for (int j = 0; j < 8; ++j) { const float4 hv = hr[64 * j], gg = ((const float4*)g)[64 * j + lane];
            v2u w; w.x = pk2(hv.x * rs * gg.x, hv.y * rs * gg.y); w.y = pk2(hv.z * rs * gg.z, hv.w * rs * gg.w); o[64 * j] = w; }
    }
}

__device__ __forceinline__ void p14_combine(const Args& a, unsigned char* lds, int wave, int lane) {
    unsigned char* ws = a.ws;
    const int G = gridDim.x, bx = blockIdx.x, tid = fresh_tid();
    const int per = M / G;
    const int m0 = bx * per, b = m0 >> 12, t0 = m0 & (SEQ - 1);
    int* inv = (int*)lds;
    for (int i = tid; i < per * 16; i += NTHREADS) inv[i] = -1;
    __syncthreads();
    const int* seltok = (const int*)(ws + WS_SELTOK) + b * 16 * CAP;
    for (int i = tid; i < 16 * CAP; i += NTHREADS) { const int e = i >> 9, c = i & 511; const int tok = seltok[i]; const int tl = tok - t0;
        if (tl >= 0 && tl < per) inv[tl * 16 + e] = e * 2048 + b * 512 + c; }
    __syncthreads();
    const bf16_t* YE = (const bf16_t*)(ws + WS_XE);
    float* out = a.out;
    for (int tl = wave; tl < per; tl += NWAVES) {
        const size_t m = (size_t)m0 + tl;
        float4* orow = (float4*)(out + m * DM) + lane;
        float4 acc[8];
#pragma unroll
        for (int j = 0; j < 8; ++j) acc[j] = orow[64 * j];
        int sl[16]; int ns = 0;
#pragma unroll
        for (int e = 0; e < 16; ++e) { const int s_ = inv[tl * 16 + e]; if (s_ >= 0) { _Pragma("unroll") for (int q = 0; q < 16; ++q) if (q == ns) sl[q] = s_; ++ns; } }
        for (int q = 0; q < ns; q += 2) { int s0 = sl[0], s1 = sl[0];
#pragma unroll
            for (int z = 0; z < 16; ++z) { if (z == q) s0 = sl[z]; if (z == q + 1) s1 = sl[z]; }
            const bool two = q + 1 < ns;
            const v2u* y0 = (const v2u*)(YE + (size_t)s0 * DM) + lane; const v2u* y1 = (const v2u*)(YE + (size_t)(two ? s1 : s0) * DM) + lane;
            v2u w0[8], w1[8];
#pragma unroll
            for (int j = 0; j < 8; ++j) { w0[j] = y0[64 * j]; w1[j] = y1[64 * j]; }
#pragma unroll
            for (int j = 0; j < 8; ++j) { acc[j].x += bflo(w0[j].x); acc[j].y += bfhi(w0[j].x); acc[j].z += bflo(w0[j].y); acc[j].w += bfhi(w0[j].y);
                if (two) { acc[j].x += bflo(w1[j].x); acc[j].y += bfhi(w1[j].x); acc[j].z += bflo(w1[j].y); acc[j].w += bfhi(w1[j].y); } } }
#pragma unroll
        for (int j = 0; j < 8; ++j) orow[64 * j] = acc[j];
    }
}


namespace scan {
typedef short bf16x8 __attribute__((ext_vector_type(8)));
typedef float f32x4 __attribute__((ext_vector_type(4)));
constexpr int TS = 72, TILE_B = 64 * TS * 2;
enum { SL_ATC = 0, SL_BTC = 1, SL_KTC = 2, SL_RTC = 3, SL_BBT = 4, SL_KBT = 5, SL_VT = 6, SL_XCA = 7, SL_TTA = 8, SL_NKA = 9, SL_NBRT = 10, SL_G = 11, SL_SB = 12,
       SL_XCB = 1, SL_TTB = 2, SL_APT = 7, SL_RP = 0, SL_HT = 9, SL_PSIT = 8, SL_WB = 10 };
constexpr int OFF_PL = 13 * TILE_B, OFF_TOT = OFF_PL + 256;
#define TILE(s) (L + (s) * TILE_B)
__device__ __forceinline__ bf16x8 frag(const LAS unsigned char* tile, int row0, int k0, int lane) {
    return *(const LAS bf16x8*)(tile + ((row0 + (lane & 15)) * TS + k0 + 8 * (lane >> 4)) * 2);
}
__device__ __forceinline__ void mma(f32x4& acc, const LAS unsigned char* A, int arow0, const LAS unsigned char* B, int brow0, int lane) {
    acc = __builtin_amdgcn_mfma_f32_16x16x32_bf16(frag(A, arow0, 0, lane), frag(B, brow0, 0, lane), acc, 0, 0, 0);
    acc = __builtin_amdgcn_mfma_f32_16x16x32_bf16(frag(A, arow0, 32, lane), frag(B, brow0, 32, lane), acc, 0, 0, 0);
}
__device__ __forceinline__ void st4(LAS unsigned char* tile, int brow, int acol0, const f32x4& v) {
    v2u w; w.x = pg8::cvt_pk_bf16(v[0], v[1]); w.y = pg8::cvt_pk_bf16(v[2], v[3]); *(LAS v2u*)(tile + (brow * TS + acol0) * 2) = w;
}
__device__ __forceinline__ f32x4 ld4(const LAS unsigned char* tile, int brow, int acol0) {
    const v2u w = *(const LAS v2u*)(tile + (brow * TS + acol0) * 2); return (f32x4){bflo(w.x), bfhi(w.x), bflo(w.y), bfhi(w.y)};
}
typedef short v4i16_t __attribute__((ext_vector_type(4)));
__device__ __forceinline__ bf16x8 fragT(const LAS unsigned char* tileT, int row0, int k0, int lane) {
    const int g = lane >> 4, q = (lane >> 2) & 3, p = lane & 3;
    const LAS unsigned char* a = tileT + ((k0 + 8 * g + q) * TS + row0 + 4 * p) * 2;
    const v4i16_t lo = __builtin_amdgcn_ds_read_tr16_b64_v4i16((LAS v4i16_t*)a), hi = __builtin_amdgcn_ds_read_tr16_b64_v4i16((LAS v4i16_t*)(a + 4 * TS * 2));
    return (bf16x8){lo[0], lo[1], lo[2], lo[3], hi[0], hi[1], hi[2], hi[3]};
}
struct Fr { bf16x8 k0, k1; };
__device__ __forceinline__ Fr ldf(const LAS unsigned char* tile, int row0, int lane) { Fr f; f.k0 = frag(tile, row0, 0, lane); f.k1 = frag(tile, row0, 32, lane); return f; }
__device__ __forceinline__ Fr ldfT(const LAS unsigned char* tileT, int row0, int lane) { Fr f; f.k0 = fragT(tileT, row0, 0, lane); f.k1 = fragT(tileT, row0, 32, lane); return f; }
__device__ __forceinline__ void mmf(f32x4& acc, const Fr& A, const Fr& B) {
    acc = __builtin_amdgcn_mfma_f32_16x16x32_bf16(A.k0, B.k0, acc, 0, 0, 0); acc = __builtin_amdgcn_mfma_f32_16x16x32_bf16(A.k1, B.k1, acc, 0, 0, 0);
}
#define ZERO4 ((f32x4){0.f, 0.f, 0.f, 0.f})
#define LWAIT() asm volatile("s_waitcnt lgkmcnt(0)" ::: "memory")

__device__ __forceinline__ void scan_phase(const Args& a, unsigned char* ldsg) {
    const int bx = blockIdx.x; if (bx >= 128) return;
    LAS unsigned char* L = (LAS unsigned char*)ldsg;
    const int tid = fresh_tid(), lane = tid & 63, w = __builtin_amdgcn_readfirstlane(tid >> 6);
    const int dir = bx >> 6, b = (bx >> 4) & 3, hh = bx & 15;
    unsigned char* ws = a.ws;
    const bf16_t* RKV = (const bf16_t*)(ws + WS_RKV) + hh * 64 + lane;
    const bf16_t* LW = (const bf16_t*)(ws + WS_LORA) + (size_t)dir * ((size_t)M * 1024) + hh * 64 + lane;
    const bf16_t* AL = (const bf16_t*)(ws + WS_LORA) + (size_t)(2 + dir) * ((size_t)M * 1024) + hh * 64 + lane;
    bf16_t* YS = (bf16_t*)((unsigned char*)a.out + (dir ? DO_YSB : DO_YSF));
    const float kkc = ((const float*)(ws + WS_SMALL))[SM_KK + hh * 64 + lane], kac = ((const float*)(ws + WS_SMALL))[SM_KA + hh * 64 + lane];
    const int g4 = lane >> 4, l15 = lane & 15;
    const int ta = w >> 1, tb0 = (w & 1) * 2;
    const int a0 = ta * 16 + 4 * g4;
    unsigned short rw[8][5]; float inr[8];
    const float* INRM = (const float*)(ws + WS_INRM) + hh;
#define RAW_LOAD(chunk) do { _Pragma("unroll") for (int j = 0; j < 8; ++j) { const int s_ = (chunk) * 64 + w * 8 + j; const int t_ = dir ? (SEQ - 1 - s_) : s_; const size_t m_ = (size_t)b * SEQ + t_; \
        rw[j][0] = RKV[m_ * 3072]; rw[j][1] = RKV[m_ * 3072 + 1024]; rw[j][2] = RKV[m_ * 3072 + 2048]; rw[j][3] = LW[m_ * 1024]; rw[j][4] = AL[m_ * 1024]; inr[j] = INRM[m_ * 16]; } } while (0)
    RAW_LOAD(0);
    f32x4 accS[4];
#pragma unroll
    for (int q = 0; q < 4; ++q) accS[q] = (f32x4){0.f, 0.f, 0.f, 0.f};
    for (int u = tid; u < TILE_B / 16; u += NTHREADS) ((LAS v4u*)TILE(SL_SB))[u] = (v4u){0u, 0u, 0u, 0u};
#pragma unroll 1
    for (int c = 0; c < SEQ / 64; ++c) {
        float cl[8];
        {
            float run = 0.f;
#pragma unroll
            for (int j = 0; j < 8; ++j) { run += bf2f(rw[j][3]); cl[j] = run; }
            ((LAS float*)(L + OFF_TOT))[w * 64 + lane] = run;
        }
        __syncthreads();
        {
            float off = 0.f, tot = 0.f;
#pragma unroll
            for (int q = 0; q < 8; ++q) { const float t_ = ((const LAS float*)(L + OFF_TOT))[q * 64 + lane]; off += (q < w) ? t_ : 0.f; tot += t_; }
            const float pLt = __expf(tot);
            if (w == 0) ((LAS float*)(L + OFF_PL))[lane] = pLt;
            float pprev = __expf(off);
            float at8[8], bt8[8], kt8[8], rt8[8], bb8[8], kb8[8]; unsigned vt[4];
#pragma unroll
            for (int j = 0; j < 8; ++j) {
                const float r = bf2f(rw[j][0]), k = bf2f(rw[j][1]), al = bf2f(rw[j][4]);
                const float p = __expf(cl[j] + off), em = __builtin_amdgcn_rcpf(p), eL = pLt * em;
                const float kk = k * kkc * inr[j], kdv = k * (1.0f + (al - 1.0f) * kac), bbj = kk * al;
                at8[j] = -kk * pprev; pprev = p; bt8[j] = bbj * em; kt8[j] = kdv * em; rt8[j] = r * p; bb8[j] = bbj * eL; kb8[j] = kdv * eL;
                if (j & 1) vt[j >> 1] |= ((unsigned)rw[j][2] << 16); else vt[j >> 1] = rw[j][2];
            }
            const int o16 = (lane * TS + w * 8) * 2;
            *(LAS v4u*)(TILE(SL_ATC) + o16) = pack8(at8); *(LAS v4u*)(TILE(SL_BTC) + o16) = pack8(bt8); *(LAS v4u*)(TILE(SL_KTC) + o16) = pack8(kt8); *(LAS v4u*)(TILE(SL_RTC) + o16) = pack8(rt8);
            *(LAS v4u*)(TILE(SL_BBT) + o16) = pack8(bb8); *(LAS v4u*)(TILE(SL_KBT) + o16) = pack8(kb8); *(LAS v4u*)(TILE(SL_VT) + o16) = (v4u){vt[0], vt[1], vt[2], vt[3]};
        }
        if (c + 1 < SEQ / 64) RAW_LOAD(c + 1);
        __syncthreads();
        f32x4 accT[2], accH[2];
        {
            const Fr aBT = ldfT(TILE(SL_BTC), ta * 16, lane), aAT = ldfT(TILE(SL_ATC), ta * 16, lane), aKT = ldfT(TILE(SL_KTC), ta * 16, lane);
            Fr bAT[2], bKT[2], bRT[2];
#pragma unroll
            for (int q = 0; q < 2; ++q) { bAT[q] = ldfT(TILE(SL_ATC), (tb0 + q) * 16, lane); bKT[q] = ldfT(TILE(SL_KTC), (tb0 + q) * 16, lane); bRT[q] = ldfT(TILE(SL_RTC), (tb0 + q) * 16, lane); }
            f32x4 d2[2], d3[2], d4[2];
#pragma unroll
            for (int q = 0; q < 2; ++q) { d2[q] = ZERO4; d3[q] = ZERO4; d4[q] = ZERO4; accH[q] = ZERO4;
                mmf(d2[q], aBT, bAT[q]);
                mmf(d3[q], aAT, bKT[q]);
                mmf(d4[q], aBT, bRT[q]);
                mmf(accH[q], aKT, bRT[q]); }
#pragma unroll
            for (int q = 0; q < 2; ++q) { const int bcol = (tb0 + q) * 16 + l15;
#pragma unroll
                for (int e = 0; e < 4; ++e) { const bool lt = bcol < a0 + e, gt = a0 + e < bcol, ge = a0 + e <= bcol;
                    d3[q][e] = lt ? d3[q][e] : 0.f;
                    d2[q][e] = gt ? d2[q][e] : 0.f; d4[q][e] = ge ? d4[q][e] : 0.f; accH[q][e] = ge ? accH[q][e] : 0.f; }
                st4(TILE(SL_NKA), bcol, a0, d3[q]); st4(TILE(SL_XCA), bcol, a0, d2[q]); st4(TILE(SL_NBRT), bcol, a0, d4[q]);
#pragma unroll
                for (int e = 0; e < 4; ++e) d2[q][e] += (a0 + e == bcol) ? 1.0f : 0.f;
                accT[q] = d2[q]; st4(TILE(SL_TTA), bcol, a0, d2[q]); }
        }
        __syncthreads();
#pragma unroll
        for (int r = 0; r <= 5; ++r) {
            LAS unsigned char* Xc = (r & 1) ? TILE(SL_XCB) : TILE(SL_XCA); LAS unsigned char* Xc2 = (r & 1) ? TILE(SL_XCA) : TILE(SL_XCB);
            LAS unsigned char* TTr = ((r - 1) & 1) ? TILE(SL_TTB) : TILE(SL_TTA); LAS unsigned char* TTw = (r & 1) ? TILE(SL_TTB) : TILE(SL_TTA);
            const Fr aX = ldfT(Xc, ta * 16, lane); Fr bTT[2], bX[2];
#pragma unroll
            for (int q = 0; q < 2; ++q) { if (r >= 1) bTT[q] = ldf(TTr, (tb0 + q) * 16, lane); if (r < 5) bX[q] = ldf(Xc, (tb0 + q) * 16, lane); }
            f32x4 x1[2];
#pragma unroll
            for (int q = 0; q < 2; ++q) {
                if (r >= 1) mmf(accT[q], aX, bTT[q]);
                if (r < 5) { x1[q] = ZERO4; mmf(x1[q], aX, bX[q]); } }
#pragma unroll
            for (int q = 0; q < 2; ++q) { const int bcol = (tb0 + q) * 16 + l15;
                if (r >= 1) st4(TTw, bcol, a0, accT[q]);
                if (r < 5) st4(Xc2, bcol, a0, x1[q]); }
            __syncthreads();
        }
        {
            const Fr aATC = ldf(TILE(SL_ATC), ta * 16, lane), aTT = ldf(TILE(SL_TTB), ta * 16, lane); Fr bTT[2], bNKA[2];
#pragma unroll
            for (int q = 0; q < 2; ++q) { bTT[q] = ldf(TILE(SL_TTB), (tb0 + q) * 16, lane); bNKA[q] = ldf(TILE(SL_NKA), (tb0 + q) * 16, lane); }
            f32x4 e1[2], e3[2];
#pragma unroll
            for (int q = 0; q < 2; ++q) { e1[q] = ZERO4; e3[q] = ZERO4;
                mmf(e1[q], aATC, bTT[q]);
                mmf(e3[q], aTT, bNKA[q]); }
#pragma unroll
            for (int q = 0; q < 2; ++q) { const int bcol = (tb0 + q) * 16 + l15; st4(TILE(SL_APT), bcol, a0, e1[q]); st4(TILE(SL_G), bcol, a0, e3[q]); }
        }
        __syncthreads();
        {
            const Fr aNB = ldf(TILE(SL_NBRT), ta * 16, lane), aG = ldf(TILE(SL_G), ta * 16, lane); Fr bAP[2], bNB[2], bBB[2]; f32x4 rp[2], ps[2];
#pragma unroll
            for (int q = 0; q < 2; ++q) { const int bcol = (tb0 + q) * 16 + l15; bAP[q] = ldfT(TILE(SL_APT), (tb0 + q) * 16, lane); bNB[q] = ldf(TILE(SL_NBRT), (tb0 + q) * 16, lane); bBB[q] = ldf(TILE(SL_BBT), (tb0 + q) * 16, lane);
                rp[q] = ld4(TILE(SL_RTC), bcol, a0); ps[q] = ld4(TILE(SL_KBT), bcol, a0); }
#pragma unroll
            for (int q = 0; q < 2; ++q) { mmf(rp[q], aNB, bAP[q]);
                mmf(accH[q], aG, bNB[q]);
                mmf(ps[q], aG, bBB[q]); }
#pragma unroll
            for (int q = 0; q < 2; ++q) { const int bcol = (tb0 + q) * 16 + l15;
                st4(TILE(SL_RP), bcol, a0, rp[q]); st4(TILE(SL_HT), bcol, a0, accH[q]); st4(TILE(SL_PSIT), bcol, a0, ps[q]); }
        }
        __syncthreads();
        if (w < 4) {
            const int vrow = w * 16 + l15;
            const Fr fS = ldf(TILE(SL_SB), w * 16, lane), fV = ldf(TILE(SL_VT), w * 16, lane);
            f32x4 wv[4], yv[4];
            {
                Fr fAPT[4];
#pragma unroll
                for (int q = 0; q < 4; ++q) fAPT[q] = ldf(TILE(SL_APT), q * 16, lane);
#pragma unroll
                for (int q = 0; q < 4; ++q) { wv[q] = ZERO4; mmf(wv[q], fAPT[q], fS); }
#pragma unroll
                for (int q = 0; q < 4; ++q) st4(TILE(SL_WB), vrow, q * 16 + 4 * g4, wv[q]);
            }
            {
                Fr fRPT[4], fHT[4];
#pragma unroll
                for (int q = 0; q < 4; ++q) { fRPT[q] = ldfT(TILE(SL_RP), q * 16, lane); fHT[q] = ldf(TILE(SL_HT), q * 16, lane); }
#pragma unroll
                for (int q = 0; q < 4; ++q) { yv[q] = ZERO4; mmf(yv[q], fS, fRPT[q]); mmf(yv[q], fV, fHT[q]); }
#pragma unroll
                for (int q = 0; q < 4; ++q) { const int s_ = c * 64 + q * 16 + l15; const int t_ = dir ? (SEQ - 1 - s_) : s_;
                    v2u o; o.x = pg8::cvt_pk_bf16(yv[q][0], yv[q][1]); o.y = pg8::cvt_pk_bf16(yv[q][2], yv[q][3]);
                    *(v2u*)(YS + ((size_t)b * SEQ + t_) * 1024 + hh * 64 + w * 16 + 4 * g4) = o; }
            }
            {
                Fr fPS[4];
#pragma unroll
                for (int q = 0; q < 4; ++q) fPS[q] = ldf(TILE(SL_PSIT), q * 16, lane);
#pragma unroll
                for (int q = 0; q < 4; ++q) { const f32x4 pl = *(const LAS f32x4*)(L + OFF_PL + (q * 16 + 4 * g4) * 4); accS[q] = accS[q] * pl; mmf(accS[q], fPS[q], fV); }
                LWAIT();
                const Fr fW = ldf(TILE(SL_WB), w * 16, lane); Fr fBB[4];
#pragma unroll
                for (int q = 0; q < 4; ++q) fBB[q] = ldf(TILE(SL_BBT), q * 16, lane);
#pragma unroll
                for (int q = 0; q < 4; ++q) { mmf(accS[q], fBB[q], fW); st4(TILE(SL_SB), vrow, q * 16 + 4 * g4, accS[q]); }
            }
        }
    }
#undef RAW_LOAD
}
#undef TILE
#undef LWAIT
}
__global__ void __launch_bounds__(NTHREADS, 2) mega_fwd(Args a) {
    extern __shared__ __attribute__((aligned(16))) unsigned char lds[];
    cg::grid_group grid = cg::this_grid();
    const int G = gridDim.x, bx = blockIdx.x;
    const int vcu = (G % 8 == 0) ? (bx % 8) * (G / 8) + bx / 8 : bx;
    const int NGW = G * NWAVES;
#define WIDS() const int tid = fresh_tid(), lane = tid & 63, wave = __builtin_amdgcn_readfirstlane(tid >> 6), gw = vcu * NWAVES + wave; (void)lane; (void)gw
    unsigned char* ws = a.ws;
    LAS unsigned char* lds3 = (LAS unsigned char*)lds;
    const int lo = a.ph_lo, hi = a.ph_hi;
#ifndef ONLY
#define ONLY -1
#endif
#define IN(k) (lo <= (k) && (k) < hi && (ONLY < 0 || ONLY == (k)))
#ifndef DUPMASK
#define DUPMASK 0
#endif
#ifndef USE_CG
#define USE_CG 0
#endif
#define GRIDBAR(k) do { if (USE_CG || a.ph_hi > 1000) grid.sync(); else xcd_barrier(bar); } while (0)
#define SEAM(k) do { if (IN(k) && IN((k) + 1)) GRIDBAR(k); } while (0)
#define PH_BEGIN(k) if (IN(k)) for (int rep_ = 0; rep_ <= ((DUPMASK >> (k)) & 1); ++rep_) { if (rep_) GRIDBAR(1);
#define PH_END(k) } SEAM(k);
    for (int u = fresh_tid(); u < 64; u += NTHREADS) ((LAS unsigned*)(lds3 + MISC_OFF))[u] = 0u;
    __syncthreads();
    XcdBarrier bar = xcd_barrier_post((unsigned*)(ws + WS_BAR), (volatile LAS unsigned*)(lds3 + MISC_OFF) + 8);

    PH_BEGIN(0) { WIDS(); p0_prologue(a, lds3, gw, NGW, wave, lane); } PH_END(0)
    PH_BEGIN(1) {
        pg8::Gemm g{(const bf16_t*)(ws + WS_HN), (const bf16_t*)(ws + WS_WINT), DM, DM, DM}; pg8::StaticOrder S; S.init(M, IN_PAD, G, bx);
        pg8::EpiProj E{(bf16_t*)(ws + WS_PDA), (bf16_t*)((unsigned char*)a.out + DO_PRW), (bf16_t*)(ws + WS_GATES)};
        pg8::gemm_phase<pg8::EpiProj, pg8::StaticOrder, true, true>(lds3, g, S, E);
        if (G == 256 && bx >= 128) { WIDS(); expert_convert(a, lds3, (bx - 128) * NWAVES + wave, 128 * NWAVES, wave, lane, 2 * 16384, 3 * 16384); }
        else if (G != 256) { WIDS(); expert_convert(a, lds3, gw, NGW, wave, lane, 2 * 16384, 3 * 16384); }
    } PH_END(1)
    PH_BEGIN(2) { WIDS(); p2_prep(a, gw, NGW, lane); } PH_END(2)
    PH_BEGIN(3) {
        const bf16_t* LIN = (const bf16_t*)((unsigned char*)a.out + DO_LIN);
        { pg8::Gemm g{LIN, (const bf16_t*)(ws + WS_BTL1), 512, 256, 256}; pg8::StaticOrder S; S.init(M, 4096, G, bx);
          pg8::EpiLora<0> E{(bf16_t*)(ws + WS_LORA), (const float*)(ws + WS_BIAS4)};
          pg8::gemm_phase<pg8::EpiLora<0>, pg8::StaticOrder, true, true>(lds3, g, S, E); }
        { pg8::Gemm g{LIN + 256, (const bf16_t*)(ws + WS_BTL2), 512, 256, 256}; pg8::StaticOrder S; S.init(M, 1024, G, bx);
          pg8::EpiLora<1> E{(bf16_t*)(ws + WS_LORA), nullptr};
          pg8::gemm_phase<pg8::EpiLora<1>, pg8::StaticOrder, true, true>(lds3, g, S, E); }
    } PH_END(3)
    PH_BEGIN(4) { WIDS();
        const float* sm = (const float*)(ws + WS_SMALL); const float d1 = wave_sum(sm[SM_LQ1 + lane] * sm[SM_LK1 + lane]), d2 = wave_sum(sm[SM_LQ2 + lane] * sm[SM_LK2 + lane]);
        const float lam = __expf(d1) - __expf(d2) + LAM_INIT;
        const bf16_t* PDA = (const bf16_t*)(ws + WS_PDA); bf16_t* YA = (bf16_t*)((unsigned char*)a.out + DO_YAB);
        if (G == 256) {
            int u0, nu;
            if (bx < 128) { scan::scan_phase(a, lds); __syncthreads(); const int i = (bx & 7) * 16 + (bx >> 3); u0 = 768 + 2 * i; nu = 2; }
            else { const int k = bx - 128, i = (k & 7) * 16 + (k >> 3); u0 = 6 * i; nu = 6; }
            for (int q = 0; q < nu; ++q) { const int u = u0 + q; const int bh = u >> 5, qb = u & 31, b = bh >> 3, h = bh & 7;
                const size_t row0 = (size_t)b * SEQ;
                attn::attn_unit(PDA + (row0 + qb * 128) * 3072 + h * 128, PDA + row0 * 3072 + 1024 + h * 128, PDA + row0 * 3072 + 2048 + h * 128,
                                YA + (row0 + qb * 128) * 2048 + h * 128, lam, sm + SM_SUBLN, SEQ, (char*)lds); }
        } else {
        const int upb = 1024 / G;
        for (int i = 0; i < upb; ++i) { const int u = vcu * upb + i; const int bh = u >> 5, qb = u & 31, b = bh >> 3, h = bh & 7;
            const size_t row0 = (size_t)b * SEQ;
            attn::attn_unit(PDA + (row0 + qb * 128) * 3072 + h * 128, PDA + row0 * 3072 + 1024 + h * 128, PDA + row0 * 3072 + 2048 + h * 128,
                            YA + (row0 + qb * 128) * 2048 + h * 128, lam, sm + SM_SUBLN, SEQ, (char*)lds); }
        }
    } PH_END(4)
    if (G != 256) { PH_BEGIN(5) { scan::scan_phase(a, lds); } PH_END(5) }
    PH_BEGIN(6) { WIDS(); p6_rwpost(a, gw, NGW, lane); } PH_END(6)
    PH_BEGIN(7) {
        bf16_t* MG = (bf16_t*)(ws + WS_MERGED); const bf16_t* GT = (const bf16_t*)(ws + WS_GATES);
        { pg8::Gemm g{(const bf16_t*)((unsigned char*)a.out + DO_YAB), (const bf16_t*)(ws + WS_WAT), DM, DM, DM}; pg8::StaticOrder S; S.init(M, DM, G, bx);
          pg8::EpiMergeF E{MG, GT}; pg8::gemm_phase<pg8::EpiMergeF, pg8::StaticOrder, true, true>(lds3, g, S, E); }
    } PH_END(7)
    PH_BEGIN(8) {
        pg8::Gemm g{(const bf16_t*)(ws + WS_MERGED), (const bf16_t*)(ws + WS_WOT), DM, DM, DM}; pg8::StaticOrder S; S.init(M, DM, G, bx);
        pg8::EpiOut E{a.in[I_X], a.out, (float*)(ws + WS_SSP)};
        pg8::gemm_phase<pg8::EpiOut, pg8::StaticOrder, true, true>(lds3, g, S, E);
    } PH_END(8)
    PH_BEGIN(9) { WIDS(); p9_router(a, lds3, gw, NGW, wave, lane); } PH_END(9)
    PH_BEGIN(10) { p10_topk(a, lds); } PH_END(10)
    if (G != 256) { PH_BEGIN(11) { WIDS(); p11_gather(a, gw, NGW, lane); } PH_END(11) }
    PH_BEGIN(12) {
        pg8::EpiMoeUp E{(bf16_t*)(ws + WS_HID)};
        if (G == 256) {
            pg8::Gemm g{(const bf16_t*)(ws + WS_HN2), (const bf16_t*)(ws + WS_W1T), DM, DM, DM}; pg8::ExpertGatherOrder S{G, bx, (const int*)(ws + WS_SELTOK)};
            pg8::gemm_phase_g<pg8::EpiMoeUp, pg8::ExpertGatherOrder, true, true>(lds3, g, S, E);
        } else {
            pg8::Gemm g{(const bf16_t*)(ws + WS_XE), (const bf16_t*)(ws + WS_W1T), DM, DM, DM}; pg8::ExpertOrder S{G, bx};
            pg8::gemm_phase<pg8::EpiMoeUp, pg8::ExpertOrder, true, true>(lds3, g, S, E);
        }
    } PH_END(12)
    PH_BEGIN(13) {
        pg8::Gemm g{(const bf16_t*)(ws + WS_HID), (const bf16_t*)(ws + WS_WDT), FF, FF, FF}; pg8::ExpertOrder S{G, bx};
        pg8::EpiMoeDown E{(bf16_t*)(ws + WS_XE), (const float*)(ws + WS_SELGATE)};
        pg8::gemm_phase<pg8::EpiMoeDown, pg8::ExpertOrder, true, true>(lds3, g, S, E);
    } PH_END(13)
    PH_BEGIN(14) { WIDS(); p14_combine(a, lds, wave, lane); } }
#undef IN
#undef SEAM
}

constexpr int NPHASES = 15;
#ifndef MK_SPLIT
#define MK_SPLIT 0
#endif
extern "C" void kernel_launch(void* const* d_in, const int* in_sizes, int n_in, void* d_out, int out_size, void* d_ws, size_t ws_size, hipStream_t stream) {
    static int grid = 0;
    if (grid == 0) {
        if (n_in != 33 || in_sizes[0] != M * DM || out_size != M * DM || ws_size < WS_NEED) {
            fprintf(stderr, "kernel_launch: unexpected shapes: n_in %d in0 %d out %d ws %zu (need %zu)\n", n_in, n_in > 0 ? in_sizes[0] : -1, out_size, ws_size, (size_t)WS_NEED); grid = -1; return; }
        int dev = 0, cus = 0, per_cu = 0;
        if (hipGetDevice(&dev) != hipSuccess || hipDeviceGetAttribute(&cus, hipDeviceAttributeMultiprocessorCount, dev) != hipSuccess) { grid = -1; return; }
        if (hipFuncSetAttribute((const void*)mega_fwd, hipFuncAttributeMaxDynamicSharedMemorySize, LDS_BYTES) != hipSuccess) { fprintf(stderr, "kernel_launch: hipFuncSetAttribute failed\n"); grid = -1; return; }
        if (hipOccupancyMaxActiveBlocksPerMultiprocessor(&per_cu, (const void*)mega_fwd, NTHREADS, LDS_BYTES) != hipSuccess || per_cu < 1) { fprintf(stderr, "kernel_launch: occupancy query says %d\n", per_cu); (void)hipGetLastError(); per_cu = 1; }
        grid = cus;
        if (grid != 256) fprintf(stderr, "kernel_launch: note: %d CUs (tuned for 256)\n", grid);
    }
    if (grid < 0) return;
    if (hipMemsetAsync((char*)d_ws + WS_BAR, 0, 16384, stream) != hipSuccess) { fprintf(stderr, "kernel_launch: memset failed\n"); return; }
    Args a{};
    for (int i = 0; i < 33; ++i) a.in[i] = (const float*)d_in[i];
    a.out = (float*)d_out; a.ws = (unsigned char*)d_ws;
#if MK_SPLIT
    for (int p = 0; p < NPHASES; ++p) { a.ph_lo = p; a.ph_hi = p + 1; void* args[] = {&a};
        hipError_t e = hipLaunchCooperativeKernel((const void*)mega_fwd, dim3(grid), dim3(NTHREADS), args, LDS_BYTES, stream);
        if (e != hipSuccess) { fprintf(stderr, "kernel_launch: launch of phase %d failed: %s\n", p, hipGetErrorString(e)); return; } }
#else
    a.ph_lo = 0; a.ph_hi = NPHASES; void* args[] = {&a};
    hipError_t e = hipLaunchCooperativeKernel((const void*)mega_fwd, dim3(grid), dim3(NTHREADS), args, LDS_BYTES, stream);
    if (e != hipSuccess) fprintf(stderr, "kernel_launch: cooperative launch failed: %s (grid %d)\n", hipGetErrorString(e), grid);
#endif
}
```

```cpp
#include <hip/hip_runtime.h>
#include <hip/hip_cooperative_groups.h>
#include <cstdio>
#include <cstdint>
namespace cg = cooperative_groups;

constexpr int NB = 4, SEQ = 4096, M = NB * SEQ, DM = 2048;
constexpr int DA_COLS = 3072, RW_COLS = 3488, RW_PAD = 3584, GATE_COLS = 4096, IN_COLS = 10656, IN_PAD = 10752;
constexpr int NE = 16, FF = 1024, CAP = 512, NSLOT = NB * NE * CAP;
constexpr float RMS_EPS = 1e-6f, GN_EPS = 64e-5f, LAM_INIT = 0.2f;
constexpr int NWAVES = 8, NTHREADS = 512;

constexpr size_t MiB = 1u << 20;
constexpr size_t WS_SSP = 5 * MiB;
constexpr size_t WS_SELTOK = 128 * 1024;
constexpr size_t WS_SELGATE = 256 * 1024;
constexpr size_t WS_BIAS4 = 512 * 1024;
constexpr size_t WS_SMALL = 576 * 1024;
constexpr int SM_QNG = 0, SM_KNG = 64, SM_LQ1 = 128, SM_LK1 = 192, SM_LQ2 = 256, SM_LK2 = 320, SM_SUBLN = 384, SM_MU = 512, SM_KK = 4096, SM_KA = 5120, SM_RK = 6144,
              SM_LNW = 7168, SM_LNB = 8192, SM_FNG = 9216, SM_WR = 11264, SM_END = 44032;
constexpr size_t WS_BAR = 768 * 1024;
constexpr size_t WS_INRM = 1 * MiB;
constexpr size_t WS_AFF = 1 * MiB;
constexpr size_t WS_ROPE = 7 * MiB;
constexpr size_t WS_BTL1 = 2 * MiB;
constexpr size_t WS_BTL2 = 4 * MiB;
constexpr size_t WS_WAT = 8 * MiB, WS_WBT = 12 * MiB, WS_WOT = 16 * MiB;
constexpr size_t WS_HN = 24 * MiB;
constexpr size_t WS_RKV = 24 * MiB;
constexpr size_t WS_WINT = 88 * MiB;
constexpr size_t WS_PDA = 130 * MiB;
constexpr size_t WS_MERGED = 130 * MiB;
constexpr size_t WS_GATES = 226 * MiB;
constexpr size_t WS_LORA = 354 * MiB;
constexpr size_t WS_END1 = 546 * MiB;
constexpr size_t WS_W1T = 24 * MiB;
__host__ __device__ __forceinline__ size_t w1t_base(int e) { return e < 4 ? (514 + 8 * (size_t)e) * MiB : e < 6 ? (610 + 8 * (size_t)(e - 4)) * MiB : e == 6 ? 120 * MiB : WS_W1T + 8 * (size_t)(e - 7) * MiB; }
constexpr int N_EARLY_EXPERTS = 7;
constexpr size_t WS_WDT = 546 * MiB;
constexpr size_t WS_XE = 216 * MiB;
constexpr size_t WS_HN2 = 216 * MiB;
constexpr size_t WS_HID = 344 * MiB;
constexpr size_t WS_NEED = 626 * MiB;
constexpr size_t DO_PRW = 0, DO_LIN = 112 * MiB, DO_YSF = 0, DO_YSB = 32 * MiB, DO_YAB = 64 * MiB;

constexpr int MISC_OFF = 143360;
constexpr int LDS_BYTES = 147456;

#define LAS __attribute__((address_space(3)))
typedef unsigned short bf16_t;
typedef unsigned v4u __attribute__((ext_vector_type(4)));
typedef unsigned v2u __attribute__((ext_vector_type(2)));

__device__ __forceinline__ int fresh_tid() { int t = threadIdx.x; asm volatile("" : "+v"(t)); return t; }
__device__ __forceinline__ float bf2f(unsigned short b) { return __builtin_bit_cast(float, (unsigned)b << 16); }
__device__ __forceinline__ float bflo(unsigned w) { return __builtin_bit_cast(float, w << 16); }
__device__ __forceinline__ float bfhi(unsigned w) { return __builtin_bit_cast(float, w & 0xffff0000u); }
__device__ __forceinline__ unsigned f2bf(float f) { unsigned u = __builtin_bit_cast(unsigned, f); return (u + 0x7fffu + ((u >> 16) & 1u)) >> 16; }
typedef float f32x2_t __attribute__((ext_vector_type(2))); typedef __bf16 bf16x2_t __attribute__((ext_vector_type(2)));
__device__ __forceinline__ unsigned pk2(float lo, float hi) { f32x2_t v = {lo, hi}; bf16x2_t b = __builtin_convertvector(v, bf16x2_t); return __builtin_bit_cast(unsigned, b); }
__device__ __forceinline__ float sigmoidf_(float x) { return __builtin_amdgcn_rcpf(1.0f + __expf(-x)); }
__device__ __forceinline__ float wave_sum(float v) {
#pragma unroll
    for (int o = 1; o < 64; o <<= 1) v += __shfl_xor(v, o);
    return v;
}
__device__ __forceinline__ float sum8(float v) { v += __shfl_xor(v, 1); v += __shfl_xor(v, 2); v += __shfl_xor(v, 4); return v; }
__device__ __forceinline__ void unpack8(const v4u& w, float (&f)[8]) {
    f[0] = bflo(w.x); f[1] = bfhi(w.x); f[2] = bflo(w.y); f[3] = bfhi(w.y); f[4] = bflo(w.z); f[5] = bfhi(w.z); f[6] = bflo(w.w); f[7] = bfhi(w.w);
}
__device__ __forceinline__ v4u pack8(const float (&f)[8]) { v4u w; w.x = pk2(f[0], f[1]); w.y = pk2(f[2], f[3]); w.z = pk2(f[4], f[5]); w.w = pk2(f[6], f[7]); return w; }

#define XB_TMO      128
#define XB_XCNT(j)  (256  + 64 * (j))
#define XB_XSUB(j)  (1280 + 64 * (j))
#define XB_XGEN(j)  (2304 + 64 * (j))
#define XB_TOP      3328
#define XB_TOPGEN   3392
#define XCD_BAR_WORDS 3456
#define XB_SPIN_CAP (1u << 18)

__device__ __forceinline__ unsigned xb_ld(unsigned* p)              { return __hip_atomic_load(p, __ATOMIC_RELAXED, __HIP_MEMORY_SCOPE_AGENT); }
__device__ __forceinline__ unsigned xb_add(unsigned* p, unsigned v) { return __hip_atomic_fetch_add(p, v, __ATOMIC_RELAXED, __HIP_MEMORY_SCOPE_AGENT); }
__device__ __forceinline__ unsigned xb_xcc_id() { return (unsigned)__builtin_amdgcn_s_getreg((3 << 11) | 20) & 0xFu; }
#define XB_SPIN(cond, bar) do { unsigned _sp = 0; while (cond) { __builtin_amdgcn_s_sleep(1); \
    if ((++_sp & 255u) == 0u) { if (xb_ld(&(bar)[XB_TMO])) break; if (_sp > XB_SPIN_CAP) { atomicAdd(&(bar)[XB_TMO], 1u); break; } } } } while (0)

struct XcdBarrier {
    unsigned* bar; unsigned x;
    volatile LAS unsigned* st;
};

__device__ __forceinline__ XcdBarrier xcd_barrier_post(unsigned* bar, volatile LAS unsigned* st) {
    XcdBarrier b; b.bar = bar; b.x = xb_xcc_id(); b.st = st;
    if (threadIdx.x == 0) (void)xb_add(&bar[XB_XCNT(b.x)], 1u);
    return b;
}
__device__ __forceinline__ void xcd_barrier_complete(unsigned* bar, unsigned x, unsigned& nloc, unsigned& nx) {
    const unsigned G = gridDim.x * gridDim.y * gridDim.z;
    unsigned sum, cnt, mine, sp = 0u;
    for (;;) {
        sum = 0u; cnt = 0u; mine = 0u;
#pragma unroll
        for (unsigned j = 0; j < 16; ++j) { const unsigned c = xb_ld(&bar[XB_XCNT(j)]); sum += c; cnt += (c > 0u) ? 1u : 0u; mine = (j == x) ? c : mine; }
        if (sum == G) break;
        __builtin_amdgcn_s_sleep(1);
        if ((++sp & 255u) == 0u) { if (xb_ld(&bar[XB_TMO])) break; if (sp > XB_SPIN_CAP) { atomicAdd(&bar[XB_TMO], 1u); break; } }
    }
    nloc = mine > 0u ? mine : 1u; nx = cnt > 0u ? cnt : 1u;
}

__device__ __forceinline__ void xcd_barrier(const XcdBarrier& b) {
    asm volatile("s_waitcnt vmcnt(0)" ::: "memory");
    __syncthreads();
    if (threadIdx.x == 0) {
        unsigned* bar = b.bar;
        __builtin_amdgcn_s_waitcnt(0);
        unsigned nloc = b.st[0], nx = b.st[1];
        if (nloc == 0u) { xcd_barrier_complete(bar, b.x, nloc, nx); b.st[0] = nloc; b.st[1] = nx; }
        const unsigned old = xb_add(&bar[XB_XSUB(b.x)], 1u);
        const unsigned gen = old / nloc;
        if (old + 1u == (gen + 1u) * nloc) {
            __builtin_amdgcn_fence(__ATOMIC_RELEASE, "agent");
            asm volatile("s_waitcnt vmcnt(0)" ::: "memory");
            const unsigned og = xb_add(&bar[XB_TOP], 1u);
            const unsigned tg = og / nx;
            if (og + 1u == (tg + 1u) * nx) xb_add(&bar[XB_TOPGEN], 1u);
            else XB_SPIN(xb_ld(&bar[XB_TOPGEN]) == tg, bar);
            __builtin_amdgcn_fence(__ATOMIC_ACQUIRE, "agent");
            xb_add(&bar[XB_XGEN(b.x)], 1u);
            asm volatile("s_waitcnt vmcnt(0)" ::: "memory");
        } else {
            XB_SPIN(xb_ld(&bar[XB_XGEN(b.x)]) == gen, bar);
            __builtin_amdgcn_fence(__ATOMIC_ACQUIRE, "agent");
            asm volatile("s_waitcnt vmcnt(0)" ::: "memory");
        }
    }
    __syncthreads();
}
namespace pg8 {
#define PG8_LAS __attribute__((address_space(3)))
typedef unsigned short bf16_t;
typedef short bf16x8 __attribute__((ext_vector_type(8)));
typedef float f32x4 __attribute__((ext_vector_type(4)));
typedef unsigned u32x4 __attribute__((ext_vector_type(4)));
constexpr int BM = 256, BK = 64, HALF = 128, HTB = HALF * BK * 2  , STAGE_BYTES = 8 * HTB, NXCD = 8, WGM = 4;

__host__ __device__ __forceinline__ int lds_byte(int r, int c) { const int st = (r >> 4) * 2 + (c >> 5), rr = r & 15, cc = c & 31, ob = rr * 64 + cc * 2; return st * 1024 + (ob ^ (((ob >> 9) & 1) << 5)); }
__host__ __device__ __forceinline__ void stage_rc(int b, int& R, int& C) { const int st = b / 1024, sb = b % 1024, swz = sb ^ (((sb >> 9) & 1) << 5); R = (st >> 1) * 16 + swz / 64; C = (st & 1) * 32 + (swz % 64) / 2; }
__host__ __device__ __forceinline__ int perm32(int rho) { const int n = rho >> 4, i = rho & 15; return 8 * (i >> 2) + 4 * n + (i & 3); }

struct Unit { int pm, pn; };
struct Gemm { const bf16_t* A; const bf16_t* Bt; int lda, ldb, K; };

struct StaticOrder {
    int nM, nN, nwg, G, c;
    __host__ __device__ void init(int M, int N, int G_, int c_) { nM = M / BM; nN = N / BM; nwg = nM * nN; G = G_; c = c_; }
    __host__ __device__ bool next(int i, Unit& u) const {
        const long L = (long)i * G + c; if (L >= nwg) return false;
        int wgid = (int)L; { const int q = nwg / NXCD, r = nwg % NXCD, xcd = wgid % NXCD, off = wgid / NXCD; wgid = (xcd < r ? xcd * (q + 1) : r * (q + 1) + (xcd - r) * q) + off; }
        const int nig = WGM * nN, gid = wgid / nig, fm = gid * WGM, gsz = (nM - fm) < WGM ? (nM - fm) : WGM;
        u.pm = fm + ((wgid % nig) % gsz); u.pn = (wgid % nig) / gsz; return true;
    }
    __device__ __forceinline__ void a_ready(const Unit&) const {}
    __device__ __forceinline__ void done(const Unit&) const {}
};

__device__ __forceinline__ unsigned cvt_pk_bf16(float lo, float hi) { return pk2(lo, hi); }
__device__ __forceinline__ u32x4 pack_bf16x8(const f32x4& v0, const f32x4& v1) { u32x4 w; w.x = cvt_pk_bf16(v0[0], v0[1]); w.y = cvt_pk_bf16(v0[2], v0[3]); w.z = cvt_pk_bf16(v1[0], v1[1]); w.w = cvt_pk_bf16(v1[2], v1[3]); return w; }
__device__ __forceinline__ float sigm(float x) { return __builtin_amdgcn_rcpf(1.0f + __expf(-x)); }
__device__ __forceinline__ f32x4 sigm4(f32x4 v) { return (f32x4){sigm(v[0]), sigm(v[1]), sigm(v[2]), sigm(v[3])}; }
__device__ __forceinline__ void unpk8(const u32x4& w, f32x4& a, f32x4& b) {
    a = (f32x4){__builtin_bit_cast(float, w.x << 16), __builtin_bit_cast(float, w.x & 0xffff0000u), __builtin_bit_cast(float, w.y << 16), __builtin_bit_cast(float, w.y & 0xffff0000u)};
    b = (f32x4){__builtin_bit_cast(float, w.z << 16), __builtin_bit_cast(float, w.z & 0xffff0000u), __builtin_bit_cast(float, w.w << 16), __builtin_bit_cast(float, w.w & 0xffff0000u)};
}

struct EpiProj {
    static constexpr bool PERM = true, AFTER_DRAIN = false, HAS_MID = false;
    bf16_t* pda; bf16_t* prw; bf16_t* gates;
    __device__ __forceinline__ void operator()(const f32x4 (&acc)[2][2][4][2], const Unit& u, int wr, int wc, int fr, int fq) const {
        const int row0 = u.pm * BM + wr * 64 + fr;
        if (u.pn >= 26) {
            const int col0 = (u.pn - 26) * 128 + wc * 32 + 8 * fq;
#pragma unroll
            for (int ai = 0; ai < 2; ++ai)
#pragma unroll
                for (int m = 0; m < 4; ++m) { bf16_t* rowp = gates + (size_t)(row0 + ai * HALF + m * 16) * 4096 + col0;
                    f32x4 rt[2], gb[2];
#pragma unroll
                    for (int n = 0; n < 2; ++n)
#pragma unroll
                        for (int e = 0; e < 4; ++e) { const float ea = __expf(-acc[ai][0][m][n][e]), eb = __expf(-acc[ai][1][m][n][e]);
                            gb[n][e] = __builtin_amdgcn_rcpf(1.0f + eb); rt[n][e] = (1.0f + eb) * __builtin_amdgcn_rcpf(1.0f + ea); }
                    *(u32x4*)rowp = pack_bf16x8(rt[0], rt[1]); *(u32x4*)(rowp + 2048) = pack_bf16x8(gb[0], gb[1]); }
            return;
        }
        bf16_t* base; int ldc, colt;
        if (u.pn < 12) { base = pda; ldc = 3072; colt = u.pn * 256; }
        else { base = prw; ldc = 3584; colt = (u.pn - 12) * 256; }
        const int col0 = colt + wc * 32 + 8 * fq;
#pragma unroll
        for (int ai = 0; ai < 2; ++ai)
#pragma unroll
            for (int m = 0; m < 4; ++m) { bf16_t* rowp = base + (size_t)(row0 + ai * HALF + m * 16) * ldc + col0;
#pragma unroll
                for (int bj = 0; bj < 2; ++bj) *(u32x4*)(rowp + bj * HALF) = pack_bf16x8(acc[ai][bj][m][0], acc[ai][bj][m][1]); }
    }
};
template <int KIND> struct EpiLora {
    static constexpr bool PERM = true, AFTER_DRAIN = false, HAS_MID = false;
    bf16_t* out; const float* bias4;
    __device__ __forceinline__ void operator()(const f32x4 (&acc)[2][2][4][2], const Unit& u, int wr, int wc, int fr, int fq) const {
        const int seg = (KIND == 0) ? (u.pn >> 2) : 4, colt = (KIND == 0) ? (u.pn & 3) * 256 : u.pn * 256;
        bf16_t* base = out + (size_t)seg * ((size_t)M * 1024);
        const float* bias = bias4 + (seg & 3) * 1024;
        const int row0 = u.pm * BM + wr * 64 + fr, col0 = colt + wc * 32 + 8 * fq;
        const float sc = (seg < 2) ? -0.60653065971f : 1.0f;
#pragma unroll
        for (int bj = 0; bj < 2; ++bj) {
            f32x4 bv0 = (f32x4){0.f, 0.f, 0.f, 0.f}, bv1 = bv0;
            if (KIND == 0) { bv0 = *(const f32x4*)(bias + col0 + bj * HALF); bv1 = *(const f32x4*)(bias + col0 + bj * HALF + 4); }
#pragma unroll
            for (int ai = 0; ai < 2; ++ai)
#pragma unroll
                for (int m = 0; m < 4; ++m) { bf16_t* rowp = base + (size_t)(row0 + ai * HALF + m * 16) * 1024 + col0;
                    f32x4 v0 = acc[ai][bj][m][0] + bv0, v1 = acc[ai][bj][m][1] + bv1;
                    if (KIND == 0) { v0 = sigm4(v0) * sc; v1 = sigm4(v1) * sc; }
                    *(u32x4*)(rowp + bj * HALF) = pack_bf16x8(v0, v1); }
        }
    }
};
struct EpiMergeF {
    static constexpr bool PERM = true, AFTER_DRAIN = false, HAS_MID = true;
    bf16_t* merged; const bf16_t* gates;
    template <int HALFSEL> __device__ __forceinline__ void scale(f32x4 (&acc)[2][2][4][2], const Unit& u, int wr, int wc, int fr, int fq, bool store) const {
        int row0 = u.pm * BM + wr * 64 + fr, col0 = u.pn * 256 + wc * 32 + 8 * fq;
        asm volatile("" : "+v"(row0), "+v"(col0));
#pragma unroll
        for (int ai = 0; ai < 2; ++ai)
#pragma unroll
            for (int mh = 0; mh < 2; ++mh) {
                u32x4 gw[2][2];
#pragma unroll
                for (int mm = 0; mm < 2; ++mm)
#pragma unroll
                    for (int bj = 0; bj < 2; ++bj) gw[mm][bj] = *(const u32x4*)(gates + (size_t)(row0 + ai * HALF + (2 * mh + mm) * 16) * 4096 + HALFSEL * 2048 + col0 + bj * HALF);
#pragma unroll
                for (int mm = 0; mm < 2; ++mm)
#pragma unroll
                    for (int bj = 0; bj < 2; ++bj) { const int m = 2 * mh + mm; f32x4 g0, g1; unpk8(gw[mm][bj], g0, g1);
                        acc[ai][bj][m][0] *= g0; acc[ai][bj][m][1] *= g1;
                        if (store) *(u32x4*)(merged + (size_t)(row0 + ai * HALF + m * 16) * 2048 + col0 + bj * HALF) = pack_bf16x8(acc[ai][bj][m][0], acc[ai][bj][m][1]); }
                asm volatile("" ::: "memory");
            }
    }
    __device__ __forceinline__ void mid(f32x4 (&acc)[2][2][4][2], const Unit& u, int wr, int wc, int fr, int fq) const { scale<0>(acc, u, wr, wc, fr, fq, false); }
    __device__ __forceinline__ void operator()(const f32x4 (&acc)[2][2][4][2], const Unit& u, int wr, int wc, int fr, int fq) const {
        f32x4 (&ac)[2][2][4][2] = const_cast<f32x4 (&)[2][2][4][2]>(acc); scale<1>(ac, u, wr, wc, fr, fq, true); }
};
struct EpiOut {
    static constexpr bool PERM = false, AFTER_DRAIN = false, HAS_MID = false;
    const float* x; float* out; float* ss;
    __device__ __forceinline__ void operator()(const f32x4 (&acc)[2][2][4][2], const Unit& u, int wr, int wc, int fr, int fq) const {
        const int row0 = u.pm * BM + wr * 64 + fr, col0 = u.pn * 256 + wc * 32 + 4 * fq;
#pragma unroll
        for (int ai = 0; ai < 2; ++ai) {
            f32x4 xv[4][2][2];
#pragma unroll
            for (int m = 0; m < 4; ++m)
#pragma unroll
                for (int bj = 0; bj < 2; ++bj)
#pragma unroll
                    for (int n = 0; n < 2; ++n) xv[m][bj][n] = *(const f32x4*)(x + (size_t)(row0 + ai * HALF + m * 16) * 2048 + col0 + bj * HALF + n * 16);
#pragma unroll
            for (int m = 0; m < 4; ++m) { const size_t r = (size_t)(row0 + ai * HALF + m * 16); float s = 0.f;
#pragma unroll
                for (int bj = 0; bj < 2; ++bj)
#pragma unroll
                    for (int n = 0; n < 2; ++n) { const f32x4 h = xv[m][bj][n] + acc[ai][bj][m][n]; *(f32x4*)(out + r * 2048 + col0 + bj * HALF + n * 16) = h;
                        s += (h[0] * h[0] + h[1] * h[1]) + (h[2] * h[2] + h[3] * h[3]); }
                s += __shfl_xor(s, 16); s += __shfl_xor(s, 32);
                if (fq == 0) ss[r * 32 + u.pn * 4 + wc] = s; }
        }
    }
};
struct EpiMoeUp {
    static constexpr bool PERM = true, AFTER_DRAIN = false, HAS_MID = false;
    bf16_t* hid;
    __device__ __forceinline__ void operator()(const f32x4 (&acc)[2][2][4][2], const Unit& u, int wr, int wc, int fr, int fq) const {
        const int row0 = u.pm * BM + wr * 64 + fr, col0 = (u.pn & 7) * 128 + wc * 32 + 8 * fq;
#pragma unroll
        for (int ai = 0; ai < 2; ++ai)
#pragma unroll
            for (int m = 0; m < 4; ++m) { bf16_t* rowp = hid + (size_t)(row0 + ai * HALF + m * 16) * 1024 + col0;
                const f32x4 g0 = acc[ai][0][m][0], g1 = acc[ai][0][m][1], u0 = acc[ai][1][m][0], u1 = acc[ai][1][m][1];
                const f32x4 v0 = g0 * sigm4(g0) * u0, v1 = g1 * sigm4(g1) * u1;
                *(u32x4*)rowp = pack_bf16x8(v0, v1); }
    }
};
struct EpiMoeDown {
    static constexpr bool PERM = true, AFTER_DRAIN = false, HAS_MID = false;
    bf16_t* ye; const float* selgate;
    __device__ __forceinline__ void operator()(const f32x4 (&acc)[2][2][4][2], const Unit& u, int wr, int wc, int fr, int fq) const {
        const int row0 = u.pm * BM + wr * 64 + fr, col0 = (u.pn & 7) * 256 + wc * 32 + 8 * fq;
#pragma unroll
        for (int ai = 0; ai < 2; ++ai)
#pragma unroll
            for (int m = 0; m < 4; ++m) { const int r = row0 + ai * HALF + m * 16; const int e = r >> 11, b = (r >> 9) & 3, c = r & 511;
                const float g = selgate[(b * 16 + e) * 512 + c];
                bf16_t* rowp = ye + (size_t)r * 2048 + col0;
#pragma unroll
                for (int bj = 0; bj < 2; ++bj) *(u32x4*)(rowp + bj * HALF) = pack_bf16x8(acc[ai][bj][m][0] * g, acc[ai][bj][m][1] * g); }
    }
};
struct ExpertOrder {
    int G, c;
    __device__ __forceinline__ bool next(int i, Unit& u) const {
        const int L = i * G + c; if (L >= 1024) return false;
        const int wgid = (L % NXCD) * (1024 / NXCD) + L / NXCD;
        const int e = wgid >> 6, r = wgid & 63; u.pm = e * 8 + (r & 3) + 4 * ((r >> 5) & 1); u.pn = e * 8 + ((r >> 2) & 7); return true;
    }
    __device__ __forceinline__ void a_ready(const Unit&) const {}
    __device__ __forceinline__ void done(const Unit&) const {}
};

struct ExpertGatherOrder {
    int G, c; const int* seltok;
    __device__ __forceinline__ bool next(int i, Unit& u) const {
        const int L = i * G + c; if (L >= 1024) return false;
        const int wgid = (L % NXCD) * (1024 / NXCD) + L / NXCD;
        const int e = wgid >> 6, r = wgid & 63; u.pm = e * 8 + (r & 3) + 4 * ((r >> 5) & 1); u.pn = e * 8 + ((r >> 2) & 7); return true;
    }
    __device__ __forceinline__ int arow(int r) const { const int e = r >> 11, b = (r >> 9) & 3, cc = r & 511; return b * 4096 + seltok[(b * 16 + e) * 512 + cc]; }
    __device__ __forceinline__ size_t boff(const Unit& u) const { return w1t_base(u.pn >> 3) + (size_t)(u.pn & 7) * (256 * 2048 * 2); }
    __device__ __forceinline__ void a_ready(const Unit&) const {}
    __device__ __forceinline__ void done(const Unit&) const {}
};
template <class Epi, class Sched, bool ALIGN_EPI = false, bool SP2 = false>
__device__ __forceinline__ void gemm_phase(PG8_LAS unsigned char* lds, const Gemm g, const Sched& S, const Epi& E) {
    const int tid = fresh_tid(), wid = __builtin_amdgcn_readfirstlane(tid >> 6), lane = tid & 63, wr = wid >> 2, wc = wid & 3, fr = lane & 15, fq = lane >> 4;
    const int K = g.K, nt = K / BK;
    unsigned voffA[2], voffB[2];
#pragma unroll
    for (int i = 0; i < 2; ++i) { int R, C; stage_rc(tid * 16 + i * 8192, R, C); const int Rb = Epi::PERM ? ((R & ~31) + perm32(R & 31)) : R;
        voffA[i] = (unsigned)(R * g.lda + C) * 2u; voffB[i] = (unsigned)(Rb * g.ldb + C) * 2u; }
    const size_t kstep = (size_t)(BK * 2);
    const size_t hsA = (size_t)HALF * g.lda * 2, hsB = (size_t)HALF * g.ldb * 2;
    const size_t tsA = 2 * hsA, tsB = 2 * hsB;
    const unsigned ldsw = (unsigned)wid * 1024u;
    const int aoff = lds_byte(wr * 64 + fr, fq * 8), boff = lds_byte(wc * 32 + fr, fq * 8);
#define PG8_SA(b, h) (((b) * 2 + (h)) * HTB)
#define PG8_SB(b, h) ((4 + (b) * 2 + (h)) * HTB)
#define PG8_STAGE(bufoff, gbase, voff) do { _Pragma("unroll") for (int _i = 0; _i < 2; ++_i) \
        __builtin_amdgcn_global_load_lds((const unsigned*)((const char*)(gbase) + (voff)[_i]), (PG8_LAS unsigned*)(lds + (bufoff) + ldsw + _i * 8192), 16, 0, 0); } while (0)
#define PG8_LDA(dst, b, h) do { _Pragma("unroll") for (int m = 0; m < 4; ++m) _Pragma("unroll") for (int k = 0; k < 2; ++k) dst[m][k] = *(const PG8_LAS bf16x8*)(lds + PG8_SA(b, h) + aoff + m * 2048 + k * 1024); } while (0)
#define PG8_LDB(dst, b, h) do { _Pragma("unroll") for (int n = 0; n < 2; ++n) _Pragma("unroll") for (int k = 0; k < 2; ++k) dst[n][k] = *(const PG8_LAS bf16x8*)(lds + PG8_SB(b, h) + boff + n * 2048 + k * 1024); } while (0)
#define PG8_MMA(ai, bj, At, Bt) do { __builtin_amdgcn_s_setprio(1); _Pragma("unroll") for (int m = 0; m < 4; ++m) _Pragma("unroll") for (int n = 0; n < 2; ++n) _Pragma("unroll") for (int k = 0; k < 2; ++k) \
        acc[ai][bj][m][n] = __builtin_amdgcn_mfma_f32_16x16x32_bf16(Bt[n][k], At[m][k], acc[ai][bj][m][n], 0, 0, 0); __builtin_amdgcn_s_setprio(0); } while (0)
#define PG8_WAIT_V(n) asm volatile("s_waitcnt vmcnt(" #n ")" ::: "memory")
#define PG8_WAIT_L(n) asm volatile("s_waitcnt lgkmcnt(" #n ")" ::: "memory")
#define PG8_BAR __builtin_amdgcn_s_barrier()
#define PG8_SCHED __builtin_amdgcn_sched_barrier(0)
    Unit cur, nxt; int ui = 0;
    if (!S.next(0, cur)) return;
    f32x4 acc[2][2][4][2];
#pragma unroll
    for (int a = 0; a < 2; ++a)
#pragma unroll
        for (int b = 0; b < 2; ++b)
#pragma unroll
            for (int m = 0; m < 4; ++m)
#pragma unroll
                for (int n = 0; n < 2; ++n) acc[a][b][m][n] = (f32x4){0.f, 0.f, 0.f, 0.f};
    bf16x8 At[4][2], B0[2][2], B1[2][2];
    const char* cA = (const char*)g.A + (size_t)cur.pm * tsA; const char* cB = (const char*)g.Bt + (size_t)cur.pn * tsB;
    S.a_ready(cur);
    if constexpr (SP2) {
        PG8_STAGE(PG8_SB(0, 0), cB, voffB); PG8_STAGE(PG8_SB(0, 1), cB + hsB, voffB); PG8_STAGE(PG8_SA(0, 0), cA, voffA); PG8_STAGE(PG8_SA(0, 1), cA + hsA, voffA);
        if (wr == 1) PG8_BAR;
        PG8_WAIT_V(2); PG8_BAR;
        PG8_STAGE(PG8_SB(1, 0), cB + kstep, voffB); PG8_STAGE(PG8_SA(1, 0), cA + kstep, voffA); PG8_STAGE(PG8_SB(1, 1), cB + hsB + kstep, voffB);
        PG8_WAIT_V(6); PG8_BAR;
    } else {
        PG8_STAGE(PG8_SB(0, 0), cB, voffB); PG8_STAGE(PG8_SA(0, 0), cA, voffA); PG8_STAGE(PG8_SB(0, 1), cB + hsB, voffB); PG8_STAGE(PG8_SA(0, 1), cA + hsA, voffA);
        if (wr == 1) PG8_BAR;
        PG8_WAIT_V(4); PG8_BAR;
        PG8_STAGE(PG8_SB(1, 0), cB + kstep, voffB); PG8_STAGE(PG8_SA(1, 0), cA + kstep, voffA); PG8_STAGE(PG8_SB(1, 1), cB + hsB + kstep, voffB);
        PG8_WAIT_V(6); PG8_BAR;
    }
    for (;;) {
        const bool has_next = S.next(ui + 1, nxt);
        const char* nA = has_next ? (const char*)g.A + (size_t)nxt.pm * tsA : cA; const char* nB = has_next ? (const char*)g.Bt + (size_t)nxt.pn * tsB : cB;
#pragma unroll 1
        for (int t = 0; t < nt; t += 2) {
            const bool last = (t == nt - 2);
            const char* a1 = cA + (size_t)(t + 1) * kstep;
            const char* a2 = last ? nA : cA + (size_t)(t + 2) * kstep; const char* b2 = last ? nB : cB + (size_t)(t + 2) * kstep;
            const char* a3 = a2 + kstep; const char* b3 = b2 + kstep;
            if (last && has_next) S.a_ready(nxt);
            if constexpr (Epi::HAS_MID) { if (t == nt / 2) E.mid(acc, cur, wr, wc, fr, fq); }
            if constexpr (SP2) {
            PG8_LDB(B0, 0, 0); PG8_LDB(B1, 0, 1); PG8_SCHED; PG8_LDA(At, 0, 0); PG8_STAGE(PG8_SA(1, 1), a1 + hsA, voffA);
            PG8_WAIT_V(8); PG8_WAIT_L(0); PG8_BAR; PG8_MMA(0, 0, At, B0); PG8_MMA(0, 1, At, B1); PG8_BAR; PG8_SCHED;
            PG8_LDA(At, 0, 1); PG8_STAGE(PG8_SB(0, 0), b2, voffB); PG8_STAGE(PG8_SB(0, 1), b2 + hsB, voffB); PG8_STAGE(PG8_SA(0, 0), a2, voffA);
            PG8_WAIT_V(8); PG8_WAIT_L(0); PG8_BAR; PG8_MMA(1, 0, At, B0); PG8_MMA(1, 1, At, B1); PG8_BAR; PG8_SCHED;
            PG8_LDB(B0, 1, 0); PG8_LDB(B1, 1, 1); PG8_SCHED; PG8_LDA(At, 1, 0); PG8_STAGE(PG8_SA(0, 1), a2 + hsA, voffA);
            PG8_WAIT_V(8); PG8_WAIT_L(0); PG8_BAR; PG8_MMA(0, 0, At, B0); PG8_MMA(0, 1, At, B1); PG8_BAR; PG8_SCHED;
            PG8_LDA(At, 1, 1); PG8_STAGE(PG8_SB(1, 0), b3, voffB); PG8_STAGE(PG8_SB(1, 1), b3 + hsB, voffB); PG8_STAGE(PG8_SA(1, 0), a3, voffA);
            PG8_WAIT_V(8); PG8_WAIT_L(0); PG8_BAR; PG8_MMA(1, 0, At, B0); PG8_MMA(1, 1, At, B1); PG8_BAR; PG8_SCHED;
            } else {
            PG8_LDB(B0, 0, 0); PG8_SCHED; PG8_LDA(At, 0, 0); PG8_STAGE(PG8_SA(1, 1), a1 + hsA, voffA);
            PG8_WAIT_L(8); PG8_BAR; PG8_WAIT_L(0); PG8_MMA(0, 0, At, B0); PG8_BAR; PG8_SCHED;
            PG8_LDB(B1, 0, 1); PG8_STAGE(PG8_SB(0, 0), b2, voffB);
            PG8_BAR; PG8_WAIT_L(0); PG8_MMA(0, 1, At, B1); PG8_BAR;
            PG8_LDA(At, 0, 1); PG8_STAGE(PG8_SA(0, 0), a2, voffA);
            PG8_BAR; PG8_WAIT_L(0); PG8_MMA(1, 0, At, B0); PG8_BAR; PG8_SCHED;
            PG8_STAGE(PG8_SB(0, 1), b2 + hsB, voffB);
            PG8_WAIT_V(6); PG8_BAR; PG8_MMA(1, 1, At, B1); PG8_BAR;
            PG8_LDB(B0, 1, 0); PG8_SCHED; PG8_LDA(At, 1, 0); PG8_STAGE(PG8_SA(0, 1), a2 + hsA, voffA);
            PG8_WAIT_L(8); PG8_BAR; PG8_WAIT_L(0); PG8_MMA(0, 0, At, B0); PG8_BAR; PG8_SCHED;
            PG8_LDB(B1, 1, 1); PG8_STAGE(PG8_SB(1, 0), b3, voffB);
            PG8_BAR; PG8_WAIT_L(0); PG8_MMA(0, 1, At, B1); PG8_BAR;
            PG8_LDA(At, 1, 1); PG8_STAGE(PG8_SA(1, 0), a3, voffA);
            PG8_BAR; PG8_WAIT_L(0); PG8_MMA(1, 0, At, B0); PG8_BAR; PG8_SCHED;
            PG8_STAGE(PG8_SB(1, 1), b3 + hsB, voffB);
            PG8_WAIT_V(6); PG8_BAR; PG8_MMA(1, 1, At, B1); PG8_BAR;
            }
        }
        if constexpr (ALIGN_EPI) { if (wr == 0) PG8_BAR; }
        if constexpr (!Epi::AFTER_DRAIN) { E(acc, cur, wr, wc, fr, fq); S.done(cur); }
        if (!has_next) break;
#pragma unroll
        for (int a = 0; a < 2; ++a)
#pragma unroll
            for (int b = 0; b < 2; ++b)
#pragma unroll
                for (int m = 0; m < 4; ++m)
#pragma unroll
                    for (int n = 0; n < 2; ++n) acc[a][b][m][n] = (f32x4){0.f, 0.f, 0.f, 0.f};
        cur = nxt; cA = nA; cB = nB; ++ui;
        if constexpr (ALIGN_EPI) { if (wr == 1) PG8_BAR; }
    }
    PG8_WAIT_V(0);
    if constexpr (!ALIGN_EPI) { if (wr == 0) PG8_BAR; }
    PG8_BAR;
    if constexpr (Epi::AFTER_DRAIN) { E.fused(acc, cur, wr, wc, fr, fq, lds, wid, lane); S.done(cur); }
#undef PG8_SA
#undef PG8_SB
#undef PG8_STAGE
#undef PG8_LDA
#undef PG8_LDB
#undef PG8_MMA
#undef PG8_WAIT_V
#undef PG8_WAIT_L
#undef PG8_BAR
#undef PG8_SCHED
}

template <class Epi, class Sched, bool ALIGN_EPI = false, bool SP2 = false>
__device__ __forceinline__ void gemm_phase_g(PG8_LAS unsigned char* lds, const Gemm g, const Sched& S, const Epi& E) {
    const int tid = fresh_tid(), wid = __builtin_amdgcn_readfirstlane(tid >> 6), lane = tid & 63, wr = wid >> 2, wc = wid & 3, fr = lane & 15, fq = lane >> 4;
    const int K = g.K, nt = K / BK;
    unsigned voffB[2]; int RAr[2]; unsigned CAb[2];
#pragma unroll
    for (int i = 0; i < 2; ++i) { int R, C; stage_rc(tid * 16 + i * 8192, R, C); const int Rb = Epi::PERM ? ((R & ~31) + perm32(R & 31)) : R;
        RAr[i] = R; CAb[i] = (unsigned)C * 2u; voffB[i] = (unsigned)(Rb * g.ldb + C) * 2u; }
    const size_t kstep = (size_t)(BK * 2);
    const size_t hsA = (size_t)HALF * g.lda * 2, hsB = (size_t)HALF * g.ldb * 2;
    const size_t tsA = 2 * hsA, tsB = 2 * hsB;
    const unsigned ldsw = (unsigned)wid * 1024u;
    const int aoff = lds_byte(wr * 64 + fr, fq * 8), boff = lds_byte(wc * 32 + fr, fq * 8);
#define PG8_SA(b, h) (((b) * 2 + (h)) * HTB)
#define PG8_SB(b, h) ((4 + (b) * 2 + (h)) * HTB)
#define PG8_STAGE(bufoff, gbase, voff) do { _Pragma("unroll") for (int _i = 0; _i < 2; ++_i) \
        __builtin_amdgcn_global_load_lds((const unsigned*)((const char*)(gbase) + (voff)[_i]), (PG8_LAS unsigned*)(lds + (bufoff) + ldsw + _i * 8192), 16, 0, 0); } while (0)
#define PG8_LDA(dst, b, h) do { _Pragma("unroll") for (int m = 0; m < 4; ++m) _Pragma("unroll") for (int k = 0; k < 2; ++k) dst[m][k] = *(const PG8_LAS bf16x8*)(lds + PG8_SA(b, h) + aoff + m * 2048 + k * 1024); } while (0)
#define PG8_LDB(dst, b, h) do { _Pragma("unroll") for (int n = 0; n < 2; ++n) _Pragma("unroll") for (int k = 0; k < 2; ++k) dst[n][k] = *(const PG8_LAS bf16x8*)(lds + PG8_SB(b, h) + boff + n * 2048 + k * 1024); } while (0)
#define PG8_MMA(ai, bj, At, Bt) do { __builtin_amdgcn_s_setprio(1); _Pragma("unroll") for (int m = 0; m < 4; ++m) _Pragma("unroll") for (int n = 0; n < 2; ++n) _Pragma("unroll") for (int k = 0; k < 2; ++k) \
        acc[ai][bj][m][n] = __builtin_amdgcn_mfma_f32_16x16x32_bf16(Bt[n][k], At[m][k], acc[ai][bj][m][n], 0, 0, 0); __builtin_amdgcn_s_setprio(0); } while (0)
#define PG8_WAIT_V(n) asm volatile("s_waitcnt vmcnt(" #n ")" ::: "memory")
#define PG8_WAIT_L(n) asm volatile("s_waitcnt lgkmcnt(" #n ")" ::: "memory")
#define PG8_BAR __builtin_amdgcn_s_barrier()
#define PG8_SCHED __builtin_amdgcn_sched_barrier(0)
    Unit cur, nxt; int ui = 0;
    if (!S.next(0, cur)) return;
    f32x4 acc[2][2][4][2];
#pragma unroll
    for (int a = 0; a < 2; ++a)
#pragma unroll
        for (int b = 0; b < 2; ++b)
#pragma unroll
            for (int m = 0; m < 4; ++m)
#pragma unroll
                for (int n = 0; n < 2; ++n) acc[a][b][m][n] = (f32x4){0.f, 0.f, 0.f, 0.f};
    bf16x8 At[4][2], B0[2][2], B1[2][2];
    unsigned vAll[4][2][2];
#pragma unroll
    for (int q = 0; q < 4; ++q) { Unit uq; const bool ok = S.next(q, uq);
#pragma unroll
        for (int h = 0; h < 2; ++h)
#pragma unroll
            for (int i = 0; i < 2; ++i) vAll[q][h][i] = ok ? (unsigned)S.arow(uq.pm * BM + h * HALF + RAr[i]) * (unsigned)(g.lda * 2) + CAb[i] : 0u; }
#define PG8_PICK(dst, idx) do { _Pragma("unroll") for (int h_ = 0; h_ < 2; ++h_) _Pragma("unroll") for (int i_ = 0; i_ < 2; ++i_) \
        dst[h_][i_] = (idx) == 0 ? vAll[0][h_][i_] : (idx) == 1 ? vAll[1][h_][i_] : (idx) == 2 ? vAll[2][h_][i_] : vAll[3][h_][i_]; } while (0)
    unsigned vA[2][2], vAn[2][2], vS[2][2];
    PG8_PICK(vA, 0);
    const char* A0 = (const char*)g.A; const char* cB = (const char*)g.Bt + S.boff(cur);
    S.a_ready(cur);
    if constexpr (SP2) {
        PG8_STAGE(PG8_SB(0, 0), cB, voffB); PG8_STAGE(PG8_SB(0, 1), cB + hsB, voffB); PG8_STAGE(PG8_SA(0, 0), A0, vA[0]); PG8_STAGE(PG8_SA(0, 1), A0, vA[1]);
        if (wr == 1) PG8_BAR;
        PG8_WAIT_V(2); PG8_BAR;
        PG8_STAGE(PG8_SB(1, 0), cB + kstep, voffB); PG8_STAGE(PG8_SA(1, 0), A0 + kstep, vA[0]); PG8_STAGE(PG8_SB(1, 1), cB + hsB + kstep, voffB);
        PG8_WAIT_V(6); PG8_BAR;
    } else {
        PG8_STAGE(PG8_SB(0, 0), cB, voffB); PG8_STAGE(PG8_SA(0, 0), A0, vA[0]); PG8_STAGE(PG8_SB(0, 1), cB + hsB, voffB); PG8_STAGE(PG8_SA(0, 1), A0, vA[1]);
        if (wr == 1) PG8_BAR;
        PG8_WAIT_V(4); PG8_BAR;
        PG8_STAGE(PG8_SB(1, 0), cB + kstep, voffB); PG8_STAGE(PG8_SA(1, 0), A0 + kstep, vA[0]); PG8_STAGE(PG8_SB(1, 1), cB + hsB + kstep, voffB);
        PG8_WAIT_V(6); PG8_BAR;
    }
    for (;;) {
        const bool has_next = S.next(ui + 1, nxt);
        const char* nB = has_next ? (const char*)g.Bt + S.boff(nxt) : cB;
        if (has_next) { PG8_PICK(vAn, ui + 1); } else { PG8_PICK(vAn, ui); }
#pragma unroll 1
        for (int t = 0; t < nt; t += 2) {
            const bool last = (t == nt - 2);
            const char* a1 = A0 + (size_t)(t + 1) * kstep;
            const char* a2 = last ? A0 : A0 + (size_t)(t + 2) * kstep; const char* b2 = last ? nB : cB + (size_t)(t + 2) * kstep;
#pragma unroll
            for (int h_ = 0; h_ < 2; ++h_)
#pragma unroll
                for (int i_ = 0; i_ < 2; ++i_) vS[h_][i_] = last ? vAn[h_][i_] : vA[h_][i_];
            const char* a3 = a2 + kstep; const char* b3 = b2 + kstep;
            if (last && has_next) S.a_ready(nxt);
            if constexpr (Epi::HAS_MID) { if (t == nt / 2) E.mid(acc, cur, wr, wc, fr, fq); }
            if constexpr (SP2) {
            PG8_LDB(B0, 0, 0); PG8_LDB(B1, 0, 1); PG8_SCHED; PG8_LDA(At, 0, 0); PG8_STAGE(PG8_SA(1, 1), a1, vA[1]);
            PG8_WAIT_V(8); PG8_WAIT_L(0); PG8_BAR; PG8_MMA(0, 0, At, B0); PG8_MMA(0, 1, At, B1); PG8_BAR; PG8_SCHED;
            PG8_LDA(At, 0, 1); PG8_STAGE(PG8_SB(0, 0), b2, voffB); PG8_STAGE(PG8_SB(0, 1), b2 + hsB, voffB); PG8_STAGE(PG8_SA(0, 0), a2, vS[0]);
            PG8_WAIT_V(8); PG8_WAIT_L(0); PG8_BAR; PG8_MMA(1, 0, At, B0); PG8_MMA(1, 1, At, B1); PG8_BAR; PG8_SCHED;
            PG8_LDB(B0, 1, 0); PG8_LDB(B1, 1, 1); PG8_SCHED; PG8_LDA(At, 1, 0); PG8_STAGE(PG8_SA(0, 1), a2, vS[1]);
            PG8_WAIT_V(8); PG8_WAIT_L(0); PG8_BAR; PG8_MMA(0, 0, At, B0); PG8_MMA(0, 1, At, B1); PG8_BAR; PG8_SCHED;
            PG8_LDA(At, 1, 1); PG8_STAGE(PG8_SB(1, 0), b3, voffB); PG8_STAGE(PG8_SB(1, 1), b3 + hsB, voffB); PG8_STAGE(PG8_SA(1, 0), a3, vS[0]);
            PG8_WAIT_V(8); PG8_WAIT_L(0); PG8_BAR; PG8_MMA(1, 0, At, B0); PG8_MMA(1, 1, At, B1); PG8_BAR; PG8_SCHED;
            } else {
            PG8_LDB(B0, 0, 0); PG8_SCHED; PG8_LDA(At, 0, 0); PG8_STAGE(PG8_SA(1, 1), a1, vA[1]);
            PG8_WAIT_L(8); PG8_BAR; PG8_WAIT_L(0); PG8_MMA(0, 0, At, B0); PG8_BAR; PG8_SCHED;
            PG8_LDB(B1, 0, 1); PG8_STAGE(PG8_SB(0, 0), b2, voffB);
            PG8_BAR; PG8_WAIT_L(0); PG8_MMA(0, 1, At, B1); PG8_BAR;
            PG8_LDA(At, 0, 1); PG8_STAGE(PG8_SA(0, 0), a2, vS[0]);
            PG8_BAR; PG8_WAIT_L(0); PG8_MMA(1, 0, At, B0); PG8_BAR; PG8_SCHED;
            PG8_STAGE(PG8_SB(0, 1), b2 + hsB, voffB);
            PG8_WAIT_V(6); PG8_BAR; PG8_MMA(1, 1, At, B1); PG8_BAR;
            PG8_LDB(B0, 1, 0); PG8_SCHED; PG8_LDA(At, 1, 0); PG8_STAGE(PG8_SA(0, 1), a2, vS[1]);
            PG8_WAIT_L(8); PG8_BAR; PG8_WAIT_L(0); PG8_MMA(0, 0, At, B0); PG8_BAR; PG8_SCHED;
            PG8_LDB(B1, 1, 1); PG8_STAGE(PG8_SB(1, 0), b3, voffB);
            PG8_BAR; PG8_WAIT_L(0); PG8_MMA(0, 1, At, B1); PG8_BAR;
            PG8_LDA(At, 1, 1); PG8_STAGE(PG8_SA(1, 0), a3, vS[0]);
            PG8_BAR; PG8_WAIT_L(0); PG8_MMA(1, 0, At, B0); PG8_BAR; PG8_SCHED;
            PG8_STAGE(PG8_SB(1, 1), b3 + hsB, voffB);
            PG8_WAIT_V(6); PG8_BAR; PG8_MMA(1, 1, At, B1); PG8_BAR;
            }
        }
        if constexpr (ALIGN_EPI) { if (wr == 0) PG8_BAR; }
        if constexpr (!Epi::AFTER_DRAIN) { E(acc, cur, wr, wc, fr, fq); S.done(cur); }
        if (!has_next) break;
#pragma unroll
        for (int a = 0; a < 2; ++a)
#pragma unroll
            for (int b = 0; b < 2; ++b)
#pragma unroll
                for (int m = 0; m < 4; ++m)
#pragma unroll
                    for (int n = 0; n < 2; ++n) acc[a][b][m][n] = (f32x4){0.f, 0.f, 0.f, 0.f};
        cur = nxt; cB = nB; ++ui;
#pragma unroll
        for (int h_ = 0; h_ < 2; ++h_)
#pragma unroll
            for (int i_ = 0; i_ < 2; ++i_) vA[h_][i_] = vAn[h_][i_];
        if constexpr (ALIGN_EPI) { if (wr == 1) PG8_BAR; }
    }
    PG8_WAIT_V(0);
    if constexpr (!ALIGN_EPI) { if (wr == 0) PG8_BAR; }
    PG8_BAR;
    if constexpr (Epi::AFTER_DRAIN) { E.fused(acc, cur, wr, wc, fr, fq, lds, wid, lane); S.done(cur); }
#undef PG8_SA
#undef PG8_SB
#undef PG8_STAGE
#undef PG8_LDA
#undef PG8_LDB
#undef PG8_MMA
#undef PG8_WAIT_V
#undef PG8_WAIT_L
#undef PG8_BAR
#undef PG8_SCHED
#undef PG8_PICK
}


}

namespace attn {
using bf16x8 = __attribute__((ext_vector_type(8))) short;
using s16x4  = __attribute__((ext_vector_type(4))) short;
using f32x16 = __attribute__((ext_vector_type(16))) float;
using u32x4  = __attribute__((ext_vector_type(4))) unsigned;
constexpr int QBLK = 32, KVBLK = 64, LDQ = 3072;
constexpr float SCALE = 0.125f, QSCALE = 0.125f * 1.4426950408889634f;
constexpr size_t SHM_V = KVBLK * 128 * 2, SHM_K = KVBLK * 128 * 2, SHM_ATTN = 2 * SHM_V + 2 * SHM_K + 8 * 64 * 4;
#define KSWZ(row, colB) ((row) * 256 + ((colB) ^ (((row) & 7) << 4)))
#define SBAR() __builtin_amdgcn_sched_barrier(0)
__device__ __forceinline__ int crow(int r, int hi) { return (r & 3) + 8 * (r >> 2) + 4 * hi; }
__device__ __forceinline__ unsigned cvtpk(float lo, float hi) { return pk2(lo, hi); }
__device__ __forceinline__ bf16x8 ld8(const bf16_t* p) { return *reinterpret_cast<const bf16x8*>(p); }

__device__ __forceinline__ void partialSM(f32x16& p0, f32x16& p1) {
  for (int r = 0; r < 16; ++r) p0[r] = __builtin_amdgcn_exp2f(p0[r]);
}
__device__ __forceinline__ void finishSM(f32x16& p0, f32x16& p1, float& l_reg, bf16x8& pa0, bf16x8& pa1, bf16x8& pa2, bf16x8& pa3) {
  for (int r = 0; r < 16; ++r) p1[r] = __builtin_amdgcn_exp2f(p1[r]);
  float ps = 0; for (int r = 0; r < 16; ++r) ps += p0[r]; for (int r = 0; r < 16; ++r) ps += p1[r];
  l_reg += ps;
#define PK4(P, BASE, OUT) do { unsigned a0 = cvtpk(P[BASE + 0], P[BASE + 1]), a1 = cvtpk(P[BASE + 2], P[BASE + 3]);   \
    unsigned b0 = cvtpk(P[BASE + 4], P[BASE + 5]), b1 = cvtpk(P[BASE + 6], P[BASE + 7]);                              \
    auto r0 = __builtin_amdgcn_permlane32_swap(a0, b0, false, false); auto r1 = __builtin_amdgcn_permlane32_swap(a1, b1, false, false); \
    u32x4 w = {r0[0], r1[0], r0[1], r1[1]}; OUT = *reinterpret_cast<bf16x8*>(&w); } while (0)
  PK4(p0, 0, pa0); PK4(p0, 8, pa1); PK4(p1, 0, pa2); PK4(p1, 8, pa3);
#undef PK4
}
__device__ __forceinline__ void qkt(f32x16& p0, f32x16& p1, const bf16_t* Ks, const bf16x8* qr, int r32, int hi, int sub) {
  p0 = f32x16{}; p1 = f32x16{};
#pragma unroll
  for (int d0 = 0; d0 < 4; ++d0) { int cb = (sub * 64 + d0 * 16 + hi * 8) * 2;
    bf16x8 b0 = *reinterpret_cast<const bf16x8*>((const char*)Ks + KSWZ(r32, cb));
    bf16x8 b1 = *reinterpret_cast<const bf16x8*>((const char*)Ks + KSWZ(32 + r32, cb));
    p0 = __builtin_amdgcn_mfma_f32_32x32x16_bf16(b0, qr[d0], p0, 0, 0, 0);
    p1 = __builtin_amdgcn_mfma_f32_32x32x16_bf16(b1, qr[d0], p1, 0, 0, 0); }
}
__device__ __forceinline__ int v_st(int k, int c) { const int kk = (k & ~0xC) | ((k & 4) << 1) | ((k & 8) >> 1); return ((kk >> 3) * 4 + (c >> 5)) * 512 + ((kk & 7) * 32 + (c & 31)) * 2; }
__device__ __forceinline__ int v_rd_base(int lane) { return ((lane & 3) << 3) | (((lane >> 2) & 3) << 6) | (((lane >> 4) & 1) << 5) | (((lane >> 5) & 1) << 8); }
constexpr int v_rd_off(int d0, int ks, int half) { return d0 * 512 + ks * 4096 + half * 2048; }
template <int OFF> __device__ __forceinline__ s16x4 tr_read(int vb) {
  s16x4 r; asm volatile("ds_read_b64_tr_b16 %0, %1 offset:%2" : "=&v"(r) : "v"(vb), "i"(OFF) : "memory"); return r;
}
template <int D0> __device__ __forceinline__ void pv_one(f32x16& od, int vb, bf16x8 pa0, bf16x8 pa1, bf16x8 pa2, bf16x8 pa3) {
  const s16x4 l0 = tr_read<v_rd_off(D0, 0, 0)>(vb), h0 = tr_read<v_rd_off(D0, 0, 1)>(vb), l1 = tr_read<v_rd_off(D0, 1, 0)>(vb), h1 = tr_read<v_rd_off(D0, 1, 1)>(vb);
  const s16x4 l2 = tr_read<v_rd_off(D0, 2, 0)>(vb), h2 = tr_read<v_rd_off(D0, 2, 1)>(vb), l3 = tr_read<v_rd_off(D0, 3, 0)>(vb), h3 = tr_read<v_rd_off(D0, 3, 1)>(vb);
  asm volatile("s_waitcnt lgkmcnt(0)" ::: "memory"); SBAR();
#define PK(L, H) (bf16x8){L[0], L[1], L[2], L[3], H[0], H[1], H[2], H[3]}
  od = __builtin_amdgcn_mfma_f32_32x32x16_bf16(pa0, PK(l0, h0), od, 0, 0, 0);
  od = __builtin_amdgcn_mfma_f32_32x32x16_bf16(pa1, PK(l1, h1), od, 0, 0, 0);
  od = __builtin_amdgcn_mfma_f32_32x32x16_bf16(pa2, PK(l2, h2), od, 0, 0, 0);
  od = __builtin_amdgcn_mfma_f32_32x32x16_bf16(pa3, PK(l3, h3), od, 0, 0, 0);
#undef PK
}
__device__ __forceinline__ void pv_d0(f32x16* o, int vb, bf16x8 pa0, bf16x8 pa1, bf16x8 pa2, bf16x8 pa3) {
  pv_one<0>(o[0], vb, pa0, pa1, pa2, pa3); pv_one<1>(o[1], vb, pa0, pa1, pa2, pa3); pv_one<2>(o[2], vb, pa0, pa1, pa2, pa3); pv_one<3>(o[3], vb, pa0, pa1, pa2, pa3);
}

__device__ __forceinline__ void attn_unit(const bf16_t* Qb, const bf16_t* Kh, const bf16_t* Vh, bf16_t* Ya, float lam, const float* subln_g, int seq, char* lds) {
  const int tid = fresh_tid(), wid = __builtin_amdgcn_readfirstlane(tid >> 6), lane = tid & 63, r32 = lane & 31, hi = lane >> 5, sub = wid >> 2, wq = wid & 3;
  bf16_t* V_lds = (bf16_t*)lds; bf16_t* K_lds = (bf16_t*)(lds + 2 * SHM_V);
  float* ws = (float*)(lds + 2 * SHM_V + 2 * SHM_K) + wid * 64; float* li_l = ws;
  float l_reg = 0; f32x16 o[4] = {}; bf16x8 qr[4];
  const bf16_t* Qw = Qb + (long)(wq * QBLK + r32) * LDQ + sub * 64 + hi * 8;
#pragma unroll
  for (int d0 = 0; d0 < 4; ++d0) qr[d0] = ld8(Qw + d0 * 16);
  const int sr = tid >> 4, sc = (tid & 15) * 8, vst0 = v_st(sr, sc), vst1 = v_st(32 + sr, sc);
  const int vb0 = (int)(uintptr_t)V_lds + v_rd_base(lane);
  struct { bf16x8 vs0, vs1, ks0, ks1; } sr_[2];
#define SLOAD(i, k0) do { sr_[i].vs0 = ld8(&Vh[(long)((k0) + sr) * LDQ + sc]); sr_[i].vs1 = ld8(&Vh[(long)((k0) + 32 + sr) * LDQ + sc]); \
    sr_[i].ks0 = ld8(&Kh[(long)((k0) + sr) * LDQ + sc]); sr_[i].ks1 = ld8(&Kh[(long)((k0) + 32 + sr) * LDQ + sc]); } while (0)
#define SWRITE(b, i) do { *(bf16x8*)((char*)V_lds + (b) * SHM_V + vst0) = sr_[i].vs0;          \
    *(bf16x8*)((char*)V_lds + (b) * SHM_V + vst1) = sr_[i].vs1; int kc = sc * 2;               \
    *(bf16x8*)((char*)K_lds + (b) * SHM_K + KSWZ(sr, kc)) = sr_[i].ks0;                       \
    *(bf16x8*)((char*)K_lds + (b) * SHM_K + KSWZ(32 + sr, kc)) = sr_[i].ks1; } while (0)
#define SWAIT() asm volatile("s_waitcnt vmcnt(4)" ::: "memory")
  f32x16 pA0, pA1, pB0, pB1; bf16x8 pa0, pa1, pa2, pa3; const int NT = seq / KVBLK;
  constexpr int SE = 0, SO = 1;
  SLOAD(SE, 0); asm volatile("s_waitcnt vmcnt(0)" ::: "memory"); SWRITE(0, SE); __syncthreads();
  qkt(pA0, pA1, K_lds, qr, r32, hi, sub); partialSM(pA0, pA1);
  SLOAD(SO, KVBLK); if (2 < NT) SLOAD(SE, 2 * KVBLK);
  SWAIT(); SWRITE(1, SO); __syncthreads();
  for (int j = 1; j + 1 < NT; j += 2) {
    SBAR(); qkt(pB0, pB1, (bf16_t*)((char*)K_lds + SHM_K), qr, r32, hi, sub);
    finishSM(pA0, pA1, l_reg, pa0, pa1, pa2, pa3); SBAR();
    SLOAD(SO, (j + 2) * KVBLK); SBAR();
    pv_d0(o, vb0, pa0, pa1, pa2, pa3); partialSM(pB0, pB1);
    __syncthreads(); SWAIT(); SWRITE(0, SE); __syncthreads();
    SBAR(); qkt(pA0, pA1, K_lds, qr, r32, hi, sub);
    finishSM(pB0, pB1, l_reg, pa0, pa1, pa2, pa3); SBAR();
    if (j + 3 < NT) SLOAD(SE, (j + 3) * KVBLK); SBAR();
    pv_d0(o, vb0 + (int)SHM_V, pa0, pa1, pa2, pa3); partialSM(pA0, pA1);
    __syncthreads(); SWAIT(); SWRITE(1, SO); __syncthreads();
  }
  SBAR(); qkt(pB0, pB1, (bf16_t*)((char*)K_lds + SHM_K), qr, r32, hi, sub);
  finishSM(pA0, pA1, l_reg, pa0, pa1, pa2, pa3); SBAR();
  pv_d0(o, vb0, pa0, pa1, pa2, pa3); partialSM(pB0, pB1);
  __syncthreads();
  finishSM(pB0, pB1, l_reg, pa0, pa1, pa2, pa3); SBAR();
  pv_d0(o, vb0 + (int)SHM_V, pa0, pa1, pa2, pa3);
  { auto rr = __builtin_amdgcn_permlane32_swap(__float_as_uint(l_reg), __float_as_uint(l_reg), false, false); l_reg = __uint_as_float(rr[0]) + __uint_as_float(rr[1]); }
  if (hi == 0) li_l[r32] = l_reg; asm volatile("s_waitcnt lgkmcnt(0)" ::: "memory");
  float rli[16];
#pragma unroll
  for (int r = 0; r < 16; ++r) rli[r] = __builtin_amdgcn_rcpf(li_l[crow(r, hi)]);
  __syncthreads();
  float* xo = (float*)lds;
  if (sub == 1) {
#pragma unroll
    for (int r = 0; r < 16; ++r) { const int orow = wq * 32 + crow(r, hi);
#pragma unroll
      for (int d0 = 0; d0 < 4; ++d0) xo[orow * 128 + d0 * 32 + r32] = o[d0][r] * rli[r]; }
  }
  __syncthreads();
  if (sub == 0) {
    float gv[4];
#pragma unroll
    for (int d0 = 0; d0 < 4; ++d0) gv[d0] = subln_g[d0 * 32 + r32] * (1.0f - LAM_INIT);
#pragma unroll
    for (int r = 0; r < 16; ++r) { const int orow = wq * 32 + crow(r, hi); float v[4]; float ssq = 0.f;
#pragma unroll
      for (int d0 = 0; d0 < 4; ++d0) { v[d0] = o[d0][r] * rli[r] - lam * xo[orow * 128 + d0 * 32 + r32]; ssq += v[d0] * v[d0]; }
      ssq += __shfl_xor(ssq, 1); ssq += __shfl_xor(ssq, 2); ssq += __shfl_xor(ssq, 4); ssq += __shfl_xor(ssq, 8); ssq += __shfl_xor(ssq, 16);
      const float sc_ = 1.0f / sqrtf(ssq * (1.0f / 128.0f) + RMS_EPS);
#pragma unroll
      for (int d0 = 0; d0 < 4; ++d0) Ya[(long)orow * 2048 + d0 * 32 + r32] = (bf16_t)f2bf(v[d0] * sc_ * gv[d0]); }
  }
  __syncthreads();
#undef SLOAD
#undef SWRITE
#undef SWAIT
}
#undef KSWZ
#undef SBAR
}

struct Args {
    const float* in[33];
    float* out; unsigned char* ws;
    int ph_lo, ph_hi;
};
enum { I_X = 0, I_ANG, I_WIN, I_QNG, I_KNG, I_LQ1, I_LK1, I_LQ2, I_LK2, I_SUBLN, I_MU, I_W0F, I_W2F, I_W0B, I_W2B, I_A0F, I_A2F, I_A0B, I_A2B, I_G2, I_KK, I_KA, I_RK,
       I_LNW, I_LNB, I_WBA, I_WBB, I_WOUT, I_FNG, I_WR, I_WG, I_WU, I_WD };

__device__ __forceinline__ void tr_item(const float* W, int ldw, int k0, int n0, bf16_t* dst, int ldd, LAS float* scr, int lane) {
    float tv[32];
    const float* src = W + (size_t)(k0 + (lane >> 5)) * ldw + n0 + (lane & 31);
#pragma unroll
    for (int i = 0; i < 32; ++i) tv[i] = src[(size_t)(2 * i) * ldw];
#pragma unroll
    for (int i = 0; i < 32; ++i) scr[(2 * i + (lane >> 5)) * 33 + (lane & 31)] = tv[i];
    asm volatile("s_waitcnt lgkmcnt(0)" ::: "memory");
    const int c = lane & 7;
#pragma unroll
    for (int j = 0; j < 4; ++j) { const int n = (lane >> 3) + 8 * j; const LAS float* s = scr + (8 * c) * 33 + n;
        v4u o; o.x = pk2(s[0 * 33], s[1 * 33]); o.y = pk2(s[2 * 33], s[3 * 33]); o.z = pk2(s[4 * 33], s[5 * 33]); o.w = pk2(s[6 * 33], s[7 * 33]);
        *(v4u*)(dst + (size_t)n * ldd + 8 * c) = o; }
    asm volatile("s_waitcnt lgkmcnt(0)" ::: "memory");
}

__device__ __forceinline__ void p0_prologue(const Args& a, LAS unsigned char* lds, int gw, int NGW, int wave, int lane) {
    unsigned char* ws = a.ws;
    LAS float* scr = (LAS float*)(lds + wave * 16384);
    bf16_t* WinT = (bf16_t*)(ws + WS_WINT);
    bf16_t* WaT = (bf16_t*)(ws + WS_WAT); bf16_t* WoT = (bf16_t*)(ws + WS_WOT);
    constexpr int I_IN = 32 * 333, I_A = 16 * 64, I_B = 16 * 64, I_O = 32 * 64, NITEMS = I_IN + I_A + I_B + I_O;
    for (int it = gw; it < NITEMS; it += NGW) {
        int r = it;
        if (r < I_IN) { const int kb = r / 333, nb = r % 333, n0 = nb * 32; int drow = n0;
            if (n0 >= 6560) { const int c = n0 - 6560, which = c >> 11, cc = c & 2047; drow = 6656 + (cc >> 7) * 256 + which * 128 + (cc & 127); }
            tr_item(a.in[I_WIN], IN_COLS, kb * 64, n0, WinT + (size_t)drow * 2048 + kb * 64, 2048, scr, lane); continue; } r -= I_IN;
        if (r < I_A) { const int kb = r / 64, nb = r % 64; tr_item(a.in[I_WBA], 2048, kb * 64, nb * 32, WaT + (size_t)(nb * 32) * 2048 + kb * 64, 2048, scr, lane); continue; } r -= I_A;
        if (r < I_B) { const int kb = r / 64, nb = r % 64; tr_item(a.in[I_WBB], 2048, kb * 64, nb * 32, WaT + (size_t)(nb * 32) * 2048 + 1024 + kb * 64, 2048, scr, lane); continue; } r -= I_B;
        { const int kb = r / 64, nb = r % 64; tr_item(a.in[I_WOUT], 2048, kb * 64, nb * 32, WoT + (size_t)(nb * 32) * 2048 + kb * 64, 2048, scr, lane); }
    }
    { const int gt = gw * 64 + lane, NT_ = NGW * 64;
      v4u z = {0u, 0u, 0u, 0u};
      for (int i = gt; i < 24576; i += NT_) ((v4u*)(WinT + (size_t)6560 * 2048))[i] = z;
      { const float invf[8] = {1.000000000e+00f, 1.939227432e-01f, 3.760603070e-02f, 7.292664610e-03f, 1.414213562e-03f, 2.742481884e-04f, 5.318296098e-05f, 1.031338616e-05f};
        for (int i = gt; i < SEQ * 8; i += NT_) { float iv = invf[0];
#pragma unroll
            for (int j = 1; j < 8; ++j) iv = ((i & 7) == j) ? invf[j] : iv;
            float sv, cv; sincosf((float)(i >> 3) * iv, &sv, &cv); ((float2*)(ws + WS_ROPE))[i] = make_float2(cv, sv); } }
      { float* sm = (float*)(ws + WS_SMALL);
#define CPY(OFF, IDX, N) for (int i = gt; i < (N); i += NT_) sm[(OFF) + i] = a.in[IDX][i];
        CPY(SM_QNG, I_QNG, 64) CPY(SM_KNG, I_KNG, 64) CPY(SM_LQ1, I_LQ1, 64) CPY(SM_LK1, I_LK1, 64) CPY(SM_LQ2, I_LQ2, 64) CPY(SM_LK2, I_LK2, 64) CPY(SM_SUBLN, I_SUBLN, 128)
        CPY(SM_MU, I_MU, 3488) CPY(SM_KK, I_KK, 1024) CPY(SM_KA, I_KA, 1024) CPY(SM_RK, I_RK, 1024) CPY(SM_LNW, I_LNW, 1024) CPY(SM_LNB, I_LNB, 1024) CPY(SM_FNG, I_FNG, 2048) CPY(SM_WR, I_WR, 32768)
#undef CPY
      }
      for (int i = gt; i < 4096; i += NT_) { const int seg = i >> 10, c = i & 1023; ((float*)(ws + WS_BIAS4))[i] = (seg == 0) ? a.in[I_W0F][c] : (seg == 1) ? a.in[I_W0B][c] : (seg == 2) ? a.in[I_A0F][c] : a.in[I_A0B][c]; }
      bf16_t* B1 = (bf16_t*)(ws + WS_BTL1); bf16_t* B2 = (bf16_t*)(ws + WS_BTL2);
      for (int i = gt; i < 4096 * 32; i += NT_) { const int n = i >> 5, kc = (i & 31) * 8, seg = n >> 10, c = n & 1023;
          const float* w2 = (seg == 0) ? a.in[I_W2F] : (seg == 1) ? a.in[I_W2B] : (seg == 2) ? a.in[I_A2F] : a.in[I_A2B];
          float f[8];
#pragma unroll
          for (int j = 0; j < 8; ++j) { const int k = kc + j - 64 * seg; f[j] = (k >= 0 && k < 64) ? w2[(size_t)k * 1024 + c] : 0.f; }
          *(v4u*)(B1 + (size_t)n * 256 + kc) = pack8(f); }
      for (int i = gt; i < 1024 * 32; i += NT_) { const int n = i >> 5, kc = (i & 31) * 8; float f[8];
#pragma unroll
          for (int j = 0; j < 8; ++j) { const int k = kc + j; f[j] = (k < 160) ? a.in[I_G2][(size_t)k * 1024 + n] : 0.f; }
          *(v4u*)(B2 + (size_t)n * 256 + kc) = pack8(f); }
    }
    bf16_t* HN = (bf16_t*)(ws + WS_HN); const float* x = a.in[I_X]; const float* g = a.in[I_ANG];
    for (int m = gw; m < M; m += NGW) {
        const float4* xr = (const float4*)(x + (size_t)m * DM) + lane; float4 v[8]; float s = 0.f;
#pragma unroll
        for (int j = 0; j < 8; ++j) { v[j] = xr[64 * j]; s += (v[j].x * v[j].x + v[j].y * v[j].y) + (v[j].z * v[j].z + v[j].w * v[j].w); }
        const float rs = 1.0f / sqrtf(wave_sum(s) * (1.0f / DM) + RMS_EPS);
        v2u* o = (v2u*)(HN + (size_t)m * DM) + lane;
#pragma unroll
        for (int j = 0; j < 8; ++j) { const float4 gg = ((const float4*)g)[64 * j + lane]; v2u w; w.x = pk2(v[j].x * rs * gg.x, v[j].y * rs * gg.y); w.y = pk2(v[j].z * rs * gg.z, v[j].w * rs * gg.w); o[64 * j] = w; }
    }
}

__device__ __forceinline__ void p2_prep(const Args& a, int gw, int NGW, int lane, bool dummy = false) {
    unsigned char* ws = a.ws;
    bf16_t* PDA = (bf16_t*)(ws + WS_PDA); const bf16_t* PRW = (const bf16_t*)((unsigned char*)a.out + DO_PRW);
    bf16_t* RKV = (bf16_t*)(ws + WS_RKV); bf16_t* LIN = (bf16_t*)((unsigned char*)a.out + DO_LIN);
    const float* sm = (const float*)(ws + WS_SMALL); const float* mu = sm + SM_MU;
    const int sub8 = lane & 7;
    float gq[8], gk[8];
#pragma unroll
    for (int j = 0; j < 8; ++j) { gq[j] = sm[SM_QNG + sub8 * 8 + j]; gk[j] = sm[SM_KNG + sub8 * 8 + j]; }
    for (int m = gw; m < M; m += NGW) {
        const int t = m & (SEQ - 1);
        const float2 csv = ((const float2*)(ws + WS_ROPE))[t * 8 + sub8]; const float cv = csv.x, sv = csv.y;
        float cs[8], sn[8];
#pragma unroll
        for (int j = 0; j < 8; ++j) { cs[j] = __shfl(cv, j); sn[j] = __shfl(sv, j); }
#pragma unroll
        for (int it = 0; it < 4; ++it) {
            const int v = it * 8 + (lane >> 3);
            bf16_t* p = PDA + (size_t)m * 3072 + (v < 16 ? 0 : 1024) + (v & 15) * 64 + sub8 * 8;
            const v4u w = *(const v4u*)p; float f[8]; unpack8(w, f);
            float s = 0.f;
#pragma unroll
            for (int j = 0; j < 8; ++j) s += f[j] * f[j];
            s = sum8(s); const float rs = 1.0f / sqrtf(s * (1.0f / 64.0f) + RMS_EPS);
            float y[8], oth[8];
#pragma unroll
            for (int j = 0; j < 8; ++j) { y[j] = f[j] * rs * (v < 16 ? gq[j] : gk[j]); }
#pragma unroll
            for (int j = 0; j < 8; ++j) oth[j] = __shfl_xor(y[j], 1);
            float o[8];
#pragma unroll
            for (int j = 0; j < 8; ++j) o[j] = (sub8 == 0) ? (y[j] * cs[j] - oth[j] * sn[j]) : (sub8 == 1) ? (y[j] * cs[j] + oth[j] * sn[j]) : y[j];
            if (v < 16) {
#pragma unroll
                for (int j = 0; j < 8; ++j) o[j] *= 0.125f * 1.4426950408889634f; }
            *(v4u*)(dummy ? (bf16_t*)(ws + WS_LORA) + (p - PDA) : p) = pack8(o);
        }
        const bool hp = t > 0, hn_ = t < SEQ - 1;
        const bf16_t* pr = PRW + (size_t)m * RW_PAD;
#pragma unroll
        for (int it = 0; it < 7; ++it) {
            const int v = it * 64 + lane; if (it == 6 && v >= 436) continue;
            const v4u wc = *(const v4u*)(pr + v * 8);
            v4u wp = {0u, 0u, 0u, 0u}, wn = {0u, 0u, 0u, 0u};
            if (hp) wp = *(const v4u*)(pr - RW_PAD + v * 8);
            if (hn_) wn = *(const v4u*)(pr + RW_PAD + v * 8);
            float c[8], pv[8], nx[8]; unpack8(wc, c); unpack8(wp, pv); unpack8(wn, nx);
            const float4 m0 = *(const float4*)(mu + v * 8), m1 = *(const float4*)(mu + v * 8 + 4);
            const float mm[8] = {m0.x, m0.y, m0.z, m0.w, m1.x, m1.y, m1.z, m1.w};
            float xs[8];
#pragma unroll
            for (int j = 0; j < 8; ++j) xs[j] = c[j] + mm[j] * (0.5f * (pv[j] + nx[j]) - c[j]);
            if (v < 384) { const v4u pw = pack8(xs); *(v4u*)(RKV + (size_t)m * 3072 + v * 8) = pw;
                if (it == 2 || it == 3) {
                    float kr[8]; unpack8(pw, kr); float ssq = 0.f;
#pragma unroll
                    for (int j = 0; j < 8; ++j) { const float kkv = kr[j] * sm[SM_KK + (v - 128) * 8 + j]; ssq += kkv * kkv; }
                    ssq = sum8(ssq);
                    if ((lane & 7) == 0) ((float*)(ws + WS_INRM))[(size_t)m * 16 + ((v - 128) >> 3)] = 1.0f / fmaxf(sqrtf(ssq), 1e-12f); } }
            else if (v < 400) {
#pragma unroll
                for (int j = 0; j < 8; ++j) xs[j] = 1.0f - 2.0f * __builtin_amdgcn_rcpf(1.0f + __expf(2.0f * xs[j]));
                *(v4u*)(LIN + (size_t)m * 512 + (v - 384) * 8) = pack8(xs); }
            else if (v < 416) { *(v4u*)(LIN + (size_t)m * 512 + (v - 384) * 8) = pack8(xs); }
            else {
#pragma unroll
                for (int j = 0; j < 8; ++j) xs[j] = sigmoidf_(xs[j]);
                *(v4u*)(LIN + (size_t)m * 512 + 256 + (v - 416) * 8) = pack8(xs); }
        }
        if (lane < 12) { v4u z = {0u, 0u, 0u, 0u}; *(v4u*)(LIN + (size_t)m * 512 + 416 + lane * 8) = z; }
    }
}

__device__ __forceinline__ void p6_rwpost(const Args& a, int gw, int NGW, int lane) {
    unsigned char* ws = a.ws;
    const bf16_t* RKV = (const bf16_t*)(ws + WS_RKV); const bf16_t* LO = (const bf16_t*)(ws + WS_LORA);
    const bf16_t* YSF = (const bf16_t*)((unsigned char*)a.out + DO_YSF); const bf16_t* YSB = (const bf16_t*)((unsigned char*)a.out + DO_YSB);
    bf16_t* YB = (bf16_t*)((unsigned char*)a.out + DO_YAB) + 1024;
    const size_t SEG = (size_t)M * 1024; const float* sm = (const float*)(ws + WS_SMALL);
    for (int it = gw; it < 2 * M; it += NGW) {
        const int m = it >> 1, col = (it & 1) * 512 + lane * 8;
        float yf[8], ybk[8], r[8], k[8], v[8], af[8], ab[8], g[8];
        unpack8(*(const v4u*)(YSF + (size_t)m * 1024 + col), yf); unpack8(*(const v4u*)(YSB + (size_t)m * 1024 + col), ybk);
        unpack8(*(const v4u*)(RKV + (size_t)m * 3072 + col), r); unpack8(*(const v4u*)(RKV + (size_t)m * 3072 + 1024 + col), k); unpack8(*(const v4u*)(RKV + (size_t)m * 3072 + 2048 + col), v);
        unpack8(*(const v4u*)(LO + 2 * SEG + (size_t)m * 1024 + col), af); unpack8(*(const v4u*)(LO + 3 * SEG + (size_t)m * 1024 + col), ab); unpack8(*(const v4u*)(LO + 4 * SEG + (size_t)m * 1024 + col), g);
        float y[8]; float s = 0.f;
#pragma unroll
        for (int j = 0; j < 8; ++j) { y[j] = yf[j] + ybk[j]; s += y[j]; }
        const float mean = sum8(s) * (1.0f / 64.0f); float q = 0.f;
#pragma unroll
        for (int j = 0; j < 8; ++j) { y[j] -= mean; q += y[j] * y[j]; }
        const float rstd = 1.0f / sqrtf(sum8(q) * (1.0f / 64.0f) + GN_EPS);
        float bs = 0.f;
#pragma unroll
        for (int j = 0; j < 8; ++j) { const float kfb = k[j] * (2.0f + (af[j] + ab[j] - 2.0f) * sm[SM_KA + col + j]); bs += r[j] * kfb * sm[SM_RK + col + j]; }
        bs = sum8(bs);
        float o[8];
#pragma unroll
        for (int j = 0; j < 8; ++j) o[j] = (y[j] * rstd * sm[SM_LNW + col + j] + sm[SM_LNB + col + j] + bs * v[j]) * g[j];
        *(v4u*)(YB + (size_t)m * 2048 + col) = pack8(o);
    }
}

__device__ __forceinline__ void expert_convert_gu(const Args& a, LAS unsigned char* lds, int gw, int NGW, int wave, int lane, int e_lo, int e_hi) {
    unsigned char* ws = a.ws;
    LAS float* scr = (LAS float*)(lds + wave * 16384);
    const int per = (e_hi - e_lo) * 1024;
    for (int it = gw; it < 2 * per; it += NGW) {
        const int which = it >= per ? 1 : 0, r = it - which * per, e = e_lo + (r >> 10), q = r & 1023;
        const int kb = q >> 5, nb = q & 31, n0 = nb * 32;
        const float* W = (which == 0 ? a.in[I_WG] : a.in[I_WU]) + (size_t)e * 2048 * 1024;
        const int drow = (n0 >> 7) * 256 + which * 128 + (n0 & 127);
        tr_item(W, 1024, kb * 64, n0, (bf16_t*)(ws + w1t_base(e)) + (size_t)drow * 2048 + kb * 64, 2048, scr, lane); }
}
__device__ __forceinline__ void expert_convert_down(const Args& a, LAS unsigned char* lds, int gw, int NGW, int wave, int lane) {
    unsigned char* ws = a.ws;
    LAS float* scr = (LAS float*)(lds + wave * 16384);
    bf16_t* WDT = (bf16_t*)(ws + WS_WDT);
    for (int it = gw; it < 16384; it += NGW) { const int e = it >> 10, q = it & 1023, kb = q >> 6, nb = q & 63;
        const float* W = a.in[I_WD] + (size_t)e * 1024 * 2048;
        tr_item(W, 2048, kb * 64, nb * 32, WDT + ((size_t)e * 2048 + nb * 32) * 1024 + kb * 64, 1024, scr, lane); }
}
__device__ __forceinline__ void p9_router(const Args& a, LAS unsigned char* lds, int gw, int NGW, int wave, int lane) {
    unsigned char* ws = a.ws;
    expert_convert_gu(a, lds, gw, NGW, wave, lane, (gridDim.x == 256) ? N_EARLY_EXPERTS : 0, NE);
    __syncthreads();
    LAS float* wrT = (LAS float*)lds;
    { const float4* wr4 = (const float4*)((const float*)(ws + WS_SMALL) + SM_WR);
      for (int idx = fresh_tid(); idx < 2048 * 4; idx += NTHREADS) { const int d = idx >> 2, q = idx & 3; const float4 w4 = wr4[idx];
          wrT[(4 * q + 0) * 2048 + d] = w4.x; wrT[(4 * q + 1) * 2048 + d] = w4.y; wrT[(4 * q + 2) * 2048 + d] = w4.z; wrT[(4 * q + 3) * 2048 + d] = w4.w; } }
    __syncthreads();
    const float* h = a.out; const float* ss = (const float*)(ws + WS_SSP); const float* g = (const float*)(ws + WS_SMALL) + SM_FNG;
    float* aff = (float*)(ws + WS_AFF); bf16_t* hn2 = (bf16_t*)(ws + WS_HN2);
    for (int mp = gw; mp < M / 2; mp += NGW) {
        const int m0 = 2 * mp;
        const float rs0 = 1.0f / sqrtf(wave_sum(lane < 32 ? ss[(size_t)m0 * 32 + lane] : 0.f) * (1.0f / DM) + RMS_EPS);
        const float rs1 = 1.0f / sqrtf(wave_sum(lane < 32 ? ss[(size_t)(m0 + 1) * 32 + lane] : 0.f) * (1.0f / DM) + RMS_EPS);
        float acc0[16], acc1[16];
#pragma unroll
        for (int e = 0; e < 16; ++e) { acc0[e] = 0.f; acc1[e] = 0.f; }
#pragma unroll 2
        for (int j = 0; j < 8; ++j) { const int d = j * 256 + lane * 4;
            const float4 gv = *(const float4*)(g + d), h0 = *(const float4*)(h + (size_t)m0 * DM + d), h1 = *(const float4*)(h + (size_t)(m0 + 1) * DM + d);
            const float x0[4] = {h0.x * rs0 * gv.x, h0.y * rs0 * gv.y, h0.z * rs0 * gv.z, h0.w * rs0 * gv.w};
            const float x1[4] = {h1.x * rs1 * gv.x, h1.y * rs1 * gv.y, h1.z * rs1 * gv.z, h1.w * rs1 * gv.w};
            { v2u w0, w1; w0.x = pk2(x0[0], x0[1]); w0.y = pk2(x0[2], x0[3]); w1.x = pk2(x1[0], x1[1]); w1.y = pk2(x1[2], x1[3]);
              *(v2u*)(hn2 + (size_t)m0 * DM + d) = w0; *(v2u*)(hn2 + (size_t)(m0 + 1) * DM + d) = w1; }
#pragma unroll
            for (int e = 0; e < 16; ++e) { const pg8::f32x4 w4 = *(const LAS pg8::f32x4*)(wrT + e * 2048 + d);
                acc0[e] += x0[0] * w4.x + x0[1] * w4.y + x0[2] * w4.z + x0[3] * w4.w;
                acc1[e] += x1[0] * w4.x + x1[1] * w4.y + x1[2] * w4.z + x1[3] * w4.w; } }
#pragma unroll
        for (int t2 = 0; t2 < 2; ++t2) {
            float mx = -1e30f, lg[16];
#pragma unroll
            for (int e = 0; e < 16; ++e) { lg[e] = wave_sum(t2 ? acc1[e] : acc0[e]); mx = fmaxf(mx, lg[e]); }
            float den = 0.f;
#pragma unroll
            for (int e = 0; e < 16; ++e) { lg[e] = __expf(lg[e] - mx); den += lg[e]; }
            float mine = lg[0];
#pragma unroll
            for (int e = 1; e < 16; ++e) mine = (lane == e) ? lg[e] : mine;
            const int m = m0 + t2;
            if (lane < 16) aff[((size_t)(m >> 12) * 16 + lane) * SEQ + (m & (SEQ - 1))] = mine / den;
        }
    }
}

__device__ __forceinline__ void p10_topk(const Args& a, unsigned char* ldsg) {
    const int bx = blockIdx.x; if (bx >= NB * NE) return;
    LAS unsigned char* L = (LAS unsigned char*)ldsg;
    const int tid = fresh_tid(), lane = tid & 63, w = tid >> 6;
    unsigned char* ws = a.ws;
    const float* aff = (const float*)(ws + WS_AFF) + (size_t)bx * SEQ;
    LAS unsigned* hist = (LAS unsigned*)L;
    LAS unsigned* ctl = hist + 256;
    LAS unsigned* wtot = hist + 272;
    unsigned v[8];
    { const v4u a0 = *(const v4u*)(aff + tid * 8), a1 = *(const v4u*)(aff + tid * 8 + 4); v[0] = a0.x; v[1] = a0.y; v[2] = a0.z; v[3] = a0.w; v[4] = a1.x; v[5] = a1.y; v[6] = a1.z; v[7] = a1.w; }
    unsigned prefix = 0u, mask = 0u, remaining = CAP;
#pragma unroll 1
    for (int pass = 0; pass < 4; ++pass) {
        const int shift = 24 - 8 * pass;
        if (tid < 256) hist[tid] = 0u;
        __syncthreads();
#pragma unroll
        for (int q = 0; q < 8; ++q) if ((v[q] & mask) == prefix) __hip_atomic_fetch_add((unsigned*)&hist[(v[q] >> shift) & 255u], 1u, __ATOMIC_RELAXED, __HIP_MEMORY_SCOPE_WORKGROUP);
        __syncthreads();
        if (w == 0) {
            const v4u hb = *(const LAS v4u*)(hist + 4 * lane);
            const unsigned own = hb.x + hb.y + hb.z + hb.w;
            unsigned suf = own;
#pragma unroll
            for (int o = 1; o < 64; o <<= 1) { const unsigned t = __shfl_down(suf, o); suf += (lane + o < 64) ? t : 0u; }
            const unsigned above = suf - own;
            if (above < remaining && remaining <= suf) {
                unsigned c3 = above, d, rem;
                if (remaining <= c3 + hb.w) { d = 3; rem = remaining - c3; }
                else { c3 += hb.w; if (remaining <= c3 + hb.z) { d = 2; rem = remaining - c3; }
                    else { c3 += hb.z; if (remaining <= c3 + hb.y) { d = 1; rem = remaining - c3; } else { c3 += hb.y; d = 0; rem = remaining - c3; } } }
                ctl[0] = 4u * lane + d; ctl[1] = rem;
            }
        }
        __syncthreads();
        prefix |= ctl[0] << shift; mask |= 255u << shift; remaining = ctl[1];
        __syncthreads();
    }
    const unsigned thr = prefix;
    unsigned ceq = 0u, cgt = 0u;
#pragma unroll
    for (int q = 0; q < 8; ++q) { ceq += (v[q] == thr) ? 1u : 0u; cgt += (v[q] > thr) ? 1u : 0u; }
    unsigned inc = ceq;
#pragma unroll
    for (int o = 1; o < 64; o <<= 1) { const unsigned t = __shfl_up(inc, o); inc += (lane >= o) ? t : 0u; }
    if (lane == 63) wtot[w] = inc;
    __syncthreads();
    unsigned eqbase = inc - ceq;
#pragma unroll
    for (int q = 0; q < 8; ++q) eqbase += (q < w) ? wtot[q] : 0u;
    __syncthreads();
    unsigned selmask = 0u, nsel = 0u, er = eqbase;
#pragma unroll
    for (int q = 0; q < 8; ++q) { bool s = v[q] > thr; if (v[q] == thr) { s = er < remaining; ++er; } selmask |= s ? (1u << q) : 0u; nsel += s ? 1u : 0u; }
    inc = nsel;
#pragma unroll
    for (int o = 1; o < 64; o <<= 1) { const unsigned t = __shfl_up(inc, o); inc += (lane >= o) ? t : 0u; }
    if (lane == 63) wtot[w] = inc;
    __syncthreads();
    unsigned pos = inc - nsel;
#pragma unroll
    for (int q = 0; q < 8; ++q) pos += (q < w) ? wtot[q] : 0u;
    int* seltok = (int*)(ws + WS_SELTOK) + bx * CAP; float* selgate = (float*)(ws + WS_SELGATE) + bx * CAP;
#pragma unroll
    for (int q = 0; q < 8; ++q) if (selmask & (1u << q)) { if (pos < (unsigned)CAP) { seltok[pos] = tid * 8 + q; selgate[pos] = __uint_as_float(v[q]); } ++pos; }
    (void)cgt;
}

__device__ __forceinline__ void p11_gather(const Args& a, int gw, int NGW, int lane) {
    unsigned char* ws = a.ws;
    const float* h = a.out; const float* ss = (const float*)(ws + WS_SSP); const float* g = (const float*)(ws + WS_SMALL) + SM_FNG;
    const int* seltok = (const int*)(ws + WS_SELTOK); bf16_t* XE = (bf16_t*)(ws + WS_XE);
    for (int r = gw; r < NSLOT; r += NGW) {
        const int e = r >> 11, b = (r >> 9) & 3, c = r & 511;
        const int tok = seltok[(b * 16 + e) * CAP + c]; const size_t m = (size_t)b * SEQ + tok;
        const float rs = 1.0f / sqrtf(wave_sum(lane < 32 ? ss[m * 32 + lane] : 0.f) * (1.0f / DM) + RMS_EPS);
        const float4* hr = (const float4*)(h + m * DM) + lane; v2u* o = (v2u*)(XE + (size_t)r * DM) + lane;
#pragma unroll
        for (int j = 0; j < 8; ++j) { const float4 hv = hr[64 * j], gg = ((const float4*)g)[64 * j + lane];
            v2u w; w.x = pk2(hv.x * rs * gg.x, hv.y * rs * gg.y); w.y = pk2(hv.z * rs * gg.z, hv.w * rs * gg.w); o[64 * j] = w; }
    }
}

__device__ __forceinline__ void p14_combine(const Args& a, unsigned char* lds, int wave, int lane) {
    unsigned char* ws = a.ws;
    const int G = gridDim.x, bx = blockIdx.x, tid = fresh_tid();
    const int per = M / G;
    const int m0 = bx * per, b = m0 >> 12, t0 = m0 & (SEQ - 1);
    int* inv = (int*)lds;
    for (int i = tid; i < per * 16; i += NTHREADS) inv[i] = -1;
    __syncthreads();
    const int* seltok = (const int*)(ws + WS_SELTOK) + b * 16 * CAP;
    for (int i = tid; i < 16 * CAP; i += NTHREADS) { const int e = i >> 9, c = i & 511; const int tok = seltok[i]; const int tl = tok - t0;
        if (tl >= 0 && tl < per) inv[tl * 16 + e] = e * 2048 + b * 512 + c; }
    __syncthreads();
    const bf16_t* YE = (const bf16_t*)(ws + WS_XE);
    float* out = a.out;
    for (int tl = wave; tl < per; tl += NWAVES) {
        const size_t m = (size_t)m0 + tl;
        float4* orow = (float4*)(out + m * DM) + lane;
        float4 acc[8];
#pragma unroll
        for (int j = 0; j < 8; ++j) acc[j] = orow[64 * j];
        int sl[16]; int ns = 0;
#pragma unroll
        for (int e = 0; e < 16; ++e) { const int s_ = inv[tl * 16 + e]; if (s_ >= 0) { _Pragma("unroll") for (int q = 0; q < 16; ++q) if (q == ns) sl[q] = s_; ++ns; } }
        for (int q = 0; q < ns; q += 2) { int s0 = sl[0], s1 = sl[0];
#pragma unroll
            for (int z = 0; z < 16; ++z) { if (z == q) s0 = sl[z]; if (z == q + 1) s1 = sl[z]; }
            const bool two = q + 1 < ns;
            const v2u* y0 = (const v2u*)(YE + (size_t)s0 * DM) + lane; const v2u* y1 = (const v2u*)(YE + (size_t)(two ? s1 : s0) * DM) + lane;
            v2u w0[8], w1[8];
#pragma unroll
            for (int j = 0; j < 8; ++j) { w0[j] = y0[64 * j]; w1[j] = y1[64 * j]; }
#pragma unroll
            for (int j = 0; j < 8; ++j) { acc[j].x += bflo(w0[j].x); acc[j].y += bfhi(w0[j].x); acc[j].z += bflo(w0[j].y); acc[j].w += bfhi(w0[j].y);
                if (two) { acc[j].x += bflo(w1[j].x); acc[j].y += bfhi(w1[j].x); acc[j].z += bflo(w1[j].y); acc[j].w += bfhi(w1[j].y); } } }
#pragma unroll
        for (int j = 0; j < 8; ++j) orow[64 * j] = acc[j];
    }
}


namespace scan {
typedef short bf16x8 __attribute__((ext_vector_type(8)));
typedef float f32x4 __attribute__((ext_vector_type(4)));
constexpr int TS = 72, TILE_B = 64 * TS * 2;
enum { SL_ATC = 0, SL_BTC = 1, SL_KTC = 2, SL_RTC = 3, SL_BBT = 4, SL_KBT = 5, SL_VT = 6, SL_XCA = 7, SL_TTA = 8, SL_NKA = 9, SL_NBRT = 10, SL_G = 11, SL_SB = 12,
       SL_XCB = 1, SL_TTB = 2, SL_APT = 7, SL_RP = 0, SL_HT = 9, SL_PSIT = 8, SL_WB = 10 };
constexpr int OFF_PL = 13 * TILE_B, OFF_TOT = OFF_PL + 256;
#define TILE(s) (L + (s) * TILE_B)
__device__ __forceinline__ bf16x8 frag(const LAS unsigned char* tile, int row0, int k0, int lane) {
    return *(const LAS bf16x8*)(tile + ((row0 + (lane & 15)) * TS + k0 + 8 * (lane >> 4)) * 2);
}
__device__ __forceinline__ void mma(f32x4& acc, const LAS unsigned char* A, int arow0, const LAS unsigned char* B, int brow0, int lane) {
    acc = __builtin_amdgcn_mfma_f32_16x16x32_bf16(frag(A, arow0, 0, lane), frag(B, brow0, 0, lane), acc, 0, 0, 0);
    acc = __builtin_amdgcn_mfma_f32_16x16x32_bf16(frag(A, arow0, 32, lane), frag(B, brow0, 32, lane), acc, 0, 0, 0);
}
__device__ __forceinline__ void st4(LAS unsigned char* tile, int brow, int acol0, const f32x4& v) {
    v2u w; w.x = pg8::cvt_pk_bf16(v[0], v[1]); w.y = pg8::cvt_pk_bf16(v[2], v[3]); *(LAS v2u*)(tile + (brow * TS + acol0) * 2) = w;
}
__device__ __forceinline__ f32x4 ld4(const LAS unsigned char* tile, int brow, int acol0) {
    const v2u w = *(const LAS v2u*)(tile + (brow * TS + acol0) * 2); return (f32x4){bflo(w.x), bfhi(w.x), bflo(w.y), bfhi(w.y)};
}
typedef short v4i16_t __attribute__((ext_vector_type(4)));
__device__ __forceinline__ bf16x8 fragT(const LAS unsigned char* tileT, int row0, int k0, int lane) {
    const int g = lane >> 4, q = (lane >> 2) & 3, p = lane & 3;
    const LAS unsigned char* a = tileT + ((k0 + 8 * g + q) * TS + row0 + 4 * p) * 2;
    const v4i16_t lo = __builtin_amdgcn_ds_read_tr16_b64_v4i16((LAS v4i16_t*)a), hi = __builtin_amdgcn_ds_read_tr16_b64_v4i16((LAS v4i16_t*)(a + 4 * TS * 2));
    return (bf16x8){lo[0], lo[1], lo[2], lo[3], hi[0], hi[1], hi[2], hi[3]};
}
struct Fr { bf16x8 k0, k1; };
__device__ __forceinline__ Fr ldf(const LAS unsigned char* tile, int row0, int lane) { Fr f; f.k0 = frag(tile, row0, 0, lane); f.k1 = frag(tile, row0, 32, lane); return f; }
__device__ __forceinline__ Fr ldfT(const LAS unsigned char* tileT, int row0, int lane) { Fr f; f.k0 = fragT(tileT, row0, 0, lane); f.k1 = fragT(tileT, row0, 32, lane); return f; }
__device__ __forceinline__ void mmf(f32x4& acc, const Fr& A, const Fr& B) {
    acc = __builtin_amdgcn_mfma_f32_16x16x32_bf16(A.k0, B.k0, acc, 0, 0, 0); acc = __builtin_amdgcn_mfma_f32_16x16x32_bf16(A.k1, B.k1, acc, 0, 0, 0);
}
#define ZERO4 ((f32x4){0.f, 0.f, 0.f, 0.f})
#define LWAIT() asm volatile("s_waitcnt lgkmcnt(0)" ::: "memory")

__device__ __forceinline__ void scan_phase(const Args& a, unsigned char* ldsg) {
    const int bx = blockIdx.x; if (bx >= 128) return;
    LAS unsigned char* L = (LAS unsigned char*)ldsg;
    const int tid = fresh_tid(), lane = tid & 63, w = __builtin_amdgcn_readfirstlane(tid >> 6);
    const int dir = bx >> 6, b = (bx >> 4) & 3, hh = bx & 15;
    unsigned char* ws = a.ws;
    const bf16_t* RKV = (const bf16_t*)(ws + WS_RKV) + hh * 64 + lane;
    const bf16_t* LW = (const bf16_t*)(ws + WS_LORA) + (size_t)dir * ((size_t)M * 1024) + hh * 64 + lane;
    const bf16_t* AL = (const bf16_t*)(ws + WS_LORA) + (size_t)(2 + dir) * ((size_t)M * 1024) + hh * 64 + lane;
    bf16_t* YS = (bf16_t*)((unsigned char*)a.out + (dir ? DO_YSB : DO_YSF));
    const float kkc = ((const float*)(ws + WS_SMALL))[SM_KK + hh * 64 + lane], kac = ((const float*)(ws + WS_SMALL))[SM_KA + hh * 64 + lane];
    const int g4 = lane >> 4, l15 = lane & 15;
    const int ta = w >> 1, tb0 = (w & 1) * 2;
    const int a0 = ta * 16 + 4 * g4;
    unsigned short rw[8][5]; float inr[8];
    const float* INRM = (const float*)(ws + WS_INRM) + hh;
#define RAW_LOAD(chunk) do { _Pragma("unroll") for (int j = 0; j < 8; ++j) { const int s_ = (chunk) * 64 + w * 8 + j; const int t_ = dir ? (SEQ - 1 - s_) : s_; const size_t m_ = (size_t)b * SEQ + t_; \
        rw[j][0] = RKV[m_ * 3072]; rw[j][1] = RKV[m_ * 3072 + 1024]; rw[j][2] = RKV[m_ * 3072 + 2048]; rw[j][3] = LW[m_ * 1024]; rw[j][4] = AL[m_ * 1024]; inr[j] = INRM[m_ * 16]; } } while (0)
    RAW_LOAD(0);
    f32x4 accS[4];
#pragma unroll
    for (int q = 0; q < 4; ++q) accS[q] = (f32x4){0.f, 0.f, 0.f, 0.f};
    for (int u = tid; u < TILE_B / 16; u += NTHREADS) ((LAS v4u*)TILE(SL_SB))[u] = (v4u){0u, 0u, 0u, 0u};
#pragma unroll 1
    for (int c = 0; c < SEQ / 64; ++c) {
        float cl[8];
        {
            float run = 0.f;
#pragma unroll
            for (int j = 0; j < 8; ++j) { run += bf2f(rw[j][3]); cl[j] = run; }
            ((LAS float*)(L + OFF_TOT))[w * 64 + lane] = run;
        }
        __syncthreads();
        {
            float off = 0.f, tot = 0.f;
#pragma unroll
            for (int q = 0; q < 8; ++q) { const float t_ = ((const LAS float*)(L + OFF_TOT))[q * 64 + lane]; off += (q < w) ? t_ : 0.f; tot += t_; }
            const float pLt = __expf(tot);
            if (w == 0) ((LAS float*)(L + OFF_PL))[lane] = pLt;
            float pprev = __expf(off);
            float at8[8], bt8[8], kt8[8], rt8[8], bb8[8], kb8[8]; unsigned vt[4];
#pragma unroll
            for (int j = 0; j < 8; ++j) {
                const float r = bf2f(rw[j][0]), k = bf2f(rw[j][1]), al = bf2f(rw[j][4]);
                const float p = __expf(cl[j] + off), em = __builtin_amdgcn_rcpf(p), eL = pLt * em;
                const float kk = k * kkc * inr[j], kdv = k * (1.0f + (al - 1.0f) * kac), bbj = kk * al;
                at8[j] = -kk * pprev; pprev = p; bt8[j] = bbj * em; kt8[j] = kdv * em; rt8[j] = r * p; bb8[j] = bbj * eL; kb8[j] = kdv * eL;
                if (j & 1) vt[j >> 1] |= ((unsigned)rw[j][2] << 16); else vt[j >> 1] = rw[j][2];
            }
            const int o16 = (lane * TS + w * 8) * 2;
            *(LAS v4u*)(TILE(SL_ATC) + o16) = pack8(at8); *(LAS v4u*)(TILE(SL_BTC) + o16) = pack8(bt8); *(LAS v4u*)(TILE(SL_KTC) + o16) = pack8(kt8); *(LAS v4u*)(TILE(SL_RTC) + o16) = pack8(rt8);
            *(LAS v4u*)(TILE(SL_BBT) + o16) = pack8(bb8); *(LAS v4u*)(TILE(SL_KBT) + o16) = pack8(kb8); *(LAS v4u*)(TILE(SL_VT) + o16) = (v4u){vt[0], vt[1], vt[2], vt[3]};
        }
        if (c + 1 < SEQ / 64) RAW_LOAD(c + 1);
        __syncthreads();
        f32x4 accT[2], accH[2];
        {
            const Fr aBT = ldfT(TILE(SL_BTC), ta * 16, lane), aAT = ldfT(TILE(SL_ATC), ta * 16, lane), aKT = ldfT(TILE(SL_KTC), ta * 16, lane);
            Fr bAT[2], bKT[2], bRT[2];
#pragma unroll
            for (int q = 0; q < 2; ++q) { bAT[q] = ldfT(TILE(SL_ATC), (tb0 + q) * 16, lane); bKT[q] = ldfT(TILE(SL_KTC), (tb0 + q) * 16, lane); bRT[q] = ldfT(TILE(SL_RTC), (tb0 + q) * 16, lane); }
            f32x4 d2[2], d3[2], d4[2];
#pragma unroll
            for (int q = 0; q < 2; ++q) { d2[q] = ZERO4; d3[q] = ZERO4; d4[q] = ZERO4; accH[q] = ZERO4;
                mmf(d2[q], aBT, bAT[q]);
                mmf(d3[q], aAT, bKT[q]);
                mmf(d4[q], aBT, bRT[q]);
                mmf(accH[q], aKT, bRT[q]); }
#pragma unroll
            for (int q = 0; q < 2; ++q) { const int bcol = (tb0 + q) * 16 + l15;
#pragma unroll
                for (int e = 0; e < 4; ++e) { const bool lt = bcol < a0 + e, gt = a0 + e < bcol, ge = a0 + e <= bcol;
                    d3[q][e] = lt ? d3[q][e] : 0.f;
                    d2[q][e] = gt ? d2[q][e] : 0.f; d4[q][e] = ge ? d4[q][e] : 0.f; accH[q][e] = ge ? accH[q][e] : 0.f; }
                st4(TILE(SL_NKA), bcol, a0, d3[q]); st4(TILE(SL_XCA), bcol, a0, d2[q]); st4(TILE(SL_NBRT), bcol, a0, d4[q]);
#pragma unroll
                for (int e = 0; e < 4; ++e) d2[q][e] += (a0 + e == bcol) ? 1.0f : 0.f;
                accT[q] = d2[q]; st4(TILE(SL_TTA), bcol, a0, d2[q]); }
        }
        __syncthreads();
#pragma unroll
        for (int r = 0; r <= 5; ++r) {
            LAS unsigned char* Xc = (r & 1) ? TILE(SL_XCB) : TILE(SL_XCA); LAS unsigned char* Xc2 = (r & 1) ? TILE(SL_XCA) : TILE(SL_XCB);
            LAS unsigned char* TTr = ((r - 1) & 1) ? TILE(SL_TTB) : TILE(SL_TTA); LAS unsigned char* TTw = (r & 1) ? TILE(SL_TTB) : TILE(SL_TTA);
            const Fr aX = ldfT(Xc, ta * 16, lane); Fr bTT[2], bX[2];
#pragma unroll
            for (int q = 0; q < 2; ++q) { if (r >= 1) bTT[q] = ldf(TTr, (tb0 + q) * 16, lane); if (r < 5) bX[q] = ldf(Xc, (tb0 + q) * 16, lane); }
            f32x4 x1[2];
#pragma unroll
            for (int q = 0; q < 2; ++q) {
                if (r >= 1) mmf(accT[q], aX, bTT[q]);
                if (r < 5) { x1[q] = ZERO4; mmf(x1[q], aX, bX[q]); } }
#pragma unroll
            for (int q = 0; q < 2; ++q) { const int bcol = (tb0 + q) * 16 + l15;
                if (r >= 1) st4(TTw, bcol, a0, accT[q]);
                if (r < 5) st4(Xc2, bcol, a0, x1[q]); }
            __syncthreads();
        }
        {
            const Fr aATC = ldf(TILE(SL_ATC), ta * 16, lane), aTT = ldf(TILE(SL_TTB), ta * 16, lane); Fr bTT[2], bNKA[2];
#pragma unroll
            for (int q = 0; q < 2; ++q) { bTT[q] = ldf(TILE(SL_TTB), (tb0 + q) * 16, lane); bNKA[q] = ldf(TILE(SL_NKA), (tb0 + q) * 16, lane); }
            f32x4 e1[2], e3[2];
#pragma unroll
            for (int q = 0; q < 2; ++q) { e1[q] = ZERO4; e3[q] = ZERO4;
                mmf(e1[q], aATC, bTT[q]);
                mmf(e3[q], aTT, bNKA[q]); }
#pragma unroll
            for (int q = 0; q < 2; ++q) { const int bcol = (tb0 + q) * 16 + l15; st4(TILE(SL_APT), bcol, a0, e1[q]); st4(TILE(SL_G), bcol, a0, e3[q]); }
        }
        __syncthreads();
        {
            const Fr aNB = ldf(TILE(SL_NBRT), ta * 16, lane), aG = ldf(TILE(SL_G), ta * 16, lane); Fr bAP[2], bNB[2], bBB[2]; f32x4 rp[2], ps[2];
#pragma unroll
            for (int q = 0; q < 2; ++q) { const int bcol = (tb0 + q) * 16 + l15; bAP[q] = ldfT(TILE(SL_APT), (tb0 + q) * 16, lane); bNB[q] = ldf(TILE(SL_NBRT), (tb0 + q) * 16, lane); bBB[q] = ldf(TILE(SL_BBT), (tb0 + q) * 16, lane);
                rp[q] = ld4(TILE(SL_RTC), bcol, a0); ps[q] = ld4(TILE(SL_KBT), bcol, a0); }
#pragma unroll
            for (int q = 0; q < 2; ++q) { mmf(rp[q], aNB, bAP[q]);
                mmf(accH[q], aG, bNB[q]);
                mmf(ps[q], aG, bBB[q]); }
#pragma unroll
            for (int q = 0; q < 2; ++q) { const int bcol = (tb0 + q) * 16 + l15;
                st4(TILE(SL_RP), bcol, a0, rp[q]); st4(TILE(SL_HT), bcol, a0, accH[q]); st4(TILE(SL_PSIT), bcol, a0, ps[q]); }
        }
        __syncthreads();
        if (w < 4) {
            const int vrow = w * 16 + l15;
            const Fr fS = ldf(TILE(SL_SB), w * 16, lane), fV = ldf(TILE(SL_VT), w * 16, lane);
            f32x4 wv[4], yv[4];
            {
                Fr fAPT[4];
#pragma unroll
                for (int q = 0; q < 4; ++q) fAPT[q] = ldf(TILE(SL_APT), q * 16, lane);
#pragma unroll
                for (int q = 0; q < 4; ++q) { wv[q] = ZERO4; mmf(wv[q], fAPT[q], fS); }
#pragma unroll
                for (int q = 0; q < 4; ++q) st4(TILE(SL_WB), vrow, q * 16 + 4 * g4, wv[q]);
            }
            {
                Fr fRPT[4], fHT[4];
#pragma unroll
                for (int q = 0; q < 4; ++q) { fRPT[q] = ldfT(TILE(SL_RP), q * 16, lane); fHT[q] = ldf(TILE(SL_HT), q * 16, lane); }
#pragma unroll
                for (int q = 0; q < 4; ++q) { yv[q] = ZERO4; mmf(yv[q], fS, fRPT[q]); mmf(yv[q], fV, fHT[q]); }
#pragma unroll
                for (int q = 0; q < 4; ++q) { const int s_ = c * 64 + q * 16 + l15; const int t_ = dir ? (SEQ - 1 - s_) : s_;
                    v2u o; o.x = pg8::cvt_pk_bf16(yv[q][0], yv[q][1]); o.y = pg8::cvt_pk_bf16(yv[q][2], yv[q][3]);
                    *(v2u*)(YS + ((size_t)b * SEQ + t_) * 1024 + hh * 64 + w * 16 + 4 * g4) = o; }
            }
            {
                Fr fPS[4];
#pragma unroll
                for (int q = 0; q < 4; ++q) fPS[q] = ldf(TILE(SL_PSIT), q * 16, lane);
#pragma unroll
                for (int q = 0; q < 4; ++q) { const f32x4 pl = *(const LAS f32x4*)(L + OFF_PL + (q * 16 + 4 * g4) * 4); accS[q] = accS[q] * pl; mmf(accS[q], fPS[q], fV); }
                LWAIT();
                const Fr fW = ldf(TILE(SL_WB), w * 16, lane); Fr fBB[4];
#pragma unroll
                for (int q = 0; q < 4; ++q) fBB[q] = ldf(TILE(SL_BBT), q * 16, lane);
#pragma unroll
                for (int q = 0; q < 4; ++q) { mmf(accS[q], fBB[q], fW); st4(TILE(SL_SB), vrow, q * 16 + 4 * g4, accS[q]); }
            }
        }
    }
#undef RAW_LOAD
}
#undef TILE
#undef LWAIT
}
__global__ void __launch_bounds__(NTHREADS, 2) mega_fwd(Args a) {
    extern __shared__ __attribute__((aligned(16))) unsigned char lds[];
    cg::grid_group grid = cg::this_grid();
    const int G = gridDim.x, bx = blockIdx.x;
    const int vcu = (G % 8 == 0) ? (bx % 8) * (G / 8) + bx / 8 : bx;
    const int NGW = G * NWAVES;
#define WIDS() const int tid = fresh_tid(), lane = tid & 63, wave = __builtin_amdgcn_readfirstlane(tid >> 6), gw = vcu * NWAVES + wave; (void)lane; (void)gw
    unsigned char* ws = a.ws;
    LAS unsigned char* lds3 = (LAS unsigned char*)lds;
    const int lo = a.ph_lo, hi = a.ph_hi;
#ifndef ONLY
#define ONLY -1
#endif
#define IN(k) (lo <= (k) && (k) < hi && (ONLY < 0 || ONLY == (k)))
#ifndef PROBE_S
#define PROBE_S 0
#endif
#ifndef PROBE_A
#define PROBE_A 0
#endif
#ifndef DUPMASK
#define DUPMASK 0
#endif
#ifndef USE_CG
#define USE_CG 0
#endif
#define GRIDBAR(k) do { if (USE_CG || a.ph_hi > 1000) grid.sync(); else xcd_barrier(bar); } while (0)
#define SEAM(k) do { if (IN(k) && IN((k) + 1)) GRIDBAR(k); } while (0)
#define PH_BEGIN(k) if (IN(k)) for (int rep_ = 0; rep_ <= ((DUPMASK >> (k)) & 1); ++rep_) { if (rep_) GRIDBAR(1);
#define PH_END(k) } SEAM(k);
    for (int u = fresh_tid(); u < 64; u += NTHREADS) ((LAS unsigned*)(lds3 + MISC_OFF))[u] = 0u;
    __syncthreads();
    XcdBarrier bar = xcd_barrier_post((unsigned*)(ws + WS_BAR), (volatile LAS unsigned*)(lds3 + MISC_OFF) + 8);

    PH_BEGIN(0) { WIDS(); p0_prologue(a, lds3, gw, NGW, wave, lane); } PH_END(0)
    PH_BEGIN(1) {
        pg8::Gemm g{(const bf16_t*)(ws + WS_HN), (const bf16_t*)(ws + WS_WINT), DM, DM, DM}; pg8::StaticOrder S; S.init(M, IN_PAD, G, bx);
        pg8::EpiProj E{(bf16_t*)(ws + WS_PDA), (bf16_t*)((unsigned char*)a.out + DO_PRW), (bf16_t*)(ws + WS_GATES)};
        pg8::gemm_phase<pg8::EpiProj, pg8::StaticOrder, true, true>(lds3, g, S, E);
        if (G == 256 && bx >= 128) { WIDS(); expert_convert_down(a, lds3, (bx - 128) * NWAVES + wave, 128 * NWAVES, wave, lane); }
        else if (G != 256) { WIDS(); expert_convert_down(a, lds3, gw, NGW, wave, lane); }
    } PH_END(1)
    PH_BEGIN(2) { WIDS(); p2_prep(a, gw, NGW, lane); } PH_END(2)
    PH_BEGIN(3) {
        const bf16_t* LIN = (const bf16_t*)((unsigned char*)a.out + DO_LIN);
        { pg8::Gemm g{LIN, (const bf16_t*)(ws + WS_BTL1), 512, 256, 256}; pg8::StaticOrder S; S.init(M, 4096, G, bx);
          pg8::EpiLora<0> E{(bf16_t*)(ws + WS_LORA), (const float*)(ws + WS_BIAS4)};
          pg8::gemm_phase<pg8::EpiLora<0>, pg8::StaticOrder, true, true>(lds3, g, S, E); }
        { pg8::Gemm g{LIN + 256, (const bf16_t*)(ws + WS_BTL2), 512, 256, 256}; pg8::StaticOrder S; S.init(M, 1024, G, bx);
          pg8::EpiLora<1> E{(bf16_t*)(ws + WS_LORA), nullptr};
          pg8::gemm_phase<pg8::EpiLora<1>, pg8::StaticOrder, true, true>(lds3, g, S, E); }
    } PH_END(3)
    PH_BEGIN(4) { WIDS();
        const float* sm = (const float*)(ws + WS_SMALL); const float d1 = wave_sum(sm[SM_LQ1 + lane] * sm[SM_LK1 + lane]), d2 = wave_sum(sm[SM_LQ2 + lane] * sm[SM_LK2 + lane]);
        const float lam = __expf(d1) - __expf(d2) + LAM_INIT;
        const bf16_t* PDA = (const bf16_t*)(ws + WS_PDA); bf16_t* YA = (bf16_t*)((unsigned char*)a.out + DO_YAB);
        if (G == 256) {
            int u0, nu;
            if (bx < 128) {
#if PROBE_S
                scan::scan_phase(a, lds); __syncthreads();
#endif
                scan::scan_phase(a, lds); __syncthreads(); const int i = (bx & 7) * 16 + (bx >> 3); u0 = 896 + i; nu = 1; }
            else { const int k = bx - 128, i = (k & 7) * 16 + (k >> 3); u0 = 7 * i; nu = 7; }
            for (int q = (PROBE_A && bx >= 128) ? -1 : 0; q < nu; ++q) { const int u = u0 + (q < 0 ? 0 : q); const int bh = u >> 5, qb = u & 31, b = bh >> 3, h = bh & 7;
                const size_t row0 = (size_t)b * SEQ;
                attn::attn_unit(PDA + (row0 + qb * 128) * 3072 + h * 128, PDA + row0 * 3072 + 1024 + h * 128, PDA + row0 * 3072 + 2048 + h * 128,
                                YA + (row0 + qb * 128) * 2048 + h * 128, lam, sm + SM_SUBLN, SEQ, (char*)lds); }
            if (bx < 128) { __syncthreads(); expert_convert_gu(a, lds3, bx * NWAVES + wave, 128 * NWAVES, wave, lane, 0, N_EARLY_EXPERTS); }
        } else {
        const int upb = 1024 / G;
        for (int i = 0; i < upb; ++i) { const int u = vcu * upb + i; const int bh = u >> 5, qb = u & 31, b = bh >> 3, h = bh & 7;
            const size_t row0 = (size_t)b * SEQ;
            attn::attn_unit(PDA + (row0 + qb * 128) * 3072 + h * 128, PDA + row0 * 3072 + 1024 + h * 128, PDA + row0 * 3072 + 2048 + h * 128,
                            YA + (row0 + qb * 128) * 2048 + h * 128, lam, sm + SM_SUBLN, SEQ, (char*)lds); }
        }
    } PH_END(4)
    if (G != 256) { PH_BEGIN(5) { scan::scan_phase(a, lds); } PH_END(5) }
    PH_BEGIN(6) { WIDS(); p6_rwpost(a, gw, NGW, lane); } PH_END(6)
    PH_BEGIN(7) {
        bf16_t* MG = (bf16_t*)(ws + WS_MERGED); const bf16_t* GT = (const bf16_t*)(ws + WS_GATES);
        { pg8::Gemm g{(const bf16_t*)((unsigned char*)a.out + DO_YAB), (const bf16_t*)(ws + WS_WAT), DM, DM, DM}; pg8::StaticOrder S; S.init(M, DM, G, bx);
          pg8::EpiMergeF E{MG, GT}; pg8::gemm_phase<pg8::EpiMergeF, pg8::StaticOrder, true, true>(lds3, g, S, E); }
    } PH_END(7)
    PH_BEGIN(8) {
        pg8::Gemm g{(const bf16_t*)(ws + WS_MERGED), (const bf16_t*)(ws + WS_WOT), DM, DM, DM}; pg8::StaticOrder S; S.init(M, DM, G, bx);
        pg8::EpiOut E{a.in[I_X], a.out, (float*)(ws + WS_SSP)};
        pg8::gemm_phase<pg8::EpiOut, pg8::StaticOrder, true, true>(lds3, g, S, E);
    } PH_END(8)
    PH_BEGIN(9) { WIDS(); p9_router(a, lds3, gw, NGW, wave, lane); } PH_END(9)
    PH_BEGIN(10) { p10_topk(a, lds); } PH_END(10)
    if (G != 256) { PH_BEGIN(11) { WIDS(); p11_gather(a, gw, NGW, lane); } PH_END(11) }
    PH_BEGIN(12) {
        pg8::EpiMoeUp E{(bf16_t*)(ws + WS_HID)};
        if (G == 256) {
            pg8::Gemm g{(const bf16_t*)(ws + WS_HN2), (const bf16_t*)ws, DM, DM, DM}; pg8::ExpertGatherOrder S{G, bx, (const int*)(ws + WS_SELTOK)};
            pg8::gemm_phase_g<pg8::EpiMoeUp, pg8::ExpertGatherOrder, true, true>(lds3, g, S, E);
        } else {
            pg8::Gemm g{(const bf16_t*)(ws + WS_XE), (const bf16_t*)(ws + WS_W1T), DM, DM, DM}; pg8::ExpertOrder S{G, bx};
            pg8::gemm_phase<pg8::EpiMoeUp, pg8::ExpertOrder, true, true>(lds3, g, S, E);
        }
    } PH_END(12)
    PH_BEGIN(13) {
        pg8::Gemm g{(const bf16_t*)(ws + WS_HID), (const bf16_t*)(ws + WS_WDT), FF, FF, FF}; pg8::ExpertOrder S{G, bx};
        pg8::EpiMoeDown E{(bf16_t*)(ws + WS_XE), (const float*)(ws + WS_SELGATE)};
        pg8::gemm_phase<pg8::EpiMoeDown, pg8::ExpertOrder, true, true>(lds3, g, S, E);
    } PH_END(13)
    PH_BEGIN(14) { WIDS(); p14_combine(a, lds, wave, lane); } }
#undef IN
#undef SEAM
}

constexpr int NPHASES = 15;
#ifndef MK_SPLIT
#define MK_SPLIT 0
#endif
extern "C" void kernel_launch(void* const* d_in, const int* in_sizes, int n_in, void* d_out, int out_size, void* d_ws, size_t ws_size, hipStream_t stream) {
    static int grid = 0;
    if (grid == 0) {
        if (n_in != 33 || in_sizes[0] != M * DM || out_size != M * DM || ws_size < WS_NEED) {
            fprintf(stderr, "kernel_launch: unexpected shapes: n_in %d in0 %d out %d ws %zu (need %zu)\n", n_in, n_in > 0 ? in_sizes[0] : -1, out_size, ws_size, (size_t)WS_NEED); grid = -1; return; }
        int dev = 0, cus = 0, per_cu = 0;
        if (hipGetDevice(&dev) != hipSuccess || hipDeviceGetAttribute(&cus, hipDeviceAttributeMultiprocessorCount, dev) != hipSuccess) { grid = -1; return; }
        if (hipFuncSetAttribute((const void*)mega_fwd, hipFuncAttributeMaxDynamicSharedMemorySize, LDS_BYTES) != hipSuccess) { fprintf(stderr, "kernel_launch: hipFuncSetAttribute failed\n"); grid = -1; return; }
        if (hipOccupancyMaxActiveBlocksPerMultiprocessor(&per_cu, (const void*)mega_fwd, NTHREADS, LDS_BYTES) != hipSuccess || per_cu < 1) { fprintf(stderr, "kernel_launch: occupancy query says %d\n", per_cu); (void)hipGetLastError(); per_cu = 1; }
        grid = cus;
        if (grid != 256) fprintf(stderr, "kernel_launch: note: %d CUs (tuned for 256)\n", grid);
    }
    if (grid < 0) return;
    if (hipMemsetAsync((char*)d_ws + WS_BAR, 0, 16384, stream) != hipSuccess) { fprintf(stderr, "kernel_launch: memset failed\n"); return; }
    Args a{};
    for (int i = 0; i < 33; ++i) a.in[i] = (const float*)d_in[i];
    a.out = (float*)d_out; a.ws = (unsigned char*)d_ws;
#if MK_SPLIT
    for (int p = 0; p < NPHASES; ++p) { a.ph_lo = p; a.ph_hi = p + 1; void* args[] = {&a};
        hipError_t e = hipLaunchCooperativeKernel((const void*)mega_fwd, dim3(grid), dim3(NTHREADS), args, LDS_BYTES, stream);
        if (e != hipSuccess) { fprintf(stderr, "kernel_launch: launch of phase %d failed: %s\n", p, hipGetErrorString(e)); return; } }
#else
    a.ph_lo = 0; a.ph_hi = NPHASES; void* args[] = {&a};
    hipError_t e = hipLaunchCooperativeKernel((const void*)mega_fwd, dim3(grid), dim3(NTHREADS), args, LDS_BYTES, stream);
    if (e != hipSuccess) fprintf(stderr, "kernel_launch: cooperative launch failed: %s (grid %d)\n", hipGetErrorString(e), grid);
#endif
}
```

```cpp
#include <hip/hip_runtime.h>
#include <hip/hip_cooperative_groups.h>
#include <cstdio>
#include <cstdint>
namespace cg = cooperative_groups;

constexpr int NB = 4, SEQ = 4096, M = NB * SEQ, DM = 2048;
constexpr int DA_COLS = 3072, RW_COLS = 3488, RW_PAD = 3584, GATE_COLS = 4096, IN_COLS = 10656, IN_PAD = 10752;
constexpr int NE = 16, FF = 1024, CAP = 512, NSLOT = NB * NE * CAP;
constexpr float RMS_EPS = 1e-6f, GN_EPS = 64e-5f, LAM_INIT = 0.2f;
constexpr int NWAVES = 8, NTHREADS = 512;

constexpr size_t MiB = 1u << 20;
constexpr size_t WS_SSP = 5 * MiB;
constexpr size_t WS_SELTOK = 128 * 1024;
constexpr size_t WS_SELGATE = 256 * 1024;
constexpr size_t WS_BIAS4 = 512 * 1024;
constexpr size_t WS_SMALL = 576 * 1024;
constexpr int SM_QNG = 0, SM_KNG = 64, SM_LQ1 = 128, SM_LK1 = 192, SM_LQ2 = 256, SM_LK2 = 320, SM_SUBLN = 384, SM_MU = 512, SM_KK = 4096, SM_KA = 5120, SM_RK = 6144,
              SM_LNW = 7168, SM_LNB = 8192, SM_FNG = 9216, SM_WR = 11264, SM_END = 44032;
constexpr size_t WS_BAR = 768 * 1024;
constexpr size_t WS_INRM = 1 * MiB;
constexpr size_t WS_AFF = 1 * MiB;
constexpr size_t WS_ROPE = 7 * MiB;
constexpr size_t WS_BTL1 = 2 * MiB;
constexpr size_t WS_BTL2 = 4 * MiB;
constexpr size_t WS_WAT = 8 * MiB, WS_WBT = 12 * MiB, WS_WOT = 16 * MiB;
constexpr size_t WS_HN = 24 * MiB;
constexpr size_t WS_RKV = 24 * MiB;
constexpr size_t WS_WINT = 88 * MiB;
constexpr size_t WS_PDA = 130 * MiB;
constexpr size_t WS_MERGED = 130 * MiB;
constexpr size_t WS_GATES = 226 * MiB;
constexpr size_t WS_LORA = 354 * MiB;
constexpr size_t WS_END1 = 546 * MiB;
constexpr size_t WS_W1T = 24 * MiB;
__host__ __device__ __forceinline__ size_t w1t_base(int e) { return e < 4 ? (514 + 8 * (size_t)e) * MiB : e < 6 ? (610 + 8 * (size_t)(e - 4)) * MiB : e == 6 ? 120 * MiB : WS_W1T + 8 * (size_t)(e - 7) * MiB; }
constexpr int N_EARLY_EXPERTS = 7, N_EARLY_S = 5;
constexpr size_t WS_WDT = 546 * MiB;
constexpr size_t WS_XE = 216 * MiB;
constexpr size_t WS_HN2 = 216 * MiB;
constexpr size_t WS_HID = 344 * MiB;
constexpr size_t WS_NEED = 626 * MiB;
constexpr size_t DO_PRW = 0, DO_LIN = 112 * MiB, DO_YSF = 0, DO_YSB = 32 * MiB, DO_YAB = 64 * MiB;

constexpr int MISC_OFF = 155648;
constexpr int LDS_BYTES = 159744;

#define LAS __attribute__((address_space(3)))
typedef unsigned short bf16_t;
typedef unsigned v4u __attribute__((ext_vector_type(4)));
typedef unsigned v2u __attribute__((ext_vector_type(2)));

__device__ __forceinline__ int fresh_tid() { int t = threadIdx.x; asm volatile("" : "+v"(t)); return t; }
__device__ __forceinline__ float bf2f(unsigned short b) { return __builtin_bit_cast(float, (unsigned)b << 16); }
__device__ __forceinline__ float bflo(unsigned w) { return __builtin_bit_cast(float, w << 16); }
__device__ __forceinline__ float bfhi(unsigned w) { return __builtin_bit_cast(float, w & 0xffff0000u); }
__device__ __forceinline__ unsigned f2bf(float f) { unsigned u = __builtin_bit_cast(unsigned, f); return (u + 0x7fffu + ((u >> 16) & 1u)) >> 16; }
typedef float f32x2_t __attribute__((ext_vector_type(2))); typedef __bf16 bf16x2_t __attribute__((ext_vector_type(2)));
__device__ __forceinline__ unsigned pk2(float lo, float hi) { f32x2_t v = {lo, hi}; bf16x2_t b = __builtin_convertvector(v, bf16x2_t); return __builtin_bit_cast(unsigned, b); }
__device__ __forceinline__ float sigmoidf_(float x) { return __builtin_amdgcn_rcpf(1.0f + __expf(-x)); }
__device__ __forceinline__ float wave_sum(float v) {
#pragma unroll
    for (int o = 1; o < 64; o <<= 1) v += __shfl_xor(v, o);
    return v;
}
__device__ __forceinline__ float sum8(float v) { v += __shfl_xor(v, 1); v += __shfl_xor(v, 2); v += __shfl_xor(v, 4); return v; }
__device__ __forceinline__ void unpack8(const v4u& w, float (&f)[8]) {
    f[0] = bflo(w.x); f[1] = bfhi(w.x); f[2] = bflo(w.y); f[3] = bfhi(w.y); f[4] = bflo(w.z); f[5] = bfhi(w.z); f[6] = bflo(w.w); f[7] = bfhi(w.w);
}
__device__ __forceinline__ v4u pack8(const float (&f)[8]) { v4u w; w.x = pk2(f[0], f[1]); w.y = pk2(f[2], f[3]); w.z = pk2(f[4], f[5]); w.w = pk2(f[6], f[7]); return w; }

#define XB_TMO      128
#define XB_XCNT(j)  (256  + 64 * (j))
#define XB_XSUB(j)  (1280 + 64 * (j))
#define XB_XGEN(j)  (2304 + 64 * (j))
#define XB_TOP      3328
#define XB_TOPGEN   3392
#define XCD_BAR_WORDS 3456
#define XB_SPIN_CAP (1u << 18)

__device__ __forceinline__ unsigned xb_ld(unsigned* p)              { return __hip_atomic_load(p, __ATOMIC_RELAXED, __HIP_MEMORY_SCOPE_AGENT); }
__device__ __forceinline__ unsigned xb_add(unsigned* p, unsigned v) { return __hip_atomic_fetch_add(p, v, __ATOMIC_RELAXED, __HIP_MEMORY_SCOPE_AGENT); }
__device__ __forceinline__ unsigned xb_xcc_id() { return (unsigned)__builtin_amdgcn_s_getreg((3 << 11) | 20) & 0xFu; }
#define XB_SPIN(cond, bar) do { unsigned _sp = 0; while (cond) { __builtin_amdgcn_s_sleep(1); \
    if ((++_sp & 255u) == 0u) { if (xb_ld(&(bar)[XB_TMO])) break; if (_sp > XB_SPIN_CAP) { atomicAdd(&(bar)[XB_TMO], 1u); break; } } } } while (0)

struct XcdBarrier {
    unsigned* bar; unsigned x;
    volatile LAS unsigned* st;
};

__device__ __forceinline__ XcdBarrier xcd_barrier_post(unsigned* bar, volatile LAS unsigned* st) {
    XcdBarrier b; b.bar = bar; b.x = xb_xcc_id(); b.st = st;
    if (threadIdx.x == 0) (void)xb_add(&bar[XB_XCNT(b.x)], 1u);
    return b;
}
__device__ __forceinline__ void xcd_barrier_complete(unsigned* bar, unsigned x, unsigned& nloc, unsigned& nx) {
    const unsigned G = gridDim.x * gridDim.y * gridDim.z;
    unsigned sum, cnt, mine, sp = 0u;
    for (;;) {
        sum = 0u; cnt = 0u; mine = 0u;
#pragma unroll
        for (unsigned j = 0; j < 16; ++j) { const unsigned c = xb_ld(&bar[XB_XCNT(j)]); sum += c; cnt += (c > 0u) ? 1u : 0u; mine = (j == x) ? c : mine; }
        if (sum == G) break;
        __builtin_amdgcn_s_sleep(1);
        if ((++sp & 255u) == 0u) { if (xb_ld(&bar[XB_TMO])) break; if (sp > XB_SPIN_CAP) { atomicAdd(&bar[XB_TMO], 1u); break; } }
    }
    nloc = mine > 0u ? mine : 1u; nx = cnt > 0u ? cnt : 1u;
}

__device__ __forceinline__ void xcd_barrier(const XcdBarrier& b) {
    asm volatile("s_waitcnt vmcnt(0)" ::: "memory");
    __syncthreads();
    if (threadIdx.x == 0) {
        unsigned* bar = b.bar;
        __builtin_amdgcn_s_waitcnt(0);
        unsigned nloc = b.st[0], nx = b.st[1];
        if (nloc == 0u) { xcd_barrier_complete(bar, b.x, nloc, nx); b.st[0] = nloc; b.st[1] = nx; }
        const unsigned old = xb_add(&bar[XB_XSUB(b.x)], 1u);
        const unsigned gen = old / nloc;
        if (old + 1u == (gen + 1u) * nloc) {
            __builtin_amdgcn_fence(__ATOMIC_RELEASE, "agent");
            asm volatile("s_waitcnt vmcnt(0)" ::: "memory");
            const unsigned og = xb_add(&bar[XB_TOP], 1u);
            const unsigned tg = og / nx;
            if (og + 1u == (tg + 1u) * nx) xb_add(&bar[XB_TOPGEN], 1u);
            else XB_SPIN(xb_ld(&bar[XB_TOPGEN]) == tg, bar);
            __builtin_amdgcn_fence(__ATOMIC_ACQUIRE, "agent");
            xb_add(&bar[XB_XGEN(b.x)], 1u);
            asm volatile("s_waitcnt vmcnt(0)" ::: "memory");
        } else {
            XB_SPIN(xb_ld(&bar[XB_XGEN(b.x)]) == gen, bar);
            __builtin_amdgcn_fence(__ATOMIC_ACQUIRE, "agent");
            asm volatile("s_waitcnt vmcnt(0)" ::: "memory");
        }
    }
    __syncthreads();
}
namespace pg8 {
#define PG8_LAS __attribute__((address_space(3)))
typedef unsigned short bf16_t;
typedef short bf16x8 __attribute__((ext_vector_type(8)));
typedef float f32x4 __attribute__((ext_vector_type(4)));
typedef unsigned u32x4 __attribute__((ext_vector_type(4)));
constexpr int BM = 256, BK = 64, HALF = 128, HTB = HALF * BK * 2  , STAGE_BYTES = 8 * HTB, NXCD = 8, WGM = 4;

__host__ __device__ __forceinline__ int lds_byte(int r, int c) { const int st = (r >> 4) * 2 + (c >> 5), rr = r & 15, cc = c & 31, ob = rr * 64 + cc * 2; return st * 1024 + (ob ^ (((ob >> 9) & 1) << 5)); }
__host__ __device__ __forceinline__ void stage_rc(int b, int& R, int& C) { const int st = b / 1024, sb = b % 1024, swz = sb ^ (((sb >> 9) & 1) << 5); R = (st >> 1) * 16 + swz / 64; C = (st & 1) * 32 + (swz % 64) / 2; }
__host__ __device__ __forceinline__ int perm32(int rho) { const int n = rho >> 4, i = rho & 15; return 8 * (i >> 2) + 4 * n + (i & 3); }

struct Unit { int pm, pn; };
struct Gemm { const bf16_t* A; const bf16_t* Bt; int lda, ldb, K; };

struct StaticOrder {
    int nM, nN, nwg, G, c;
    __host__ __device__ void init(int M, int N, int G_, int c_) { nM = M / BM; nN = N / BM; nwg = nM * nN; G = G_; c = c_; }
    __host__ __device__ bool next(int i, Unit& u) const {
        const long L = (long)i * G + c; if (L >= nwg) return false;
        int wgid = (int)L; { const int q = nwg / NXCD, r = nwg % NXCD, xcd = wgid % NXCD, off = wgid / NXCD; wgid = (xcd < r ? xcd * (q + 1) : r * (q + 1) + (xcd - r) * q) + off; }
        const int nig = WGM * nN, gid = wgid / nig, fm = gid * WGM, gsz = (nM - fm) < WGM ? (nM - fm) : WGM;
        u.pm = fm + ((wgid % nig) % gsz); u.pn = (wgid % nig) / gsz; return true;
    }
    __device__ __forceinline__ void a_ready(const Unit&) const {}
    __device__ __forceinline__ void done(const Unit&) const {}
};

__device__ __forceinline__ unsigned cvt_pk_bf16(float lo, float hi) { return pk2(lo, hi); }
__device__ __forceinline__ u32x4 pack_bf16x8(const f32x4& v0, const f32x4& v1) { u32x4 w; w.x = cvt_pk_bf16(v0[0], v0[1]); w.y = cvt_pk_bf16(v0[2], v0[3]); w.z = cvt_pk_bf16(v1[0], v1[1]); w.w = cvt_pk_bf16(v1[2], v1[3]); return w; }
__device__ __forceinline__ float sigm(float x) { return __builtin_amdgcn_rcpf(1.0f + __expf(-x)); }
__device__ __forceinline__ f32x4 sigm4(f32x4 v) { return (f32x4){sigm(v[0]), sigm(v[1]), sigm(v[2]), sigm(v[3])}; }
__device__ __forceinline__ void unpk8(const u32x4& w, f32x4& a, f32x4& b) {
    a = (f32x4){__builtin_bit_cast(float, w.x << 16), __builtin_bit_cast(float, w.x & 0xffff0000u), __builtin_bit_cast(float, w.y << 16), __builtin_bit_cast(float, w.y & 0xffff0000u)};
    b = (f32x4){__builtin_bit_cast(float, w.z << 16), __builtin_bit_cast(float, w.z & 0xffff0000u), __builtin_bit_cast(float, w.w << 16), __builtin_bit_cast(float, w.w & 0xffff0000u)};
}

struct EpiProj {
    static constexpr bool PERM = true, AFTER_DRAIN = false, HAS_MID = false, HAS_INIT = false;
    bf16_t* pda; bf16_t* prw; bf16_t* gates;
    __device__ __forceinline__ void operator()(const f32x4 (&acc)[2][2][4][2], const Unit& u, int wr, int wc, int fr, int fq) const {
        const int row0 = u.pm * BM + wr * 64 + fr;
        if (u.pn >= 26) {
            const int col0 = (u.pn - 26) * 128 + wc * 32 + 8 * fq;
#pragma unroll
            for (int ai = 0; ai < 2; ++ai)
#pragma unroll
                for (int m = 0; m < 4; ++m) { bf16_t* rowp = gates + (size_t)(row0 + ai * HALF + m * 16) * 4096 + col0;
                    f32x4 rt[2], gb[2];
#pragma unroll
                    for (int n = 0; n < 2; ++n)
#pragma unroll
                        for (int e = 0; e < 4; ++e) { const float ea = __expf(-acc[ai][0][m][n][e]), eb = __expf(-acc[ai][1][m][n][e]);
                            gb[n][e] = __builtin_amdgcn_rcpf(1.0f + eb); rt[n][e] = (1.0f + eb) * __builtin_amdgcn_rcpf(1.0f + ea); }
                    *(u32x4*)rowp = pack_bf16x8(rt[0], rt[1]); *(u32x4*)(rowp + 2048) = pack_bf16x8(gb[0], gb[1]); }
            return;
        }
        bf16_t* base; int ldc, colt;
        if (u.pn < 12) { base = pda; ldc = 3072; colt = u.pn * 256; }
        else { base = prw; ldc = 3584; colt = (u.pn - 12) * 256; }
        const int col0 = colt + wc * 32 + 8 * fq;
#pragma unroll
        for (int ai = 0; ai < 2; ++ai)
#pragma unroll
            for (int m = 0; m < 4; ++m) { bf16_t* rowp = base + (size_t)(row0 + ai * HALF + m * 16) * ldc + col0;
#pragma unroll
                for (int bj = 0; bj < 2; ++bj) *(u32x4*)(rowp + bj * HALF) = pack_bf16x8(acc[ai][bj][m][0], acc[ai][bj][m][1]); }
    }
};
template <int KIND> struct EpiLora {
    static constexpr bool PERM = true, AFTER_DRAIN = false, HAS_MID = false, HAS_INIT = false;
    bf16_t* out; const float* bias4;
    __device__ __forceinline__ void operator()(const f32x4 (&acc)[2][2][4][2], const Unit& u, int wr, int wc, int fr, int fq) const {
        const int seg = (KIND == 0) ? (u.pn >> 2) : 4, colt = (KIND == 0) ? (u.pn & 3) * 256 : u.pn * 256;
        bf16_t* base = out + (size_t)seg * ((size_t)M * 1024);
        const float* bias = bias4 + (seg & 3) * 1024;
        const int row0 = u.pm * BM + wr * 64 + fr, col0 = colt + wc * 32 + 8 * fq;
        const float sc = (seg < 2) ? -0.60653065971f : 1.0f;
#pragma unroll
        for (int bj = 0; bj < 2; ++bj) {
            f32x4 bv0 = (f32x4){0.f, 0.f, 0.f, 0.f}, bv1 = bv0;
            if (KIND == 0) { bv0 = *(const f32x4*)(bias + col0 + bj * HALF); bv1 = *(const f32x4*)(bias + col0 + bj * HALF + 4); }
#pragma unroll
            for (int ai = 0; ai < 2; ++ai)
#pragma unroll
                for (int m = 0; m < 4; ++m) { bf16_t* rowp = base + (size_t)(row0 + ai * HALF + m * 16) * 1024 + col0;
                    f32x4 v0 = acc[ai][bj][m][0] + bv0, v1 = acc[ai][bj][m][1] + bv1;
                    if (KIND == 0) { v0 = sigm4(v0) * sc; v1 = sigm4(v1) * sc; }
                    *(u32x4*)(rowp + bj * HALF) = pack_bf16x8(v0, v1); }
        }
    }
};
struct EpiMergeF {
    static constexpr bool PERM = true, AFTER_DRAIN = false, HAS_MID = true, HAS_INIT = false;
    bf16_t* merged; const bf16_t* gates;
    template <int HALFSEL> __device__ __forceinline__ void scale(f32x4 (&acc)[2][2][4][2], const Unit& u, int wr, int wc, int fr, int fq, bool store) const {
        int row0 = u.pm * BM + wr * 64 + fr, col0 = u.pn * 256 + wc * 32 + 8 * fq;
        asm volatile("" : "+v"(row0), "+v"(col0));
        u32x4 gw[2][2][2];
#define EMF_LOAD(g) do { _Pragma("unroll") for (int mm = 0; mm < 2; ++mm) _Pragma("unroll") for (int bj = 0; bj < 2; ++bj) \
            gw[(g) & 1][mm][bj] = *(const u32x4*)(gates + (size_t)(row0 + ((g) >> 1) * HALF + (2 * ((g) & 1) + mm) * 16) * 4096 + HALFSEL * 2048 + col0 + bj * HALF); } while (0)
        EMF_LOAD(0);
#pragma unroll
        for (int g = 0; g < 4; ++g) { const int ai = g >> 1, mh = g & 1;
            if (g < 3) EMF_LOAD(g + 1);
#pragma unroll
            for (int mm = 0; mm < 2; ++mm)
#pragma unroll
                for (int bj = 0; bj < 2; ++bj) { const int m = 2 * mh + mm; f32x4 g0, g1; unpk8(gw[g & 1][mm][bj], g0, g1);
                    acc[ai][bj][m][0] *= g0; acc[ai][bj][m][1] *= g1;
                    if (store) *(u32x4*)(merged + (size_t)(row0 + ai * HALF + m * 16) * 2048 + col0 + bj * HALF) = pack_bf16x8(acc[ai][bj][m][0], acc[ai][bj][m][1]); }
            asm volatile("" ::: "memory");
        }
#undef EMF_LOAD
    }
    __device__ __forceinline__ void mid(f32x4 (&acc)[2][2][4][2], const Unit& u, int wr, int wc, int fr, int fq) const { scale<0>(acc, u, wr, wc, fr, fq, false); }
    __device__ __forceinline__ void operator()(const f32x4 (&acc)[2][2][4][2], const Unit& u, int wr, int wc, int fr, int fq) const {
        f32x4 (&ac)[2][2][4][2] = const_cast<f32x4 (&)[2][2][4][2]>(acc); scale<1>(ac, u, wr, wc, fr, fq, true); }
};
struct EpiOut {
    static constexpr bool PERM = false, AFTER_DRAIN = false, HAS_MID = false, HAS_INIT = true;
    const float* x; float* out; float* ss;
    __device__ __forceinline__ void init(f32x4 (&acc)[2][2][4][2], const Unit& u, int wr, int wc, int fr, int fq) const {
        const int row0 = u.pm * BM + wr * 64 + fr, col0 = u.pn * 256 + wc * 32 + 4 * fq;
#pragma unroll
        for (int ai = 0; ai < 2; ++ai)
#pragma unroll
            for (int m = 0; m < 4; ++m)
#pragma unroll
                for (int bj = 0; bj < 2; ++bj)
#pragma unroll
                    for (int n = 0; n < 2; ++n) acc[ai][bj][m][n] = *(const f32x4*)(x + (size_t)(row0 + ai * HALF + m * 16) * 2048 + col0 + bj * HALF + n * 16);
    }
    __device__ __forceinline__ void operator()(const f32x4 (&acc)[2][2][4][2], const Unit& u, int wr, int wc, int fr, int fq) const {
        const int row0 = u.pm * BM + wr * 64 + fr, col0 = u.pn * 256 + wc * 32 + 4 * fq;
#pragma unroll
        for (int ai = 0; ai < 2; ++ai) {
#pragma unroll
            for (int m = 0; m < 4; ++m) { const size_t r = (size_t)(row0 + ai * HALF + m * 16); float s = 0.f;
#pragma unroll
                for (int bj = 0; bj < 2; ++bj)
#pragma unroll
                    for (int n = 0; n < 2; ++n) { const f32x4 h = acc[ai][bj][m][n]; *(f32x4*)(out + r * 2048 + col0 + bj * HALF + n * 16) = h;
                        s += (h[0] * h[0] + h[1] * h[1]) + (h[2] * h[2] + h[3] * h[3]); }
                s += __shfl_xor(s, 16); s += __shfl_xor(s, 32);
                if (fq == 0) ss[r * 32 + u.pn * 4 + wc] = s; }
        }
    }
};
struct EpiMoeUp {
    static constexpr bool PERM = true, AFTER_DRAIN = false, HAS_MID = false, HAS_INIT = false;
    bf16_t* hid;
    __device__ __forceinline__ void operator()(const f32x4 (&acc)[2][2][4][2], const Unit& u, int wr, int wc, int fr, int fq) const {
        const int row0 = u.pm * BM + wr * 64 + fr, col0 = (u.pn & 7) * 128 + wc * 32 + 8 * fq;
#pragma unroll
        for (int ai = 0; ai < 2; ++ai)
#pragma unroll
            for (int m = 0; m < 4; ++m) { bf16_t* rowp = hid + (size_t)(row0 + ai * HALF + m * 16) * 1024 + col0;
                const f32x4 g0 = acc[ai][0][m][0], g1 = acc[ai][0][m][1], u0 = acc[ai][1][m][0], u1 = acc[ai][1][m][1];
                const f32x4 v0 = g0 * sigm4(g0) * u0, v1 = g1 * sigm4(g1) * u1;
                *(u32x4*)rowp = pack_bf16x8(v0, v1); }
    }
};
struct EpiMoeDown {
    static constexpr bool PERM = true, AFTER_DRAIN = false, HAS_MID = false, HAS_INIT = false;
    bf16_t* ye; const float* selgate;
    __device__ __forceinline__ void operator()(const f32x4 (&acc)[2][2][4][2], const Unit& u, int wr, int wc, int fr, int fq) const {
        const int row0 = u.pm * BM + wr * 64 + fr, col0 = (u.pn & 7) * 256 + wc * 32 + 8 * fq;
#pragma unroll
        for (int ai = 0; ai < 2; ++ai)
#pragma unroll
            for (int m = 0; m < 4; ++m) { const int r = row0 + ai * HALF + m * 16; const int e = r >> 11, b = (r >> 9) & 3, c = r & 511;
                const float g = selgate[(b * 16 + e) * 512 + c];
                bf16_t* rowp = ye + (size_t)r * 2048 + col0;
#pragma unroll
                for (int bj = 0; bj < 2; ++bj) *(u32x4*)(rowp + bj * HALF) = pack_bf16x8(acc[ai][bj][m][0] * g, acc[ai][bj][m][1] * g); }
    }
};
struct ExpertOrder {
    int G, c;
    __device__ __forceinline__ bool next(int i, Unit& u) const {
        const int L = i * G + c; if (L >= 1024) return false;
        const int wgid = (L % NXCD) * (1024 / NXCD) + L / NXCD;
        const int e = wgid >> 6, r = wgid & 63; u.pm = e * 8 + (r & 3) + 4 * ((r >> 5) & 1); u.pn = e * 8 + ((r >> 2) & 7); return true;
    }
    __device__ __forceinline__ void a_ready(const Unit&) const {}
    __device__ __forceinline__ void done(const Unit&) const {}
};

struct ExpertGatherOrder {
    int G, c; const int* seltok;
    __device__ __forceinline__ bool next(int i, Unit& u) const {
        const int L = i * G + c; if (L >= 1024) return false;
        const int wgid = (L % NXCD) * (1024 / NXCD) + L / NXCD;
        const int e = wgid >> 6, r = wgid & 63; u.pm = e * 8 + (r & 3) + 4 * ((r >> 5) & 1); u.pn = e * 8 + ((r >> 2) & 7); return true;
    }
    __device__ __forceinline__ int arow(int r) const { const int e = r >> 11, b = (r >> 9) & 3, cc = r & 511; return b * 4096 + seltok[(b * 16 + e) * 512 + cc]; }
    __device__ __forceinline__ size_t boff(const Unit& u) const { return w1t_base(u.pn >> 3) + (size_t)(u.pn & 7) * (256 * 2048 * 2); }
    __device__ __forceinline__ void a_ready(const Unit&) const {}
    __device__ __forceinline__ void done(const Unit&) const {}
};
template <class Epi, class Sched, bool ALIGN_EPI = false, bool SP2 = false>
__device__ __forceinline__ void gemm_phase(PG8_LAS unsigned char* lds, const Gemm g, const Sched& S, const Epi& E) {
    const int tid = fresh_tid(), wid = __builtin_amdgcn_readfirstlane(tid >> 6), lane = tid & 63, wr = wid >> 2, wc = wid & 3, fr = lane & 15, fq = lane >> 4;
    const int K = g.K, nt = K / BK;
    unsigned voffA[2], voffB[2];
#pragma unroll
    for (int i = 0; i < 2; ++i) { int R, C; stage_rc(tid * 16 + i * 8192, R, C); const int Rb = Epi::PERM ? ((R & ~31) + perm32(R & 31)) : R;
        voffA[i] = (unsigned)(R * g.lda + C) * 2u; voffB[i] = (unsigned)(Rb * g.ldb + C) * 2u; }
    const size_t kstep = (size_t)(BK * 2);
    const size_t hsA = (size_t)HALF * g.lda * 2, hsB = (size_t)HALF * g.ldb * 2;
    const size_t tsA = 2 * hsA, tsB = 2 * hsB;
    const unsigned ldsw = (unsigned)wid * 1024u;
    const int aoff = lds_byte(wr * 64 + fr, fq * 8), boff = lds_byte(wc * 32 + fr, fq * 8);
#define PG8_SA(b, h) (((b) * 2 + (h)) * HTB)
#define PG8_SB(b, h) ((4 + (b) * 2 + (h)) * HTB)
#define PG8_STAGE(bufoff, gbase, voff) do { _Pragma("unroll") for (int _i = 0; _i < 2; ++_i) \
        __builtin_amdgcn_global_load_lds((const unsigned*)((const char*)(gbase) + (voff)[_i]), (PG8_LAS unsigned*)(lds + (bufoff) + ldsw + _i * 8192), 16, 0, 0); } while (0)
#define PG8_LDA(dst, b, h) do { _Pragma("unroll") for (int m = 0; m < 4; ++m) _Pragma("unroll") for (int k = 0; k < 2; ++k) dst[m][k] = *(const PG8_LAS bf16x8*)(lds + PG8_SA(b, h) + aoff + m * 2048 + k * 1024); } while (0)
#define PG8_LDB(dst, b, h) do { _Pragma("unroll") for (int n = 0; n < 2; ++n) _Pragma("unroll") for (int k = 0; k < 2; ++k) dst[n][k] = *(const PG8_LAS bf16x8*)(lds + PG8_SB(b, h) + boff + n * 2048 + k * 1024); } while (0)
#define PG8_MMA(ai, bj, At, Bt) do { __builtin_amdgcn_s_setprio(1); _Pragma("unroll") for (int m = 0; m < 4; ++m) _Pragma("unroll") for (int n = 0; n < 2; ++n) _Pragma("unroll") for (int k = 0; k < 2; ++k) \
        acc[ai][bj][m][n] = __builtin_amdgcn_mfma_f32_16x16x32_bf16(Bt[n][k], At[m][k], acc[ai][bj][m][n], 0, 0, 0); __builtin_amdgcn_s_setprio(0); } while (0)
#define PG8_WAIT_V(n) asm volatile("s_waitcnt vmcnt(" #n ")" ::: "memory")
#define PG8_WAIT_L(n) asm volatile("s_waitcnt lgkmcnt(" #n ")" ::: "memory")
#define PG8_BAR __builtin_amdgcn_s_barrier()
#define PG8_SCHED __builtin_amdgcn_sched_barrier(0)
    Unit cur, nxt; int ui = 0;
    if (!S.next(0, cur)) return;
    f32x4 acc[2][2][4][2];
    if constexpr (Epi::HAS_INIT) E.init(acc, cur, wr, wc, fr, fq); else {
#pragma unroll
    for (int a = 0; a < 2; ++a)
#pragma unroll
        for (int b = 0; b < 2; ++b)
#pragma unroll
            for (int m = 0; m < 4; ++m)
#pragma unroll
                for (int n = 0; n < 2; ++n) acc[a][b][m][n] = (f32x4){0.f, 0.f, 0.f, 0.f};
    }
    bf16x8 At[4][2], B0[2][2], B1[2][2];
    const char* cA = (const char*)g.A + (size_t)cur.pm * tsA; const char* cB = (const char*)g.Bt + (size_t)cur.pn * tsB;
    S.a_ready(cur);
    if constexpr (SP2) {
        PG8_STAGE(PG8_SB(0, 0), cB, voffB); PG8_STAGE(PG8_SB(0, 1), cB + hsB, voffB); PG8_STAGE(PG8_SA(0, 0), cA, voffA); PG8_STAGE(PG8_SA(0, 1), cA + hsA, voffA);
        if (wr == 1) PG8_BAR;
        PG8_WAIT_V(2); PG8_BAR;
        PG8_STAGE(PG8_SB(1, 0), cB + kstep, voffB); PG8_STAGE(PG8_SA(1, 0), cA + kstep, voffA); PG8_STAGE(PG8_SB(1, 1), cB + hsB + kstep, voffB);
        PG8_WAIT_V(6); PG8_BAR;
    } else {
        PG8_STAGE(PG8_SB(0, 0), cB, voffB); PG8_STAGE(PG8_SA(0, 0), cA, voffA); PG8_STAGE(PG8_SB(0, 1), cB + hsB, voffB); PG8_STAGE(PG8_SA(0, 1), cA + hsA, voffA);
        if (wr == 1) PG8_BAR;
        PG8_WAIT_V(4); PG8_BAR;
        PG8_STAGE(PG8_SB(1, 0), cB + kstep, voffB); PG8_STAGE(PG8_SA(1, 0), cA + kstep, voffA); PG8_STAGE(PG8_SB(1, 1), cB + hsB + kstep, voffB);
        PG8_WAIT_V(6); PG8_BAR;
    }
    for (;;) {
        const bool has_next = S.next(ui + 1, nxt);
        const char* nA = has_next ? (const char*)g.A + (size_t)nxt.pm * tsA : cA; const char* nB = has_next ? (const char*)g.Bt + (size_t)nxt.pn * tsB : cB;
#pragma unroll 1
        for (int t = 0; t < nt; t += 2) {
            const bool last = (t == nt - 2);
            const char* a1 = cA + (size_t)(t + 1) * kstep;
            const char* a2 = last ? nA : cA + (size_t)(t + 2) * kstep; const char* b2 = last ? nB : cB + (size_t)(t + 2) * kstep;
            const char* a3 = a2 + kstep; const char* b3 = b2 + kstep;
            if (last && has_next) S.a_ready(nxt);
            if constexpr (Epi::HAS_MID) { if (t == nt / 2) E.mid(acc, cur, wr, wc, fr, fq); }
            if constexpr (SP2) {
            PG8_LDB(B0, 0, 0); PG8_LDB(B1, 0, 1); PG8_SCHED; PG8_LDA(At, 0, 0); PG8_STAGE(PG8_SA(1, 1), a1 + hsA, voffA);
            PG8_WAIT_V(8); PG8_WAIT_L(0); PG8_BAR; PG8_MMA(0, 0, At, B0); PG8_MMA(0, 1, At, B1); PG8_BAR; PG8_SCHED;
            PG8_LDA(At, 0, 1); PG8_STAGE(PG8_SB(0, 0), b2, voffB); PG8_STAGE(PG8_SB(0, 1), b2 + hsB, voffB); PG8_STAGE(PG8_SA(0, 0), a2, voffA);
            PG8_WAIT_V(8); PG8_WAIT_L(0); PG8_BAR; PG8_MMA(1, 0, At, B0); PG8_MMA(1, 1, At, B1); PG8_BAR; PG8_SCHED;
            PG8_LDB(B0, 1, 0); PG8_LDB(B1, 1, 1); PG8_SCHED; PG8_LDA(At, 1, 0); PG8_STAGE(PG8_SA(0, 1), a2 + hsA, voffA);
            PG8_WAIT_V(8); PG8_WAIT_L(0); PG8_BAR; PG8_MMA(0, 0, At, B0); PG8_MMA(0, 1, At, B1); PG8_BAR; PG8_SCHED;
            PG8_LDA(At, 1, 1); PG8_STAGE(PG8_SB(1, 0), b3, voffB); PG8_STAGE(PG8_SB(1, 1), b3 + hsB, voffB); PG8_STAGE(PG8_SA(1, 0), a3, voffA);
            PG8_WAIT_V(8); PG8_WAIT_L(0); PG8_BAR; PG8_MMA(1, 0, At, B0); PG8_MMA(1, 1, At, B1); PG8_BAR; PG8_SCHED;
            } else {
            PG8_LDB(B0, 0, 0); PG8_SCHED; PG8_LDA(At, 0, 0); PG8_STAGE(PG8_SA(1, 1), a1 + hsA, voffA);
            PG8_WAIT_L(8); PG8_BAR; PG8_WAIT_L(0); PG8_MMA(0, 0, At, B0); PG8_BAR; PG8_SCHED;
            PG8_LDB(B1, 0, 1); PG8_STAGE(PG8_SB(0, 0), b2, voffB);
            PG8_BAR; PG8_WAIT_L(0); PG8_MMA(0, 1, At, B1); PG8_BAR;
            PG8_LDA(At, 0, 1); PG8_STAGE(PG8_SA(0, 0), a2, voffA);
            PG8_BAR; PG8_WAIT_L(0); PG8_MMA(1, 0, At, B0); PG8_BAR; PG8_SCHED;
            PG8_STAGE(PG8_SB(0, 1), b2 + hsB, voffB);
            PG8_WAIT_V(6); PG8_BAR; PG8_MMA(1, 1, At, B1); PG8_BAR;
            PG8_LDB(B0, 1, 0); PG8_SCHED; PG8_LDA(At, 1, 0); PG8_STAGE(PG8_SA(0, 1), a2 + hsA, voffA);
            PG8_WAIT_L(8); PG8_BAR; PG8_WAIT_L(0); PG8_MMA(0, 0, At, B0); PG8_BAR; PG8_SCHED;
            PG8_LDB(B1, 1, 1); PG8_STAGE(PG8_SB(1, 0), b3, voffB);
            PG8_BAR; PG8_WAIT_L(0); PG8_MMA(0, 1, At, B1); PG8_BAR;
            PG8_LDA(At, 1, 1); PG8_STAGE(PG8_SA(1, 0), a3, voffA);
            PG8_BAR; PG8_WAIT_L(0); PG8_MMA(1, 0, At, B0); PG8_BAR; PG8_SCHED;
            PG8_STAGE(PG8_SB(1, 1), b3 + hsB, voffB);
            PG8_WAIT_V(6); PG8_BAR; PG8_MMA(1, 1, At, B1); PG8_BAR;
            }
        }
        if constexpr (ALIGN_EPI) { if (wr == 0) PG8_BAR; }
        if constexpr (!Epi::AFTER_DRAIN) { E(acc, cur, wr, wc, fr, fq); S.done(cur); }
        if (!has_next) break;
        if constexpr (Epi::HAS_INIT) E.init(acc, nxt, wr, wc, fr, fq); else {
#pragma unroll
        for (int a = 0; a < 2; ++a)
#pragma unroll
            for (int b = 0; b < 2; ++b)
#pragma unroll
                for (int m = 0; m < 4; ++m)
#pragma unroll
                    for (int n = 0; n < 2; ++n) acc[a][b][m][n] = (f32x4){0.f, 0.f, 0.f, 0.f};
        }
        cur = nxt; cA = nA; cB = nB; ++ui;
        if constexpr (ALIGN_EPI) { if (wr == 1) PG8_BAR; }
    }
    PG8_WAIT_V(0);
    if constexpr (!ALIGN_EPI) { if (wr == 0) PG8_BAR; }
    PG8_BAR;
    if constexpr (Epi::AFTER_DRAIN) { E.fused(acc, cur, wr, wc, fr, fq, lds, wid, lane); S.done(cur); }
#undef PG8_SA
#undef PG8_SB
#undef PG8_STAGE
#undef PG8_LDA
#undef PG8_LDB
#undef PG8_MMA
#undef PG8_WAIT_V
#undef PG8_WAIT_L
#undef PG8_BAR
#undef PG8_SCHED
}

template <class Epi, class Sched, bool ALIGN_EPI = false, bool SP2 = false>
__device__ __forceinline__ void gemm_phase_g(PG8_LAS unsigned char* lds, const Gemm g, const Sched& S, const Epi& E) {
    const int tid = fresh_tid(), wid = __builtin_amdgcn_readfirstlane(tid >> 6), lane = tid & 63, wr = wid >> 2, wc = wid & 3, fr = lane & 15, fq = lane >> 4;
    const int K = g.K, nt = K / BK;
    unsigned voffB[2]; int RAr[2]; unsigned CAb[2];
#pragma unroll
    for (int i = 0; i < 2; ++i) { int R, C; stage_rc(tid * 16 + i * 8192, R, C); const int Rb = Epi::PERM ? ((R & ~31) + perm32(R & 31)) : R;
        RAr[i] = R; CAb[i] = (unsigned)C * 2u; voffB[i] = (unsigned)(Rb * g.ldb + C) * 2u; }
    const size_t kstep = (size_t)(BK * 2);
    const size_t hsA = (size_t)HALF * g.lda * 2, hsB = (size_t)HALF * g.ldb * 2;
    const size_t tsA = 2 * hsA, tsB = 2 * hsB;
    const unsigned ldsw = (unsigned)wid * 1024u;
    const int aoff = lds_byte(wr * 64 + fr, fq * 8), boff = lds_byte(wc * 32 + fr, fq * 8);
#define PG8_SA(b, h) (((b) * 2 + (h)) * HTB)
#define PG8_SB(b, h) ((4 + (b) * 2 + (h)) * HTB)
#define PG8_STAGE(bufoff, gbase, voff) do { _Pragma("unroll") for (int _i = 0; _i < 2; ++_i) \
        __builtin_amdgcn_global_load_lds((const unsigned*)((const char*)(gbase) + (voff)[_i]), (PG8_LAS unsigned*)(lds + (bufoff) + ldsw + _i * 8192), 16, 0, 0); } while (0)
#define PG8_LDA(dst, b, h) do { _Pragma("unroll") for (int m = 0; m < 4; ++m) _Pragma("unroll") for (int k = 0; k < 2; ++k) dst[m][k] = *(const PG8_LAS bf16x8*)(lds + PG8_SA(b, h) + aoff + m * 2048 + k * 1024); } while (0)
#define PG8_LDB(dst, b, h) do { _Pragma("unroll") for (int n = 0; n < 2; ++n) _Pragma("unroll") for (int k = 0; k < 2; ++k) dst[n][k] = *(const PG8_LAS bf16x8*)(lds + PG8_SB(b, h) + boff + n * 2048 + k * 1024); } while (0)
#define PG8_MMA(ai, bj, At, Bt) do { __builtin_amdgcn_s_setprio(1); _Pragma("unroll") for (int m = 0; m < 4; ++m) _Pragma("unroll") for (int n = 0; n < 2; ++n) _Pragma("unroll") for (int k = 0; k < 2; ++k) \
        acc[ai][bj][m][n] = __builtin_amdgcn_mfma_f32_16x16x32_bf16(Bt[n][k], At[m][k], acc[ai][bj][m][n], 0, 0, 0); __builtin_amdgcn_s_setprio(0); } while (0)
#define PG8_WAIT_V(n) asm volatile("s_waitcnt vmcnt(" #n ")" ::: "memory")
#define PG8_WAIT_L(n) asm volatile("s_waitcnt lgkmcnt(" #n ")" ::: "memory")
#define PG8_BAR __builtin_amdgcn_s_barrier()
#define PG8_SCHED __builtin_amdgcn_sched_barrier(0)
    Unit cur, nxt; int ui = 0;
    if (!S.next(0, cur)) return;
    f32x4 acc[2][2][4][2];
    if constexpr (Epi::HAS_INIT) E.init(acc, cur, wr, wc, fr, fq); else {
#pragma unroll
    for (int a = 0; a < 2; ++a)
#pragma unroll
        for (int b = 0; b < 2; ++b)
#pragma unroll
            for (int m = 0; m < 4; ++m)
#pragma unroll
                for (int n = 0; n < 2; ++n) acc[a][b][m][n] = (f32x4){0.f, 0.f, 0.f, 0.f};
    }
    bf16x8 At[4][2], B0[2][2], B1[2][2];
    unsigned vAll[4][2][2];
#pragma unroll
    for (int q = 0; q < 4; ++q) { Unit uq; const bool ok = S.next(q, uq);
#pragma unroll
        for (int h = 0; h < 2; ++h)
#pragma unroll
            for (int i = 0; i < 2; ++i) vAll[q][h][i] = ok ? (unsigned)S.arow(uq.pm * BM + h * HALF + RAr[i]) * (unsigned)(g.lda * 2) + CAb[i] : 0u; }
#define PG8_PICK(dst, idx) do { _Pragma("unroll") for (int h_ = 0; h_ < 2; ++h_) _Pragma("unroll") for (int i_ = 0; i_ < 2; ++i_) \
        dst[h_][i_] = (idx) == 0 ? vAll[0][h_][i_] : (idx) == 1 ? vAll[1][h_][i_] : (idx) == 2 ? vAll[2][h_][i_] : vAll[3][h_][i_]; } while (0)
    unsigned vA[2][2], vAn[2][2], vS[2][2];
    PG8_PICK(vA, 0);
    const char* A0 = (const char*)g.A; const char* cB = (const char*)g.Bt + S.boff(cur);
    S.a_ready(cur);
    if constexpr (SP2) {
        PG8_STAGE(PG8_SB(0, 0), cB, voffB); PG8_STAGE(PG8_SB(0, 1), cB + hsB, voffB); PG8_STAGE(PG8_SA(0, 0), A0, vA[0]); PG8_STAGE(PG8_SA(0, 1), A0, vA[1]);
        if (wr == 1) PG8_BAR;
        PG8_WAIT_V(2); PG8_BAR;
        PG8_STAGE(PG8_SB(1, 0), cB + kstep, voffB); PG8_STAGE(PG8_SA(1, 0), A0 + kstep, vA[0]); PG8_STAGE(PG8_SB(1, 1), cB + hsB + kstep, voffB);
        PG8_WAIT_V(6); PG8_BAR;
    } else {
        PG8_STAGE(PG8_SB(0, 0), cB, voffB); PG8_STAGE(PG8_SA(0, 0), A0, vA[0]); PG8_STAGE(PG8_SB(0, 1), cB + hsB, voffB); PG8_STAGE(PG8_SA(0, 1), A0, vA[1]);
        if (wr == 1) PG8_BAR;
        PG8_WAIT_V(4); PG8_BAR;
        PG8_STAGE(PG8_SB(1, 0), cB + kstep, voffB); PG8_STAGE(PG8_SA(1, 0), A0 + kstep, vA[0]); PG8_STAGE(PG8_SB(1, 1), cB + hsB + kstep, voffB);
        PG8_WAIT_V(6); PG8_BAR;
    }
    for (;;) {
        const bool has_next = S.next(ui + 1, nxt);
        const char* nB = has_next ? (const char*)g.Bt + S.boff(nxt) : cB;
        if (has_next) { PG8_PICK(vAn, ui + 1); } else { PG8_PICK(vAn, ui); }
#pragma unroll 1
        for (int t = 0; t < nt; t += 2) {
            const bool last = (t == nt - 2);
            const char* a1 = A0 + (size_t)(t + 1) * kstep;
            const char* a2 = last ? A0 : A0 + (size_t)(t + 2) * kstep; const char* b2 = last ? nB : cB + (size_t)(t + 2) * kstep;
#pragma unroll
            for (int h_ = 0; h_ < 2; ++h_)
#pragma unroll
                for (int i_ = 0; i_ < 2; ++i_) vS[h_][i_] = last ? vAn[h_][i_] : vA[h_][i_];
            const char* a3 = a2 + kstep; const char* b3 = b2 + kstep;
            if (last && has_next) S.a_ready(nxt);
            if constexpr (Epi::HAS_MID) { if (t == nt / 2) E.mid(acc, cur, wr, wc, fr, fq); }
            if constexpr (SP2) {
            PG8_LDB(B0, 0, 0); PG8_LDB(B1, 0, 1); PG8_SCHED; PG8_LDA(At, 0, 0); PG8_STAGE(PG8_SA(1, 1), a1, vA[1]);
            PG8_WAIT_V(8); PG8_WAIT_L(0); PG8_BAR; PG8_MMA(0, 0, At, B0); PG8_MMA(0, 1, At, B1); PG8_BAR; PG8_SCHED;
            PG8_LDA(At, 0, 1); PG8_STAGE(PG8_SB(0, 0), b2, voffB); PG8_STAGE(PG8_SB(0, 1), b2 + hsB, voffB); PG8_STAGE(PG8_SA(0, 0), a2, vS[0]);
            PG8_WAIT_V(8); PG8_WAIT_L(0); PG8_BAR; PG8_MMA(1, 0, At, B0); PG8_MMA(1, 1, At, B1); PG8_BAR; PG8_SCHED;
            PG8_LDB(B0, 1, 0); PG8_LDB(B1, 1, 1); PG8_SCHED; PG8_LDA(At, 1, 0); PG8_STAGE(PG8_SA(0, 1), a2, vS[1]);
            PG8_WAIT_V(8); PG8_WAIT_L(0); PG8_BAR; PG8_MMA(0, 0, At, B0); PG8_MMA(0, 1, At, B1); PG8_BAR; PG8_SCHED;
            PG8_LDA(At, 1, 1); PG8_STAGE(PG8_SB(1, 0), b3, voffB); PG8_STAGE(PG8_SB(1, 1), b3 + hsB, voffB); PG8_STAGE(PG8_SA(1, 0), a3, vS[0]);
            PG8_WAIT_V(8); PG8_WAIT_L(0); PG8_BAR; PG8_MMA(1, 0, At, B0); PG8_MMA(1, 1, At, B1); PG8_BAR; PG8_SCHED;
            } else {
            PG8_LDB(B0, 0, 0); PG8_SCHED; PG8_LDA(At, 0, 0); PG8_STAGE(PG8_SA(1, 1), a1, vA[1]);
            PG8_WAIT_L(8); PG8_BAR; PG8_WAIT_L(0); PG8_MMA(0, 0, At, B0); PG8_BAR; PG8_SCHED;
            PG8_LDB(B1, 0, 1); PG8_STAGE(PG8_SB(0, 0), b2, voffB);
            PG8_BAR; PG8_WAIT_L(0); PG8_MMA(0, 1, At, B1); PG8_BAR;
            PG8_LDA(At, 0, 1); PG8_STAGE(PG8_SA(0, 0), a2, vS[0]);
            PG8_BAR; PG8_WAIT_L(0); PG8_MMA(1, 0, At, B0); PG8_BAR; PG8_SCHED;
            PG8_STAGE(PG8_SB(0, 1), b2 + hsB, voffB);
            PG8_WAIT_V(6); PG8_BAR; PG8_MMA(1, 1, At, B1); PG8_BAR;
            PG8_LDB(B0, 1, 0); PG8_SCHED; PG8_LDA(At, 1, 0); PG8_STAGE(PG8_SA(0, 1), a2, vS[1]);
            PG8_WAIT_L(8); PG8_BAR; PG8_WAIT_L(0); PG8_MMA(0, 0, At, B0); PG8_BAR; PG8_SCHED;
            PG8_LDB(B1, 1, 1); PG8_STAGE(PG8_SB(1, 0), b3, voffB);
            PG8_BAR; PG8_WAIT_L(0); PG8_MMA(0, 1, At, B1); PG8_BAR;
            PG8_LDA(At, 1, 1); PG8_STAGE(PG8_SA(1, 0), a3, vS[0]);
            PG8_BAR; PG8_WAIT_L(0); PG8_MMA(1, 0, At, B0); PG8_BAR; PG8_SCHED;
            PG8_STAGE(PG8_SB(1, 1), b3 + hsB, voffB);
            PG8_WAIT_V(6); PG8_BAR; PG8_MMA(1, 1, At, B1); PG8_BAR;
            }
        }
        if constexpr (ALIGN_EPI) { if (wr == 0) PG8_BAR; }
        if constexpr (!Epi::AFTER_DRAIN) { E(acc, cur, wr, wc, fr, fq); S.done(cur); }
        if (!has_next) break;
        if constexpr (Epi::HAS_INIT) E.init(acc, nxt, wr, wc, fr, fq); else {
#pragma unroll
        for (int a = 0; a < 2; ++a)
#pragma unroll
            for (int b = 0; b < 2; ++b)
#pragma unroll
                for (int m = 0; m < 4; ++m)
#pragma unroll
                    for (int n = 0; n < 2; ++n) acc[a][b][m][n] = (f32x4){0.f, 0.f, 0.f, 0.f};
        }
        cur = nxt; cB = nB; ++ui;
#pragma unroll
        for (int h_ = 0; h_ < 2; ++h_)
#pragma unroll
            for (int i_ = 0; i_ < 2; ++i_) vA[h_][i_] = vAn[h_][i_];
        if constexpr (ALIGN_EPI) { if (wr == 1) PG8_BAR; }
    }
    PG8_WAIT_V(0);
    if constexpr (!ALIGN_EPI) { if (wr == 0) PG8_BAR; }
    PG8_BAR;
    if constexpr (Epi::AFTER_DRAIN) { E.fused(acc, cur, wr, wc, fr, fq, lds, wid, lane); S.done(cur); }
#undef PG8_SA
#undef PG8_SB
#undef PG8_STAGE
#undef PG8_LDA
#undef PG8_LDB
#undef PG8_MMA
#undef PG8_WAIT_V
#undef PG8_WAIT_L
#undef PG8_BAR
#undef PG8_SCHED
#undef PG8_PICK
}


}

namespace attn {
using bf16x8 = __attribute__((ext_vector_type(8))) short;
using s16x4  = __attribute__((ext_vector_type(4))) short;
using f32x16 = __attribute__((ext_vector_type(16))) float;
using u32x4  = __attribute__((ext_vector_type(4))) unsigned;
constexpr int QBLK = 32, KVBLK = 64, LDQ = 3072;
constexpr float SCALE = 0.125f, QSCALE = 0.125f * 1.4426950408889634f;
constexpr size_t SHM_V = KVBLK * 128 * 2, SHM_K = KVBLK * 128 * 2, SHM_ATTN = 2 * SHM_V + 2 * SHM_K + 8 * 64 * 4;
#define KSWZ(row, colB) ((row) * 256 + ((colB) ^ (((row) & 7) << 4)))
#define SBAR() __builtin_amdgcn_sched_barrier(0)
__device__ __forceinline__ int crow(int r, int hi) { return (r & 3) + 8 * (r >> 2) + 4 * hi; }
__device__ __forceinline__ unsigned cvtpk(float lo, float hi) { return pk2(lo, hi); }
__device__ __forceinline__ bf16x8 ld8(const bf16_t* p) { return *reinterpret_cast<const bf16x8*>(p); }

__device__ __forceinline__ void partialSM(f32x16& p0, f32x16& p1) {
  for (int r = 0; r < 16; ++r) p0[r] = __builtin_amdgcn_exp2f(p0[r]);
}
__device__ __forceinline__ void finishSM(f32x16& p0, f32x16& p1, float& l_reg, bf16x8& pa0, bf16x8& pa1, bf16x8& pa2, bf16x8& pa3) {
  for (int r = 0; r < 16; ++r) p1[r] = __builtin_amdgcn_exp2f(p1[r]);
  float ps = 0; for (int r = 0; r < 16; ++r) ps += p0[r]; for (int r = 0; r < 16; ++r) ps += p1[r];
  l_reg += ps;
#define PK4(P, BASE, OUT) do { unsigned a0 = cvtpk(P[BASE + 0], P[BASE + 1]), a1 = cvtpk(P[BASE + 2], P[BASE + 3]);   \
    unsigned b0 = cvtpk(P[BASE + 4], P[BASE + 5]), b1 = cvtpk(P[BASE + 6], P[BASE + 7]);                              \
    auto r0 = __builtin_amdgcn_permlane32_swap(a0, b0, false, false); auto r1 = __builtin_amdgcn_permlane32_swap(a1, b1, false, false); \
    u32x4 w = {r0[0], r1[0], r0[1], r1[1]}; OUT = *reinterpret_cast<bf16x8*>(&w); } while (0)
  PK4(p0, 0, pa0); PK4(p0, 8, pa1); PK4(p1, 0, pa2); PK4(p1, 8, pa3);
#undef PK4
}
__device__ __forceinline__ void qkt(f32x16& p0, f32x16& p1, const bf16_t* Ks, const bf16x8* qr, int r32, int hi, int sub) {
  p0 = f32x16{}; p1 = f32x16{};
#pragma unroll
  for (int d0 = 0; d0 < 4; ++d0) { int cb = (sub * 64 + d0 * 16 + hi * 8) * 2;
    bf16x8 b0 = *reinterpret_cast<const bf16x8*>((const char*)Ks + KSWZ(r32, cb));
    bf16x8 b1 = *reinterpret_cast<const bf16x8*>((const char*)Ks + KSWZ(32 + r32, cb));
    p0 = __builtin_amdgcn_mfma_f32_32x32x16_bf16(b0, qr[d0], p0, 0, 0, 0);
    p1 = __builtin_amdgcn_mfma_f32_32x32x16_bf16(b1, qr[d0], p1, 0, 0, 0); }
}
__device__ __forceinline__ int v_st(int k, int c) { const int kk = (k & ~0xC) | ((k & 4) << 1) | ((k & 8) >> 1); return ((kk >> 3) * 4 + (c >> 5)) * 512 + ((kk & 7) * 32 + (c & 31)) * 2; }
__device__ __forceinline__ int v_rd_base(int lane) { return ((lane & 3) << 3) | (((lane >> 2) & 3) << 6) | (((lane >> 4) & 1) << 5) | (((lane >> 5) & 1) << 8); }
constexpr int v_rd_off(int d0, int ks, int half) { return d0 * 512 + ks * 4096 + half * 2048; }
template <int OFF> __device__ __forceinline__ s16x4 tr_read(int vb) {
  s16x4 r; asm volatile("ds_read_b64_tr_b16 %0, %1 offset:%2" : "=&v"(r) : "v"(vb), "i"(OFF) : "memory"); return r;
}
template <int D0> __device__ __forceinline__ void pv_one(f32x16& od, int vb, bf16x8 pa0, bf16x8 pa1, bf16x8 pa2, bf16x8 pa3) {
  const s16x4 l0 = tr_read<v_rd_off(D0, 0, 0)>(vb), h0 = tr_read<v_rd_off(D0, 0, 1)>(vb), l1 = tr_read<v_rd_off(D0, 1, 0)>(vb), h1 = tr_read<v_rd_off(D0, 1, 1)>(vb);
  const s16x4 l2 = tr_read<v_rd_off(D0, 2, 0)>(vb), h2 = tr_read<v_rd_off(D0, 2, 1)>(vb), l3 = tr_read<v_rd_off(D0, 3, 0)>(vb), h3 = tr_read<v_rd_off(D0, 3, 1)>(vb);
  asm volatile("s_waitcnt lgkmcnt(0)" ::: "memory"); SBAR();
#define PK(L, H) (bf16x8){L[0], L[1], L[2], L[3], H[0], H[1], H[2], H[3]}
  od = __builtin_amdgcn_mfma_f32_32x32x16_bf16(pa0, PK(l0, h0), od, 0, 0, 0);
  od = __builtin_amdgcn_mfma_f32_32x32x16_bf16(pa1, PK(l1, h1), od, 0, 0, 0);
  od = __builtin_amdgcn_mfma_f32_32x32x16_bf16(pa2, PK(l2, h2), od, 0, 0, 0);
  od = __builtin_amdgcn_mfma_f32_32x32x16_bf16(pa3, PK(l3, h3), od, 0, 0, 0);
#undef PK
}
__device__ __forceinline__ void pv_d0(f32x16* o, int vb, bf16x8 pa0, bf16x8 pa1, bf16x8 pa2, bf16x8 pa3) {
  pv_one<0>(o[0], vb, pa0, pa1, pa2, pa3); pv_one<1>(o[1], vb, pa0, pa1, pa2, pa3); pv_one<2>(o[2], vb, pa0, pa1, pa2, pa3); pv_one<3>(o[3], vb, pa0, pa1, pa2, pa3);
}

struct Stage { bf16x8 vs0, vs1, ks0, ks1; };
__device__ __forceinline__ void attn_prime(const bf16_t* Kh, const bf16_t* Vh, Stage (&sr_)[2]) {
  const int tid = fresh_tid(), sr = tid >> 4, sc = (tid & 15) * 8;
  sr_[0].vs0 = ld8(&Vh[(long)sr * LDQ + sc]); sr_[0].vs1 = ld8(&Vh[(long)(32 + sr) * LDQ + sc]); sr_[0].ks0 = ld8(&Kh[(long)sr * LDQ + sc]); sr_[0].ks1 = ld8(&Kh[(long)(32 + sr) * LDQ + sc]);
}
__device__ __forceinline__ void attn_unit(const bf16_t* Qb, const bf16_t* Kh, const bf16_t* Vh, bf16_t* Ya, float lam, const float* subln_g, int seq, char* lds, const bf16_t* nKh, const bf16_t* nVh, Stage (&sr_)[2]) {
  const int tid = fresh_tid(), wid = __builtin_amdgcn_readfirstlane(tid >> 6), lane = tid & 63, r32 = lane & 31, hi = lane >> 5, sub = wid >> 2, wq = wid & 3;
  bf16_t* V_lds = (bf16_t*)lds; bf16_t* K_lds = (bf16_t*)(lds + 2 * SHM_V);
  float* ws = (float*)(lds + 2 * SHM_V + 2 * SHM_K) + wid * 64; float* li_l = ws;
  float l_reg = 0; f32x16 o[4] = {}; bf16x8 qr[4];
  const bf16_t* Qw = Qb + (long)(wq * QBLK + r32) * LDQ + sub * 64 + hi * 8;
#pragma unroll
  for (int d0 = 0; d0 < 4; ++d0) qr[d0] = ld8(Qw + d0 * 16);
  const int sr = tid >> 4, sc = (tid & 15) * 8, vst0 = v_st(sr, sc), vst1 = v_st(32 + sr, sc);
  const int vb0 = (int)(uintptr_t)V_lds + v_rd_base(lane);
#define SLOAD(i, k0) do { sr_[i].vs0 = ld8(&Vh[(long)((k0) + sr) * LDQ + sc]); sr_[i].vs1 = ld8(&Vh[(long)((k0) + 32 + sr) * LDQ + sc]); \
    sr_[i].ks0 = ld8(&Kh[(long)((k0) + sr) * LDQ + sc]); sr_[i].ks1 = ld8(&Kh[(long)((k0) + 32 + sr) * LDQ + sc]); } while (0)
#define SWRITE(b, i) do { *(bf16x8*)((char*)V_lds + (b) * SHM_V + vst0) = sr_[i].vs0;          \
    *(bf16x8*)((char*)V_lds + (b) * SHM_V + vst1) = sr_[i].vs1; int kc = sc * 2;               \
    *(bf16x8*)((char*)K_lds + (b) * SHM_K + KSWZ(sr, kc)) = sr_[i].ks0;                       \
    *(bf16x8*)((char*)K_lds + (b) * SHM_K + KSWZ(32 + sr, kc)) = sr_[i].ks1; } while (0)
#define SWAIT() asm volatile("s_waitcnt vmcnt(4)" ::: "memory")
  f32x16 pA0, pA1, pB0, pB1; bf16x8 pa0, pa1, pa2, pa3; const int NT = seq / KVBLK;
  constexpr int SE = 0, SO = 1;
  asm volatile("s_waitcnt vmcnt(0)" ::: "memory"); SWRITE(0, SE); __syncthreads();
  qkt(pA0, pA1, K_lds, qr, r32, hi, sub); partialSM(pA0, pA1);
  SLOAD(SO, KVBLK); if (2 < NT) SLOAD(SE, 2 * KVBLK);
  SWAIT(); SWRITE(1, SO); __syncthreads();
  for (int j = 1; j + 1 < NT; j += 2) {
    SBAR(); qkt(pB0, pB1, (bf16_t*)((char*)K_lds + SHM_K), qr, r32, hi, sub);
    finishSM(pA0, pA1, l_reg, pa0, pa1, pa2, pa3); SBAR();
    SLOAD(SO, (j + 2) * KVBLK); SBAR();
    pv_d0(o, vb0, pa0, pa1, pa2, pa3); partialSM(pB0, pB1);
    __syncthreads(); SWAIT(); SWRITE(0, SE); __syncthreads();
    SBAR(); qkt(pA0, pA1, K_lds, qr, r32, hi, sub);
    finishSM(pB0, pB1, l_reg, pa0, pa1, pa2, pa3); SBAR();
    if (j + 3 < NT) SLOAD(SE, (j + 3) * KVBLK); SBAR();
    pv_d0(o, vb0 + (int)SHM_V, pa0, pa1, pa2, pa3); partialSM(pA0, pA1);
    __syncthreads(); SWAIT(); SWRITE(1, SO); __syncthreads();
  }
  sr_[SE].vs0 = ld8(&nVh[(long)sr * LDQ + sc]); sr_[SE].vs1 = ld8(&nVh[(long)(32 + sr) * LDQ + sc]); sr_[SE].ks0 = ld8(&nKh[(long)sr * LDQ + sc]); sr_[SE].ks1 = ld8(&nKh[(long)(32 + sr) * LDQ + sc]);
  SBAR(); qkt(pB0, pB1, (bf16_t*)((char*)K_lds + SHM_K), qr, r32, hi, sub);
  finishSM(pA0, pA1, l_reg, pa0, pa1, pa2, pa3); SBAR();
  pv_d0(o, vb0, pa0, pa1, pa2, pa3); partialSM(pB0, pB1);
  __syncthreads();
  finishSM(pB0, pB1, l_reg, pa0, pa1, pa2, pa3); SBAR();
  pv_d0(o, vb0 + (int)SHM_V, pa0, pa1, pa2, pa3);
  { auto rr = __builtin_amdgcn_permlane32_swap(__float_as_uint(l_reg), __float_as_uint(l_reg), false, false); l_reg = __uint_as_float(rr[0]) + __uint_as_float(rr[1]); }
  if (hi == 0) li_l[r32] = l_reg; asm volatile("s_waitcnt lgkmcnt(0)" ::: "memory");
  float rli[16];
#pragma unroll
  for (int r = 0; r < 16; ++r) rli[r] = __builtin_amdgcn_rcpf(li_l[crow(r, hi)]);
  __syncthreads();
  float* xo = (float*)lds;
  if (sub == 1) {
#pragma unroll
    for (int r = 0; r < 16; ++r) { const int orow = wq * 32 + crow(r, hi);
#pragma unroll
      for (int d0 = 0; d0 < 4; ++d0) xo[orow * 128 + d0 * 32 + r32] = o[d0][r] * rli[r]; }
  }
  __syncthreads();
  if (sub == 0) {
    float gv[4];
#pragma unroll
    for (int d0 = 0; d0 < 4; ++d0) gv[d0] = subln_g[d0 * 32 + r32] * (1.0f - LAM_INIT);
#pragma unroll
    for (int r = 0; r < 16; ++r) { const int orow = wq * 32 + crow(r, hi); float v[4]; float ssq = 0.f;
#pragma unroll
      for (int d0 = 0; d0 < 4; ++d0) { v[d0] = o[d0][r] * rli[r] - lam * xo[orow * 128 + d0 * 32 + r32]; ssq += v[d0] * v[d0]; }
      ssq += __shfl_xor(ssq, 1); ssq += __shfl_xor(ssq, 2); ssq += __shfl_xor(ssq, 4); ssq += __shfl_xor(ssq, 8); ssq += __shfl_xor(ssq, 16);
      const float sc_ = 1.0f / sqrtf(ssq * (1.0f / 128.0f) + RMS_EPS);
#pragma unroll
      for (int d0 = 0; d0 < 4; ++d0) Ya[(long)orow * 2048 + d0 * 32 + r32] = (bf16_t)f2bf(v[d0] * sc_ * gv[d0]); }
  }
  __syncthreads();
#undef SLOAD
#undef SWRITE
#undef SWAIT
}
#undef KSWZ
#undef SBAR
}

struct Args {
    const float* in[33];
    float* out; unsigned char* ws;
    int ph_lo, ph_hi;
};
enum { I_X = 0, I_ANG, I_WIN, I_QNG, I_KNG, I_LQ1, I_LK1, I_LQ2, I_LK2, I_SUBLN, I_MU, I_W0F, I_W2F, I_W0B, I_W2B, I_A0F, I_A2F, I_A0B, I_A2B, I_G2, I_KK, I_KA, I_RK,
       I_LNW, I_LNB, I_WBA, I_WBB, I_WOUT, I_FNG, I_WR, I_WG, I_WU, I_WD };

__device__ __forceinline__ void tr_item(const float* W, int ldw, int k0, int n0, bf16_t* dst, int ldd, LAS float* scr, int lane) {
    float tv[32];
    const float* src = W + (size_t)(k0 + (lane >> 5)) * ldw + n0 + (lane & 31);
#pragma unroll
    for (int i = 0; i < 32; ++i) tv[i] = src[(size_t)(2 * i) * ldw];
#pragma unroll
    for (int i = 0; i < 32; ++i) scr[(2 * i + (lane >> 5)) * 33 + (lane & 31)] = tv[i];
    asm volatile("s_waitcnt lgkmcnt(0)" ::: "memory");
    const int c = lane & 7;
#pragma unroll
    for (int j = 0; j < 4; ++j) { const int n = (lane >> 3) + 8 * j; const LAS float* s = scr + (8 * c) * 33 + n;
        v4u o; o.x = pk2(s[0 * 33], s[1 * 33]); o.y = pk2(s[2 * 33], s[3 * 33]); o.z = pk2(s[4 * 33], s[5 * 33]); o.w = pk2(s[6 * 33], s[7 * 33]);
        *(v4u*)(dst + (size_t)n * ldd + 8 * c) = o; }
    asm volatile("s_waitcnt lgkmcnt(0)" ::: "memory");
}

__device__ __forceinline__ void p0_prologue(const Args& a, LAS unsigned char* lds, int gw, int NGW, int wave, int lane) {
    unsigned char* ws = a.ws;
    LAS float* scr = (LAS float*)(lds + wave * 16384);
    bf16_t* WinT = (bf16_t*)(ws + WS_WINT);
    bf16_t* WaT = (bf16_t*)(ws + WS_WAT); bf16_t* WoT = (bf16_t*)(ws + WS_WOT);
    constexpr int I_IN = 32 * 333, I_A = 16 * 64, I_B = 16 * 64, I_O = 32 * 64, NITEMS = I_IN + I_A + I_B + I_O;
    for (int it = gw; it < NITEMS; it += NGW) {
        int r = it;
        if (r < I_IN) { const int kb = r / 333, nb = r % 333, n0 = nb * 32; int drow = n0;
            if (n0 >= 6560) { const int c = n0 - 6560, which = c >> 11, cc = c & 2047; drow = 6656 + (cc >> 7) * 256 + which * 128 + (cc & 127); }
            tr_item(a.in[I_WIN], IN_COLS, kb * 64, n0, WinT + (size_t)drow * 2048 + kb * 64, 2048, scr, lane); continue; } r -= I_IN;
        if (r < I_A) { const int kb = r / 64, nb = r % 64; tr_item(a.in[I_WBA], 2048, kb * 64, nb * 32, WaT + (size_t)(nb * 32) * 2048 + kb * 64, 2048, scr, lane); continue; } r -= I_A;
        if (r < I_B) { const int kb = r / 64, nb = r % 64; tr_item(a.in[I_WBB], 2048, kb * 64, nb * 32, WaT + (size_t)(nb * 32) * 2048 + 1024 + kb * 64, 2048, scr, lane); continue; } r -= I_B;
        { const int kb = r / 64, nb = r % 64; tr_item(a.in[I_WOUT], 2048, kb * 64, nb * 32, WoT + (size_t)(nb * 32) * 2048 + kb * 64, 2048, scr, lane); }
    }
    { const int gt = gw * 64 + lane, NT_ = NGW * 64;
      v4u z = {0u, 0u, 0u, 0u};
      for (int i = gt; i < 24576; i += NT_) ((v4u*)(WinT + (size_t)6560 * 2048))[i] = z;
      { const float invf[8] = {1.000000000e+00f, 1.939227432e-01f, 3.760603070e-02f, 7.292664610e-03f, 1.414213562e-03f, 2.742481884e-04f, 5.318296098e-05f, 1.031338616e-05f};
        for (int i = gt; i < SEQ * 8; i += NT_) { float iv = invf[0];
#pragma unroll
            for (int j = 1; j < 8; ++j) iv = ((i & 7) == j) ? invf[j] : iv;
            float sv, cv; sincosf((float)(i >> 3) * iv, &sv, &cv); ((float2*)(ws + WS_ROPE))[i] = make_float2(cv, sv); } }
      { float* sm = (float*)(ws + WS_SMALL);
#define CPY(OFF, IDX, N) for (int i = gt; i < (N); i += NT_) sm[(OFF) + i] = a.in[IDX][i];
        CPY(SM_QNG, I_QNG, 64) CPY(SM_KNG, I_KNG, 64) CPY(SM_LQ1, I_LQ1, 64) CPY(SM_LK1, I_LK1, 64) CPY(SM_LQ2, I_LQ2, 64) CPY(SM_LK2, I_LK2, 64) CPY(SM_SUBLN, I_SUBLN, 128)
        CPY(SM_MU, I_MU, 3488) CPY(SM_KK, I_KK, 1024) CPY(SM_KA, I_KA, 1024) CPY(SM_RK, I_RK, 1024) CPY(SM_LNW, I_LNW, 1024) CPY(SM_LNB, I_LNB, 1024) CPY(SM_FNG, I_FNG, 2048) CPY(SM_WR, I_WR, 32768)
#undef CPY
      }
      for (int i = gt; i < 4096; i += NT_) { const int seg = i >> 10, c = i & 1023; ((float*)(ws + WS_BIAS4))[i] = (seg == 0) ? a.in[I_W0F][c] : (seg == 1) ? a.in[I_W0B][c] : (seg == 2) ? a.in[I_A0F][c] : a.in[I_A0B][c]; }
      bf16_t* B1 = (bf16_t*)(ws + WS_BTL1); bf16_t* B2 = (bf16_t*)(ws + WS_BTL2);
      for (int i = gt; i < 4096 * 32; i += NT_) { const int n = i >> 5, kc = (i & 31) * 8, seg = n >> 10, c = n & 1023;
          const float* w2 = (seg == 0) ? a.in[I_W2F] : (seg == 1) ? a.in[I_W2B] : (seg == 2) ? a.in[I_A2F] : a.in[I_A2B];
          float f[8];
#pragma unroll
          for (int j = 0; j < 8; ++j) { const int k = kc + j - 64 * seg; f[j] = (k >= 0 && k < 64) ? w2[(size_t)k * 1024 + c] : 0.f; }
          *(v4u*)(B1 + (size_t)n * 256 + kc) = pack8(f); }
      for (int i = gt; i < 1024 * 32; i += NT_) { const int n = i >> 5, kc = (i & 31) * 8; float f[8];
#pragma unroll
          for (int j = 0; j < 8; ++j) { const int k = kc + j; f[j] = (k < 160) ? a.in[I_G2][(size_t)k * 1024 + n] : 0.f; }
          *(v4u*)(B2 + (size_t)n * 256 + kc) = pack8(f); }
    }
    bf16_t* HN = (bf16_t*)(ws + WS_HN); const float* x = a.in[I_X]; const float* g = a.in[I_ANG];
    for (int m = gw; m < M; m += NGW) {
        const float4* xr = (const float4*)(x + (size_t)m * DM) + lane; float4 v[8]; float s = 0.f;
#pragma unroll
        for (int j = 0; j < 8; ++j) { v[j] = xr[64 * j]; s += (v[j].x * v[j].x + v[j].y * v[j].y) + (v[j].z * v[j].z + v[j].w * v[j].w); }
        const float rs = 1.0f / sqrtf(wave_sum(s) * (1.0f / DM) + RMS_EPS);
        v2u* o = (v2u*)(HN + (size_t)m * DM) + lane;
#pragma unroll
        for (int j = 0; j < 8; ++j) { const float4 gg = ((const float4*)g)[64 * j + lane]; v2u w; w.x = pk2(v[j].x * rs * gg.x, v[j].y * rs * gg.y); w.y = pk2(v[j].z * rs * gg.z, v[j].w * rs * gg.w); o[64 * j] = w; }
    }
}

__device__ __forceinline__ void p2_prep(const Args& a, int gw, int NGW, int lane, bool dummy = false) {
    unsigned char* ws = a.ws;
    bf16_t* PDA = (bf16_t*)(ws + WS_PDA); const bf16_t* PRW = (const bf16_t*)((unsigned char*)a.out + DO_PRW);
    bf16_t* RKV = (bf16_t*)(ws + WS_RKV); bf16_t* LIN = (bf16_t*)((unsigned char*)a.out + DO_LIN);
    const float* sm = (const float*)(ws + WS_SMALL); const float* mu = sm + SM_MU;
    const int sub8 = lane & 7;
    float gq[8], gk[8];
#pragma unroll
    for (int j = 0; j < 8; ++j) { gq[j] = sm[SM_QNG + sub8 * 8 + j]; gk[j] = sm[SM_KNG + sub8 * 8 + j]; }
    for (int m = gw; m < M; m += NGW) {
        const int t = m & (SEQ - 1);
        const float2 csv = ((const float2*)(ws + WS_ROPE))[t * 8 + sub8]; const float cv = csv.x, sv = csv.y;
        float cs[8], sn[8];
#pragma unroll
        for (int j = 0; j < 8; ++j) { cs[j] = __shfl(cv, j); sn[j] = __shfl(sv, j); }
#pragma unroll
        for (int it = 0; it < 4; ++it) {
            const int v = it * 8 + (lane >> 3);
            bf16_t* p = PDA + (size_t)m * 3072 + (v < 16 ? 0 : 1024) + (v & 15) * 64 + sub8 * 8;
            const v4u w = *(const v4u*)p; float f[8]; unpack8(w, f);
            float s = 0.f;
#pragma unroll
            for (int j = 0; j < 8; ++j) s += f[j] * f[j];
            s = sum8(s); const float rs = 1.0f / sqrtf(s * (1.0f / 64.0f) + RMS_EPS);
            float y[8], oth[8];
#pragma unroll
            for (int j = 0; j < 8; ++j) { y[j] = f[j] * rs * (v < 16 ? gq[j] : gk[j]); }
#pragma unroll
            for (int j = 0; j < 8; ++j) oth[j] = __shfl_xor(y[j], 1);
            float o[8];
#pragma unroll
            for (int j = 0; j < 8; ++j) o[j] = (sub8 == 0) ? (y[j] * cs[j] - oth[j] * sn[j]) : (sub8 == 1) ? (y[j] * cs[j] + oth[j] * sn[j]) : y[j];
            if (v < 16) {
#pragma unroll
                for (int j = 0; j < 8; ++j) o[j] *= 0.125f * 1.4426950408889634f; }
            *(v4u*)(dummy ? (bf16_t*)(ws + WS_LORA) + (p - PDA) : p) = pack8(o);
        }
        const bool hp = t > 0, hn_ = t < SEQ - 1;
        const bf16_t* pr = PRW + (size_t)m * RW_PAD;
#pragma unroll
        for (int it = 0; it < 7; ++it) {
            const int v = it * 64 + lane; if (it == 6 && v >= 436) continue;
            const v4u wc = *(const v4u*)(pr + v * 8);
            v4u wp = {0u, 0u, 0u, 0u}, wn = {0u, 0u, 0u, 0u};
            if (hp) wp = *(const v4u*)(pr - RW_PAD + v * 8);
            if (hn_) wn = *(const v4u*)(pr + RW_PAD + v * 8);
            float c[8], pv[8], nx[8]; unpack8(wc, c); unpack8(wp, pv); unpack8(wn, nx);
            const float4 m0 = *(const float4*)(mu + v * 8), m1 = *(const float4*)(mu + v * 8 + 4);
            const float mm[8] = {m0.x, m0.y, m0.z, m0.w, m1.x, m1.y, m1.z, m1.w};
            float xs[8];
#pragma unroll
            for (int j = 0; j < 8; ++j) xs[j] = c[j] + mm[j] * (0.5f * (pv[j] + nx[j]) - c[j]);
            if (v < 384) { const v4u pw = pack8(xs); *(v4u*)(RKV + (size_t)m * 3072 + v * 8) = pw;
                if (it == 2 || it == 3) {
                    float kr[8]; unpack8(pw, kr); float ssq = 0.f;
#pragma unroll
                    for (int j = 0; j < 8; ++j) { const float kkv = kr[j] * sm[SM_KK + (v - 128) * 8 + j]; ssq += kkv * kkv; }
                    ssq = sum8(ssq);
                    if ((lane & 7) == 0) ((float*)(ws + WS_INRM))[(size_t)m * 16 + ((v - 128) >> 3)] = 1.0f / fmaxf(sqrtf(ssq), 1e-12f); } }
            else if (v < 400) {
#pragma unroll
                for (int j = 0; j < 8; ++j) xs[j] = 1.0f - 2.0f * __builtin_amdgcn_rcpf(1.0f + __expf(2.0f * xs[j]));
                *(v4u*)(LIN + (size_t)m * 512 + (v - 384) * 8) = pack8(xs); }
            else if (v < 416) { *(v4u*)(LIN + (size_t)m * 512 + (v - 384) * 8) = pack8(xs); }
            else {
#pragma unroll
                for (int j = 0; j < 8; ++j) xs[j] = sigmoidf_(xs[j]);
                *(v4u*)(LIN + (size_t)m * 512 + 256 + (v - 416) * 8) = pack8(xs); }
        }
        if (lane < 12) { v4u z = {0u, 0u, 0u, 0u}; *(v4u*)(LIN + (size_t)m * 512 + 416 + lane * 8) = z; }
    }
}

struct P6Raw { v4u yf, ybk, r, k, v, af, ab, g; };
__device__ __forceinline__ void p6_load(P6Raw& q, const bf16_t* RKV, const bf16_t* LO, const bf16_t* YSF, const bf16_t* YSB, size_t SEG, int it, int lane) {
    const int m = it >> 1, col = (it & 1) * 512 + lane * 8;
    q.yf = *(const v4u*)(YSF + (size_t)m * 1024 + col); q.ybk = *(const v4u*)(YSB + (size_t)m * 1024 + col);
    q.r = *(const v4u*)(RKV + (size_t)m * 3072 + col); q.k = *(const v4u*)(RKV + (size_t)m * 3072 + 1024 + col); q.v = *(const v4u*)(RKV + (size_t)m * 3072 + 2048 + col);
    q.af = *(const v4u*)(LO + 2 * SEG + (size_t)m * 1024 + col); q.ab = *(const v4u*)(LO + 3 * SEG + (size_t)m * 1024 + col); q.g = *(const v4u*)(LO + 4 * SEG + (size_t)m * 1024 + col);
}
__device__ __forceinline__ void p6_item(const P6Raw& q, bf16_t* YB, const float* sm, int it, int lane) {
    const int m = it >> 1, col = (it & 1) * 512 + lane * 8;
    float yf[8], ybk[8], r[8], k[8], v[8], af[8], ab[8], g[8];
    unpack8(q.yf, yf); unpack8(q.ybk, ybk); unpack8(q.r, r); unpack8(q.k, k); unpack8(q.v, v); unpack8(q.af, af); unpack8(q.ab, ab); unpack8(q.g, g);
    float y[8]; float s = 0.f;
#pragma unroll
    for (int j = 0; j < 8; ++j) { y[j] = yf[j] + ybk[j]; s += y[j]; }
    const float mean = sum8(s) * (1.0f / 64.0f); float qq = 0.f;
#pragma unroll
    for (int j = 0; j < 8; ++j) { y[j] -= mean; qq += y[j] * y[j]; }
    const float rstd = 1.0f / sqrtf(sum8(qq) * (1.0f / 64.0f) + GN_EPS);
    float bs = 0.f;
#pragma unroll
    for (int j = 0; j < 8; ++j) { const float kfb = k[j] * (2.0f + (af[j] + ab[j] - 2.0f) * sm[SM_KA + col + j]); bs += r[j] * kfb * sm[SM_RK + col + j]; }
    bs = sum8(bs);
    float o[8];
#pragma unroll
    for (int j = 0; j < 8; ++j) o[j] = (y[j] * rstd * sm[SM_LNW + col + j] + sm[SM_LNB + col + j] + bs * v[j]) * g[j];
    *(v4u*)(YB + (size_t)m * 2048 + col) = pack8(o);
}
__device__ __forceinline__ void p6_rwpost(const Args& a, int gw, int NGW, int lane) {
    unsigned char* ws = a.ws;
    const bf16_t* RKV = (const bf16_t*)(ws + WS_RKV); const bf16_t* LO = (const bf16_t*)(ws + WS_LORA);
    const bf16_t* YSF = (const bf16_t*)((unsigned char*)a.out + DO_YSF); const bf16_t* YSB = (const bf16_t*)((unsigned char*)a.out + DO_YSB);
    bf16_t* YB = (bf16_t*)((unsigned char*)a.out + DO_YAB) + 1024;
    const size_t SEG = (size_t)M * 1024; const float* sm = (const float*)(ws + WS_SMALL);
    for (int it = gw; it < 2 * M; it += 2 * NGW) {
        P6Raw qa, qb; const int it2 = it + NGW; const bool two = it2 < 2 * M;
        p6_load(qa, RKV, LO, YSF, YSB, SEG, it, lane);
        if (two) p6_load(qb, RKV, LO, YSF, YSB, SEG, it2, lane);
        p6_item(qa, YB, sm, it, lane);
        if (two) p6_item(qb, YB, sm, it2, lane);
    }
}

__device__ __forceinline__ void expert_convert_gu(const Args& a, LAS unsigned char* lds, int gw, int NGW, int wave, int lane, int e_lo, int e_hi, int it_end = 1 << 30) {
    unsigned char* ws = a.ws;
    LAS float* scr = (LAS float*)(lds + wave * 16384);
    const int per = (e_hi - e_lo) * 1024;
    for (int it = gw; it < 2 * per && it < it_end; it += NGW) {
        const int which = it >= per ? 1 : 0, r = it - which * per, e = e_lo + (r >> 10), q = r & 1023;
        const int kb = q >> 5, nb = q & 31, n0 = nb * 32;
        const float* W = (which == 0 ? a.in[I_WG] : a.in[I_WU]) + (size_t)e * 2048 * 1024;
        const int drow = (n0 >> 7) * 256 + which * 128 + (n0 & 127);
        tr_item(W, 1024, kb * 64, n0, (bf16_t*)(ws + w1t_base(e)) + (size_t)drow * 2048 + kb * 64, 2048, scr, lane); }
}
__device__ __forceinline__ void expert_convert_down(const Args& a, LAS unsigned char* lds, int gw, int NGW, int wave, int lane) {
    unsigned char* ws = a.ws;
    LAS float* scr = (LAS float*)(lds + wave * 16384);
    bf16_t* WDT = (bf16_t*)(ws + WS_WDT);
    for (int it = gw; it < 16384; it += NGW) { const int e = it >> 10, q = it & 1023, kb = q >> 6, nb = q & 63;
        const float* W = a.in[I_WD] + (size_t)e * 1024 * 2048;
        tr_item(W, 2048, kb * 64, nb * 32, WDT + ((size_t)e * 2048 + nb * 32) * 1024 + kb * 64, 1024, scr, lane); }
}
__device__ __forceinline__ void p9_router(const Args& a, LAS unsigned char* lds, int gw, int NGW, int wave, int lane) {
    unsigned char* ws = a.ws;
    expert_convert_gu(a, lds, gw, NGW, wave, lane, (gridDim.x == 256) ? N_EARLY_EXPERTS : 0, NE);
    __syncthreads();
    LAS float* wrT = (LAS float*)lds;
    { const float4* wr4 = (const float4*)((const float*)(ws + WS_SMALL) + SM_WR);
      for (int idx = fresh_tid(); idx < 2048 * 4; idx += NTHREADS) { const int d = idx >> 2, q = idx & 3; const float4 w4 = wr4[idx];
          wrT[(4 * q + 0) * 2048 + d] = w4.x; wrT[(4 * q + 1) * 2048 + d] = w4.y; wrT[(4 * q + 2) * 2048 + d] = w4.z; wrT[(4 * q + 3) * 2048 + d] = w4.w; } }
    __syncthreads();
    const float* h = a.out; const float* ss = (const float*)(ws + WS_SSP); const float* g = (const float*)(ws + WS_SMALL) + SM_FNG;
    float* aff = (float*)(ws + WS_AFF); bf16_t* hn2 = (bf16_t*)(ws + WS_HN2);
    for (int mp = gw; mp < M / 2; mp += NGW) {
        const int m0 = 2 * mp;
        const float rs0 = 1.0f / sqrtf(wave_sum(lane < 32 ? ss[(size_t)m0 * 32 + lane] : 0.f) * (1.0f / DM) + RMS_EPS);
        const float rs1 = 1.0f / sqrtf(wave_sum(lane < 32 ? ss[(size_t)(m0 + 1) * 32 + lane] : 0.f) * (1.0f / DM) + RMS_EPS);
        float acc0[16], acc1[16];
#pragma unroll
        for (int e = 0; e < 16; ++e) { acc0[e] = 0.f; acc1[e] = 0.f; }
#pragma unroll 2
        for (int j = 0; j < 8; ++j) { const int d = j * 256 + lane * 4;
            const float4 gv = *(const float4*)(g + d), h0 = *(const float4*)(h + (size_t)m0 * DM + d), h1 = *(const float4*)(h + (size_t)(m0 + 1) * DM + d);
            const float x0[4] = {h0.x * rs0 * gv.x, h0.y * rs0 * gv.y, h0.z * rs0 * gv.z, h0.w * rs0 * gv.w};
            const float x1[4] = {h1.x * rs1 * gv.x, h1.y * rs1 * gv.y, h1.z * rs1 * gv.z, h1.w * rs1 * gv.w};
            { v2u w0, w1; w0.x = pk2(x0[0], x0[1]); w0.y = pk2(x0[2], x0[3]); w1.x = pk2(x1[0], x1[1]); w1.y = pk2(x1[2], x1[3]);
              *(v2u*)(hn2 + (size_t)m0 * DM + d) = w0; *(v2u*)(hn2 + (size_t)(m0 + 1) * DM + d) = w1; }
#pragma unroll
            for (int e = 0; e < 16; ++e) { const pg8::f32x4 w4 = *(const LAS pg8::f32x4*)(wrT + e * 2048 + d);
                acc0[e] += x0[0] * w4.x + x0[1] * w4.y + x0[2] * w4.z + x0[3] * w4.w;
                acc1[e] += x1[0] * w4.x + x1[1] * w4.y + x1[2] * w4.z + x1[3] * w4.w; } }
#pragma unroll
        for (int t2 = 0; t2 < 2; ++t2) {
            float mx = -1e30f, lg[16];
#pragma unroll
            for (int e = 0; e < 16; ++e) { lg[e] = wave_sum(t2 ? acc1[e] : acc0[e]); mx = fmaxf(mx, lg[e]); }
            float den = 0.f;
#pragma unroll
            for (int e = 0; e < 16; ++e) { lg[e] = __expf(lg[e] - mx); den += lg[e]; }
            float mine = lg[0];
#pragma unroll
            for (int e = 1; e < 16; ++e) mine = (lane == e) ? lg[e] : mine;
            const int m = m0 + t2;
            if (lane < 16) aff[((size_t)(m >> 12) * 16 + lane) * SEQ + (m & (SEQ - 1))] = mine / den;
        }
    }
}

__device__ __forceinline__ void p10_topk(const Args& a, unsigned char* ldsg) {
    const int bx = blockIdx.x; if (bx >= NB * NE) return;
    LAS unsigned char* L = (LAS unsigned char*)ldsg;
    const int tid = fresh_tid(), lane = tid & 63, w = tid >> 6;
    unsigned char* ws = a.ws;
    const float* aff = (const float*)(ws + WS_AFF) + (size_t)bx * SEQ;
    LAS unsigned* hist = (LAS unsigned*)L;
    LAS unsigned* ctl = hist + 256;
    LAS unsigned* wtot = hist + 272;
    unsigned v[8];
    { const v4u a0 = *(const v4u*)(aff + tid * 8), a1 = *(const v4u*)(aff + tid * 8 + 4); v[0] = a0.x; v[1] = a0.y; v[2] = a0.z; v[3] = a0.w; v[4] = a1.x; v[5] = a1.y; v[6] = a1.z; v[7] = a1.w; }
    unsigned prefix = 0u, mask = 0u, remaining = CAP;
#pragma unroll 1
    for (int pass = 0; pass < 4; ++pass) {
        const int shift = 24 - 8 * pass;
        if (tid < 256) hist[tid] = 0u;
        __syncthreads();
#pragma unroll
        for (int q = 0; q < 8; ++q) if ((v[q] & mask) == prefix) __hip_atomic_fetch_add((unsigned*)&hist[(v[q] >> shift) & 255u], 1u, __ATOMIC_RELAXED, __HIP_MEMORY_SCOPE_WORKGROUP);
        __syncthreads();
        if (w == 0) {
            const v4u hb = *(const LAS v4u*)(hist + 4 * lane);
            const unsigned own = hb.x + hb.y + hb.z + hb.w;
            unsigned suf = own;
#pragma unroll
            for (int o = 1; o < 64; o <<= 1) { const unsigned t = __shfl_down(suf, o); suf += (lane + o < 64) ? t : 0u; }
            const unsigned above = suf - own;
            if (above < remaining && remaining <= suf) {
                unsigned c3 = above, d, rem;
                if (remaining <= c3 + hb.w) { d = 3; rem = remaining - c3; }
                else { c3 += hb.w; if (remaining <= c3 + hb.z) { d = 2; rem = remaining - c3; }
                    else { c3 += hb.z; if (remaining <= c3 + hb.y) { d = 1; rem = remaining - c3; } else { c3 += hb.y; d = 0; rem = remaining - c3; } } }
                ctl[0] = 4u * lane + d; ctl[1] = rem;
            }
        }
        __syncthreads();
        prefix |= ctl[0] << shift; mask |= 255u << shift; remaining = ctl[1];
        __syncthreads();
    }
    const unsigned thr = prefix;
    unsigned ceq = 0u, cgt = 0u;
#pragma unroll
    for (int q = 0; q < 8; ++q) { ceq += (v[q] == thr) ? 1u : 0u; cgt += (v[q] > thr) ? 1u : 0u; }
    unsigned inc = ceq;
#pragma unroll
    for (int o = 1; o < 64; o <<= 1) { const unsigned t = __shfl_up(inc, o); inc += (lane >= o) ? t : 0u; }
    if (lane == 63) wtot[w] = inc;
    __syncthreads();
    unsigned eqbase = inc - ceq;
#pragma unroll
    for (int q = 0; q < 8; ++q) eqbase += (q < w) ? wtot[q] : 0u;
    __syncthreads();
    unsigned selmask = 0u, nsel = 0u, er = eqbase;
#pragma unroll
    for (int q = 0; q < 8; ++q) { bool s = v[q] > thr; if (v[q] == thr) { s = er < remaining; ++er; } selmask |= s ? (1u << q) : 0u; nsel += s ? 1u : 0u; }
    inc = nsel;
#pragma unroll
    for (int o = 1; o < 64; o <<= 1) { const unsigned t = __shfl_up(inc, o); inc += (lane >= o) ? t : 0u; }
    if (lane == 63) wtot[w] = inc;
    __syncthreads();
    unsigned pos = inc - nsel;
#pragma unroll
    for (int q = 0; q < 8; ++q) pos += (q < w) ? wtot[q] : 0u;
    int* seltok = (int*)(ws + WS_SELTOK) + bx * CAP; float* selgate = (float*)(ws + WS_SELGATE) + bx * CAP;
#pragma unroll
    for (int q = 0; q < 8; ++q) if (selmask & (1u << q)) { if (pos < (unsigned)CAP) { seltok[pos] = tid * 8 + q; selgate[pos] = __uint_as_float(v[q]); } ++pos; }
    (void)cgt;
}

__device__ __forceinline__ void p11_gather(const Args& a, int gw, int NGW, int lane) {
    unsigned char* ws = a.ws;
    const float* h = a.out; const float* ss = (const float*)(ws + WS_SSP); const float* g = (const float*)(ws + WS_SMALL) + SM_FNG;
    const int* seltok = (const int*)(ws + WS_SELTOK); bf16_t* XE = (bf16_t*)(ws + WS_XE);
    for (int r = gw; r < NSLOT; r += NGW) {
        const int e = r >> 11, b = (r >> 9) & 3, c = r & 511;
        const int tok = seltok[(b * 16 + e) * CAP + c]; const size_t m = (size_t)b * SEQ + tok;
        const float rs = 1.0f / sqrtf(wave_sum(lane < 32 ? ss[m * 32 + lane] : 0.f) * (1.0f / DM) + RMS_EPS);
        const float4* hr = (const float4*)(h + m * DM) + lane; v2u* o = (v2u*)(XE + (size_t)r * DM) + lane;
#pragma unroll
        for (int j = 0; j < 8; ++j) { const float4 hv = hr[64 * j], gg = ((const float4*)g)[64 * j + lane];
            v2u w; w.x = pk2(hv.x * rs * gg.x, hv.y * rs * gg.y); w.y = pk2(hv.z * rs * gg.z, hv.w * rs * gg.w); o[64 * j] = w; }
    }
}

__device__ __forceinline__ void p14_combine(const Args& a, unsigned char* lds, int wave, int lane) {
    unsigned char* ws = a.ws;
    const int G = gridDim.x, bx = blockIdx.x, tid = fresh_tid();
    const int per = M / G;
    const int m0 = bx * per, b = m0 >> 12, t0 = m0 & (SEQ - 1);
    int* inv = (int*)lds;
    for (int i = tid; i < per * 16; i += NTHREADS) inv[i] = -1;
    __syncthreads();
    const int* seltok = (const int*)(ws + WS_SELTOK) + b * 16 * CAP;
    for (int i = tid; i < 16 * CAP; i += NTHREADS) { const int e = i >> 9, c = i & 511; const int tok = seltok[i]; const int tl = tok - t0;
        if (tl >= 0 && tl < per) inv[tl * 16 + e] = e * 2048 + b * 512 + c; }
    __syncthreads();
    const bf16_t* YE = (const bf16_t*)(ws + WS_XE);
    float* out = a.out;
    for (int tl = wave; tl < per; tl += NWAVES) {
        const size_t m = (size_t)m0 + tl;
        float4* orow = (float4*)(out + m * DM) + lane;
        float4 acc[8];
#pragma unroll
        for (int j = 0; j < 8; ++j) acc[j] = orow[64 * j];
        int sl[16]; int ns = 0;
#pragma unroll
        for (int e = 0; e < 16; ++e) { const int s_ = inv[tl * 16 + e]; if (s_ >= 0) { _Pragma("unroll") for (int q = 0; q < 16; ++q) if (q == ns) sl[q] = s_; ++ns; } }
        for (int q = 0; q < ns; q += 2) { int s0 = sl[0], s1 = sl[0];
#pragma unroll
            for (int z = 0; z < 16; ++z) { if (z == q) s0 = sl[z]; if (z == q + 1) s1 = sl[z]; }
            const bool two = q + 1 < ns;
            const v2u* y0 = (const v2u*)(YE + (size_t)s0 * DM) + lane; const v2u* y1 = (const v2u*)(YE + (size_t)(two ? s1 : s0) * DM) + lane;
            v2u w0[8], w1[8];
#pragma unroll
            for (int j = 0; j < 8; ++j) { w0[j] = y0[64 * j]; w1[j] = y1[64 * j]; }
#pragma unroll
            for (int j = 0; j < 8; ++j) { acc[j].x += bflo(w0[j].x); acc[j].y += bfhi(w0[j].x); acc[j].z += bflo(w0[j].y); acc[j].w += bfhi(w0[j].y);
                if (two) { acc[j].x += bflo(w1[j].x); acc[j].y += bfhi(w1[j].x); acc[j].z += bflo(w1[j].y); acc[j].w += bfhi(w1[j].y); } } }
#pragma unroll
        for (int j = 0; j < 8; ++j) orow[64 * j] = acc[j];
    }
}


namespace scan {
typedef short bf16x8 __attribute__((ext_vector_type(8)));
typedef float f32x4 __attribute__((ext_vector_type(4)));
constexpr int TILE_B = 64 * 128;
enum { SL_ATC = 0, SL_BTC = 1, SL_KTC = 2, SL_RTC = 3, SL_BBT = 4, SL_KBT = 5, SL_VT = 6, SL_XCA = 7, SL_TTA = 8, SL_NKA = 9, SL_NBRT = 10, SL_G = 11, SL_SB = 12, SL_RP = 13, SL_BBT1 = 14, SL_VT1 = 15, SL_NKR = 16,
       SL_XCB = 1, SL_TTB = 2, SL_APT = 7, SL_HT = 9, SL_PSIT = 8, SL_WB = 10 };
constexpr int OFF_PL = 17 * TILE_B, OFF_TOT = OFF_PL + 512, OFF_CNT = OFF_TOT + 4096;
#define TILE(s) (L + (s) * TILE_B)
__device__ __forceinline__ int swz16(int r) { return (((r & 7) ^ (((r >> 3) & 1) * 5)) << 4); }
__device__ __forceinline__ int toff(int row, int colbyte) { return row * 128 + (colbyte ^ swz16(row)); }
__device__ __forceinline__ bf16x8 frag(const LAS unsigned char* tile, int row0, int k0, int lane) {
    const int l15 = lane & 15, g4 = lane >> 4;
    return *(const LAS bf16x8*)(tile + row0 * 128 + l15 * 128 + (((g4 << 4) ^ swz16(l15)) ^ (k0 * 2)));
}
__device__ __forceinline__ void st4(LAS unsigned char* tile, int brow, int acol0, const f32x4& v) {
    v2u w; w.x = pg8::cvt_pk_bf16(v[0], v[1]); w.y = pg8::cvt_pk_bf16(v[2], v[3]); *(LAS v2u*)(tile + toff(brow, acol0 * 2)) = w;
}
__device__ __forceinline__ f32x4 ld4(const LAS unsigned char* tile, int brow, int acol0) {
    const v2u w = *(const LAS v2u*)(tile + toff(brow, acol0 * 2)); return (f32x4){bflo(w.x), bfhi(w.x), bflo(w.y), bfhi(w.y)};
}
typedef short v4i16_t __attribute__((ext_vector_type(4)));
typedef short bf16x4 __attribute__((ext_vector_type(4)));
typedef float f32x2 __attribute__((ext_vector_type(2)));
__device__ __forceinline__ bf16x8 fragT(const LAS unsigned char* tileT, int row0, int k0, int lane) {
    const int g = lane >> 4, q = (lane >> 2) & 3, p = lane & 3;
    const int t0 = (8 * g + q) * 128 + ((8 * p) ^ ((q ^ ((g & 1) * 5)) << 4));
    const LAS unsigned char* a = tileT + k0 * 128;
    const v4i16_t lo = __builtin_amdgcn_ds_read_tr16_b64_v4i16((LAS v4i16_t*)(a + (t0 ^ (row0 * 2)))), hi = __builtin_amdgcn_ds_read_tr16_b64_v4i16((LAS v4i16_t*)(a + 512 + ((t0 ^ 64) ^ (row0 * 2))));
    return (bf16x8){lo[0], lo[1], lo[2], lo[3], hi[0], hi[1], hi[2], hi[3]};
}
struct Fr { bf16x8 k0, k1; };
__device__ __forceinline__ Fr ldf(const LAS unsigned char* tile, int row0, int lane) { Fr f; f.k0 = frag(tile, row0, 0, lane); f.k1 = frag(tile, row0, 32, lane); return f; }
__device__ __forceinline__ Fr ldfT(const LAS unsigned char* tileT, int row0, int lane) { Fr f; f.k0 = fragT(tileT, row0, 0, lane); f.k1 = fragT(tileT, row0, 32, lane); return f; }
__device__ __forceinline__ void mmf(f32x4& acc, const Fr& A, const Fr& B) {
    acc = __builtin_amdgcn_mfma_f32_16x16x32_bf16(A.k0, B.k0, acc, 0, 0, 0); acc = __builtin_amdgcn_mfma_f32_16x16x32_bf16(A.k1, B.k1, acc, 0, 0, 0);
}
#define ZERO4 ((f32x4){0.f, 0.f, 0.f, 0.f})
#ifndef TP_SEL
#define TP_SEL -1
#endif
#ifndef TP_WAVE
#define TP_WAVE 0
#endif
#if TP_SEL >= 0
#define TP_MARK(k) do { if (w == TP_WAVE) { const unsigned long long t_ = __builtin_amdgcn_s_memtime(); if (TP_SEL == (k) || TP_SEL == 7) tp_acc += t_ - tp_last; tp_last = t_; } } while (0)
#else
#define TP_MARK(k) do { } while (0)
#endif
__device__ __forceinline__ int opq(int x) { asm volatile("" : "+v"(x)); return x; }
#define LWAIT() asm volatile("s_waitcnt lgkmcnt(0)" ::: "memory")

__device__ __forceinline__ void scan_phase(const Args& a, unsigned char* ldsg) {
    const int bx = blockIdx.x; if (bx >= 128) return;
    LAS unsigned char* L = (LAS unsigned char*)ldsg;
    const int tid = fresh_tid(), lane0 = tid & 63, w = __builtin_amdgcn_readfirstlane(tid >> 6);
    const int dir = bx >> 6, b = (bx >> 4) & 3, hh = bx & 15;
    unsigned char* ws = a.ws;
    bf16_t* YS = (bf16_t*)((unsigned char*)a.out + (dir ? DO_YSB : DO_YSF));
    const int ta = w >> 1, tb0 = (w & 1) * 2;
#define STAGE_LANE() const int lane = opq(lane0), g4 = lane >> 4, l15 = lane & 15, a0 = ta * 16 + 4 * g4
    unsigned rw[8][5]; float inr[8];
    const int wk = w & 3, tg = lane0 >> 5, cp = lane0 & 31;
    const unsigned char* RKVh = ws + WS_RKV + hh * 128; const unsigned char* LWh = ws + WS_LORA + (size_t)dir * ((size_t)M * 2048) + hh * 128; const unsigned char* ALh = ws + WS_LORA + (size_t)(2 + dir) * ((size_t)M * 2048) + hh * 128;
    const int tlane = dir ? (1 - tg) * 8 : tg * 8;
    const unsigned vR = (unsigned)(tlane * 6144 + cp * 4), vL = (unsigned)(tlane * 2048 + cp * 4), vI = (unsigned)(tlane * 64);
    const float* INRM = (const float*)(ws + WS_INRM) + hh;
    const f32x2 kkc2 = *(const f32x2*)((const float*)(ws + WS_SMALL) + SM_KK + hh * 64 + 2 * cp), kac2 = *(const f32x2*)((const float*)(ws + WS_SMALL) + SM_KA + hh * 64 + 2 * cp);
#define RAW_LOAD(chunk, j0) do { _Pragma("unroll") for (int j = (j0); j < (j0) + 4; ++j) { const int s_ = (chunk) * 64 + wk * 16 + j; const int t_ = dir ? (SEQ - 1 - s_ - 8) : s_; const size_t m_ = (size_t)b * SEQ + t_; \
        const unsigned char* pr_ = RKVh + m_ * 6144; const unsigned char* pl_ = LWh + m_ * 2048; const unsigned char* pa_ = ALh + m_ * 2048; \
        rw[j][0] = *(const unsigned*)(pr_ + vR); rw[j][1] = *(const unsigned*)(pr_ + 2048 + vR); rw[j][2] = *(const unsigned*)(pr_ + 4096 + vR); rw[j][3] = *(const unsigned*)(pl_ + vL); rw[j][4] = *(const unsigned*)(pa_ + vL); \
        inr[j] = *(const float*)((const unsigned char*)(INRM + m_ * 16) + vI); } } while (0)
#define DSUM(n) do { const int l2_ = fresh_tid() & 63, tg_ = l2_ >> 5, cp_ = l2_ & 31; \
        f32x2 run_ = {0.f, 0.f}; _Pragma("unroll") for (int j = 0; j < 8; ++j) run_ += (f32x2){bflo(rw[j][3]), bfhi(rw[j][3])}; \
        *(LAS f32x2*)(L + OFF_TOT + ((((n) & 1) * 8 + 2 * wk + tg_) * 64 + 2 * cp_) * 4) = run_; \
        LWAIT(); \
        if (l2_ == 0) __hip_atomic_fetch_add((unsigned*)(L + OFF_CNT), 1u, __ATOMIC_RELAXED, __HIP_MEMORY_SCOPE_WORKGROUP); \
        while (*(volatile LAS unsigned*)(L + OFF_CNT) < 4u * (unsigned)((n) + 1)) __builtin_amdgcn_s_sleep(1); } while (0)
    f32x2 prun, ppv, ppl; unsigned pk[6][2][4], vt[2][4];
#define PTOK(jp) do { f32x2 o[2][6]; \
        _Pragma("unroll") for (int h = 0; h < 2; ++h) { const int j = 2 * (jp) + h; \
            prun += (f32x2){bflo(rw[j][3]), bfhi(rw[j][3])} * 1.44269504f; \
            const f32x2 p = {__builtin_amdgcn_exp2f(prun[0]), __builtin_amdgcn_exp2f(prun[1])}, em = {__builtin_amdgcn_rcpf(p[0]), __builtin_amdgcn_rcpf(p[1])}, eL = ppl * em; \
            const f32x2 r = {bflo(rw[j][0]), bfhi(rw[j][0])}, k = {bflo(rw[j][1]), bfhi(rw[j][1])}, al = {bflo(rw[j][4]), bfhi(rw[j][4])}; \
            const f32x2 kk = k * kkc2 * inr[j], kdv = k * (1.0f + (al - 1.0f) * kac2), bbj = kk * al; \
            o[h][0] = -kk * ppv; ppv = p; o[h][1] = bbj * em; o[h][2] = kdv * em; o[h][3] = r * p; o[h][4] = bbj * eL; o[h][5] = kdv * eL; } \
        _Pragma("unroll") for (int q = 0; q < 6; ++q) { pk[q][0][jp] = pk2(o[0][q][0], o[1][q][0]); pk[q][1][jp] = pk2(o[0][q][1], o[1][q][1]); } \
        vt[0][jp] = (rw[2 * (jp)][2] & 0xffffu) | (rw[2 * (jp) + 1][2] << 16); vt[1][jp] = (rw[2 * (jp)][2] >> 16) | (rw[2 * (jp) + 1][2] & 0xffff0000u); } while (0)
#define PREP1(n) do { const int l2_ = fresh_tid() & 63, tg_ = l2_ >> 5, cp_ = l2_ & 31; \
        f32x2 run = {0.f, 0.f}, tot = {0.f, 0.f}; \
        _Pragma("unroll") for (int q = 0; q < 8; ++q) { const f32x2 t_ = *(const LAS f32x2*)(L + OFF_TOT + ((((n) & 1) * 8 + q) * 64 + 2 * cp_) * 4); \
            const float m_ = (q < 2 * wk + tg_) ? 1.0f : 0.f; run += t_ * m_; tot += t_; } \
        run *= 1.44269504f; tot *= 1.44269504f;                                                                \
        ppl = (f32x2){__builtin_amdgcn_exp2f(tot[0]), __builtin_amdgcn_exp2f(tot[1])}; \
        if (wk == 0 && tg_ == 0) *(LAS f32x2*)(L + OFF_PL + (((n) & 1) * 64 + 2 * cp_) * 4) = ppl; \
        prun = run; ppv = (f32x2){__builtin_amdgcn_exp2f(run[0]), __builtin_amdgcn_exp2f(run[1])}; \
        PTOK(0); PTOK(1); } while (0)
#define PREP2(n) do { const int l2_ = fresh_tid() & 63, tg_ = l2_ >> 5, cp_ = l2_ & 31; \
        PTOK(2); PTOK(3); \
        LAS unsigned char* bbt_ = TILE(((n) & 1) ? SL_BBT1 : SL_BBT); LAS unsigned char* vt_ = TILE(((n) & 1) ? SL_VT1 : SL_VT); \
        _Pragma("unroll") for (int x = 0; x < 2; ++x) { const int o16 = toff(2 * cp_ + x, (wk * 16 + tg_ * 8) * 2); \
            *(LAS v4u*)(TILE(SL_ATC) + o16) = (v4u){pk[0][x][0], pk[0][x][1], pk[0][x][2], pk[0][x][3]}; *(LAS v4u*)(TILE(SL_BTC) + o16) = (v4u){pk[1][x][0], pk[1][x][1], pk[1][x][2], pk[1][x][3]}; \
            *(LAS v4u*)(TILE(SL_KTC) + o16) = (v4u){pk[2][x][0], pk[2][x][1], pk[2][x][2], pk[2][x][3]}; *(LAS v4u*)(TILE(SL_RTC) + o16) = (v4u){pk[3][x][0], pk[3][x][1], pk[3][x][2], pk[3][x][3]}; \
            *(LAS v4u*)(bbt_ + o16) = (v4u){pk[4][x][0], pk[4][x][1], pk[4][x][2], pk[4][x][3]}; *(LAS v4u*)(TILE(SL_KBT) + o16) = (v4u){pk[5][x][0], pk[5][x][1], pk[5][x][2], pk[5][x][3]}; \
            *(LAS v4u*)(vt_ + o16) = (v4u){vt[x][0], vt[x][1], vt[x][2], vt[x][3]}; } \
    } while (0)
#if TP_SEL >= 0
    unsigned long long tp_acc = 0, tp_last = __builtin_amdgcn_s_memtime();
#endif
    f32x4 accS[4];
#pragma unroll
    for (int q = 0; q < 4; ++q) accS[q] = (f32x4){0.f, 0.f, 0.f, 0.f};
    for (int u = tid; u < TILE_B / 16; u += NTHREADS) ((LAS v4u*)TILE(SL_SB))[u] = (v4u){0u, 0u, 0u, 0u};
    if (tid == 0) *(LAS unsigned*)(L + OFF_CNT) = 0u;
    if (w >= 4) { RAW_LOAD(0, 0); RAW_LOAD(0, 4); }
    __syncthreads();
    if (w >= 4) { DSUM(0); PREP1(0); PREP2(0); }
#pragma unroll 1
    for (int c = 0; c < SEQ / 64; ++c) {
        LAS unsigned char* BBTc = TILE((c & 1) ? SL_BBT1 : SL_BBT); LAS unsigned char* VTc = TILE((c & 1) ? SL_VT1 : SL_VT);
        TP_MARK(5);
        __syncthreads();
        TP_MARK(0);
        if (w >= 4 && c + 1 < SEQ / 64) { RAW_LOAD(c + 1, 0); RAW_LOAD(c + 1, 4); }
        {   STAGE_LANE();
            const int p = w & 3;
            LAS unsigned char* As = TILE((p == 0 || p == 2) ? SL_BTC : SL_KTC); LAS unsigned char* Bs = TILE(p < 2 ? SL_ATC : SL_RTC);
            LAS unsigned char* Ds = TILE(p == 0 ? SL_XCA : p == 1 ? SL_NKA : p == 2 ? SL_NBRT : SL_NKR);
            const int lim = l15 + (p < 2 ? 0 : 1) - 4 * g4;
#define S1_MASK(dv) do { _Pragma("unroll") for (int e = 0; e < 4; ++e) (dv)[e] = (e < lim) ? (dv)[e] : 0.f; } while (0)
#define S1_EYE(dv) do { _Pragma("unroll") for (int e = 0; e < 4; ++e) (dv)[e] += (e == l15 - 4 * g4) ? 1.0f : 0.f; } while (0)
            if (w < 4) {
                const Fr a0f = ldfT(As, 0, lane), a1f = ldfT(As, 16, lane); Fr bf[4];
#pragma unroll
                for (int j = 0; j < 4; ++j) bf[j] = ldfT(Bs, j * 16, lane);
                f32x4 d0[4], d1[3];
#pragma unroll
                for (int j = 0; j < 4; ++j) { d0[j] = ZERO4; mmf(d0[j], a0f, bf[j]); }
#pragma unroll
                for (int j = 0; j < 3; ++j) { d1[j] = ZERO4; mmf(d1[j], a1f, bf[j + 1]); }
                S1_MASK(d0[0]); S1_MASK(d1[0]);
#pragma unroll
                for (int j = 0; j < 4; ++j) st4(Ds, j * 16 + l15, 4 * g4, d0[j]);
#pragma unroll
                for (int j = 0; j < 3; ++j) st4(Ds, (j + 1) * 16 + l15, 16 + 4 * g4, d1[j]);
                if (p == 0) { S1_EYE(d0[0]); S1_EYE(d1[0]);
#pragma unroll
                    for (int j = 0; j < 4; ++j) st4(TILE(SL_TTA), j * 16 + l15, 4 * g4, d0[j]);
#pragma unroll
                    for (int j = 0; j < 3; ++j) st4(TILE(SL_TTA), (j + 1) * 16 + l15, 16 + 4 * g4, d1[j]); }
            } else {
                const Fr a2f = ldfT(As, 32, lane), a3f = ldfT(As, 48, lane), b2f = ldfT(Bs, 32, lane), b3f = ldfT(Bs, 48, lane);
                f32x4 d22 = ZERO4, d23 = ZERO4, d33 = ZERO4;
                mmf(d22, a2f, b2f); mmf(d23, a2f, b3f); mmf(d33, a3f, b3f);
                S1_MASK(d22); S1_MASK(d33);
                st4(Ds, 32 + l15, 32 + 4 * g4, d22); st4(Ds, 48 + l15, 32 + 4 * g4, d23); st4(Ds, 48 + l15, 48 + 4 * g4, d33);
                if (p < 3) { LAS unsigned char* Zs = p == 0 ? TILE(SL_TTA) : Ds; const f32x4 z = ZERO4;
                    st4(Zs, l15, 16 + 4 * g4, z); st4(Zs, l15, 32 + 4 * g4, z); st4(Zs, l15, 48 + 4 * g4, z); st4(Zs, 16 + l15, 32 + 4 * g4, z); st4(Zs, 16 + l15, 48 + 4 * g4, z); st4(Zs, 32 + l15, 48 + 4 * g4, z); }
                if (p == 0) { const f32x4 z = ZERO4; st4(Ds, l15, 16 + 4 * g4, z); st4(Ds, 32 + l15, 48 + 4 * g4, z);
                    S1_EYE(d22); S1_EYE(d33); st4(TILE(SL_TTA), 32 + l15, 32 + 4 * g4, d22); st4(TILE(SL_TTA), 48 + l15, 32 + 4 * g4, d23); st4(TILE(SL_TTA), 48 + l15, 48 + 4 * g4, d33); }
            }
#undef S1_MASK
#undef S1_EYE
        }
        __syncthreads();
        TP_MARK(1);
        if (w < 2) {
            STAGE_LANE();
            const int d = w, s0 = 2 * d, s1 = 2 * d + 1, kd = 32 * d;
#define CAT(lo, hi) ((bf16x8)__builtin_shufflevector(lo, hi, 0, 1, 2, 3, 4, 5, 6, 7))
#define CV4(v) __builtin_bit_cast(bf16x4, (v2u){pk2((v)[0], (v)[1]), pk2((v)[2], (v)[3])})
#define MM(A, B, C) __builtin_amdgcn_mfma_f32_16x16x32_bf16(A, B, C, 0, 0, 0)
            const bf16x4 z4 = {0, 0, 0, 0};
            bf16x8 AF0 = fragT(TILE(SL_XCA), s0 * 16, kd, lane), AF1 = fragT(TILE(SL_XCA), s1 * 16, kd, lane);
            bf16x8 BF0 = frag(TILE(SL_XCA), s0 * 16, kd, lane), BF1 = frag(TILE(SL_XCA), s1 * 16, kd, lane);
            f32x4 t00 = ld4(TILE(SL_TTA), s0 * 16 + l15, s0 * 16 + 4 * g4), t01 = ld4(TILE(SL_TTA), s1 * 16 + l15, s0 * 16 + 4 * g4), t11 = ld4(TILE(SL_TTA), s1 * 16 + l15, s1 * 16 + 4 * g4);
            f32x4 l02, l03, l12, l13;
            if (w == 0) {
                l02 = ld4(TILE(SL_TTA), 32 + l15, 4 * g4); l03 = ld4(TILE(SL_TTA), 48 + l15, 4 * g4); l12 = ld4(TILE(SL_TTA), 32 + l15, 16 + 4 * g4); l13 = ld4(TILE(SL_TTA), 48 + l15, 16 + 4 * g4);
                const bf16x8 C2 = frag(TILE(SL_TTA), 32, 0, lane), C3 = frag(TILE(SL_TTA), 48, 0, lane);
                l02 = MM(AF0, C2, l02); l03 = MM(AF0, C3, l03); l12 = MM(AF1, C2, l12); l13 = MM(AF1, C3, l13);
            }
#pragma unroll
            for (int r = 0; r <= 4; ++r) {
                if (r >= 1) {
                    const bf16x8 BT0 = CAT(CV4(t00), z4), BT1 = CAT(CV4(t01), CV4(t11));
                    if (w == 0) { const bf16x8 BL2 = CAT(CV4(l02), CV4(l12)), BL3 = CAT(CV4(l03), CV4(l13));
                        l02 = MM(AF0, BL2, l02); l03 = MM(AF0, BL3, l03); l12 = MM(AF1, BL2, l12); l13 = MM(AF1, BL3, l13); }
                    t00 = MM(AF0, BT0, t00); t01 = MM(AF0, BT1, t01); t11 = MM(AF1, BT1, t11);
                }
                if (r < 4) {
                    const f32x4 x00 = MM(AF0, BF0, ZERO4), x01 = MM(AF0, BF1, ZERO4), x11 = MM(AF1, BF1, ZERO4);
                    const f32x4 y00 = MM(BF0, AF0, ZERO4), y10 = MM(BF1, AF0, ZERO4), y11 = MM(BF1, AF1, ZERO4);
                    BF0 = CAT(CV4(x00), z4); BF1 = CAT(CV4(x01), CV4(x11));
                    AF0 = CAT(CV4(y00), CV4(y10)); AF1 = CAT(z4, CV4(y11));
                }
            }
            st4(TILE(SL_TTA), s0 * 16 + l15, s0 * 16 + 4 * g4, t00); st4(TILE(SL_TTA), s1 * 16 + l15, s0 * 16 + 4 * g4, t01); st4(TILE(SL_TTA), s1 * 16 + l15, s1 * 16 + 4 * g4, t11);
            if (w == 0) { st4(TILE(SL_TTA), 32 + l15, 4 * g4, l02); st4(TILE(SL_TTA), 48 + l15, 4 * g4, l03); st4(TILE(SL_TTA), 32 + l15, 16 + 4 * g4, l12); st4(TILE(SL_TTA), 48 + l15, 16 + 4 * g4, l13); }
#undef CAT
#undef CV4
#undef MM
        }
        else if (w >= 4 && c + 1 < SEQ / 64) { DSUM(c + 1); PREP1(c + 1); }
        __syncthreads();
        if (w < 2) {
            STAGE_LANE();
            const bf16x8 A = fragT(TILE(SL_TTA), w * 16, 32, lane), B2 = frag(TILE(SL_TTA), 32, 32, lane), B3 = frag(TILE(SL_TTA), 48, 32, lane);
            const f32x4 u2 = __builtin_amdgcn_mfma_f32_16x16x32_bf16(A, B2, ZERO4, 0, 0, 0), u3 = __builtin_amdgcn_mfma_f32_16x16x32_bf16(A, B3, ZERO4, 0, 0, 0);
            st4(TILE(SL_TTA), 32 + l15, w * 16 + 4 * g4, u2); st4(TILE(SL_TTA), 48 + l15, w * 16 + 4 * g4, u3);
        }
        __syncthreads();
        TP_MARK(2);
        {   STAGE_LANE();
            const Fr aATC = ldf(TILE(SL_ATC), ta * 16, lane), aTT = ldf(TILE(SL_TTA), ta * 16, lane); Fr bTT[2], bNKA[2];
#pragma unroll
            for (int q = 0; q < 2; ++q) { bTT[q] = ldf(TILE(SL_TTA), (tb0 + q) * 16, lane); bNKA[q] = ldfT(TILE(SL_NKA), (tb0 + q) * 16, lane); }
            f32x4 e1[2], e3[2];
#pragma unroll
            for (int q = 0; q < 2; ++q) { e1[q] = ZERO4; e3[q] = ZERO4;
                mmf(e1[q], aATC, bTT[q]);
                mmf(e3[q], aTT, bNKA[q]); }
#pragma unroll
            for (int q = 0; q < 2; ++q) { const int bcol = (tb0 + q) * 16 + l15; st4(TILE(SL_APT), bcol, a0, e1[q]); st4(TILE(SL_G), bcol, a0, e3[q]); }
        }
        __syncthreads();
        TP_MARK(3);
        {   STAGE_LANE();
            const Fr aNB = ldf(TILE(SL_NBRT), ta * 16, lane), aG = ldf(TILE(SL_G), ta * 16, lane); Fr bAP[2], bNB[2], bBB[2]; f32x4 rp[2], ps[2], accH[2];
#pragma unroll
            for (int q = 0; q < 2; ++q) { const int bcol = (tb0 + q) * 16 + l15; bAP[q] = ldfT(TILE(SL_APT), (tb0 + q) * 16, lane); bNB[q] = ldf(TILE(SL_NBRT), (tb0 + q) * 16, lane); bBB[q] = ldf(BBTc, (tb0 + q) * 16, lane);
                rp[q] = ld4(TILE(SL_RTC), bcol, a0); ps[q] = ld4(TILE(SL_KBT), bcol, a0); accH[q] = ld4(TILE(SL_NKR), bcol, a0); if (ta > tb0 + q) accH[q] = ZERO4; }
#pragma unroll
            for (int q = 0; q < 2; ++q) { mmf(rp[q], aNB, bAP[q]);
                mmf(accH[q], aG, bNB[q]);
                mmf(ps[q], aG, bBB[q]); }
#pragma unroll
            for (int q = 0; q < 2; ++q) { const int bcol = (tb0 + q) * 16 + l15;
                st4(TILE(SL_RP), bcol, a0, rp[q]); st4(TILE(SL_HT), bcol, a0, accH[q]); st4(TILE(SL_PSIT), bcol, a0, ps[q]); }
        }
        __syncthreads();
        TP_MARK(4);
        if (w < 4) {
            STAGE_LANE();
            const int vrow = w * 16 + l15;
            const Fr fS = ldf(TILE(SL_SB), w * 16, lane), fV = ldf(VTc, w * 16, lane);
            f32x4 wv[4], yv[4];
            {
                Fr fAPT[4];
#pragma unroll
                for (int q = 0; q < 4; ++q) fAPT[q] = ldf(TILE(SL_APT), q * 16, lane);
#pragma unroll
                for (int q = 0; q < 4; ++q) { wv[q] = ZERO4; mmf(wv[q], fAPT[q], fS); }
#pragma unroll
                for (int q = 0; q < 4; ++q) st4(TILE(SL_WB), vrow, q * 16 + 4 * g4, wv[q]);
            }
            {
                Fr fRPT[4], fHT[4];
#pragma unroll
                for (int q = 0; q < 4; ++q) { fRPT[q] = ldfT(TILE(SL_RP), q * 16, lane); fHT[q] = ldf(TILE(SL_HT), q * 16, lane); }
#pragma unroll
                for (int q = 0; q < 4; ++q) { yv[q] = ZERO4; mmf(yv[q], fS, fRPT[q]); mmf(yv[q], fV, fHT[q]); }
#pragma unroll
                for (int q = 0; q < 4; ++q) { const int s_ = c * 64 + q * 16 + l15; const int t_ = dir ? (SEQ - 1 - s_) : s_;
                    v2u o; o.x = pg8::cvt_pk_bf16(yv[q][0], yv[q][1]); o.y = pg8::cvt_pk_bf16(yv[q][2], yv[q][3]);
                    *(v2u*)(YS + ((size_t)b * SEQ + t_) * 1024 + hh * 64 + w * 16 + 4 * g4) = o; }
            }
            {
                Fr fPS[4];
#pragma unroll
                for (int q = 0; q < 4; ++q) fPS[q] = ldf(TILE(SL_PSIT), q * 16, lane);
#pragma unroll
                for (int q = 0; q < 4; ++q) { const f32x4 pl = *(const LAS f32x4*)(L + OFF_PL + ((c & 1) * 64 + q * 16 + 4 * g4) * 4); accS[q] = accS[q] * pl; mmf(accS[q], fPS[q], fV); }
                LWAIT();
                const Fr fW = ldf(TILE(SL_WB), w * 16, lane); Fr fBB[4];
#pragma unroll
                for (int q = 0; q < 4; ++q) fBB[q] = ldf(BBTc, q * 16, lane);
#pragma unroll
                for (int q = 0; q < 4; ++q) { mmf(accS[q], fBB[q], fW); st4(TILE(SL_SB), vrow, q * 16 + 4 * g4, accS[q]); }
            }
        } else if (c + 1 < SEQ / 64) { PREP2(c + 1); }
    }
#if TP_SEL >= 0
    if (bx == 0 && w == TP_WAVE && lane0 == 0) *(unsigned long long*)(ws + 760 * 1024) = tp_acc;
#endif
#undef RAW_LOAD
#undef STAGE_LANE
#undef PREP1
#undef PREP2
#undef PTOK
#undef DSUM
}
#undef TILE
#undef LWAIT
}
__global__ void __launch_bounds__(NTHREADS, 2) mega_fwd(Args a) {
    extern __shared__ __attribute__((aligned(16))) unsigned char lds[];
    cg::grid_group grid = cg::this_grid();
    const int G = gridDim.x, bx = blockIdx.x;
    const int vcu = (G % 8 == 0) ? (bx % 8) * (G / 8) + bx / 8 : bx;
    const int NGW = G * NWAVES;
#define WIDS() const int tid = fresh_tid(), lane = tid & 63, wave = __builtin_amdgcn_readfirstlane(tid >> 6), gw = vcu * NWAVES + wave; (void)lane; (void)gw
    unsigned char* ws = a.ws;
    LAS unsigned char* lds3 = (LAS unsigned char*)lds;
    const int lo = a.ph_lo, hi = a.ph_hi;
#ifndef ONLY
#define ONLY -1
#endif
#define IN(k) (lo <= (k) && (k) < hi && (ONLY < 0 || ONLY == (k)))
#ifndef PROBE_S
#define PROBE_S 0
#endif
#ifndef PROBE_A
#define PROBE_A 0
#endif
#ifndef DUPMASK
#define DUPMASK 0
#endif
#ifndef USE_CG
#define USE_CG 0
#endif
#define GRIDBAR(k) do { if (USE_CG || a.ph_hi > 1000) grid.sync(); else xcd_barrier(bar); } while (0)
#define SEAM(k) do { if (IN(k) && IN((k) + 1)) GRIDBAR(k); } while (0)
#define PH_BEGIN(k) if (IN(k)) for (int rep_ = 0; rep_ <= ((DUPMASK >> (k)) & 1); ++rep_) { if (rep_) GRIDBAR(1);
#define PH_END(k) } SEAM(k);
    for (int u = fresh_tid(); u < 64; u += NTHREADS) ((LAS unsigned*)(lds3 + MISC_OFF))[u] = 0u;
    __syncthreads();
    XcdBarrier bar = xcd_barrier_post((unsigned*)(ws + WS_BAR), (volatile LAS unsigned*)(lds3 + MISC_OFF) + 8);

    PH_BEGIN(0) { WIDS(); p0_prologue(a, lds3, gw, NGW, wave, lane); } PH_END(0)
    PH_BEGIN(1) {
        pg8::Gemm g{(const bf16_t*)(ws + WS_HN), (const bf16_t*)(ws + WS_WINT), DM, DM, DM}; pg8::StaticOrder S; S.init(M, IN_PAD, G, bx);
        pg8::EpiProj E{(bf16_t*)(ws + WS_PDA), (bf16_t*)((unsigned char*)a.out + DO_PRW), (bf16_t*)(ws + WS_GATES)};
        pg8::gemm_phase<pg8::EpiProj, pg8::StaticOrder, true, true>(lds3, g, S, E);
        if (G == 256 && bx >= 128) { WIDS(); expert_convert_down(a, lds3, (bx - 128) * NWAVES + wave, 128 * NWAVES, wave, lane); }
        else if (G != 256) { WIDS(); expert_convert_down(a, lds3, gw, NGW, wave, lane); }
    } PH_END(1)
    PH_BEGIN(2) { WIDS(); p2_prep(a, gw, NGW, lane); } PH_END(2)
    PH_BEGIN(3) {
        const bf16_t* LIN = (const bf16_t*)((unsigned char*)a.out + DO_LIN);
        { pg8::Gemm g{LIN, (const bf16_t*)(ws + WS_BTL1), 512, 256, 256}; pg8::StaticOrder S; S.init(M, 4096, G, bx);
          pg8::EpiLora<0> E{(bf16_t*)(ws + WS_LORA), (const float*)(ws + WS_BIAS4)};
          pg8::gemm_phase<pg8::EpiLora<0>, pg8::StaticOrder, true, true>(lds3, g, S, E); }
        { pg8::Gemm g{LIN + 256, (const bf16_t*)(ws + WS_BTL2), 512, 256, 256}; pg8::StaticOrder S; S.init(M, 1024, G, bx);
          pg8::EpiLora<1> E{(bf16_t*)(ws + WS_LORA), nullptr};
          pg8::gemm_phase<pg8::EpiLora<1>, pg8::StaticOrder, true, true>(lds3, g, S, E); }
    } PH_END(3)
    PH_BEGIN(4) { WIDS();
        const float* sm = (const float*)(ws + WS_SMALL); const float d1 = wave_sum(sm[SM_LQ1 + lane] * sm[SM_LK1 + lane]), d2 = wave_sum(sm[SM_LQ2 + lane] * sm[SM_LK2 + lane]);
        const float lam = __int_as_float(__builtin_amdgcn_readfirstlane(__float_as_int(__expf(d1) - __expf(d2) + LAM_INIT)));
        const bf16_t* PDA = (const bf16_t*)(ws + WS_PDA); bf16_t* YA = (bf16_t*)((unsigned char*)a.out + DO_YAB);
        if (G == 256) {
            int u0, nu;
            if (bx < 128) {
#if PROBE_S
                scan::scan_phase(a, lds); __syncthreads();
#endif
                scan::scan_phase(a, lds); __syncthreads(); const int i = (bx & 7) * 16 + (bx >> 3); u0 = 768 + 2 * i; nu = 2; }
            else { const int k = bx - 128, i = (k & 7) * 16 + (k >> 3); u0 = 6 * i; nu = 6; }
            attn::Stage stg[2];
            { const int bh = u0 >> 5, b = bh >> 3, h = bh & 7; const size_t row0 = (size_t)b * SEQ; attn::attn_prime(PDA + row0 * 3072 + 1024 + h * 128, PDA + row0 * 3072 + 2048 + h * 128, stg); }
            for (int q = (PROBE_A && bx >= 128) ? -1 : 0; q < nu; ++q) { const int u = u0 + (q < 0 ? 0 : q); const int bh = u >> 5, qb = u & 31, b = bh >> 3, h = bh & 7;
                const size_t row0 = (size_t)b * SEQ;
                const int un = (q + 1 < nu) ? u0 + q + 1 : u; const int bhn = un >> 5, bn = bhn >> 3, hn_ = bhn & 7; const size_t rown = (size_t)bn * SEQ;
                attn::attn_unit(PDA + (row0 + qb * 128) * 3072 + h * 128, PDA + row0 * 3072 + 1024 + h * 128, PDA + row0 * 3072 + 2048 + h * 128,
                                YA + (row0 + qb * 128) * 2048 + h * 128, lam, sm + SM_SUBLN, SEQ, (char*)lds, PDA + rown * 3072 + 1024 + hn_ * 128, PDA + rown * 3072 + 2048 + hn_ * 128, stg); }
            { __syncthreads(); const int t2 = fresh_tid(); const bool sb = bx < 128;
              expert_convert_gu(a, lds3, (sb ? bx : bx - 128) * NWAVES + (t2 >> 6), 128 * NWAVES, t2 >> 6, t2 & 63, sb ? 0 : N_EARLY_S, sb ? N_EARLY_S : N_EARLY_EXPERTS); }
        } else {
        const int upb = 1024 / G;
        for (int i = 0; i < upb; ++i) { const int u = vcu * upb + i; const int bh = u >> 5, qb = u & 31, b = bh >> 3, h = bh & 7;
            const size_t row0 = (size_t)b * SEQ;
            attn::Stage stg[2]; attn::attn_prime(PDA + row0 * 3072 + 1024 + h * 128, PDA + row0 * 3072 + 2048 + h * 128, stg);
            attn::attn_unit(PDA + (row0 + qb * 128) * 3072 + h * 128, PDA + row0 * 3072 + 1024 + h * 128, PDA + row0 * 3072 + 2048 + h * 128,
                            YA + (row0 + qb * 128) * 2048 + h * 128, lam, sm + SM_SUBLN, SEQ, (char*)lds, PDA + row0 * 3072 + 1024 + h * 128, PDA + row0 * 3072 + 2048 + h * 128, stg); }
        }
    } PH_END(4)
    if (G != 256) { PH_BEGIN(5) { scan::scan_phase(a, lds); } PH_END(5) }
    PH_BEGIN(6) { WIDS(); p6_rwpost(a, gw, NGW, lane); } PH_END(6)
    PH_BEGIN(7) {
        bf16_t* MG = (bf16_t*)(ws + WS_MERGED); const bf16_t* GT = (const bf16_t*)(ws + WS_GATES);
        { pg8::Gemm g{(const bf16_t*)((unsigned char*)a.out + DO_YAB), (const bf16_t*)(ws + WS_WAT), DM, DM, DM}; pg8::StaticOrder S; S.init(M, DM, G, bx);
          pg8::EpiMergeF E{MG, GT}; pg8::gemm_phase<pg8::EpiMergeF, pg8::StaticOrder, true, true>(lds3, g, S, E); }
    } PH_END(7)
    PH_BEGIN(8) {
        pg8::Gemm g{(const bf16_t*)(ws + WS_MERGED), (const bf16_t*)(ws + WS_WOT), DM, DM, DM}; pg8::StaticOrder S; S.init(M, DM, G, bx);
        pg8::EpiOut E{a.in[I_X], a.out, (float*)(ws + WS_SSP)};
        pg8::gemm_phase<pg8::EpiOut, pg8::StaticOrder, true, true>(lds3, g, S, E);
    } PH_END(8)
    PH_BEGIN(9) { WIDS(); p9_router(a, lds3, gw, NGW, wave, lane); } PH_END(9)
    PH_BEGIN(10) { p10_topk(a, lds); } PH_END(10)
    if (G != 256) { PH_BEGIN(11) { WIDS(); p11_gather(a, gw, NGW, lane); } PH_END(11) }
    PH_BEGIN(12) {
        pg8::EpiMoeUp E{(bf16_t*)(ws + WS_HID)};
        if (G == 256) {
            pg8::Gemm g{(const bf16_t*)(ws + WS_HN2), (const bf16_t*)ws, DM, DM, DM}; pg8::ExpertGatherOrder S{G, bx, (const int*)(ws + WS_SELTOK)};
            pg8::gemm_phase_g<pg8::EpiMoeUp, pg8::ExpertGatherOrder, true, true>(lds3, g, S, E);
        } else {
            pg8::Gemm g{(const bf16_t*)(ws + WS_XE), (const bf16_t*)(ws + WS_W1T), DM, DM, DM}; pg8::ExpertOrder S{G, bx};
            pg8::gemm_phase<pg8::EpiMoeUp, pg8::ExpertOrder, true, true>(lds3, g, S, E);
        }
    } PH_END(12)
    PH_BEGIN(13) {
        pg8::Gemm g{(const bf16_t*)(ws + WS_HID), (const bf16_t*)(ws + WS_WDT), FF, FF, FF}; pg8::ExpertOrder S{G, bx};
        pg8::EpiMoeDown E{(bf16_t*)(ws + WS_XE), (const float*)(ws + WS_SELGATE)};
        pg8::gemm_phase<pg8::EpiMoeDown, pg8::ExpertOrder, true, true>(lds3, g, S, E);
    } PH_END(13)
    PH_BEGIN(14) { WIDS(); p14_combine(a, lds, wave, lane); } }
#if TP_SEL >= 0
    if (a.ph_hi >= 15 && blockIdx.x == 0 && fresh_tid() == 0) { const unsigned long long d_ = 16ull * *(volatile unsigned long long*)(ws + 760 * 1024), t0_ = __builtin_amdgcn_s_memtime(); while (__builtin_amdgcn_s_memtime() - t0_ < d_) __builtin_amdgcn_s_sleep(8); }
#endif
#undef IN
#undef SEAM
}

constexpr int NPHASES = 15;
#ifndef MK_SPLIT
#define MK_SPLIT 0
#endif
extern "C" void kernel_launch(void* const* d_in, const int* in_sizes, int n_in, void* d_out, int out_size, void* d_ws, size_t ws_size, hipStream_t stream) {
    static int grid = 0;
    if (grid == 0) {
        if (n_in != 33 || in_sizes[0] != M * DM || out_size != M * DM || ws_size < WS_NEED) {
            fprintf(stderr, "kernel_launch: unexpected shapes: n_in %d in0 %d out %d ws %zu (need %zu)\n", n_in, n_in > 0 ? in_sizes[0] : -1, out_size, ws_size, (size_t)WS_NEED); grid = -1; return; }
        int dev = 0, cus = 0, per_cu = 0;
        if (hipGetDevice(&dev) != hipSuccess || hipDeviceGetAttribute(&cus, hipDeviceAttributeMultiprocessorCount, dev) != hipSuccess) { grid = -1; return; }
        if (hipFuncSetAttribute((const void*)mega_fwd, hipFuncAttributeMaxDynamicSharedMemorySize, LDS_BYTES) != hipSuccess) { fprintf(stderr, "kernel_launch: hipFuncSetAttribute failed\n"); grid = -1; return; }
        if (hipOccupancyMaxActiveBlocksPerMultiprocessor(&per_cu, (const void*)mega_fwd, NTHREADS, LDS_BYTES) != hipSuccess || per_cu < 1) { fprintf(stderr, "kernel_launch: occupancy query says %d\n", per_cu); (void)hipGetLastError(); per_cu = 1; }
        grid = cus;
        if (grid != 256) { fprintf(stderr, "kernel_launch: this kernel is built for a 256-CU MI355X (got %d CUs); nothing launched\n", grid); grid = -1; return; }
    }
    if (grid < 0) return;
    if (hipMemsetAsync((char*)d_ws + WS_BAR, 0, 16384, stream) != hipSuccess) { fprintf(stderr, "kernel_launch: memset failed\n"); return; }
    Args a{};
    for (int i = 0; i < 33; ++i) a.in[i] = (const float*)d_in[i];
    a.out = (float*)d_out; a.ws = (unsigned char*)d_ws;
#if MK_SPLIT
    for (int p = 0; p < NPHASES; ++p) { a.ph_lo = p; a.ph_hi = p + 1; void* args[] = {&a};
        hipError_t e = hipLaunchCooperativeKernel((const void*)mega_fwd, dim3(grid), dim3(NTHREADS), args, LDS_BYTES, stream);
        if (e != hipSuccess) { fprintf(stderr, "kernel_launch: launch of phase %d failed: %s\n", p, hipGetErrorString(e)); return; } }
#else
    a.ph_lo = 0; a.ph_hi = NPHASES; void* args[] = {&a};
    hipError_t e = hipLaunchCooperativeKernel((const void*)mega_fwd, dim3(grid), dim3(NTHREADS), args, LDS_BYTES, stream);
    if (e != hipSuccess) fprintf(stderr, "kernel_launch: cooperative launch failed: %s (grid %d)\n", hipGetErrorString(e), grid);
#endif
}
```

```cpp
#include <hip/hip_runtime.h>
#include <hip/hip_cooperative_groups.h>
#include <cstdio>
#include <cstdint>
namespace cg = cooperative_groups;

constexpr int NB = 4, SEQ = 4096, M = NB * SEQ, DM = 2048;
constexpr int DA_COLS = 3072, RW_COLS = 3488, RW_PAD = 3584, GATE_COLS = 4096, IN_COLS = 10656, IN_PAD = 10752;
constexpr int NE = 16, FF = 1024, CAP = 512, NSLOT = NB * NE * CAP;
constexpr float RMS_EPS = 1e-6f, GN_EPS = 64e-5f, LAM_INIT = 0.2f;
constexpr int NWAVES = 8, NTHREADS = 512;

constexpr size_t MiB = 1u << 20;
constexpr size_t WS_SSP = 5 * MiB;
constexpr size_t WS_SELTOK = 128 * 1024;
constexpr size_t WS_SELGATE = 256 * 1024;
constexpr size_t WS_BIAS4 = 512 * 1024;
constexpr size_t WS_SMALL = 576 * 1024;
constexpr int SM_QNG = 0, SM_KNG = 64, SM_LQ1 = 128, SM_LK1 = 192, SM_LQ2 = 256, SM_LK2 = 320, SM_SUBLN = 384, SM_MU = 512, SM_KK = 4096, SM_KA = 5120, SM_RK = 6144,
              SM_LNW = 7168, SM_LNB = 8192, SM_FNG = 9216, SM_WR = 11264, SM_END = 44032;
constexpr size_t WS_BAR = 768 * 1024;
constexpr size_t WS_INRM = 1 * MiB;
constexpr size_t WS_AFF = 1 * MiB;
constexpr size_t WS_ROPE = 7 * MiB;
constexpr size_t WS_BTL1 = 2 * MiB;
constexpr size_t WS_BTL2 = 4 * MiB;
constexpr size_t WS_WAT = 8 * MiB, WS_WBT = 12 * MiB, WS_WOT = 16 * MiB;
constexpr size_t WS_HN = 24 * MiB;
constexpr size_t WS_RKV = 24 * MiB;
constexpr size_t WS_WINT = 88 * MiB;
constexpr size_t WS_PDA = 130 * MiB;
constexpr size_t WS_MERGED = 130 * MiB;
constexpr size_t WS_GATES = 226 * MiB;
constexpr size_t WS_LORA = 354 * MiB;
constexpr size_t WS_END1 = 546 * MiB;
constexpr size_t WS_W1T = 24 * MiB;
__host__ __device__ __forceinline__ size_t w1t_base(int e) { return e < 4 ? (514 + 8 * (size_t)e) * MiB : e < 6 ? (610 + 8 * (size_t)(e - 4)) * MiB : e == 6 ? 120 * MiB : WS_W1T + 8 * (size_t)(e - 7) * MiB; }
constexpr int N_EARLY_EXPERTS = 7, N_EARLY_S = 5;
constexpr size_t WS_WDT = 546 * MiB;
constexpr size_t WS_XE = 216 * MiB;
constexpr size_t WS_HN2 = 216 * MiB;
constexpr size_t WS_HID = 344 * MiB;
constexpr size_t WS_NEED = 626 * MiB;
constexpr size_t DO_PRW = 0, DO_LIN = 112 * MiB, DO_YSF = 0, DO_YSB = 32 * MiB, DO_YAB = 64 * MiB;

constexpr int MISC_OFF = 155648;
constexpr int LDS_BYTES = 159744;

#define LAS __attribute__((address_space(3)))
typedef unsigned short bf16_t;
typedef unsigned v4u __attribute__((ext_vector_type(4)));
typedef unsigned v2u __attribute__((ext_vector_type(2)));

__device__ __forceinline__ int fresh_tid() { int t = threadIdx.x; asm volatile("" : "+v"(t)); return t; }
__device__ __forceinline__ float bf2f(unsigned short b) { return __builtin_bit_cast(float, (unsigned)b << 16); }
__device__ __forceinline__ float bflo(unsigned w) { return __builtin_bit_cast(float, w << 16); }
__device__ __forceinline__ float bfhi(unsigned w) { return __builtin_bit_cast(float, w & 0xffff0000u); }
__device__ __forceinline__ unsigned f2bf(float f) { unsigned u = __builtin_bit_cast(unsigned, f); return (u + 0x7fffu + ((u >> 16) & 1u)) >> 16; }
typedef float f32x2_t __attribute__((ext_vector_type(2))); typedef __bf16 bf16x2_t __attribute__((ext_vector_type(2)));
__device__ __forceinline__ unsigned pk2(float lo, float hi) { f32x2_t v = {lo, hi}; bf16x2_t b = __builtin_convertvector(v, bf16x2_t); return __builtin_bit_cast(unsigned, b); }
__device__ __forceinline__ float sigmoidf_(float x) { return __builtin_amdgcn_rcpf(1.0f + __expf(-x)); }
__device__ __forceinline__ float wave_sum(float v) {
#pragma unroll
    for (int o = 1; o < 64; o <<= 1) v += __shfl_xor(v, o);
    return v;
}
__device__ __forceinline__ float sum8(float v) { v += __shfl_xor(v, 1); v += __shfl_xor(v, 2); v += __shfl_xor(v, 4); return v; }
__device__ __forceinline__ void unpack8(const v4u& w, float (&f)[8]) {
    f[0] = bflo(w.x); f[1] = bfhi(w.x); f[2] = bflo(w.y); f[3] = bfhi(w.y); f[4] = bflo(w.z); f[5] = bfhi(w.z); f[6] = bflo(w.w); f[7] = bfhi(w.w);
}
__device__ __forceinline__ v4u pack8(const float (&f)[8]) { v4u w; w.x = pk2(f[0], f[1]); w.y = pk2(f[2], f[3]); w.z = pk2(f[4], f[5]); w.w = pk2(f[6], f[7]); return w; }

#define XB_TMO      128
#define XB_XCNT(j)  (256  + 64 * (j))
#define XB_XSUB(j)  (1280 + 64 * (j))
#define XB_XGEN(j)  (2304 + 64 * (j))
#define XB_TOP      3328
#define XB_TOPGEN   3392
#define XCD_BAR_WORDS 3456
#define XB_SPIN_CAP (1u << 18)

__device__ __forceinline__ unsigned xb_ld(unsigned* p)              { return __hip_atomic_load(p, __ATOMIC_RELAXED, __HIP_MEMORY_SCOPE_AGENT); }
__device__ __forceinline__ unsigned xb_add(unsigned* p, unsigned v) { return __hip_atomic_fetch_add(p, v, __ATOMIC_RELAXED, __HIP_MEMORY_SCOPE_AGENT); }
__device__ __forceinline__ unsigned xb_xcc_id() { return (unsigned)__builtin_amdgcn_s_getreg((3 << 11) | 20) & 0xFu; }
#define XB_SPIN(cond, bar) do { unsigned _sp = 0; while (cond) { __builtin_amdgcn_s_sleep(1); \
    if ((++_sp & 255u) == 0u) { if (xb_ld(&(bar)[XB_TMO])) break; if (_sp > XB_SPIN_CAP) { atomicAdd(&(bar)[XB_TMO], 1u); break; } } } } while (0)

struct XcdBarrier {
    unsigned* bar; unsigned x;
    volatile LAS unsigned* st;
};

__device__ __forceinline__ XcdBarrier xcd_barrier_post(unsigned* bar, volatile LAS unsigned* st) {
    XcdBarrier b; b.bar = bar; b.x = xb_xcc_id(); b.st = st;
    if (threadIdx.x == 0) (void)xb_add(&bar[XB_XCNT(b.x)], 1u);
    return b;
}
__device__ __forceinline__ void xcd_barrier_complete(unsigned* bar, unsigned x, unsigned& nloc, unsigned& nx) {
    const unsigned G = gridDim.x * gridDim.y * gridDim.z;
    unsigned sum, cnt, mine, sp = 0u;
    for (;;) {
        sum = 0u; cnt = 0u; mine = 0u;
#pragma unroll
        for (unsigned j = 0; j < 16; ++j) { const unsigned c = xb_ld(&bar[XB_XCNT(j)]); sum += c; cnt += (c > 0u) ? 1u : 0u; mine = (j == x) ? c : mine; }
        if (sum == G) break;
        __builtin_amdgcn_s_sleep(1);
        if ((++sp & 255u) == 0u) { if (xb_ld(&bar[XB_TMO])) break; if (sp > XB_SPIN_CAP) { atomicAdd(&bar[XB_TMO], 1u); break; } }
    }
    nloc = mine > 0u ? mine : 1u; nx = cnt > 0u ? cnt : 1u;
}

__device__ __forceinline__ void xcd_barrier(const XcdBarrier& b) {
    asm volatile("s_waitcnt vmcnt(0)" ::: "memory");
    __syncthreads();
    if (threadIdx.x == 0) {
        unsigned* bar = b.bar;
        __builtin_amdgcn_s_waitcnt(0);
        unsigned nloc = b.st[0], nx = b.st[1];
        if (nloc == 0u) { xcd_barrier_complete(bar, b.x, nloc, nx); b.st[0] = nloc; b.st[1] = nx; }
        const unsigned old = xb_add(&bar[XB_XSUB(b.x)], 1u);
        const unsigned gen = old / nloc;
        if (old + 1u == (gen + 1u) * nloc) {
            __builtin_amdgcn_fence(__ATOMIC_RELEASE, "agent");
            asm volatile("s_waitcnt vmcnt(0)" ::: "memory");
            const unsigned og = xb_add(&bar[XB_TOP], 1u);
            const unsigned tg = og / nx;
            if (og + 1u == (tg + 1u) * nx) xb_add(&bar[XB_TOPGEN], 1u);
            else XB_SPIN(xb_ld(&bar[XB_TOPGEN]) == tg, bar);
            __builtin_amdgcn_fence(__ATOMIC_ACQUIRE, "agent");
            xb_add(&bar[XB_XGEN(b.x)], 1u);
            asm volatile("s_waitcnt vmcnt(0)" ::: "memory");
        } else {
            XB_SPIN(xb_ld(&bar[XB_XGEN(b.x)]) == gen, bar);
            __builtin_amdgcn_fence(__ATOMIC_ACQUIRE, "agent");
            asm volatile("s_waitcnt vmcnt(0)" ::: "memory");
        }
    }
    __syncthreads();
}
namespace pg8 {
#define PG8_LAS __attribute__((address_space(3)))
typedef unsigned short bf16_t;
typedef short bf16x8 __attribute__((ext_vector_type(8)));
typedef float f32x4 __attribute__((ext_vector_type(4)));
typedef unsigned u32x4 __attribute__((ext_vector_type(4)));
constexpr int BM = 256, BK = 64, HALF = 128, HTB = HALF * BK * 2  , STAGE_BYTES = 8 * HTB, NXCD = 8, WGM = 4;

__host__ __device__ __forceinline__ int lds_byte(int r, int c) { const int st = (r >> 4) * 2 + (c >> 5), rr = r & 15, cc = c & 31, ob = rr * 64 + cc * 2; return st * 1024 + (ob ^ (((ob >> 9) & 1) << 5)); }
__host__ __device__ __forceinline__ void stage_rc(int b, int& R, int& C) { const int st = b / 1024, sb = b % 1024, swz = sb ^ (((sb >> 9) & 1) << 5); R = (st >> 1) * 16 + swz / 64; C = (st & 1) * 32 + (swz % 64) / 2; }
__host__ __device__ __forceinline__ int perm32(int rho) { const int n = rho >> 4, i = rho & 15; return 8 * (i >> 2) + 4 * n + (i & 3); }

struct Unit { int pm, pn; };
struct Gemm { const bf16_t* A; const bf16_t* Bt; int lda, ldb, K; };

struct StaticOrder {
    int nM, nN, nwg, G, c;
    __host__ __device__ void init(int M, int N, int G_, int c_) { nM = M / BM; nN = N / BM; nwg = nM * nN; G = G_; c = c_; }
    __host__ __device__ bool next(int i, Unit& u) const {
        const long L = (long)i * G + c; if (L >= nwg) return false;
        int wgid = (int)L; { const int q = nwg / NXCD, r = nwg % NXCD, xcd = wgid % NXCD, off = wgid / NXCD; wgid = (xcd < r ? xcd * (q + 1) : r * (q + 1) + (xcd - r) * q) + off; }
        const int nig = WGM * nN, gid = wgid / nig, fm = gid * WGM, gsz = (nM - fm) < WGM ? (nM - fm) : WGM;
        u.pm = fm + ((wgid % nig) % gsz); u.pn = (wgid % nig) / gsz; return true;
    }
    __device__ __forceinline__ void a_ready(const Unit&) const {}
    __device__ __forceinline__ void done(const Unit&) const {}
};

__device__ __forceinline__ unsigned cvt_pk_bf16(float lo, float hi) { return pk2(lo, hi); }
__device__ __forceinline__ u32x4 pack_bf16x8(const f32x4& v0, const f32x4& v1) { u32x4 w; w.x = cvt_pk_bf16(v0[0], v0[1]); w.y = cvt_pk_bf16(v0[2], v0[3]); w.z = cvt_pk_bf16(v1[0], v1[1]); w.w = cvt_pk_bf16(v1[2], v1[3]); return w; }
__device__ __forceinline__ float sigm(float x) { return __builtin_amdgcn_rcpf(1.0f + __expf(-x)); }
__device__ __forceinline__ f32x4 sigm4(f32x4 v) { return (f32x4){sigm(v[0]), sigm(v[1]), sigm(v[2]), sigm(v[3])}; }
__device__ __forceinline__ void unpk8(const u32x4& w, f32x4& a, f32x4& b) {
    a = (f32x4){__builtin_bit_cast(float, w.x << 16), __builtin_bit_cast(float, w.x & 0xffff0000u), __builtin_bit_cast(float, w.y << 16), __builtin_bit_cast(float, w.y & 0xffff0000u)};
    b = (f32x4){__builtin_bit_cast(float, w.z << 16), __builtin_bit_cast(float, w.z & 0xffff0000u), __builtin_bit_cast(float, w.w << 16), __builtin_bit_cast(float, w.w & 0xffff0000u)};
}

struct EpiProj {
    static constexpr bool PERM = true, AFTER_DRAIN = false, HAS_MID = false, HAS_INIT = false;
    bf16_t* pda; bf16_t* prw; bf16_t* gates;
    __device__ __forceinline__ void operator()(const f32x4 (&acc)[2][2][4][2], const Unit& u, int wr, int wc, int fr, int fq) const {
        const int row0 = u.pm * BM + wr * 64 + fr;
        if (u.pn >= 26) {
            const int col0 = (u.pn - 26) * 128 + wc * 32 + 8 * fq;
#pragma unroll
            for (int ai = 0; ai < 2; ++ai)
#pragma unroll
                for (int m = 0; m < 4; ++m) { bf16_t* rowp = gates + (size_t)(row0 + ai * HALF + m * 16) * 4096 + col0;
                    f32x4 rt[2], gb[2];
#pragma unroll
                    for (int n = 0; n < 2; ++n)
#pragma unroll
                        for (int e = 0; e < 4; ++e) { const float ea = __expf(-acc[ai][0][m][n][e]), eb = __expf(-acc[ai][1][m][n][e]);
                            gb[n][e] = __builtin_amdgcn_rcpf(1.0f + eb); rt[n][e] = (1.0f + eb) * __builtin_amdgcn_rcpf(1.0f + ea); }
                    *(u32x4*)rowp = pack_bf16x8(rt[0], rt[1]); *(u32x4*)(rowp + 2048) = pack_bf16x8(gb[0], gb[1]); }
            return;
        }
        bf16_t* base; int ldc, colt;
        if (u.pn < 12) { base = pda; ldc = 3072; colt = u.pn * 256; }
        else { base = prw; ldc = 3584; colt = (u.pn - 12) * 256; }
        const int col0 = colt + wc * 32 + 8 * fq;
#pragma unroll
        for (int ai = 0; ai < 2; ++ai)
#pragma unroll
            for (int m = 0; m < 4; ++m) { bf16_t* rowp = base + (size_t)(row0 + ai * HALF + m * 16) * ldc + col0;
#pragma unroll
                for (int bj = 0; bj < 2; ++bj) *(u32x4*)(rowp + bj * HALF) = pack_bf16x8(acc[ai][bj][m][0], acc[ai][bj][m][1]); }
    }
};
template <int KIND> struct EpiLora {
    static constexpr bool PERM = true, AFTER_DRAIN = false, HAS_MID = false, HAS_INIT = false;
    bf16_t* out; const float* bias4;
    __device__ __forceinline__ void operator()(const f32x4 (&acc)[2][2][4][2], const Unit& u, int wr, int wc, int fr, int fq) const {
        const int seg = (KIND == 0) ? (u.pn >> 2) : 4, colt = (KIND == 0) ? (u.pn & 3) * 256 : u.pn * 256;
        bf16_t* base = out + (size_t)seg * ((size_t)M * 1024);
        const float* bias = bias4 + (seg & 3) * 1024;
        const int row0 = u.pm * BM + wr * 64 + fr, col0 = colt + wc * 32 + 8 * fq;
        const float sc = (seg < 2) ? -0.60653065971f : 1.0f;
#pragma unroll
        for (int bj = 0; bj < 2; ++bj) {
            f32x4 bv0 = (f32x4){0.f, 0.f, 0.f, 0.f}, bv1 = bv0;
            if (KIND == 0) { bv0 = *(const f32x4*)(bias + col0 + bj * HALF); bv1 = *(const f32x4*)(bias + col0 + bj * HALF + 4); }
#pragma unroll
            for (int ai = 0; ai < 2; ++ai)
#pragma unroll
                for (int m = 0; m < 4; ++m) { bf16_t* rowp = base + (size_t)(row0 + ai * HALF + m * 16) * 1024 + col0;
                    f32x4 v0 = acc[ai][bj][m][0] + bv0, v1 = acc[ai][bj][m][1] + bv1;
                    if (KIND == 0) { v0 = sigm4(v0) * sc; v1 = sigm4(v1) * sc; }
                    *(u32x4*)(rowp + bj * HALF) = pack_bf16x8(v0, v1); }
        }
    }
};
struct EpiMergeF {
    static constexpr bool PERM = true, AFTER_DRAIN = false, HAS_MID = true, HAS_INIT = false;
    bf16_t* merged; const bf16_t* gates;
    template <int HALFSEL> __device__ __forceinline__ void scale(f32x4 (&acc)[2][2][4][2], const Unit& u, int wr, int wc, int fr, int fq, bool store) const {
        int row0 = u.pm * BM + wr * 64 + fr, col0 = u.pn * 256 + wc * 32 + 8 * fq;
        asm volatile("" : "+v"(row0), "+v"(col0));
        u32x4 gw[2][2][2];
#define EMF_LOAD(g) do { _Pragma("unroll") for (int mm = 0; mm < 2; ++mm) _Pragma("unroll") for (int bj = 0; bj < 2; ++bj) \
            gw[(g) & 1][mm][bj] = *(const u32x4*)(gates + (size_t)(row0 + ((g) >> 1) * HALF + (2 * ((g) & 1) + mm) * 16) * 4096 + HALFSEL * 2048 + col0 + bj * HALF); } while (0)
        EMF_LOAD(0);
#pragma unroll
        for (int g = 0; g < 4; ++g) { const int ai = g >> 1, mh = g & 1;
            if (g < 3) EMF_LOAD(g + 1);
#pragma unroll
            for (int mm = 0; mm < 2; ++mm)
#pragma unroll
                for (int bj = 0; bj < 2; ++bj) { const int m = 2 * mh + mm; f32x4 g0, g1; unpk8(gw[g & 1][mm][bj], g0, g1);
                    acc[ai][bj][m][0] *= g0; acc[ai][bj][m][1] *= g1;
                    if (store) *(u32x4*)(merged + (size_t)(row0 + ai * HALF + m * 16) * 2048 + col0 + bj * HALF) = pack_bf16x8(acc[ai][bj][m][0], acc[ai][bj][m][1]); }
            asm volatile("" ::: "memory");
        }
#undef EMF_LOAD
    }
    __device__ __forceinline__ void mid(f32x4 (&acc)[2][2][4][2], const Unit& u, int wr, int wc, int fr, int fq) const { scale<0>(acc, u, wr, wc, fr, fq, false); }
    __device__ __forceinline__ void operator()(const f32x4 (&acc)[2][2][4][2], const Unit& u, int wr, int wc, int fr, int fq) const {
        f32x4 (&ac)[2][2][4][2] = const_cast<f32x4 (&)[2][2][4][2]>(acc); scale<1>(ac, u, wr, wc, fr, fq, true); }
};
struct EpiOut {
    static constexpr bool PERM = false, AFTER_DRAIN = false, HAS_MID = false, HAS_INIT = true;
    const float* x; float* out; float* ss;
    __device__ __forceinline__ void init(f32x4 (&acc)[2][2][4][2], const Unit& u, int wr, int wc, int fr, int fq) const {
        const int row0 = u.pm * BM + wr * 64 + fr, col0 = u.pn * 256 + wc * 32 + 4 * fq;
#pragma unroll
        for (int ai = 0; ai < 2; ++ai)
#pragma unroll
            for (int m = 0; m < 4; ++m)
#pragma unroll
                for (int bj = 0; bj < 2; ++bj)
#pragma unroll
                    for (int n = 0; n < 2; ++n) acc[ai][bj][m][n] = *(const f32x4*)(x + (size_t)(row0 + ai * HALF + m * 16) * 2048 + col0 + bj * HALF + n * 16);
    }
    __device__ __forceinline__ void operator()(const f32x4 (&acc)[2][2][4][2], const Unit& u, int wr, int wc, int fr, int fq) const {
        const int row0 = u.pm * BM + wr * 64 + fr, col0 = u.pn * 256 + wc * 32 + 4 * fq;
#pragma unroll
        for (int ai = 0; ai < 2; ++ai) {
#pragma unroll
            for (int m = 0; m < 4; ++m) { const size_t r = (size_t)(row0 + ai * HALF + m * 16); float s = 0.f;
#pragma unroll
                for (int bj = 0; bj < 2; ++bj)
#pragma unroll
                    for (int n = 0; n < 2; ++n) { const f32x4 h = acc[ai][bj][m][n]; *(f32x4*)(out + r * 2048 + col0 + bj * HALF + n * 16) = h;
                        s += (h[0] * h[0] + h[1] * h[1]) + (h[2] * h[2] + h[3] * h[3]); }
                s += __shfl_xor(s, 16); s += __shfl_xor(s, 32);
                if (fq == 0) ss[r * 32 + u.pn * 4 + wc] = s; }
        }
    }
};
struct EpiMoeUp {
    static constexpr bool PERM = true, AFTER_DRAIN = false, HAS_MID = false, HAS_INIT = false;
    bf16_t* hid;
    __device__ __forceinline__ void operator()(const f32x4 (&acc)[2][2][4][2], const Unit& u, int wr, int wc, int fr, int fq) const {
        const int row0 = u.pm * BM + wr * 64 + fr, col0 = (u.pn & 7) * 128 + wc * 32 + 8 * fq;
#pragma unroll
        for (int ai = 0; ai < 2; ++ai)
#pragma unroll
            for (int m = 0; m < 4; ++m) { bf16_t* rowp = hid + (size_t)(row0 + ai * HALF + m * 16) * 1024 + col0;
                const f32x4 g0 = acc[ai][0][m][0], g1 = acc[ai][0][m][1], u0 = acc[ai][1][m][0], u1 = acc[ai][1][m][1];
                const f32x4 v0 = g0 * sigm4(g0) * u0, v1 = g1 * sigm4(g1) * u1;
                *(u32x4*)rowp = pack_bf16x8(v0, v1); }
    }
};
struct EpiMoeDown {
    static constexpr bool PERM = true, AFTER_DRAIN = false, HAS_MID = false, HAS_INIT = false;
    bf16_t* ye; const float* selgate;
    __device__ __forceinline__ void operator()(const f32x4 (&acc)[2][2][4][2], const Unit& u, int wr, int wc, int fr, int fq) const {
        const int row0 = u.pm * BM + wr * 64 + fr, col0 = (u.pn & 7) * 256 + wc * 32 + 8 * fq;
#pragma unroll
        for (int ai = 0; ai < 2; ++ai)
#pragma unroll
            for (int m = 0; m < 4; ++m) { const int r = row0 + ai * HALF + m * 16; const int e = r >> 11, b = (r >> 9) & 3, c = r & 511;
                const float g = selgate[(b * 16 + e) * 512 + c];
                bf16_t* rowp = ye + (size_t)r * 2048 + col0;
#pragma unroll
                for (int bj = 0; bj < 2; ++bj) *(u32x4*)(rowp + bj * HALF) = pack_bf16x8(acc[ai][bj][m][0] * g, acc[ai][bj][m][1] * g); }
    }
};
struct ExpertOrder {
    int G, c;
    __device__ __forceinline__ bool next(int i, Unit& u) const {
        const int L = i * G + c; if (L >= 1024) return false;
        const int wgid = (L % NXCD) * (1024 / NXCD) + L / NXCD;
        const int e = wgid >> 6, r = wgid & 63; u.pm = e * 8 + (r & 3) + 4 * ((r >> 5) & 1); u.pn = e * 8 + ((r >> 2) & 7); return true;
    }
    __device__ __forceinline__ void a_ready(const Unit&) const {}
    __device__ __forceinline__ void done(const Unit&) const {}
};

struct ExpertGatherOrder {
    int G, c; const int* seltok;
    __device__ __forceinline__ bool next(int i, Unit& u) const {
        const int L = i * G + c; if (L >= 1024) return false;
        const int wgid = (L % NXCD) * (1024 / NXCD) + L / NXCD;
        const int e = wgid >> 6, r = wgid & 63; u.pm = e * 8 + (r & 3) + 4 * ((r >> 5) & 1); u.pn = e * 8 + ((r >> 2) & 7); return true;
    }
    __device__ __forceinline__ int arow(int r) const { const int e = r >> 11, b = (r >> 9) & 3, cc = r & 511; return b * 4096 + seltok[(b * 16 + e) * 512 + cc]; }
    __device__ __forceinline__ size_t boff(const Unit& u) const { return w1t_base(u.pn >> 3) + (size_t)(u.pn & 7) * (256 * 2048 * 2); }
    __device__ __forceinline__ void a_ready(const Unit&) const {}
    __device__ __forceinline__ void done(const Unit&) const {}
};
template <class Epi, class Sched, bool ALIGN_EPI = false, bool SP2 = false>
__device__ __forceinline__ void gemm_phase(PG8_LAS unsigned char* lds, const Gemm g, const Sched& S, const Epi& E) {
    const int tid = fresh_tid(), wid = __builtin_amdgcn_readfirstlane(tid >> 6), lane = tid & 63, wr = wid >> 2, wc = wid & 3, fr = lane & 15, fq = lane >> 4;
    const int K = g.K, nt = K / BK;
    unsigned voffA[2], voffB[2];
#pragma unroll
    for (int i = 0; i < 2; ++i) { int R, C; stage_rc(tid * 16 + i * 8192, R, C); const int Rb = Epi::PERM ? ((R & ~31) + perm32(R & 31)) : R;
        voffA[i] = (unsigned)(R * g.lda + C) * 2u; voffB[i] = (unsigned)(Rb * g.ldb + C) * 2u; }
    const size_t kstep = (size_t)(BK * 2);
    const size_t hsA = (size_t)HALF * g.lda * 2, hsB = (size_t)HALF * g.ldb * 2;
    const size_t tsA = 2 * hsA, tsB = 2 * hsB;
    const unsigned ldsw = (unsigned)wid * 1024u;
    const int aoff = lds_byte(wr * 64 + fr, fq * 8), boff = lds_byte(wc * 32 + fr, fq * 8);
#define PG8_SA(b, h) (((b) * 2 + (h)) * HTB)
#define PG8_SB(b, h) ((4 + (b) * 2 + (h)) * HTB)
#define PG8_STAGE(bufoff, gbase, voff) do { _Pragma("unroll") for (int _i = 0; _i < 2; ++_i) \
        __builtin_amdgcn_global_load_lds((const unsigned*)((const char*)(gbase) + (voff)[_i]), (PG8_LAS unsigned*)(lds + (bufoff) + ldsw + _i * 8192), 16, 0, 0); } while (0)
#define PG8_LDA(dst, b, h) do { _Pragma("unroll") for (int m = 0; m < 4; ++m) _Pragma("unroll") for (int k = 0; k < 2; ++k) dst[m][k] = *(const PG8_LAS bf16x8*)(lds + PG8_SA(b, h) + aoff + m * 2048 + k * 1024); } while (0)
#define PG8_LDB(dst, b, h) do { _Pragma("unroll") for (int n = 0; n < 2; ++n) _Pragma("unroll") for (int k = 0; k < 2; ++k) dst[n][k] = *(const PG8_LAS bf16x8*)(lds + PG8_SB(b, h) + boff + n * 2048 + k * 1024); } while (0)
#define PG8_MMA(ai, bj, At, Bt) do { __builtin_amdgcn_s_setprio(1); _Pragma("unroll") for (int m = 0; m < 4; ++m) _Pragma("unroll") for (int n = 0; n < 2; ++n) _Pragma("unroll") for (int k = 0; k < 2; ++k) \
        acc[ai][bj][m][n] = __builtin_amdgcn_mfma_f32_16x16x32_bf16(Bt[n][k], At[m][k], acc[ai][bj][m][n], 0, 0, 0); __builtin_amdgcn_s_setprio(0); } while (0)
#define PG8_WAIT_V(n) asm volatile("s_waitcnt vmcnt(" #n ")" ::: "memory")
#define PG8_WAIT_L(n) asm volatile("s_waitcnt lgkmcnt(" #n ")" ::: "memory")
#define PG8_BAR __builtin_amdgcn_s_barrier()
#define PG8_SCHED __builtin_amdgcn_sched_barrier(0)
    Unit cur, nxt; int ui = 0;
    if (!S.next(0, cur)) return;
    f32x4 acc[2][2][4][2];
    if constexpr (Epi::HAS_INIT) E.init(acc, cur, wr, wc, fr, fq); else {
#pragma unroll
    for (int a = 0; a < 2; ++a)
#pragma unroll
        for (int b = 0; b < 2; ++b)
#pragma unroll
            for (int m = 0; m < 4; ++m)
#pragma unroll
                for (int n = 0; n < 2; ++n) acc[a][b][m][n] = (f32x4){0.f, 0.f, 0.f, 0.f};
    }
    bf16x8 At[4][2], B0[2][2], B1[2][2];
    const char* cA = (const char*)g.A + (size_t)cur.pm * tsA; const char* cB = (const char*)g.Bt + (size_t)cur.pn * tsB;
    S.a_ready(cur);
    if constexpr (SP2) {
        PG8_STAGE(PG8_SB(0, 0), cB, voffB); PG8_STAGE(PG8_SB(0, 1), cB + hsB, voffB); PG8_STAGE(PG8_SA(0, 0), cA, voffA); PG8_STAGE(PG8_SA(0, 1), cA + hsA, voffA);
        if (wr == 1) PG8_BAR;
        PG8_WAIT_V(2); PG8_BAR;
        PG8_STAGE(PG8_SB(1, 0), cB + kstep, voffB); PG8_STAGE(PG8_SA(1, 0), cA + kstep, voffA); PG8_STAGE(PG8_SB(1, 1), cB + hsB + kstep, voffB);
        PG8_WAIT_V(6); PG8_BAR;
    } else {
        PG8_STAGE(PG8_SB(0, 0), cB, voffB); PG8_STAGE(PG8_SA(0, 0), cA, voffA); PG8_STAGE(PG8_SB(0, 1), cB + hsB, voffB); PG8_STAGE(PG8_SA(0, 1), cA + hsA, voffA);
        if (wr == 1) PG8_BAR;
        PG8_WAIT_V(4); PG8_BAR;
        PG8_STAGE(PG8_SB(1, 0), cB + kstep, voffB); PG8_STAGE(PG8_SA(1, 0), cA + kstep, voffA); PG8_STAGE(PG8_SB(1, 1), cB + hsB + kstep, voffB);
        PG8_WAIT_V(6); PG8_BAR;
    }
    for (;;) {
        const bool has_next = S.next(ui + 1, nxt);
        const char* nA = has_next ? (const char*)g.A + (size_t)nxt.pm * tsA : cA; const char* nB = has_next ? (const char*)g.Bt + (size_t)nxt.pn * tsB : cB;
#pragma unroll 1
        for (int t = 0; t < nt; t += 2) {
            const bool last = (t == nt - 2);
            const char* a1 = cA + (size_t)(t + 1) * kstep;
            const char* a2 = last ? nA : cA + (size_t)(t + 2) * kstep; const char* b2 = last ? nB : cB + (size_t)(t + 2) * kstep;
            const char* a3 = a2 + kstep; const char* b3 = b2 + kstep;
            if (last && has_next) S.a_ready(nxt);
            if constexpr (Epi::HAS_MID) { if (t == nt / 2) E.mid(acc, cur, wr, wc, fr, fq); }
            if constexpr (SP2) {
            PG8_LDB(B0, 0, 0); PG8_LDB(B1, 0, 1); PG8_SCHED; PG8_LDA(At, 0, 0); PG8_STAGE(PG8_SA(1, 1), a1 + hsA, voffA);
            PG8_WAIT_V(8); PG8_WAIT_L(0); PG8_BAR; PG8_MMA(0, 0, At, B0); PG8_MMA(0, 1, At, B1); PG8_BAR; PG8_SCHED;
            PG8_LDA(At, 0, 1); PG8_STAGE(PG8_SB(0, 0), b2, voffB); PG8_STAGE(PG8_SB(0, 1), b2 + hsB, voffB); PG8_STAGE(PG8_SA(0, 0), a2, voffA);
            PG8_WAIT_V(8); PG8_WAIT_L(0); PG8_BAR; PG8_MMA(1, 0, At, B0); PG8_MMA(1, 1, At, B1); PG8_BAR; PG8_SCHED;
            PG8_LDB(B0, 1, 0); PG8_LDB(B1, 1, 1); PG8_SCHED; PG8_LDA(At, 1, 0); PG8_STAGE(PG8_SA(0, 1), a2 + hsA, voffA);
            PG8_WAIT_V(8); PG8_WAIT_L(0); PG8_BAR; PG8_MMA(0, 0, At, B0); PG8_MMA(0, 1, At, B1); PG8_BAR; PG8_SCHED;
            PG8_LDA(At, 1, 1); PG8_STAGE(PG8_SB(1, 0), b3, voffB); PG8_STAGE(PG8_SB(1, 1), b3 + hsB, voffB); PG8_STAGE(PG8_SA(1, 0), a3, voffA);
            PG8_WAIT_V(8); PG8_WAIT_L(0); PG8_BAR; PG8_MMA(1, 0, At, B0); PG8_MMA(1, 1, At, B1); PG8_BAR; PG8_SCHED;
            } else {
            PG8_LDB(B0, 0, 0); PG8_SCHED; PG8_LDA(At, 0, 0); PG8_STAGE(PG8_SA(1, 1), a1 + hsA, voffA);
            PG8_WAIT_L(8); PG8_BAR; PG8_WAIT_L(0); PG8_MMA(0, 0, At, B0); PG8_BAR; PG8_SCHED;
            PG8_LDB(B1, 0, 1); PG8_STAGE(PG8_SB(0, 0), b2, voffB);
            PG8_BAR; PG8_WAIT_L(0); PG8_MMA(0, 1, At, B1); PG8_BAR;
            PG8_LDA(At, 0, 1); PG8_STAGE(PG8_SA(0, 0), a2, voffA);
            PG8_BAR; PG8_WAIT_L(0); PG8_MMA(1, 0, At, B0); PG8_BAR; PG8_SCHED;
            PG8_STAGE(PG8_SB(0, 1), b2 + hsB, voffB);
            PG8_WAIT_V(6); PG8_BAR; PG8_MMA(1, 1, At, B1); PG8_BAR;
            PG8_LDB(B0, 1, 0); PG8_SCHED; PG8_LDA(At, 1, 0); PG8_STAGE(PG8_SA(0, 1), a2 + hsA, voffA);
            PG8_WAIT_L(8); PG8_BAR; PG8_WAIT_L(0); PG8_MMA(0, 0, At, B0); PG8_BAR; PG8_SCHED;
            PG8_LDB(B1, 1, 1); PG8_STAGE(PG8_SB(1, 0), b3, voffB);
            PG8_BAR; PG8_WAIT_L(0); PG8_MMA(0, 1, At, B1); PG8_BAR;
            PG8_LDA(At, 1, 1); PG8_STAGE(PG8_SA(1, 0), a3, voffA);
            PG8_BAR; PG8_WAIT_L(0); PG8_MMA(1, 0, At, B0); PG8_BAR; PG8_SCHED;
            PG8_STAGE(PG8_SB(1, 1), b3 + hsB, voffB);
            PG8_WAIT_V(6); PG8_BAR; PG8_MMA(1, 1, At, B1); PG8_BAR;
            }
        }
        if constexpr (ALIGN_EPI) { if (wr == 0) PG8_BAR; }
        if constexpr (!Epi::AFTER_DRAIN) { E(acc, cur, wr, wc, fr, fq); S.done(cur); }
        if (!has_next) break;
        if constexpr (Epi::HAS_INIT) E.init(acc, nxt, wr, wc, fr, fq); else {
#pragma unroll
        for (int a = 0; a < 2; ++a)
#pragma unroll
            for (int b = 0; b < 2; ++b)
#pragma unroll
                for (int m = 0; m < 4; ++m)
#pragma unroll
                    for (int n = 0; n < 2; ++n) acc[a][b][m][n] = (f32x4){0.f, 0.f, 0.f, 0.f};
        }
        cur = nxt; cA = nA; cB = nB; ++ui;
        if constexpr (ALIGN_EPI) { if (wr == 1) PG8_BAR; }
    }
    PG8_WAIT_V(0);
    if constexpr (!ALIGN_EPI) { if (wr == 0) PG8_BAR; }
    PG8_BAR;
    if constexpr (Epi::AFTER_DRAIN) { E.fused(acc, cur, wr, wc, fr, fq, lds, wid, lane); S.done(cur); }
#undef PG8_SA
#undef PG8_SB
#undef PG8_STAGE
#undef PG8_LDA
#undef PG8_LDB
#undef PG8_MMA
#undef PG8_WAIT_V
#undef PG8_WAIT_L
#undef PG8_BAR
#undef PG8_SCHED
}

template <class Epi, class Sched, bool ALIGN_EPI = false, bool SP2 = false>
__device__ __forceinline__ void gemm_phase_g(PG8_LAS unsigned char* lds, const Gemm g, const Sched& S, const Epi& E) {
    const int tid = fresh_tid(), wid = __builtin_amdgcn_readfirstlane(tid >> 6), lane = tid & 63, wr = wid >> 2, wc = wid & 3, fr = lane & 15, fq = lane >> 4;
    const int K = g.K, nt = K / BK;
    unsigned voffB[2]; int RAr[2]; unsigned CAb[2];
#pragma unroll
    for (int i = 0; i < 2; ++i) { int R, C; stage_rc(tid * 16 + i * 8192, R, C); const int Rb = Epi::PERM ? ((R & ~31) + perm32(R & 31)) : R;
        RAr[i] = R; CAb[i] = (unsigned)C * 2u; voffB[i] = (unsigned)(Rb * g.ldb + C) * 2u; }
    const size_t kstep = (size_t)(BK * 2);
    const size_t hsA = (size_t)HALF * g.lda * 2, hsB = (size_t)HALF * g.ldb * 2;
    const size_t tsA = 2 * hsA, tsB = 2 * hsB;
    const unsigned ldsw = (unsigned)wid * 1024u;
    const int aoff = lds_byte(wr * 64 + fr, fq * 8), boff = lds_byte(wc * 32 + fr, fq * 8);
#define PG8_SA(b, h) (((b) * 2 + (h)) * HTB)
#define PG8_SB(b, h) ((4 + (b) * 2 + (h)) * HTB)
#define PG8_STAGE(bufoff, gbase, voff) do { _Pragma("unroll") for (int _i = 0; _i < 2; ++_i) \
        __builtin_amdgcn_global_load_lds((const unsigned*)((const char*)(gbase) + (voff)[_i]), (PG8_LAS unsigned*)(lds + (bufoff) + ldsw + _i * 8192), 16, 0, 0); } while (0)
#define PG8_LDA(dst, b, h) do { _Pragma("unroll") for (int m = 0; m < 4; ++m) _Pragma("unroll") for (int k = 0; k < 2; ++k) dst[m][k] = *(const PG8_LAS bf16x8*)(lds + PG8_SA(b, h) + aoff + m * 2048 + k * 1024); } while (0)
#define PG8_LDB(dst, b, h) do { _Pragma("unroll") for (int n = 0; n < 2; ++n) _Pragma("unroll") for (int k = 0; k < 2; ++k) dst[n][k] = *(const PG8_LAS bf16x8*)(lds + PG8_SB(b, h) + boff + n * 2048 + k * 1024); } while (0)
#define PG8_MMA(ai, bj, At, Bt) do { __builtin_amdgcn_s_setprio(1); _Pragma("unroll") for (int m = 0; m < 4; ++m) _Pragma("unroll") for (int n = 0; n < 2; ++n) _Pragma("unroll") for (int k = 0; k < 2; ++k) \
        acc[ai][bj][m][n] = __builtin_amdgcn_mfma_f32_16x16x32_bf16(Bt[n][k], At[m][k], acc[ai][bj][m][n], 0, 0, 0); __builtin_amdgcn_s_setprio(0); } while (0)
#define PG8_WAIT_V(n) asm volatile("s_waitcnt vmcnt(" #n ")" ::: "memory")
#define PG8_WAIT_L(n) asm volatile("s_waitcnt lgkmcnt(" #n ")" ::: "memory")
#define PG8_BAR __builtin_amdgcn_s_barrier()
#define PG8_SCHED __builtin_amdgcn_sched_barrier(0)
    Unit cur, nxt; int ui = 0;
    if (!S.next(0, cur)) return;
    f32x4 acc[2][2][4][2];
    if constexpr (Epi::HAS_INIT) E.init(acc, cur, wr, wc, fr, fq); else {
#pragma unroll
    for (int a = 0; a < 2; ++a)
#pragma unroll
        for (int b = 0; b < 2; ++b)
#pragma unroll
            for (int m = 0; m < 4; ++m)
#pragma unroll
                for (int n = 0; n < 2; ++n) acc[a][b][m][n] = (f32x4){0.f, 0.f, 0.f, 0.f};
    }
    bf16x8 At[4][2], B0[2][2], B1[2][2];
    unsigned vAll[4][2][2];
#pragma unroll
    for (int q = 0; q < 4; ++q) { Unit uq; const bool ok = S.next(q, uq);
#pragma unroll
        for (int h = 0; h < 2; ++h)
#pragma unroll
            for (int i = 0; i < 2; ++i) vAll[q][h][i] = ok ? (unsigned)S.arow(uq.pm * BM + h * HALF + RAr[i]) * (unsigned)(g.lda * 2) + CAb[i] : 0u; }
#define PG8_PICK(dst, idx) do { _Pragma("unroll") for (int h_ = 0; h_ < 2; ++h_) _Pragma("unroll") for (int i_ = 0; i_ < 2; ++i_) \
        dst[h_][i_] = (idx) == 0 ? vAll[0][h_][i_] : (idx) == 1 ? vAll[1][h_][i_] : (idx) == 2 ? vAll[2][h_][i_] : vAll[3][h_][i_]; } while (0)
    unsigned vA[2][2], vAn[2][2], vS[2][2];
    PG8_PICK(vA, 0);
    const char* A0 = (const char*)g.A; const char* cB = (const char*)g.Bt + S.boff(cur);
    S.a_ready(cur);
    if constexpr (SP2) {
        PG8_STAGE(PG8_SB(0, 0), cB, voffB); PG8_STAGE(PG8_SB(0, 1), cB + hsB, voffB); PG8_STAGE(PG8_SA(0, 0), A0, vA[0]); PG8_STAGE(PG8_SA(0, 1), A0, vA[1]);
        if (wr == 1) PG8_BAR;
        PG8_WAIT_V(2); PG8_BAR;
        PG8_STAGE(PG8_SB(1, 0), cB + kstep, voffB); PG8_STAGE(PG8_SA(1, 0), A0 + kstep, vA[0]); PG8_STAGE(PG8_SB(1, 1), cB + hsB + kstep, voffB);
        PG8_WAIT_V(6); PG8_BAR;
    } else {
        PG8_STAGE(PG8_SB(0, 0), cB, voffB); PG8_STAGE(PG8_SA(0, 0), A0, vA[0]); PG8_STAGE(PG8_SB(0, 1), cB + hsB, voffB); PG8_STAGE(PG8_SA(0, 1), A0, vA[1]);
        if (wr == 1) PG8_BAR;
        PG8_WAIT_V(4); PG8_BAR;
        PG8_STAGE(PG8_SB(1, 0), cB + kstep, voffB); PG8_STAGE(PG8_SA(1, 0), A0 + kstep, vA[0]); PG8_STAGE(PG8_SB(1, 1), cB + hsB + kstep, voffB);
        PG8_WAIT_V(6); PG8_BAR;
    }
    for (;;) {
        const bool has_next = S.next(ui + 1, nxt);
        const char* nB = has_next ? (const char*)g.Bt + S.boff(nxt) : cB;
        if (has_next) { PG8_PICK(vAn, ui + 1); } else { PG8_PICK(vAn, ui); }
#pragma unroll 1
        for (int t = 0; t < nt; t += 2) {
            const bool last = (t == nt - 2);
            const char* a1 = A0 + (size_t)(t + 1) * kstep;
            const char* a2 = last ? A0 : A0 + (size_t)(t + 2) * kstep; const char* b2 = last ? nB : cB + (size_t)(t + 2) * kstep;
#pragma unroll
            for (int h_ = 0; h_ < 2; ++h_)
#pragma unroll
                for (int i_ = 0; i_ < 2; ++i_) vS[h_][i_] = last ? vAn[h_][i_] : vA[h_][i_];
            const char* a3 = a2 + kstep; const char* b3 = b2 + kstep;
            if (last && has_next) S.a_ready(nxt);
            if constexpr (Epi::HAS_MID) { if (t == nt / 2) E.mid(acc, cur, wr, wc, fr, fq); }
            if constexpr (SP2) {
            PG8_LDB(B0, 0, 0); PG8_LDB(B1, 0, 1); PG8_SCHED; PG8_LDA(At, 0, 0); PG8_STAGE(PG8_SA(1, 1), a1, vA[1]);
            PG8_WAIT_V(8); PG8_WAIT_L(0); PG8_BAR; PG8_MMA(0, 0, At, B0); PG8_MMA(0, 1, At, B1); PG8_BAR; PG8_SCHED;
            PG8_LDA(At, 0, 1); PG8_STAGE(PG8_SB(0, 0), b2, voffB); PG8_STAGE(PG8_SB(0, 1), b2 + hsB, voffB); PG8_STAGE(PG8_SA(0, 0), a2, vS[0]);
            PG8_WAIT_V(8); PG8_WAIT_L(0); PG8_BAR; PG8_MMA(1, 0, At, B0); PG8_MMA(1, 1, At, B1); PG8_BAR; PG8_SCHED;
            PG8_LDB(B0, 1, 0); PG8_LDB(B1, 1, 1); PG8_SCHED; PG8_LDA(At, 1, 0); PG8_STAGE(PG8_SA(0, 1), a2, vS[1]);
            PG8_WAIT_V(8); PG8_WAIT_L(0); PG8_BAR; PG8_MMA(0, 0, At, B0); PG8_MMA(0, 1, At, B1); PG8_BAR; PG8_SCHED;
            PG8_LDA(At, 1, 1); PG8_STAGE(PG8_SB(1, 0), b3, voffB); PG8_STAGE(PG8_SB(1, 1), b3 + hsB, voffB); PG8_STAGE(PG8_SA(1, 0), a3, vS[0]);
            PG8_WAIT_V(8); PG8_WAIT_L(0); PG8_BAR; PG8_MMA(1, 0, At, B0); PG8_MMA(1, 1, At, B1); PG8_BAR; PG8_SCHED;
            } else {
            PG8_LDB(B0, 0, 0); PG8_SCHED; PG8_LDA(At, 0, 0); PG8_STAGE(PG8_SA(1, 1), a1, vA[1]);
            PG8_WAIT_L(8); PG8_BAR; PG8_WAIT_L(0); PG8_MMA(0, 0, At, B0); PG8_BAR; PG8_SCHED;
            PG8_LDB(B1, 0, 1); PG8_STAGE(PG8_SB(0, 0), b2, voffB);
            PG8_BAR; PG8_WAIT_L(0); PG8_MMA(0, 1, At, B1); PG8_BAR;
            PG8_LDA(At, 0, 1); PG8_STAGE(PG8_SA(0, 0), a2, vS[0]);
            PG8_BAR; PG8_WAIT_L(0); PG8_MMA(1, 0, At, B0); PG8_BAR; PG8_SCHED;
            PG8_STAGE(PG8_SB(0, 1), b2 + hsB, voffB);
            PG8_WAIT_V(6); PG8_BAR; PG8_MMA(1, 1, At, B1); PG8_BAR;
            PG8_LDB(B0, 1, 0); PG8_SCHED; PG8_LDA(At, 1, 0); PG8_STAGE(PG8_SA(0, 1), a2, vS[1]);
            PG8_WAIT_L(8); PG8_BAR; PG8_WAIT_L(0); PG8_MMA(0, 0, At, B0); PG8_BAR; PG8_SCHED;
            PG8_LDB(B1, 1, 1); PG8_STAGE(PG8_SB(1, 0), b3, voffB);
            PG8_BAR; PG8_WAIT_L(0); PG8_MMA(0, 1, At, B1); PG8_BAR;
            PG8_LDA(At, 1, 1); PG8_STAGE(PG8_SA(1, 0), a3, vS[0]);
            PG8_BAR; PG8_WAIT_L(0); PG8_MMA(1, 0, At, B0); PG8_BAR; PG8_SCHED;
            PG8_STAGE(PG8_SB(1, 1), b3 + hsB, voffB);
            PG8_WAIT_V(6); PG8_BAR; PG8_MMA(1, 1, At, B1); PG8_BAR;
            }
        }
        if constexpr (ALIGN_EPI) { if (wr == 0) PG8_BAR; }
        if constexpr (!Epi::AFTER_DRAIN) { E(acc, cur, wr, wc, fr, fq); S.done(cur); }
        if (!has_next) break;
        if constexpr (Epi::HAS_INIT) E.init(acc, nxt, wr, wc, fr, fq); else {
#pragma unroll
        for (int a = 0; a < 2; ++a)
#pragma unroll
            for (int b = 0; b < 2; ++b)
#pragma unroll
                for (int m = 0; m < 4; ++m)
#pragma unroll
                    for (int n = 0; n < 2; ++n) acc[a][b][m][n] = (f32x4){0.f, 0.f, 0.f, 0.f};
        }
        cur = nxt; cB = nB; ++ui;
#pragma unroll
        for (int h_ = 0; h_ < 2; ++h_)
#pragma unroll
            for (int i_ = 0; i_ < 2; ++i_) vA[h_][i_] = vAn[h_][i_];
        if constexpr (ALIGN_EPI) { if (wr == 1) PG8_BAR; }
    }
    PG8_WAIT_V(0);
    if constexpr (!ALIGN_EPI) { if (wr == 0) PG8_BAR; }
    PG8_BAR;
    if constexpr (Epi::AFTER_DRAIN) { E.fused(acc, cur, wr, wc, fr, fq, lds, wid, lane); S.done(cur); }
#undef PG8_SA
#undef PG8_SB
#undef PG8_STAGE
#undef PG8_LDA
#undef PG8_LDB
#undef PG8_MMA
#undef PG8_WAIT_V
#undef PG8_WAIT_L
#undef PG8_BAR
#undef PG8_SCHED
#undef PG8_PICK
}


}

namespace attn {
using bf16x8 = __attribute__((ext_vector_type(8))) short;
using s16x4  = __attribute__((ext_vector_type(4))) short;
using f32x16 = __attribute__((ext_vector_type(16))) float;
using u32x4  = __attribute__((ext_vector_type(4))) unsigned;
constexpr int QBLK = 32, KVBLK = 64, LDQ = 3072;
constexpr float SCALE = 0.125f, QSCALE = 0.125f * 1.4426950408889634f;
constexpr size_t SHM_V = KVBLK * 128 * 2, SHM_K = KVBLK * 128 * 2, SHM_ATTN = 2 * SHM_V + 2 * SHM_K + 8 * 64 * 4;
#define KSWZ(row, colB) ((row) * 256 + ((colB) ^ (((row) & 7) << 4)))
#define SBAR() __builtin_amdgcn_sched_barrier(0)
__device__ __forceinline__ int crow(int r, int hi) { return (r & 3) + 8 * (r >> 2) + 4 * hi; }
__device__ __forceinline__ unsigned cvtpk(float lo, float hi) { return pk2(lo, hi); }
__device__ __forceinline__ bf16x8 ld8(const bf16_t* p) { return *reinterpret_cast<const bf16x8*>(p); }

__device__ __forceinline__ void partialSM(f32x16& p0, f32x16& p1) {
  for (int r = 0; r < 16; ++r) p0[r] = __builtin_amdgcn_exp2f(p0[r]);
}
__device__ __forceinline__ void finishSM(f32x16& p0, f32x16& p1, float& l_reg, bf16x8& pa0, bf16x8& pa1, bf16x8& pa2, bf16x8& pa3) {
  for (int r = 0; r < 16; ++r) p1[r] = __builtin_amdgcn_exp2f(p1[r]);
  float ps = 0; for (int r = 0; r < 16; ++r) ps += p0[r]; for (int r = 0; r < 16; ++r) ps += p1[r];
  l_reg += ps;
#define PK4(P, BASE, OUT) do { unsigned a0 = cvtpk(P[BASE + 0], P[BASE + 1]), a1 = cvtpk(P[BASE + 2], P[BASE + 3]);   \
    unsigned b0 = cvtpk(P[BASE + 4], P[BASE + 5]), b1 = cvtpk(P[BASE + 6], P[BASE + 7]);                              \
    auto r0 = __builtin_amdgcn_permlane32_swap(a0, b0, false, false); auto r1 = __builtin_amdgcn_permlane32_swap(a1, b1, false, false); \
    u32x4 w = {r0[0], r1[0], r0[1], r1[1]}; OUT = *reinterpret_cast<bf16x8*>(&w); } while (0)
  PK4(p0, 0, pa0); PK4(p0, 8, pa1); PK4(p1, 0, pa2); PK4(p1, 8, pa3);
#undef PK4
}
__device__ __forceinline__ void qkt(f32x16& p0, f32x16& p1, const bf16_t* Ks, const bf16x8* qr, int r32, int hi, int sub) {
  p0 = f32x16{}; p1 = f32x16{};
#pragma unroll
  for (int d0 = 0; d0 < 4; ++d0) { int cb = (sub * 64 + d0 * 16 + hi * 8) * 2;
    bf16x8 b0 = *reinterpret_cast<const bf16x8*>((const char*)Ks + KSWZ(r32, cb));
    bf16x8 b1 = *reinterpret_cast<const bf16x8*>((const char*)Ks + KSWZ(32 + r32, cb));
    p0 = __builtin_amdgcn_mfma_f32_32x32x16_bf16(b0, qr[d0], p0, 0, 0, 0);
    p1 = __builtin_amdgcn_mfma_f32_32x32x16_bf16(b1, qr[d0], p1, 0, 0, 0); }
}
__device__ __forceinline__ int v_st(int k, int c) { const int kk = (k & ~0xC) | ((k & 4) << 1) | ((k & 8) >> 1); return ((kk >> 3) * 4 + (c >> 5)) * 512 + ((kk & 7) * 32 + (c & 31)) * 2; }
__device__ __forceinline__ int v_rd_base(int lane) { return ((lane & 3) << 3) | (((lane >> 2) & 3) << 6) | (((lane >> 4) & 1) << 5) | (((lane >> 5) & 1) << 8); }
constexpr int v_rd_off(int d0, int ks, int half) { return d0 * 512 + ks * 4096 + half * 2048; }
template <int OFF> __device__ __forceinline__ s16x4 tr_read(int vb) {
  s16x4 r; asm volatile("ds_read_b64_tr_b16 %0, %1 offset:%2" : "=&v"(r) : "v"(vb), "i"(OFF) : "memory"); return r;
}
template <int D0> __device__ __forceinline__ void pv_one(f32x16& od, int vb, bf16x8 pa0, bf16x8 pa1, bf16x8 pa2, bf16x8 pa3) {
  const s16x4 l0 = tr_read<v_rd_off(D0, 0, 0)>(vb), h0 = tr_read<v_rd_off(D0, 0, 1)>(vb), l1 = tr_read<v_rd_off(D0, 1, 0)>(vb), h1 = tr_read<v_rd_off(D0, 1, 1)>(vb);
  const s16x4 l2 = tr_read<v_rd_off(D0, 2, 0)>(vb), h2 = tr_read<v_rd_off(D0, 2, 1)>(vb), l3 = tr_read<v_rd_off(D0, 3, 0)>(vb), h3 = tr_read<v_rd_off(D0, 3, 1)>(vb);
  asm volatile("s_waitcnt lgkmcnt(0)" ::: "memory"); SBAR();
#define PK(L, H) (bf16x8){L[0], L[1], L[2], L[3], H[0], H[1], H[2], H[3]}
  od = __builtin_amdgcn_mfma_f32_32x32x16_bf16(pa0, PK(l0, h0), od, 0, 0, 0);
  od = __builtin_amdgcn_mfma_f32_32x32x16_bf16(pa1, PK(l1, h1), od, 0, 0, 0);
  od = __builtin_amdgcn_mfma_f32_32x32x16_bf16(pa2, PK(l2, h2), od, 0, 0, 0);
  od = __builtin_amdgcn_mfma_f32_32x32x16_bf16(pa3, PK(l3, h3), od, 0, 0, 0);
#undef PK
}
__device__ __forceinline__ void pv_d0(f32x16* o, int vb, bf16x8 pa0, bf16x8 pa1, bf16x8 pa2, bf16x8 pa3) {
  pv_one<0>(o[0], vb, pa0, pa1, pa2, pa3); pv_one<1>(o[1], vb, pa0, pa1, pa2, pa3); pv_one<2>(o[2], vb, pa0, pa1, pa2, pa3); pv_one<3>(o[3], vb, pa0, pa1, pa2, pa3);
}

struct Stage { bf16x8 vs0, vs1, ks0, ks1; };
__device__ __forceinline__ void attn_prime(const bf16_t* Kh, const bf16_t* Vh, Stage (&sr_)[2]) {
  const int tid = fresh_tid(), sr = tid >> 4, sc = (tid & 15) * 8;
  sr_[0].vs0 = ld8(&Vh[(long)sr * LDQ + sc]); sr_[0].vs1 = ld8(&Vh[(long)(32 + sr) * LDQ + sc]); sr_[0].ks0 = ld8(&Kh[(long)sr * LDQ + sc]); sr_[0].ks1 = ld8(&Kh[(long)(32 + sr) * LDQ + sc]);
}
__device__ __forceinline__ void attn_unit(const bf16_t* Qb, const bf16_t* Kh, const bf16_t* Vh, bf16_t* Ya, float lam, const float* subln_g, int seq, char* lds, const bf16_t* nKh, const bf16_t* nVh, Stage (&sr_)[2]) {
  const int tid = fresh_tid(), wid = __builtin_amdgcn_readfirstlane(tid >> 6), lane = tid & 63, r32 = lane & 31, hi = lane >> 5, sub = wid >> 2, wq = wid & 3;
  bf16_t* V_lds = (bf16_t*)lds; bf16_t* K_lds = (bf16_t*)(lds + 2 * SHM_V);
  float* ws = (float*)(lds + 2 * SHM_V + 2 * SHM_K) + wid * 64; float* li_l = ws;
  float l_reg = 0; f32x16 o[4] = {}; bf16x8 qr[4];
  const bf16_t* Qw = Qb + (long)(wq * QBLK + r32) * LDQ + sub * 64 + hi * 8;
#pragma unroll
  for (int d0 = 0; d0 < 4; ++d0) qr[d0] = ld8(Qw + d0 * 16);
  const int sr = tid >> 4, sc = (tid & 15) * 8, vst0 = v_st(sr, sc), vst1 = v_st(32 + sr, sc);
  const int vb0 = (int)(uintptr_t)V_lds + v_rd_base(lane);
#define SLOAD(i, k0) do { sr_[i].vs0 = ld8(&Vh[(long)((k0) + sr) * LDQ + sc]); sr_[i].vs1 = ld8(&Vh[(long)((k0) + 32 + sr) * LDQ + sc]); \
    sr_[i].ks0 = ld8(&Kh[(long)((k0) + sr) * LDQ + sc]); sr_[i].ks1 = ld8(&Kh[(long)((k0) + 32 + sr) * LDQ + sc]); } while (0)
#define SWRITE(b, i) do { *(bf16x8*)((char*)V_lds + (b) * SHM_V + vst0) = sr_[i].vs0;          \
    *(bf16x8*)((char*)V_lds + (b) * SHM_V + vst1) = sr_[i].vs1; int kc = sc * 2;               \
    *(bf16x8*)((char*)K_lds + (b) * SHM_K + KSWZ(sr, kc)) = sr_[i].ks0;                       \
    *(bf16x8*)((char*)K_lds + (b) * SHM_K + KSWZ(32 + sr, kc)) = sr_[i].ks1; } while (0)
#define SWAIT() asm volatile("s_waitcnt vmcnt(4)" ::: "memory")
  f32x16 pA0, pA1, pB0, pB1; bf16x8 pa0, pa1, pa2, pa3; const int NT = seq / KVBLK;
  constexpr int SE = 0, SO = 1;
  asm volatile("s_waitcnt vmcnt(0)" ::: "memory"); SWRITE(0, SE); __syncthreads();
  qkt(pA0, pA1, K_lds, qr, r32, hi, sub); partialSM(pA0, pA1);
  SLOAD(SO, KVBLK); if (2 < NT) SLOAD(SE, 2 * KVBLK);
  SWAIT(); SWRITE(1, SO); __syncthreads();
  for (int j = 1; j + 1 < NT; j += 2) {
    SBAR(); qkt(pB0, pB1, (bf16_t*)((char*)K_lds + SHM_K), qr, r32, hi, sub);
    finishSM(pA0, pA1, l_reg, pa0, pa1, pa2, pa3); SBAR();
    SLOAD(SO, (j + 2) * KVBLK); SBAR();
    pv_d0(o, vb0, pa0, pa1, pa2, pa3); partialSM(pB0, pB1);
    __syncthreads(); SWAIT(); SWRITE(0, SE); __syncthreads();
    SBAR(); qkt(pA0, pA1, K_lds, qr, r32, hi, sub);
    finishSM(pB0, pB1, l_reg, pa0, pa1, pa2, pa3); SBAR();
    if (j + 3 < NT) SLOAD(SE, (j + 3) * KVBLK); SBAR();
    pv_d0(o, vb0 + (int)SHM_V, pa0, pa1, pa2, pa3); partialSM(pA0, pA1);
    __syncthreads(); SWAIT(); SWRITE(1, SO); __syncthreads();
  }
  sr_[SE].vs0 = ld8(&nVh[(long)sr * LDQ + sc]); sr_[SE].vs1 = ld8(&nVh[(long)(32 + sr) * LDQ + sc]); sr_[SE].ks0 = ld8(&nKh[(long)sr * LDQ + sc]); sr_[SE].ks1 = ld8(&nKh[(long)(32 + sr) * LDQ + sc]);
  SBAR(); qkt(pB0, pB1, (bf16_t*)((char*)K_lds + SHM_K), qr, r32, hi, sub);
  finishSM(pA0, pA1, l_reg, pa0, pa1, pa2, pa3); SBAR();
  pv_d0(o, vb0, pa0, pa1, pa2, pa3); partialSM(pB0, pB1);
  __syncthreads();
  finishSM(pB0, pB1, l_reg, pa0, pa1, pa2, pa3); SBAR();
  pv_d0(o, vb0 + (int)SHM_V, pa0, pa1, pa2, pa3);
  { auto rr = __builtin_amdgcn_permlane32_swap(__float_as_uint(l_reg), __float_as_uint(l_reg), false, false); l_reg = __uint_as_float(rr[0]) + __uint_as_float(rr[1]); }
  if (hi == 0) li_l[r32] = l_reg; asm volatile("s_waitcnt lgkmcnt(0)" ::: "memory");
  float rli[16];
#pragma unroll
  for (int r = 0; r < 16; ++r) rli[r] = __builtin_amdgcn_rcpf(li_l[crow(r, hi)]);
  __syncthreads();
  float* xo = (float*)lds;
  if (sub == 1) {
#pragma unroll
    for (int r = 0; r < 16; ++r) { const int orow = wq * 32 + crow(r, hi);
#pragma unroll
      for (int d0 = 0; d0 < 4; ++d0) xo[orow * 128 + d0 * 32 + r32] = o[d0][r] * rli[r]; }
  }
  __syncthreads();
  if (sub == 0) {
    float gv[4];
#pragma unroll
    for (int d0 = 0; d0 < 4; ++d0) gv[d0] = subln_g[d0 * 32 + r32] * (1.0f - LAM_INIT);
#pragma unroll
    for (int r = 0; r < 16; ++r) { const int orow = wq * 32 + crow(r, hi); float v[4]; float ssq = 0.f;
#pragma unroll
      for (int d0 = 0; d0 < 4; ++d0) { v[d0] = o[d0][r] * rli[r] - lam * xo[orow * 128 + d0 * 32 + r32]; ssq += v[d0] * v[d0]; }
      ssq += __shfl_xor(ssq, 1); ssq += __shfl_xor(ssq, 2); ssq += __shfl_xor(ssq, 4); ssq += __shfl_xor(ssq, 8); ssq += __shfl_xor(ssq, 16);
      const float sc_ = 1.0f / sqrtf(ssq * (1.0f / 128.0f) + RMS_EPS);
#pragma unroll
      for (int d0 = 0; d0 < 4; ++d0) Ya[(long)orow * 2048 + d0 * 32 + r32] = (bf16_t)f2bf(v[d0] * sc_ * gv[d0]); }
  }
  __syncthreads();
#undef SLOAD
#undef SWRITE
#undef SWAIT
}
#undef KSWZ
#undef SBAR
}

struct Args {
    const float* in[33];
    float* out; unsigned char* ws;
    int ph_lo, ph_hi;
};
enum { I_X = 0, I_ANG, I_WIN, I_QNG, I_KNG, I_LQ1, I_LK1, I_LQ2, I_LK2, I_SUBLN, I_MU, I_W0F, I_W2F, I_W0B, I_W2B, I_A0F, I_A2F, I_A0B, I_A2B, I_G2, I_KK, I_KA, I_RK,
       I_LNW, I_LNB, I_WBA, I_WBB, I_WOUT, I_FNG, I_WR, I_WG, I_WU, I_WD };

__device__ __forceinline__ void tr_item(const float* W, int ldw, int k0, int n0, bf16_t* dst, int ldd, LAS float* scr, int lane) {
    float tv[32];
    const float* src = W + (size_t)(k0 + (lane >> 5)) * ldw + n0 + (lane & 31);
#pragma unroll
    for (int i = 0; i < 32; ++i) tv[i] = src[(size_t)(2 * i) * ldw];
#pragma unroll
    for (int i = 0; i < 32; ++i) scr[(2 * i + (lane >> 5)) * 33 + (lane & 31)] = tv[i];
    asm volatile("s_waitcnt lgkmcnt(0)" ::: "memory");
    const int c = lane & 7;
#pragma unroll
    for (int j = 0; j < 4; ++j) { const int n = (lane >> 3) + 8 * j; const LAS float* s = scr + (8 * c) * 33 + n;
        v4u o; o.x = pk2(s[0 * 33], s[1 * 33]); o.y = pk2(s[2 * 33], s[3 * 33]); o.z = pk2(s[4 * 33], s[5 * 33]); o.w = pk2(s[6 * 33], s[7 * 33]);
        *(v4u*)(dst + (size_t)n * ldd + 8 * c) = o; }
    asm volatile("s_waitcnt lgkmcnt(0)" ::: "memory");
}

__device__ __forceinline__ void p0_prologue(const Args& a, LAS unsigned char* lds, int gw, int NGW, int wave, int lane) {
    unsigned char* ws = a.ws;
    LAS float* scr = (LAS float*)(lds + wave * 16384);
    bf16_t* WinT = (bf16_t*)(ws + WS_WINT);
    bf16_t* WaT = (bf16_t*)(ws + WS_WAT); bf16_t* WoT = (bf16_t*)(ws + WS_WOT);
    constexpr int I_IN = 32 * 333, I_A = 16 * 64, I_B = 16 * 64, I_O = 32 * 64, NITEMS = I_IN + I_A + I_B + I_O;
    for (int it = gw; it < NITEMS; it += NGW) {
        int r = it;
        if (r < I_IN) { const int kb = r / 333, nb = r % 333, n0 = nb * 32; int drow = n0;
            if (n0 >= 6560) { const int c = n0 - 6560, which = c >> 11, cc = c & 2047; drow = 6656 + (cc >> 7) * 256 + which * 128 + (cc & 127); }
            tr_item(a.in[I_WIN], IN_COLS, kb * 64, n0, WinT + (size_t)drow * 2048 + kb * 64, 2048, scr, lane); continue; } r -= I_IN;
        if (r < I_A) { const int kb = r / 64, nb = r % 64; tr_item(a.in[I_WBA], 2048, kb * 64, nb * 32, WaT + (size_t)(nb * 32) * 2048 + kb * 64, 2048, scr, lane); continue; } r -= I_A;
        if (r < I_B) { const int kb = r / 64, nb = r % 64; tr_item(a.in[I_WBB], 2048, kb * 64, nb * 32, WaT + (size_t)(nb * 32) * 2048 + 1024 + kb * 64, 2048, scr, lane); continue; } r -= I_B;
        { const int kb = r / 64, nb = r % 64; tr_item(a.in[I_WOUT], 2048, kb * 64, nb * 32, WoT + (size_t)(nb * 32) * 2048 + kb * 64, 2048, scr, lane); }
    }
    { const int gt = gw * 64 + lane, NT_ = NGW * 64;
      v4u z = {0u, 0u, 0u, 0u};
      for (int i = gt; i < 24576; i += NT_) ((v4u*)(WinT + (size_t)6560 * 2048))[i] = z;
      { const float invf[8] = {1.000000000e+00f, 1.939227432e-01f, 3.760603070e-02f, 7.292664610e-03f, 1.414213562e-03f, 2.742481884e-04f, 5.318296098e-05f, 1.031338616e-05f};
        for (int i = gt; i < SEQ * 8; i += NT_) { float iv = invf[0];
#pragma unroll
            for (int j = 1; j < 8; ++j) iv = ((i & 7) == j) ? invf[j] : iv;
            float sv, cv; sincosf((float)(i >> 3) * iv, &sv, &cv); ((float2*)(ws + WS_ROPE))[i] = make_float2(cv, sv); } }
      { float* sm = (float*)(ws + WS_SMALL);
#define CPY(OFF, IDX, N) for (int i = gt; i < (N); i += NT_) sm[(OFF) + i] = a.in[IDX][i];
        CPY(SM_QNG, I_QNG, 64) CPY(SM_KNG, I_KNG, 64) CPY(SM_LQ1, I_LQ1, 64) CPY(SM_LK1, I_LK1, 64) CPY(SM_LQ2, I_LQ2, 64) CPY(SM_LK2, I_LK2, 64) CPY(SM_SUBLN, I_SUBLN, 128)
        CPY(SM_MU, I_MU, 3488) CPY(SM_KK, I_KK, 1024) CPY(SM_KA, I_KA, 1024) CPY(SM_RK, I_RK, 1024) CPY(SM_LNW, I_LNW, 1024) CPY(SM_LNB, I_LNB, 1024) CPY(SM_FNG, I_FNG, 2048) CPY(SM_WR, I_WR, 32768)
#undef CPY
      }
      for (int i = gt; i < 4096; i += NT_) { const int seg = i >> 10, c = i & 1023; ((float*)(ws + WS_BIAS4))[i] = (seg == 0) ? a.in[I_W0F][c] : (seg == 1) ? a.in[I_W0B][c] : (seg == 2) ? a.in[I_A0F][c] : a.in[I_A0B][c]; }
      bf16_t* B1 = (bf16_t*)(ws + WS_BTL1); bf16_t* B2 = (bf16_t*)(ws + WS_BTL2);
      for (int i = gt; i < 4096 * 32; i += NT_) { const int n = i >> 5, kc = (i & 31) * 8, seg = n >> 10, c = n & 1023;
          const float* w2 = (seg == 0) ? a.in[I_W2F] : (seg == 1) ? a.in[I_W2B] : (seg == 2) ? a.in[I_A2F] : a.in[I_A2B];
          float f[8];
#pragma unroll
          for (int j = 0; j < 8; ++j) { const int k = kc + j - 64 * seg; f[j] = (k >= 0 && k < 64) ? w2[(size_t)k * 1024 + c] : 0.f; }
          *(v4u*)(B1 + (size_t)n * 256 + kc) = pack8(f); }
      for (int i = gt; i < 1024 * 32; i += NT_) { const int n = i >> 5, kc = (i & 31) * 8; float f[8];
#pragma unroll
          for (int j = 0; j < 8; ++j) { const int k = kc + j; f[j] = (k < 160) ? a.in[I_G2][(size_t)k * 1024 + n] : 0.f; }
          *(v4u*)(B2 + (size_t)n * 256 + kc) = pack8(f); }
    }
    bf16_t* HN = (bf16_t*)(ws + WS_HN); const float* x = a.in[I_X]; const float* g = a.in[I_ANG];
    for (int m = gw; m < M; m += NGW) {
        const float4* xr = (const float4*)(x + (size_t)m * DM) + lane; float4 v[8]; float s = 0.f;
#pragma unroll
        for (int j = 0; j < 8; ++j) { v[j] = xr[64 * j]; s += (v[j].x * v[j].x + v[j].y * v[j].y) + (v[j].z * v[j].z + v[j].w * v[j].w); }
        const float rs = 1.0f / sqrtf(wave_sum(s) * (1.0f / DM) + RMS_EPS);
        v2u* o = (v2u*)(HN + (size_t)m * DM) + lane;
#pragma unroll
        for (int j = 0; j < 8; ++j) { const float4 gg = ((const float4*)g)[64 * j + lane]; v2u w; w.x = pk2(v[j].x * rs * gg.x, v[j].y * rs * gg.y); w.y = pk2(v[j].z * rs * gg.z, v[j].w * rs * gg.w); o[64 * j] = w; }
    }
}

__device__ __forceinline__ void p2_prep(const Args& a, int gw, int NGW, int lane, bool dummy = false) {
    unsigned char* ws = a.ws;
    bf16_t* PDA = (bf16_t*)(ws + WS_PDA); const bf16_t* PRW = (const bf16_t*)((unsigned char*)a.out + DO_PRW);
    bf16_t* RKV = (bf16_t*)(ws + WS_RKV); bf16_t* LIN = (bf16_t*)((unsigned char*)a.out + DO_LIN);
    const float* sm = (const float*)(ws + WS_SMALL); const float* mu = sm + SM_MU;
    const int sub8 = lane & 7;
    float gq[8], gk[8];
#pragma unroll
    for (int j = 0; j < 8; ++j) { gq[j] = sm[SM_QNG + sub8 * 8 + j]; gk[j] = sm[SM_KNG + sub8 * 8 + j]; }
    for (int m = gw; m < M; m += NGW) {
        const int t = m & (SEQ - 1);
        const float2 csv = ((const float2*)(ws + WS_ROPE))[t * 8 + sub8]; const float cv = csv.x, sv = csv.y;
        float cs[8], sn[8];
#pragma unroll
        for (int j = 0; j < 8; ++j) { cs[j] = __shfl(cv, j); sn[j] = __shfl(sv, j); }
        v4u wq[4];
#pragma unroll
        for (int it = 0; it < 4; ++it) { const int v = it * 8 + (lane >> 3); wq[it] = *(const v4u*)(PDA + (size_t)m * 3072 + (v < 16 ? 0 : 1024) + (v & 15) * 64 + sub8 * 8); }
#pragma unroll
        for (int it = 0; it < 4; ++it) {
            const int v = it * 8 + (lane >> 3);
            bf16_t* p = PDA + (size_t)m * 3072 + (v < 16 ? 0 : 1024) + (v & 15) * 64 + sub8 * 8;
            const v4u w = wq[it]; float f[8]; unpack8(w, f);
            float s = 0.f;
#pragma unroll
            for (int j = 0; j < 8; ++j) s += f[j] * f[j];
            s = sum8(s); const float rs = 1.0f / sqrtf(s * (1.0f / 64.0f) + RMS_EPS);
            float y[8], oth[8];
#pragma unroll
            for (int j = 0; j < 8; ++j) { y[j] = f[j] * rs * (v < 16 ? gq[j] : gk[j]); }
#pragma unroll
            for (int j = 0; j < 8; ++j) oth[j] = __shfl_xor(y[j], 1);
            float o[8];
#pragma unroll
            for (int j = 0; j < 8; ++j) o[j] = (sub8 == 0) ? (y[j] * cs[j] - oth[j] * sn[j]) : (sub8 == 1) ? (y[j] * cs[j] + oth[j] * sn[j]) : y[j];
            if (v < 16) {
#pragma unroll
                for (int j = 0; j < 8; ++j) o[j] *= 0.125f * 1.4426950408889634f; }
            *(v4u*)(dummy ? (bf16_t*)(ws + WS_LORA) + (p - PDA) : p) = pack8(o);
        }
        const bool hp = t > 0, hn_ = t < SEQ - 1;
        const bf16_t* pr = PRW + (size_t)m * RW_PAD;
#pragma unroll
        for (int it = 0; it < 7; ++it) {
            const int v = it * 64 + lane; if (it == 6 && v >= 436) continue;
            const v4u wc = *(const v4u*)(pr + v * 8);
            v4u wp = {0u, 0u, 0u, 0u}, wn = {0u, 0u, 0u, 0u};
            if (hp) wp = *(const v4u*)(pr - RW_PAD + v * 8);
            if (hn_) wn = *(const v4u*)(pr + RW_PAD + v * 8);
            float c[8], pv[8], nx[8]; unpack8(wc, c); unpack8(wp, pv); unpack8(wn, nx);
            const float4 m0 = *(const float4*)(mu + v * 8), m1 = *(const float4*)(mu + v * 8 + 4);
            const float mm[8] = {m0.x, m0.y, m0.z, m0.w, m1.x, m1.y, m1.z, m1.w};
            float xs[8];
#pragma unroll
            for (int j = 0; j < 8; ++j) xs[j] = c[j] + mm[j] * (0.5f * (pv[j] + nx[j]) - c[j]);
            if (v < 384) { const v4u pw = pack8(xs); *(v4u*)(RKV + (size_t)m * 3072 + v * 8) = pw;
                if (it == 2 || it == 3) {
                    float kr[8]; unpack8(pw, kr); float ssq = 0.f;
#pragma unroll
                    for (int j = 0; j < 8; ++j) { const float kkv = kr[j] * sm[SM_KK + (v - 128) * 8 + j]; ssq += kkv * kkv; }
                    ssq = sum8(ssq);
                    if ((lane & 7) == 0) ((float*)(ws + WS_INRM))[(size_t)m * 16 + ((v - 128) >> 3)] = 1.0f / fmaxf(sqrtf(ssq), 1e-12f); } }
            else if (v < 400) {
#pragma unroll
                for (int j = 0; j < 8; ++j) xs[j] = 1.0f - 2.0f * __builtin_amdgcn_rcpf(1.0f + __expf(2.0f * xs[j]));
                *(v4u*)(LIN + (size_t)m * 512 + (v - 384) * 8) = pack8(xs); }
            else if (v < 416) { *(v4u*)(LIN + (size_t)m * 512 + (v - 384) * 8) = pack8(xs); }
            else {
#pragma unroll
                for (int j = 0; j < 8; ++j) xs[j] = sigmoidf_(xs[j]);
                *(v4u*)(LIN + (size_t)m * 512 + 256 + (v - 416) * 8) = pack8(xs); }
        }
        if (lane < 12) { v4u z = {0u, 0u, 0u, 0u}; *(v4u*)(LIN + (size_t)m * 512 + 416 + lane * 8) = z; }
    }
}

__device__ __forceinline__ void p6_rwpost(const Args& a, int gw, int NGW, int lane) {
    unsigned char* ws = a.ws;
    const bf16_t* RKV = (const bf16_t*)(ws + WS_RKV); const bf16_t* LO = (const bf16_t*)(ws + WS_LORA);
    const bf16_t* YSF = (const bf16_t*)((unsigned char*)a.out + DO_YSF); const bf16_t* YSB = (const bf16_t*)((unsigned char*)a.out + DO_YSB);
    bf16_t* YB = (bf16_t*)((unsigned char*)a.out + DO_YAB) + 1024;
    const size_t SEG = (size_t)M * 1024; const float* sm = (const float*)(ws + WS_SMALL);
    for (int it = gw; it < 2 * M; it += NGW) {
        const int m = it >> 1, col = (it & 1) * 512 + lane * 8;
        float yf[8], ybk[8], r[8], k[8], v[8], af[8], ab[8], g[8];
        unpack8(*(const v4u*)(YSF + (size_t)m * 1024 + col), yf); unpack8(*(const v4u*)(YSB + (size_t)m * 1024 + col), ybk);
        unpack8(*(const v4u*)(RKV + (size_t)m * 3072 + col), r); unpack8(*(const v4u*)(RKV + (size_t)m * 3072 + 1024 + col), k); unpack8(*(const v4u*)(RKV + (size_t)m * 3072 + 2048 + col), v);
        unpack8(*(const v4u*)(LO + 2 * SEG + (size_t)m * 1024 + col), af); unpack8(*(const v4u*)(LO + 3 * SEG + (size_t)m * 1024 + col), ab); unpack8(*(const v4u*)(LO + 4 * SEG + (size_t)m * 1024 + col), g);
        float y[8]; float s = 0.f;
#pragma unroll
        for (int j = 0; j < 8; ++j) { y[j] = yf[j] + ybk[j]; s += y[j]; }
        const float mean = sum8(s) * (1.0f / 64.0f); float q = 0.f;
#pragma unroll
        for (int j = 0; j < 8; ++j) { y[j] -= mean; q += y[j] * y[j]; }
        const float rstd = 1.0f / sqrtf(sum8(q) * (1.0f / 64.0f) + GN_EPS);
        float bs = 0.f;
#pragma unroll
        for (int j = 0; j < 8; ++j) { const float kfb = k[j] * (2.0f + (af[j] + ab[j] - 2.0f) * sm[SM_KA + col + j]); bs += r[j] * kfb * sm[SM_RK + col + j]; }
        bs = sum8(bs);
        float o[8];
#pragma unroll
        for (int j = 0; j < 8; ++j) o[j] = (y[j] * rstd * sm[SM_LNW + col + j] + sm[SM_LNB + col + j] + bs * v[j]) * g[j];
        *(v4u*)(YB + (size_t)m * 2048 + col) = pack8(o);
    }
}

__device__ __forceinline__ void expert_convert_gu(const Args& a, LAS unsigned char* lds, int gw, int NGW, int wave, int lane, int e_lo, int e_hi, int it_end = 1 << 30) {
    unsigned char* ws = a.ws;
    LAS float* scr = (LAS float*)(lds + wave * 16384);
    const int per = (e_hi - e_lo) * 1024;
    for (int it = gw; it < 2 * per && it < it_end; it += NGW) {
        const int which = it >= per ? 1 : 0, r = it - which * per, e = e_lo + (r >> 10), q = r & 1023;
        const int kb = q >> 5, nb = q & 31, n0 = nb * 32;
        const float* W = (which == 0 ? a.in[I_WG] : a.in[I_WU]) + (size_t)e * 2048 * 1024;
        const int drow = (n0 >> 7) * 256 + which * 128 + (n0 & 127);
        tr_item(W, 1024, kb * 64, n0, (bf16_t*)(ws + w1t_base(e)) + (size_t)drow * 2048 + kb * 64, 2048, scr, lane); }
}
__device__ __forceinline__ void expert_convert_down(const Args& a, LAS unsigned char* lds, int gw, int NGW, int wave, int lane) {
    unsigned char* ws = a.ws;
    LAS float* scr = (LAS float*)(lds + wave * 16384);
    bf16_t* WDT = (bf16_t*)(ws + WS_WDT);
    for (int it = gw; it < 16384; it += NGW) { const int e = it >> 10, q = it & 1023, kb = q >> 6, nb = q & 63;
        const float* W = a.in[I_WD] + (size_t)e * 1024 * 2048;
        tr_item(W, 2048, kb * 64, nb * 32, WDT + ((size_t)e * 2048 + nb * 32) * 1024 + kb * 64, 1024, scr, lane); }
}
__device__ __forceinline__ void p9_router(const Args& a, LAS unsigned char* lds, int gw, int NGW, int wave, int lane) {
    unsigned char* ws = a.ws;
    expert_convert_gu(a, lds, gw, NGW, wave, lane, (gridDim.x == 256) ? N_EARLY_EXPERTS : 0, NE);
    __syncthreads();
    LAS float* wrT = (LAS float*)lds;
    { const float4* wr4 = (const float4*)((const float*)(ws + WS_SMALL) + SM_WR);
      for (int idx = fresh_tid(); idx < 2048 * 4; idx += NTHREADS) { const int d = idx >> 2, q = idx & 3; const float4 w4 = wr4[idx];
          wrT[(4 * q + 0) * 2048 + d] = w4.x; wrT[(4 * q + 1) * 2048 + d] = w4.y; wrT[(4 * q + 2) * 2048 + d] = w4.z; wrT[(4 * q + 3) * 2048 + d] = w4.w; } }
    __syncthreads();
    const float* h = a.out; const float* ss = (const float*)(ws + WS_SSP); const float* g = (const float*)(ws + WS_SMALL) + SM_FNG;
    float* aff = (float*)(ws + WS_AFF); bf16_t* hn2 = (bf16_t*)(ws + WS_HN2);
    for (int mp = gw; mp < M / 2; mp += NGW) {
        const int m0 = 2 * mp;
        const float rs0 = 1.0f / sqrtf(wave_sum(lane < 32 ? ss[(size_t)m0 * 32 + lane] : 0.f) * (1.0f / DM) + RMS_EPS);
        const float rs1 = 1.0f / sqrtf(wave_sum(lane < 32 ? ss[(size_t)(m0 + 1) * 32 + lane] : 0.f) * (1.0f / DM) + RMS_EPS);
        float acc0[16], acc1[16];
#pragma unroll
        for (int e = 0; e < 16; ++e) { acc0[e] = 0.f; acc1[e] = 0.f; }
#pragma unroll 2
        for (int j = 0; j < 8; ++j) { const int d = j * 256 + lane * 4;
            const float4 gv = *(const float4*)(g + d), h0 = *(const float4*)(h + (size_t)m0 * DM + d), h1 = *(const float4*)(h + (size_t)(m0 + 1) * DM + d);
            const float x0[4] = {h0.x * rs0 * gv.x, h0.y * rs0 * gv.y, h0.z * rs0 * gv.z, h0.w * rs0 * gv.w};
            const float x1[4] = {h1.x * rs1 * gv.x, h1.y * rs1 * gv.y, h1.z * rs1 * gv.z, h1.w * rs1 * gv.w};
            { v2u w0, w1; w0.x = pk2(x0[0], x0[1]); w0.y = pk2(x0[2], x0[3]); w1.x = pk2(x1[0], x1[1]); w1.y = pk2(x1[2], x1[3]);
              *(v2u*)(hn2 + (size_t)m0 * DM + d) = w0; *(v2u*)(hn2 + (size_t)(m0 + 1) * DM + d) = w1; }
#pragma unroll
            for (int e = 0; e < 16; ++e) { const pg8::f32x4 w4 = *(const LAS pg8::f32x4*)(wrT + e * 2048 + d);
                acc0[e] += x0[0] * w4.x + x0[1] * w4.y + x0[2] * w4.z + x0[3] * w4.w;
                acc1[e] += x1[0] * w4.x + x1[1] * w4.y + x1[2] * w4.z + x1[3] * w4.w; } }
#pragma unroll
        for (int t2 = 0; t2 < 2; ++t2) {
            float mx = -1e30f, lg[16];
#pragma unroll
            for (int e = 0; e < 16; ++e) { lg[e] = wave_sum(t2 ? acc1[e] : acc0[e]); mx = fmaxf(mx, lg[e]); }
            float den = 0.f;
#pragma unroll
            for (int e = 0; e < 16; ++e) { lg[e] = __expf(lg[e] - mx); den += lg[e]; }
            float mine = lg[0];
#pragma unroll
            for (int e = 1; e < 16; ++e) mine = (lane == e) ? lg[e] : mine;
            const int m = m0 + t2;
            if (lane < 16) aff[((size_t)(m >> 12) * 16 + lane) * SEQ + (m & (SEQ - 1))] = mine / den;
        }
    }
}

__device__ __forceinline__ void p10_topk(const Args& a, unsigned char* ldsg) {
    const int bx = blockIdx.x; if (bx >= NB * NE) return;
    LAS unsigned char* L = (LAS unsigned char*)ldsg;
    const int tid = fresh_tid(), lane = tid & 63, w = tid >> 6;
    unsigned char* ws = a.ws;
    const float* aff = (const float*)(ws + WS_AFF) + (size_t)bx * SEQ;
    LAS unsigned* hist = (LAS unsigned*)L;
    LAS unsigned* ctl = hist + 256;
    LAS unsigned* wtot = hist + 272;
    unsigned v[8];
    { const v4u a0 = *(const v4u*)(aff + tid * 8), a1 = *(const v4u*)(aff + tid * 8 + 4); v[0] = a0.x; v[1] = a0.y; v[2] = a0.z; v[3] = a0.w; v[4] = a1.x; v[5] = a1.y; v[6] = a1.z; v[7] = a1.w; }
    unsigned prefix = 0u, mask = 0u, remaining = CAP;
#pragma unroll 1
    for (int pass = 0; pass < 4; ++pass) {
        const int shift = 24 - 8 * pass;
        if (tid < 256) hist[tid] = 0u;
        __syncthreads();
#pragma unroll
        for (int q = 0; q < 8; ++q) if ((v[q] & mask) == prefix) __hip_atomic_fetch_add((unsigned*)&hist[(v[q] >> shift) & 255u], 1u, __ATOMIC_RELAXED, __HIP_MEMORY_SCOPE_WORKGROUP);
        __syncthreads();
        if (w == 0) {
            const v4u hb = *(const LAS v4u*)(hist + 4 * lane);
            const unsigned own = hb.x + hb.y + hb.z + hb.w;
            unsigned suf = own;
#pragma unroll
            for (int o = 1; o < 64; o <<= 1) { const unsigned t = __shfl_down(suf, o); suf += (lane + o < 64) ? t : 0u; }
            const unsigned above = suf - own;
            if (above < remaining && remaining <= suf) {
                unsigned c3 = above, d, rem;
                if (remaining <= c3 + hb.w) { d = 3; rem = remaining - c3; }
                else { c3 += hb.w; if (remaining <= c3 + hb.z) { d = 2; rem = remaining - c3; }
                    else { c3 += hb.z; if (remaining <= c3 + hb.y) { d = 1; rem = remaining - c3; } else { c3 += hb.y; d = 0; rem = remaining - c3; } } }
                ctl[0] = 4u * lane + d; ctl[1] = rem;
            }
        }
        __syncthreads();
        prefix |= ctl[0] << shift; mask |= 255u << shift; remaining = ctl[1];
        __syncthreads();
    }
    const unsigned thr = prefix;
    unsigned ceq = 0u, cgt = 0u;
#pragma unroll
    for (int q = 0; q < 8; ++q) { ceq += (v[q] == thr) ? 1u : 0u; cgt += (v[q] > thr) ? 1u : 0u; }
    unsigned inc = ceq;
#pragma unroll
    for (int o = 1; o < 64; o <<= 1) { const unsigned t = __shfl_up(inc, o); inc += (lane >= o) ? t : 0u; }
    if (lane == 63) wtot[w] = inc;
    __syncthreads();
    unsigned eqbase = inc - ceq;
#pragma unroll
    for (int q = 0; q < 8; ++q) eqbase += (q < w) ? wtot[q] : 0u;
    __syncthreads();
    unsigned selmask = 0u, nsel = 0u, er = eqbase;
#pragma unroll
    for (int q = 0; q < 8; ++q) { bool s = v[q] > thr; if (v[q] == thr) { s = er < remaining; ++er; } selmask |= s ? (1u << q) : 0u; nsel += s ? 1u : 0u; }
    inc = nsel;
#pragma unroll
    for (int o = 1; o < 64; o <<= 1) { const unsigned t = __shfl_up(inc, o); inc += (lane >= o) ? t : 0u; }
    if (lane == 63) wtot[w] = inc;
    __syncthreads();
    unsigned pos = inc - nsel;
#pragma unroll
    for (int q = 0; q < 8; ++q) pos += (q < w) ? wtot[q] : 0u;
    int* seltok = (int*)(ws + WS_SELTOK) + bx * CAP; float* selgate = (float*)(ws + WS_SELGATE) + bx * CAP;
#pragma unroll
    for (int q = 0; q < 8; ++q) if (selmask & (1u << q)) { if (pos < (unsigned)CAP) { seltok[pos] = tid * 8 + q; selgate[pos] = __uint_as_float(v[q]); } ++pos; }
    (void)cgt;
}

__device__ __forceinline__ void p11_gather(const Args& a, int gw, int NGW, int lane) {
    unsigned char* ws = a.ws;
    const float* h = a.out; const float* ss = (const float*)(ws + WS_SSP); const float* g = (const float*)(ws + WS_SMALL) + SM_FNG;
    const int* seltok = (const int*)(ws + WS_SELTOK); bf16_t* XE = (bf16_t*)(ws + WS_XE);
    for (int r = gw; r < NSLOT; r += NGW) {
        const int e = r >> 11, b = (r >> 9) & 3, c = r & 511;
        const int tok = seltok[(b * 16 + e) * CAP + c]; const size_t m = (size_t)b * SEQ + tok;
        const float rs = 1.0f / sqrtf(wave_sum(lane < 32 ? ss[m * 32 + lane] : 0.f) * (1.0f / DM) + RMS_EPS);
        const float4* hr = (const float4*)(h + m * DM) + lane; v2u* o = (v2u*)(XE + (size_t)r * DM) + lane;
#pragma unroll
        for (int j = 0; j < 8; ++j) { const float4 hv = hr[64 * j], gg = ((const float4*)g)[64 * j + lane];
            v2u w; w.x = pk2(hv.x * rs * gg.x, hv.y * rs * gg.y); w.y = pk2(hv.z * rs * gg.z, hv.w * rs * gg.w); o[64 * j] = w; }
    }
}

__device__ __forceinline__ void p14_combine(const Args& a, unsigned char* lds, int wave, int lane) {
    unsigned char* ws = a.ws;
    const int G = gridDim.x, bx = blockIdx.x, tid = fresh_tid();
    const int per = M / G;
    const int m0 = bx * per, b = m0 >> 12, t0 = m0 & (SEQ - 1);
    int* inv = (int*)lds;
    for (int i = tid; i < per * 16; i += NTHREADS) inv[i] = -1;
    __syncthreads();
    const int* seltok = (const int*)(ws + WS_SELTOK) + b * 16 * CAP;
    for (int i = tid; i < 16 * CAP; i += NTHREADS) { const int e = i >> 9, c = i & 511; const int tok = seltok[i]; const int tl = tok - t0;
        if (tl >= 0 && tl < per) inv[tl * 16 + e] = e * 2048 + b * 512 + c; }
    __syncthreads();
    const bf16_t* YE = (const bf16_t*)(ws + WS_XE);
    float* out = a.out;
    for (int tl = wave; tl < per; tl += NWAVES) {
        const size_t m = (size_t)m0 + tl;
        float4* orow = (float4*)(out + m * DM) + lane;
        float4 acc[8];
#pragma unroll
        for (int j = 0; j < 8; ++j) acc[j] = orow[64 * j];
        int sl[16]; int ns = 0;
#pragma unroll
        for (int e = 0; e < 16; ++e) { const int s_ = inv[tl * 16 + e]; if (s_ >= 0) { _Pragma("unroll") for (int q = 0; q < 16; ++q) if (q == ns) sl[q] = s_; ++ns; } }
        for (int q = 0; q < ns; q += 2) { int s0 = sl[0], s1 = sl[0];
#pragma unroll
            for (int z = 0; z < 16; ++z) { if (z == q) s0 = sl[z]; if (z == q + 1) s1 = sl[z]; }
            const bool two = q + 1 < ns;
            const v2u* y0 = (const v2u*)(YE + (size_t)s0 * DM) + lane; const v2u* y1 = (const v2u*)(YE + (size_t)(two ? s1 : s0) * DM) + lane;
            v2u w0[8], w1[8];
#pragma unroll
            for (int j = 0; j < 8; ++j) { w0[j] = y0[64 * j]; w1[j] = y1[64 * j]; }
#pragma unroll
            for (int j = 0; j < 8; ++j) { acc[j].x += bflo(w0[j].x); acc[j].y += bfhi(w0[j].x); acc[j].z += bflo(w0[j].y); acc[j].w += bfhi(w0[j].y);
                if (two) { acc[j].x += bflo(w1[j].x); acc[j].y += bfhi(w1[j].x); acc[j].z += bflo(w1[j].y); acc[j].w += bfhi(w1[j].y); } } }
#pragma unroll
        for (int j = 0; j < 8; ++j) orow[64 * j] = acc[j];
    }
}


namespace scan {
typedef short bf16x8 __attribute__((ext_vector_type(8)));
typedef float f32x4 __attribute__((ext_vector_type(4)));
constexpr int TILE_B = 64 * 128;
enum { SL_ATC = 0, SL_BTC = 1, SL_KTC = 2, SL_RTC = 3, SL_BBT = 4, SL_KBT = 5, SL_VT = 6, SL_XCA = 7, SL_TTA = 8, SL_NKA = 9, SL_NBRT = 10, SL_G = 11, SL_SB = 12, SL_RP = 13, SL_BBT1 = 14, SL_VT1 = 15, SL_NKR = 16,
       SL_XCB = 1, SL_TTB = 2, SL_APT = 7, SL_HT = 9, SL_PSIT = 8, SL_WB = 10 };
constexpr int OFF_PL = 17 * TILE_B, OFF_TOT = OFF_PL + 512, OFF_CNT = OFF_TOT + 4096;
#define TILE(s) (L + (s) * TILE_B)
__device__ __forceinline__ int swz16(int r) { return (((r & 7) ^ (((r >> 3) & 1) * 5)) << 4); }
__device__ __forceinline__ int toff(int row, int colbyte) { return row * 128 + (colbyte ^ swz16(row)); }
__device__ __forceinline__ bf16x8 frag(const LAS unsigned char* tile, int row0, int k0, int lane) {
    const int l15 = lane & 15, g4 = lane >> 4;
    return *(const LAS bf16x8*)(tile + row0 * 128 + l15 * 128 + (((g4 << 4) ^ swz16(l15)) ^ (k0 * 2)));
}
__device__ __forceinline__ void st4(LAS unsigned char* tile, int brow, int acol0, const f32x4& v) {
    v2u w; w.x = pg8::cvt_pk_bf16(v[0], v[1]); w.y = pg8::cvt_pk_bf16(v[2], v[3]); *(LAS v2u*)(tile + toff(brow, acol0 * 2)) = w;
}
__device__ __forceinline__ f32x4 ld4(const LAS unsigned char* tile, int brow, int acol0) {
    const v2u w = *(const LAS v2u*)(tile + toff(brow, acol0 * 2)); return (f32x4){bflo(w.x), bfhi(w.x), bflo(w.y), bfhi(w.y)};
}
typedef short v4i16_t __attribute__((ext_vector_type(4)));
typedef short bf16x4 __attribute__((ext_vector_type(4)));
typedef float f32x2 __attribute__((ext_vector_type(2)));
__device__ __forceinline__ bf16x8 fragT(const LAS unsigned char* tileT, int row0, int k0, int lane) {
    const int g = lane >> 4, q = (lane >> 2) & 3, p = lane & 3;
    const int t0 = (8 * g + q) * 128 + ((8 * p) ^ ((q ^ ((g & 1) * 5)) << 4));
    const LAS unsigned char* a = tileT + k0 * 128;
    const v4i16_t lo = __builtin_amdgcn_ds_read_tr16_b64_v4i16((LAS v4i16_t*)(a + (t0 ^ (row0 * 2)))), hi = __builtin_amdgcn_ds_read_tr16_b64_v4i16((LAS v4i16_t*)(a + 512 + ((t0 ^ 64) ^ (row0 * 2))));
    return (bf16x8){lo[0], lo[1], lo[2], lo[3], hi[0], hi[1], hi[2], hi[3]};
}
struct Fr { bf16x8 k0, k1; };
__device__ __forceinline__ Fr ldf(const LAS unsigned char* tile, int row0, int lane) { Fr f; f.k0 = frag(tile, row0, 0, lane); f.k1 = frag(tile, row0, 32, lane); return f; }
__device__ __forceinline__ Fr ldfT(const LAS unsigned char* tileT, int row0, int lane) { Fr f; f.k0 = fragT(tileT, row0, 0, lane); f.k1 = fragT(tileT, row0, 32, lane); return f; }
__device__ __forceinline__ void mmf(f32x4& acc, const Fr& A, const Fr& B) {
    acc = __builtin_amdgcn_mfma_f32_16x16x32_bf16(A.k0, B.k0, acc, 0, 0, 0); acc = __builtin_amdgcn_mfma_f32_16x16x32_bf16(A.k1, B.k1, acc, 0, 0, 0);
}
#define ZERO4 ((f32x4){0.f, 0.f, 0.f, 0.f})
#ifndef TP_SEL
#define TP_SEL -1
#endif
#ifndef TP_WAVE
#define TP_WAVE 0
#endif
#if TP_SEL >= 0
#define TP_MARK(k) do { if (w == TP_WAVE) { const unsigned long long t_ = __builtin_amdgcn_s_memtime(); if (TP_SEL == (k) || TP_SEL == 7) tp_acc += t_ - tp_last; tp_last = t_; } } while (0)
#else
#define TP_MARK(k) do { } while (0)
#endif
__device__ __forceinline__ int opq(int x) { asm volatile("" : "+v"(x)); return x; }
#define LWAIT() asm volatile("s_waitcnt lgkmcnt(0)" ::: "memory")

__device__ __forceinline__ void scan_phase(const Args& a, unsigned char* ldsg) {
    const int bx = blockIdx.x; if (bx >= 128) return;
    LAS unsigned char* L = (LAS unsigned char*)ldsg;
    const int tid = fresh_tid(), lane0 = tid & 63, w = __builtin_amdgcn_readfirstlane(tid >> 6);
    const int dir = bx >> 6, b = (bx >> 4) & 3, hh = bx & 15;
    unsigned char* ws = a.ws;
    bf16_t* YS = (bf16_t*)((unsigned char*)a.out + (dir ? DO_YSB : DO_YSF));
    const int ta = w >> 1, tb0 = (w & 1) * 2;
#define STAGE_LANE() const int lane = opq(lane0), g4 = lane >> 4, l15 = lane & 15, a0 = ta * 16 + 4 * g4
    unsigned rw[8][5]; float inr[8];
    const int wk = w & 3, tg = lane0 >> 5, cp = lane0 & 31;
    const unsigned char* RKVh = ws + WS_RKV + hh * 128; const unsigned char* LWh = ws + WS_LORA + (size_t)dir * ((size_t)M * 2048) + hh * 128; const unsigned char* ALh = ws + WS_LORA + (size_t)(2 + dir) * ((size_t)M * 2048) + hh * 128;
    const int tlane = dir ? (1 - tg) * 8 : tg * 8;
    const unsigned vR = (unsigned)(tlane * 6144 + cp * 4), vL = (unsigned)(tlane * 2048 + cp * 4), vI = (unsigned)(tlane * 64);
    const float* INRM = (const float*)(ws + WS_INRM) + hh;
    const f32x2 kkc2 = *(const f32x2*)((const float*)(ws + WS_SMALL) + SM_KK + hh * 64 + 2 * cp), kac2 = *(const f32x2*)((const float*)(ws + WS_SMALL) + SM_KA + hh * 64 + 2 * cp);
#define RAW_LOAD(chunk, j0) do { _Pragma("unroll") for (int j = (j0); j < (j0) + 4; ++j) { const int s_ = (chunk) * 64 + wk * 16 + j; const int t_ = dir ? (SEQ - 1 - s_ - 8) : s_; const size_t m_ = (size_t)b * SEQ + t_; \
        const unsigned char* pr_ = RKVh + m_ * 6144; const unsigned char* pl_ = LWh + m_ * 2048; const unsigned char* pa_ = ALh + m_ * 2048; \
        rw[j][0] = *(const unsigned*)(pr_ + vR); rw[j][1] = *(const unsigned*)(pr_ + 2048 + vR); rw[j][2] = *(const unsigned*)(pr_ + 4096 + vR); rw[j][3] = *(const unsigned*)(pl_ + vL); rw[j][4] = *(const unsigned*)(pa_ + vL); \
        inr[j] = *(const float*)((const unsigned char*)(INRM + m_ * 16) + vI); } } while (0)
#define DSUM(n) do { const int l2_ = fresh_tid() & 63, tg_ = l2_ >> 5, cp_ = l2_ & 31; \
        f32x2 run_ = {0.f, 0.f}; _Pragma("unroll") for (int j = 0; j < 8; ++j) run_ += (f32x2){bflo(rw[j][3]), bfhi(rw[j][3])}; \
        *(LAS f32x2*)(L + OFF_TOT + ((((n) & 1) * 8 + 2 * wk + tg_) * 64 + 2 * cp_) * 4) = run_; \
        LWAIT(); \
        if (l2_ == 0) __hip_atomic_fetch_add((unsigned*)(L + OFF_CNT), 1u, __ATOMIC_RELAXED, __HIP_MEMORY_SCOPE_WORKGROUP); \
        while (*(volatile LAS unsigned*)(L + OFF_CNT) < 4u * (unsigned)((n) + 1)) __builtin_amdgcn_s_sleep(1); } while (0)
    f32x2 prun, ppv, ppl; unsigned pk[6][2][4], vt[2][4];
#define PTOK(jp) do { f32x2 o[2][6]; \
        _Pragma("unroll") for (int h = 0; h < 2; ++h) { const int j = 2 * (jp) + h; \
            prun += (f32x2){bflo(rw[j][3]), bfhi(rw[j][3])} * 1.44269504f; \
            const f32x2 p = {__builtin_amdgcn_exp2f(prun[0]), __builtin_amdgcn_exp2f(prun[1])}, em = {__builtin_amdgcn_rcpf(p[0]), __builtin_amdgcn_rcpf(p[1])}, eL = ppl * em; \
            const f32x2 r = {bflo(rw[j][0]), bfhi(rw[j][0])}, k = {bflo(rw[j][1]), bfhi(rw[j][1])}, al = {bflo(rw[j][4]), bfhi(rw[j][4])}; \
            const f32x2 kk = k * kkc2 * inr[j], kdv = k * (1.0f + (al - 1.0f) * kac2), bbj = kk * al; \
            o[h][0] = -kk * ppv; ppv = p; o[h][1] = bbj * em; o[h][2] = kdv * em; o[h][3] = r * p; o[h][4] = bbj * eL; o[h][5] = kdv * eL; } \
        _Pragma("unroll") for (int q = 0; q < 6; ++q) { pk[q][0][jp] = pk2(o[0][q][0], o[1][q][0]); pk[q][1][jp] = pk2(o[0][q][1], o[1][q][1]); } \
        vt[0][jp] = (rw[2 * (jp)][2] & 0xffffu) | (rw[2 * (jp) + 1][2] << 16); vt[1][jp] = (rw[2 * (jp)][2] >> 16) | (rw[2 * (jp) + 1][2] & 0xffff0000u); } while (0)
#define PREP1(n) do { const int l2_ = fresh_tid() & 63, tg_ = l2_ >> 5, cp_ = l2_ & 31; \
        f32x2 run = {0.f, 0.f}, tot = {0.f, 0.f}; \
        _Pragma("unroll") for (int q = 0; q < 8; ++q) { const f32x2 t_ = *(const LAS f32x2*)(L + OFF_TOT + ((((n) & 1) * 8 + q) * 64 + 2 * cp_) * 4); \
            const float m_ = (q < 2 * wk + tg_) ? 1.0f : 0.f; run += t_ * m_; tot += t_; } \
        run *= 1.44269504f; tot *= 1.44269504f;                                                                \
        ppl = (f32x2){__builtin_amdgcn_exp2f(tot[0]), __builtin_amdgcn_exp2f(tot[1])}; \
        if (wk == 0 && tg_ == 0) *(LAS f32x2*)(L + OFF_PL + (((n) & 1) * 64 + 2 * cp_) * 4) = ppl; \
        prun = run; ppv = (f32x2){__builtin_amdgcn_exp2f(run[0]), __builtin_amdgcn_exp2f(run[1])}; \
        PTOK(0); PTOK(1); } while (0)
#define PREP2(n) do { const int l2_ = fresh_tid() & 63, tg_ = l2_ >> 5, cp_ = l2_ & 31; \
        PTOK(2); PTOK(3); \
        LAS unsigned char* bbt_ = TILE(((n) & 1) ? SL_BBT1 : SL_BBT); LAS unsigned char* vt_ = TILE(((n) & 1) ? SL_VT1 : SL_VT); \
        _Pragma("unroll") for (int x = 0; x < 2; ++x) { const int o16 = toff(2 * cp_ + x, (wk * 16 + tg_ * 8) * 2); \
            *(LAS v4u*)(TILE(SL_ATC) + o16) = (v4u){pk[0][x][0], pk[0][x][1], pk[0][x][2], pk[0][x][3]}; *(LAS v4u*)(TILE(SL_BTC) + o16) = (v4u){pk[1][x][0], pk[1][x][1], pk[1][x][2], pk[1][x][3]}; \
            *(LAS v4u*)(TILE(SL_KTC) + o16) = (v4u){pk[2][x][0], pk[2][x][1], pk[2][x][2], pk[2][x][3]}; *(LAS v4u*)(TILE(SL_RTC) + o16) = (v4u){pk[3][x][0], pk[3][x][1], pk[3][x][2], pk[3][x][3]}; \
            *(LAS v4u*)(bbt_ + o16) = (v4u){pk[4][x][0], pk[4][x][1], pk[4][x][2], pk[4][x][3]}; *(LAS v4u*)(TILE(SL_KBT) + o16) = (v4u){pk[5][x][0], pk[5][x][1], pk[5][x][2], pk[5][x][3]}; \
            *(LAS v4u*)(vt_ + o16) = (v4u){vt[x][0], vt[x][1], vt[x][2], vt[x][3]}; } \
    } while (0)
#if TP_SEL >= 0
    unsigned long long tp_acc = 0, tp_last = __builtin_amdgcn_s_memtime();
#endif
    f32x4 accS[4];
#pragma unroll
    for (int q = 0; q < 4; ++q) accS[q] = (f32x4){0.f, 0.f, 0.f, 0.f};
    for (int u = tid; u < TILE_B / 16; u += NTHREADS) ((LAS v4u*)TILE(SL_SB))[u] = (v4u){0u, 0u, 0u, 0u};
    if (tid == 0) *(LAS unsigned*)(L + OFF_CNT) = 0u;
    if (w >= 4) { RAW_LOAD(0, 0); RAW_LOAD(0, 4); }
    __syncthreads();
    if (w >= 4) { DSUM(0); PREP1(0); PREP2(0); }
#pragma unroll 1
    for (int c = 0; c < SEQ / 64; ++c) {
        LAS unsigned char* BBTc = TILE((c & 1) ? SL_BBT1 : SL_BBT); LAS unsigned char* VTc = TILE((c & 1) ? SL_VT1 : SL_VT);
        TP_MARK(5);
        __syncthreads();
        TP_MARK(0);
        if (w >= 4 && c + 1 < SEQ / 64) { RAW_LOAD(c + 1, 0); RAW_LOAD(c + 1, 4); }
        {   STAGE_LANE();
            const int p = w & 3;
            LAS unsigned char* As = TILE((p == 0 || p == 2) ? SL_BTC : SL_KTC); LAS unsigned char* Bs = TILE(p < 2 ? SL_ATC : SL_RTC);
            LAS unsigned char* Ds = TILE(p == 0 ? SL_XCA : p == 1 ? SL_NKA : p == 2 ? SL_NBRT : SL_NKR);
            const int lim = l15 + (p < 2 ? 0 : 1) - 4 * g4;
#define S1_MASK(dv) do { _Pragma("unroll") for (int e = 0; e < 4; ++e) (dv)[e] = (e < lim) ? (dv)[e] : 0.f; } while (0)
#define S1_EYE(dv) do { _Pragma("unroll") for (int e = 0; e < 4; ++e) (dv)[e] += (e == l15 - 4 * g4) ? 1.0f : 0.f; } while (0)
            if (w < 4) {
                const Fr a0f = ldfT(As, 0, lane), a1f = ldfT(As, 16, lane); Fr bf[4];
#pragma unroll
                for (int j = 0; j < 4; ++j) bf[j] = ldfT(Bs, j * 16, lane);
                f32x4 d0[4], d1[3];
#pragma unroll
                for (int j = 0; j < 4; ++j) { d0[j] = ZERO4; mmf(d0[j], a0f, bf[j]); }
#pragma unroll
                for (int j = 0; j < 3; ++j) { d1[j] = ZERO4; mmf(d1[j], a1f, bf[j + 1]); }
                S1_MASK(d0[0]); S1_MASK(d1[0]);
#pragma unroll
                for (int j = 0; j < 4; ++j) st4(Ds, j * 16 + l15, 4 * g4, d0[j]);
#pragma unroll
                for (int j = 0; j < 3; ++j) st4(Ds, (j + 1) * 16 + l15, 16 + 4 * g4, d1[j]);
                if (p == 0) { S1_EYE(d0[0]); S1_EYE(d1[0]);
#pragma unroll
                    for (int j = 0; j < 4; ++j) st4(TILE(SL_TTA), j * 16 + l15, 4 * g4, d0[j]);
#pragma unroll
                    for (int j = 0; j < 3; ++j) st4(TILE(SL_TTA), (j + 1) * 16 + l15, 16 + 4 * g4, d1[j]); }
            } else {
                const Fr a2f = ldfT(As, 32, lane), a3f = ldfT(As, 48, lane), b2f = ldfT(Bs, 32, lane), b3f = ldfT(Bs, 48, lane);
                f32x4 d22 = ZERO4, d23 = ZERO4, d33 = ZERO4;
                mmf(d22, a2f, b2f); mmf(d23, a2f, b3f); mmf(d33, a3f, b3f);
                S1_MASK(d22); S1_MASK(d33);
                st4(Ds, 32 + l15, 32 + 4 * g4, d22); st4(Ds, 48 + l15, 32 + 4 * g4, d23); st4(Ds, 48 + l15, 48 + 4 * g4, d33);
                if (p < 3) { LAS unsigned char* Zs = p == 0 ? TILE(SL_TTA) : Ds; const f32x4 z = ZERO4;
                    st4(Zs, l15, 16 + 4 * g4, z); st4(Zs, l15, 32 + 4 * g4, z); st4(Zs, l15, 48 + 4 * g4, z); st4(Zs, 16 + l15, 32 + 4 * g4, z); st4(Zs, 16 + l15, 48 + 4 * g4, z); st4(Zs, 32 + l15, 48 + 4 * g4, z); }
                if (p == 0) { const f32x4 z = ZERO4; st4(Ds, l15, 16 + 4 * g4, z); st4(Ds, 32 + l15, 48 + 4 * g4, z);
                    S1_EYE(d22); S1_EYE(d33); st4(TILE(SL_TTA), 32 + l15, 32 + 4 * g4, d22); st4(TILE(SL_TTA), 48 + l15, 32 + 4 * g4, d23); st4(TILE(SL_TTA), 48 + l15, 48 + 4 * g4, d33); }
            }
#undef S1_MASK
#undef S1_EYE
        }
        __syncthreads();
        TP_MARK(1);
        if (w < 2) {
            STAGE_LANE();
            const int d = w, s0 = 2 * d, s1 = 2 * d + 1, kd = 32 * d;
#define CAT(lo, hi) ((bf16x8)__builtin_shufflevector(lo, hi, 0, 1, 2, 3, 4, 5, 6, 7))
#define CV4(v) __builtin_bit_cast(bf16x4, (v2u){pk2((v)[0], (v)[1]), pk2((v)[2], (v)[3])})
#define MM(A, B, C) __builtin_amdgcn_mfma_f32_16x16x32_bf16(A, B, C, 0, 0, 0)
            const bf16x4 z4 = {0, 0, 0, 0};
            bf16x8 AF0 = fragT(TILE(SL_XCA), s0 * 16, kd, lane), AF1 = fragT(TILE(SL_XCA), s1 * 16, kd, lane);
            bf16x8 BF0 = frag(TILE(SL_XCA), s0 * 16, kd, lane), BF1 = frag(TILE(SL_XCA), s1 * 16, kd, lane);
            f32x4 t00 = ld4(TILE(SL_TTA), s0 * 16 + l15, s0 * 16 + 4 * g4), t01 = ld4(TILE(SL_TTA), s1 * 16 + l15, s0 * 16 + 4 * g4), t11 = ld4(TILE(SL_TTA), s1 * 16 + l15, s1 * 16 + 4 * g4);
            f32x4 l02, l03, l12, l13;
            if (w == 0) {
                l02 = ld4(TILE(SL_TTA), 32 + l15, 4 * g4); l03 = ld4(TILE(SL_TTA), 48 + l15, 4 * g4); l12 = ld4(TILE(SL_TTA), 32 + l15, 16 + 4 * g4); l13 = ld4(TILE(SL_TTA), 48 + l15, 16 + 4 * g4);
                const bf16x8 C2 = frag(TILE(SL_TTA), 32, 0, lane), C3 = frag(TILE(SL_TTA), 48, 0, lane);
                l02 = MM(AF0, C2, l02); l03 = MM(AF0, C3, l03); l12 = MM(AF1, C2, l12); l13 = MM(AF1, C3, l13);
            }
#pragma unroll
            for (int r = 0; r <= 4; ++r) {
                if (r >= 1) {
                    const bf16x8 BT0 = CAT(CV4(t00), z4), BT1 = CAT(CV4(t01), CV4(t11));
                    if (w == 0) { const bf16x8 BL2 = CAT(CV4(l02), CV4(l12)), BL3 = CAT(CV4(l03), CV4(l13));
                        l02 = MM(AF0, BL2, l02); l03 = MM(AF0, BL3, l03); l12 = MM(AF1, BL2, l12); l13 = MM(AF1, BL3, l13); }
                    t00 = MM(AF0, BT0, t00); t01 = MM(AF0, BT1, t01); t11 = MM(AF1, BT1, t11);
                }
                if (r < 4) {
                    const f32x4 x00 = MM(AF0, BF0, ZERO4), x01 = MM(AF0, BF1, ZERO4), x11 = MM(AF1, BF1, ZERO4);
                    const f32x4 y00 = MM(BF0, AF0, ZERO4), y10 = MM(BF1, AF0, ZERO4), y11 = MM(BF1, AF1, ZERO4);
                    BF0 = CAT(CV4(x00), z4); BF1 = CAT(CV4(x01), CV4(x11));
                    AF0 = CAT(CV4(y00), CV4(y10)); AF1 = CAT(z4, CV4(y11));
                }
            }
            st4(TILE(SL_TTA), s0 * 16 + l15, s0 * 16 + 4 * g4, t00); st4(TILE(SL_TTA), s1 * 16 + l15, s0 * 16 + 4 * g4, t01); st4(TILE(SL_TTA), s1 * 16 + l15, s1 * 16 + 4 * g4, t11);
            if (w == 0) { st4(TILE(SL_TTA), 32 + l15, 4 * g4, l02); st4(TILE(SL_TTA), 48 + l15, 4 * g4, l03); st4(TILE(SL_TTA), 32 + l15, 16 + 4 * g4, l12); st4(TILE(SL_TTA), 48 + l15, 16 + 4 * g4, l13); }
#undef CAT
#undef CV4
#undef MM
        }
        else if (w >= 4 && c + 1 < SEQ / 64) { DSUM(c + 1); PREP1(c + 1); }
        __syncthreads();
        if (w < 2) {
            STAGE_LANE();
            const bf16x8 A = fragT(TILE(SL_TTA), w * 16, 32, lane), B2 = frag(TILE(SL_TTA), 32, 32, lane), B3 = frag(TILE(SL_TTA), 48, 32, lane);
            const f32x4 u2 = __builtin_amdgcn_mfma_f32_16x16x32_bf16(A, B2, ZERO4, 0, 0, 0), u3 = __builtin_amdgcn_mfma_f32_16x16x32_bf16(A, B3, ZERO4, 0, 0, 0);
            st4(TILE(SL_TTA), 32 + l15, w * 16 + 4 * g4, u2); st4(TILE(SL_TTA), 48 + l15, w * 16 + 4 * g4, u3);
        }
        __syncthreads();
        TP_MARK(2);
        {   STAGE_LANE();
            const Fr aATC = ldf(TILE(SL_ATC), ta * 16, lane), aTT = ldf(TILE(SL_TTA), ta * 16, lane); Fr bTT[2], bNKA[2];
#pragma unroll
            for (int q = 0; q < 2; ++q) { bTT[q] = ldf(TILE(SL_TTA), (tb0 + q) * 16, lane); bNKA[q] = ldfT(TILE(SL_NKA), (tb0 + q) * 16, lane); }
            f32x4 e1[2], e3[2];
#pragma unroll
            for (int q = 0; q < 2; ++q) { e1[q] = ZERO4; e3[q] = ZERO4;
                mmf(e1[q], aATC, bTT[q]);
                mmf(e3[q], aTT, bNKA[q]); }
#pragma unroll
            for (int q = 0; q < 2; ++q) { const int bcol = (tb0 + q) * 16 + l15; st4(TILE(SL_APT), bcol, a0, e1[q]); st4(TILE(SL_G), bcol, a0, e3[q]); }
        }
        __syncthreads();
        TP_MARK(3);
        {   STAGE_LANE();
            const Fr aNB = ldf(TILE(SL_NBRT), ta * 16, lane), aG = ldf(TILE(SL_G), ta * 16, lane); Fr bAP[2], bNB[2], bBB[2]; f32x4 rp[2], ps[2], accH[2];
#pragma unroll
            for (int q = 0; q < 2; ++q) { const int bcol = (tb0 + q) * 16 + l15; bAP[q] = ldfT(TILE(SL_APT), (tb0 + q) * 16, lane); bNB[q] = ldf(TILE(SL_NBRT), (tb0 + q) * 16, lane); bBB[q] = ldf(BBTc, (tb0 + q) * 16, lane);
                rp[q] = ld4(TILE(SL_RTC), bcol, a0); ps[q] = ld4(TILE(SL_KBT), bcol, a0); accH[q] = ld4(TILE(SL_NKR), bcol, a0); if (ta > tb0 + q) accH[q] = ZERO4; }
#pragma unroll
            for (int q = 0; q < 2; ++q) { mmf(rp[q], aNB, bAP[q]);
                mmf(accH[q], aG, bNB[q]);
                mmf(ps[q], aG, bBB[q]); }
#pragma unroll
            for (int q = 0; q < 2; ++q) { const int bcol = (tb0 + q) * 16 + l15;
                st4(TILE(SL_RP), bcol, a0, rp[q]); st4(TILE(SL_HT), bcol, a0, accH[q]); st4(TILE(SL_PSIT), bcol, a0, ps[q]); }
        }
        __syncthreads();
        TP_MARK(4);
        if (w < 4) {
            STAGE_LANE();
            const int vrow = w * 16 + l15;
            const Fr fS = ldf(TILE(SL_SB), w * 16, lane), fV = ldf(VTc, w * 16, lane);
            f32x4 wv[4], yv[4];
            {
                Fr fAPT[4];
#pragma unroll
                for (int q = 0; q < 4; ++q) fAPT[q] = ldf(TILE(SL_APT), q * 16, lane);
#pragma unroll
                for (int q = 0; q < 4; ++q) { wv[q] = ZERO4; mmf(wv[q], fAPT[q], fS); }
#pragma unroll
                for (int q = 0; q < 4; ++q) st4(TILE(SL_WB), vrow, q * 16 + 4 * g4, wv[q]);
            }
            {
                Fr fRPT[4], fHT[4];
#pragma unroll
                for (int q = 0; q < 4; ++q) { fRPT[q] = ldfT(TILE(SL_RP), q * 16, lane); fHT[q] = ldf(TILE(SL_HT), q * 16, lane); }
#pragma unroll
                for (int q = 0; q < 4; ++q) { yv[q] = ZERO4; mmf(yv[q], fS, fRPT[q]); mmf(yv[q], fV, fHT[q]); }
#pragma unroll
                for (int q = 0; q < 4; ++q) { const int s_ = c * 64 + q * 16 + l15; const int t_ = dir ? (SEQ - 1 - s_) : s_;
                    v2u o; o.x = pg8::cvt_pk_bf16(yv[q][0], yv[q][1]); o.y = pg8::cvt_pk_bf16(yv[q][2], yv[q][3]);
                    *(v2u*)(YS + ((size_t)b * SEQ + t_) * 1024 + hh * 64 + w * 16 + 4 * g4) = o; }
            }
            {
                Fr fPS[4];
#pragma unroll
                for (int q = 0; q < 4; ++q) fPS[q] = ldf(TILE(SL_PSIT), q * 16, lane);
#pragma unroll
                for (int q = 0; q < 4; ++q) { const f32x4 pl = *(const LAS f32x4*)(L + OFF_PL + ((c & 1) * 64 + q * 16 + 4 * g4) * 4); accS[q] = accS[q] * pl; mmf(accS[q], fPS[q], fV); }
                LWAIT();
                const Fr fW = ldf(TILE(SL_WB), w * 16, lane); Fr fBB[4];
#pragma unroll
                for (int q = 0; q < 4; ++q) fBB[q] = ldf(BBTc, q * 16, lane);
#pragma unroll
                for (int q = 0; q < 4; ++q) { mmf(accS[q], fBB[q], fW); st4(TILE(SL_SB), vrow, q * 16 + 4 * g4, accS[q]); }
            }
        } else if (c + 1 < SEQ / 64) { PREP2(c + 1); }
    }
#if TP_SEL >= 0
    if (bx == 0 && w == TP_WAVE && lane0 == 0) *(unsigned long long*)(ws + 760 * 1024) = tp_acc;
#endif
#undef RAW_LOAD
#undef STAGE_LANE
#undef PREP1
#undef PREP2
#undef PTOK
#undef DSUM
}
#undef TILE
#undef LWAIT
}
__global__ void __launch_bounds__(NTHREADS, 2) mega_fwd(Args a) {
    extern __shared__ __attribute__((aligned(16))) unsigned char lds[];
    cg::grid_group grid = cg::this_grid();
    const int G = gridDim.x, bx = blockIdx.x;
    const int vcu = (G % 8 == 0) ? (bx % 8) * (G / 8) + bx / 8 : bx;
    const int NGW = G * NWAVES;
#define WIDS() const int tid = fresh_tid(), lane = tid & 63, wave = __builtin_amdgcn_readfirstlane(tid >> 6), gw = vcu * NWAVES + wave; (void)lane; (void)gw
    unsigned char* ws = a.ws;
    LAS unsigned char* lds3 = (LAS unsigned char*)lds;
    const int lo = a.ph_lo, hi = a.ph_hi;
#ifndef ONLY
#define ONLY -1
#endif
#define IN(k) (lo <= (k) && (k) < hi && (ONLY < 0 || ONLY == (k)))
#ifndef PROBE_S
#define PROBE_S 0
#endif
#ifndef PROBE_A
#define PROBE_A 0
#endif
#ifndef DUPMASK
#define DUPMASK 0
#endif
#ifndef USE_CG
#define USE_CG 0
#endif
#define GRIDBAR(k) do { if (USE_CG || a.ph_hi > 1000) grid.sync(); else xcd_barrier(bar); } while (0)
#define SEAM(k) do { if (IN(k) && IN((k) + 1)) GRIDBAR(k); } while (0)
#define PH_BEGIN(k) if (IN(k)) for (int rep_ = 0; rep_ <= ((DUPMASK >> (k)) & 1); ++rep_) { if (rep_) GRIDBAR(1);
#define PH_END(k) } SEAM(k);
    for (int u = fresh_tid(); u < 64; u += NTHREADS) ((LAS unsigned*)(lds3 + MISC_OFF))[u] = 0u;
    __syncthreads();
    XcdBarrier bar = xcd_barrier_post((unsigned*)(ws + WS_BAR), (volatile LAS unsigned*)(lds3 + MISC_OFF) + 8);

    PH_BEGIN(0) { WIDS(); p0_prologue(a, lds3, gw, NGW, wave, lane); } PH_END(0)
    PH_BEGIN(1) {
        pg8::Gemm g{(const bf16_t*)(ws + WS_HN), (const bf16_t*)(ws + WS_WINT), DM, DM, DM}; pg8::StaticOrder S; S.init(M, IN_PAD, G, bx);
        pg8::EpiProj E{(bf16_t*)(ws + WS_PDA), (bf16_t*)((unsigned char*)a.out + DO_PRW), (bf16_t*)(ws + WS_GATES)};
        pg8::gemm_phase<pg8::EpiProj, pg8::StaticOrder, true, true>(lds3, g, S, E);
        if (G == 256 && bx >= 128) { WIDS(); expert_convert_down(a, lds3, (bx - 128) * NWAVES + wave, 128 * NWAVES, wave, lane); }
        else if (G != 256) { WIDS(); expert_convert_down(a, lds3, gw, NGW, wave, lane); }
    } PH_END(1)
    PH_BEGIN(2) { WIDS(); p2_prep(a, gw, NGW, lane); } PH_END(2)
    PH_BEGIN(3) {
        const bf16_t* LIN = (const bf16_t*)((unsigned char*)a.out + DO_LIN);
        { pg8::Gemm g{LIN, (const bf16_t*)(ws + WS_BTL1), 512, 256, 256}; pg8::StaticOrder S; S.init(M, 4096, G, bx);
          pg8::EpiLora<0> E{(bf16_t*)(ws + WS_LORA), (const float*)(ws + WS_BIAS4)};
          pg8::gemm_phase<pg8::EpiLora<0>, pg8::StaticOrder, true, true>(lds3, g, S, E); }
        { pg8::Gemm g{LIN + 256, (const bf16_t*)(ws + WS_BTL2), 512, 256, 256}; pg8::StaticOrder S; S.init(M, 1024, G, bx);
          pg8::EpiLora<1> E{(bf16_t*)(ws + WS_LORA), nullptr};
          pg8::gemm_phase<pg8::EpiLora<1>, pg8::StaticOrder, true, true>(lds3, g, S, E); }
    } PH_END(3)
    PH_BEGIN(4) { WIDS();
        const float* sm = (const float*)(ws + WS_SMALL); const float d1 = wave_sum(sm[SM_LQ1 + lane] * sm[SM_LK1 + lane]), d2 = wave_sum(sm[SM_LQ2 + lane] * sm[SM_LK2 + lane]);
        const float lam = __int_as_float(__builtin_amdgcn_readfirstlane(__float_as_int(__expf(d1) - __expf(d2) + LAM_INIT)));
        const bf16_t* PDA = (const bf16_t*)(ws + WS_PDA); bf16_t* YA = (bf16_t*)((unsigned char*)a.out + DO_YAB);
        if (G == 256) {
            int u0, nu;
            if (bx < 128) {
#if PROBE_S
                scan::scan_phase(a, lds); __syncthreads();
#endif
                scan::scan_phase(a, lds); __syncthreads(); const int i = (bx & 7) * 16 + (bx >> 3); u0 = 768 + 2 * i; nu = 2; }
            else { const int k = bx - 128, i = (k & 7) * 16 + (k >> 3); u0 = 6 * i; nu = 6; }
            attn::Stage stg[2];
            { const int bh = u0 >> 5, b = bh >> 3, h = bh & 7; const size_t row0 = (size_t)b * SEQ; attn::attn_prime(PDA + row0 * 3072 + 1024 + h * 128, PDA + row0 * 3072 + 2048 + h * 128, stg); }
            for (int q = (PROBE_A && bx >= 128) ? -1 : 0; q < nu; ++q) { const int u = u0 + (q < 0 ? 0 : q); const int bh = u >> 5, qb = u & 31, b = bh >> 3, h = bh & 7;
                const size_t row0 = (size_t)b * SEQ;
                const int un = (q + 1 < nu) ? u0 + q + 1 : u; const int bhn = un >> 5, bn = bhn >> 3, hn_ = bhn & 7; const size_t rown = (size_t)bn * SEQ;
                attn::attn_unit(PDA + (row0 + qb * 128) * 3072 + h * 128, PDA + row0 * 3072 + 1024 + h * 128, PDA + row0 * 3072 + 2048 + h * 128,
                                YA + (row0 + qb * 128) * 2048 + h * 128, lam, sm + SM_SUBLN, SEQ, (char*)lds, PDA + rown * 3072 + 1024 + hn_ * 128, PDA + rown * 3072 + 2048 + hn_ * 128, stg); }
            { __syncthreads(); const int t2 = fresh_tid(); const bool sb = bx < 128;
              expert_convert_gu(a, lds3, (sb ? bx : bx - 128) * NWAVES + (t2 >> 6), 128 * NWAVES, t2 >> 6, t2 & 63, sb ? 0 : N_EARLY_S, sb ? N_EARLY_S : N_EARLY_EXPERTS); }
        } else {
        const int upb = 1024 / G;
        for (int i = 0; i < upb; ++i) { const int u = vcu * upb + i; const int bh = u >> 5, qb = u & 31, b = bh >> 3, h = bh & 7;
            const size_t row0 = (size_t)b * SEQ;
            attn::Stage stg[2]; attn::attn_prime(PDA + row0 * 3072 + 1024 + h * 128, PDA + row0 * 3072 + 2048 + h * 128, stg);
            attn::attn_unit(PDA + (row0 + qb * 128) * 3072 + h * 128, PDA + row0 * 3072 + 1024 + h * 128, PDA + row0 * 3072 + 2048 + h * 128,
                            YA + (row0 + qb * 128) * 2048 + h * 128, lam, sm + SM_SUBLN, SEQ, (char*)lds, PDA + row0 * 3072 + 1024 + h * 128, PDA + row0 * 3072 + 2048 + h * 128, stg); }
        }
    } PH_END(4)
    if (G != 256) { PH_BEGIN(5) { scan::scan_phase(a, lds); } PH_END(5) }
    PH_BEGIN(6) { WIDS(); p6_rwpost(a, gw, NGW, lane); } PH_END(6)
    PH_BEGIN(7) {
        bf16_t* MG = (bf16_t*)(ws + WS_MERGED); const bf16_t* GT = (const bf16_t*)(ws + WS_GATES);
        { pg8::Gemm g{(const bf16_t*)((unsigned char*)a.out + DO_YAB), (const bf16_t*)(ws + WS_WAT), DM, DM, DM}; pg8::StaticOrder S; S.init(M, DM, G, bx);
          pg8::EpiMergeF E{MG, GT}; pg8::gemm_phase<pg8::EpiMergeF, pg8::StaticOrder, true, true>(lds3, g, S, E); }
    } PH_END(7)
    PH_BEGIN(8) {
        pg8::Gemm g{(const bf16_t*)(ws + WS_MERGED), (const bf16_t*)(ws + WS_WOT), DM, DM, DM}; pg8::StaticOrder S; S.init(M, DM, G, bx);
        pg8::EpiOut E{a.in[I_X], a.out, (float*)(ws + WS_SSP)};
        pg8::gemm_phase<pg8::EpiOut, pg8::StaticOrder, true, true>(lds3, g, S, E);
    } PH_END(8)
    PH_BEGIN(9) { WIDS(); p9_router(a, lds3, gw, NGW, wave, lane); } PH_END(9)
    PH_BEGIN(10) { p10_topk(a, lds); } PH_END(10)
    if (G != 256) { PH_BEGIN(11) { WIDS(); p11_gather(a, gw, NGW, lane); } PH_END(11) }
    PH_BEGIN(12) {
        pg8::EpiMoeUp E{(bf16_t*)(ws + WS_HID)};
        if (G == 256) {
            pg8::Gemm g{(const bf16_t*)(ws + WS_HN2), (const bf16_t*)ws, DM, DM, DM}; pg8::ExpertGatherOrder S{G, bx, (const int*)(ws + WS_SELTOK)};
            pg8::gemm_phase_g<pg8::EpiMoeUp, pg8::ExpertGatherOrder, true, true>(lds3, g, S, E);
        } else {
            pg8::Gemm g{(const bf16_t*)(ws + WS_XE), (const bf16_t*)(ws + WS_W1T), DM, DM, DM}; pg8::ExpertOrder S{G, bx};
            pg8::gemm_phase<pg8::EpiMoeUp, pg8::ExpertOrder, true, true>(lds3, g, S, E);
        }
    } PH_END(12)
    PH_BEGIN(13) {
        pg8::Gemm g{(const bf16_t*)(ws + WS_HID), (const bf16_t*)(ws + WS_WDT), FF, FF, FF}; pg8::ExpertOrder S{G, bx};
        pg8::EpiMoeDown E{(bf16_t*)(ws + WS_XE), (const float*)(ws + WS_SELGATE)};
        pg8::gemm_phase<pg8::EpiMoeDown, pg8::ExpertOrder, true, true>(lds3, g, S, E);
    } PH_END(13)
    PH_BEGIN(14) { WIDS(); p14_combine(a, lds, wave, lane); } }
#if TP_SEL >= 0
    if (a.ph_hi >= 15 && blockIdx.x == 0 && fresh_tid() == 0) { const unsigned long long d_ = 16ull * *(volatile unsigned long long*)(ws + 760 * 1024), t0_ = __builtin_amdgcn_s_memtime(); while (__builtin_amdgcn_s_memtime() - t0_ < d_) __builtin_amdgcn_s_sleep(8); }
#endif
#undef IN
#undef SEAM
}

constexpr int NPHASES = 15;
#ifndef MK_SPLIT
#define MK_SPLIT 0
#endif
extern "C" void kernel_launch(void* const* d_in, const int* in_sizes, int n_in, void* d_out, int out_size, void* d_ws, size_t ws_size, hipStream_t stream) {
    static int grid = 0;
    if (grid == 0) {
        if (n_in != 33 || in_sizes[0] != M * DM || out_size != M * DM || ws_size < WS_NEED) {
            fprintf(stderr, "kernel_launch: unexpected shapes: n_in %d in0 %d out %d ws %zu (need %zu)\n", n_in, n_in > 0 ? in_sizes[0] : -1, out_size, ws_size, (size_t)WS_NEED); grid = -1; return; }
        int dev = 0, cus = 0, per_cu = 0;
        if (hipGetDevice(&dev) != hipSuccess || hipDeviceGetAttribute(&cus, hipDeviceAttributeMultiprocessorCount, dev) != hipSuccess) { grid = -1; return; }
        if (hipFuncSetAttribute((const void*)mega_fwd, hipFuncAttributeMaxDynamicSharedMemorySize, LDS_BYTES) != hipSuccess) { fprintf(stderr, "kernel_launch: hipFuncSetAttribute failed\n"); grid = -1; return; }
        if (hipOccupancyMaxActiveBlocksPerMultiprocessor(&per_cu, (const void*)mega_fwd, NTHREADS, LDS_BYTES) != hipSuccess || per_cu < 1) { fprintf(stderr, "kernel_launch: occupancy query says %d\n", per_cu); (void)hipGetLastError(); per_cu = 1; }
        grid = cus;
        if (grid != 256) { fprintf(stderr, "kernel_launch: this kernel is built for a 256-CU MI355X (got %d CUs); nothing launched\n", grid); grid = -1; return; }
    }
    if (grid < 0) return;
    if (hipMemsetAsync((char*)d_ws + WS_BAR, 0, 16384, stream) != hipSuccess) { fprintf(stderr, "kernel_launch: memset failed\n"); return; }
    Args a{};
    for (int i = 0; i < 33; ++i) a.in[i] = (const float*)d_in[i];
    a.out = (float*)d_out; a.ws = (unsigned char*)d_ws;
#if MK_SPLIT
    for (int p = 0; p < NPHASES; ++p) { a.ph_lo = p; a.ph_hi = p + 1; void* args[] = {&a};
        hipError_t e = hipLaunchCooperativeKernel((const void*)mega_fwd, dim3(grid), dim3(NTHREADS), args, LDS_BYTES, stream);
        if (e != hipSuccess) { fprintf(stderr, "kernel_launch: launch of phase %d failed: %s\n", p, hipGetErrorString(e)); return; } }
#else
    a.ph_lo = 0; a.ph_hi = NPHASES; void* args[] = {&a};
    hipError_t e = hipLaunchCooperativeKernel((const void*)mega_fwd, dim3(grid), dim3(NTHREADS), args, LDS_BYTES, stream);
    if (e != hipSuccess) fprintf(stderr, "kernel_launch: cooperative launch failed: %s (grid %d)\n", hipGetErrorString(e), grid);
#endif
}
```

```cpp
#include <hip/hip_runtime.h>
#include <hip/hip_cooperative_groups.h>
#include <cstdio>
#include <cstdint>
namespace cg = cooperative_groups;

constexpr int NB = 4, SEQ = 4096, M = NB * SEQ, DM = 2048;
constexpr int DA_COLS = 3072, RW_COLS = 3488, RW_PAD = 3584, GATE_COLS = 4096, IN_COLS = 10656, IN_PAD = 10752;
constexpr int NE = 16, FF = 1024, CAP = 512, NSLOT = NB * NE * CAP;
constexpr float RMS_EPS = 1e-6f, GN_EPS = 64e-5f, LAM_INIT = 0.2f;
constexpr int NWAVES = 8, NTHREADS = 512;

constexpr size_t MiB = 1u << 20;
constexpr size_t WS_SSP = 5 * MiB;
constexpr size_t WS_SELTOK = 128 * 1024;
constexpr size_t WS_SELGATE = 256 * 1024;
constexpr size_t WS_BIAS4 = 512 * 1024;
constexpr size_t WS_SMALL = 576 * 1024;
constexpr int SM_QNG = 0, SM_KNG = 64, SM_LQ1 = 128, SM_LK1 = 192, SM_LQ2 = 256, SM_LK2 = 320, SM_SUBLN = 384, SM_MU = 512, SM_KK = 4096, SM_KA = 5120, SM_RK = 6144,
              SM_LNW = 7168, SM_LNB = 8192, SM_FNG = 9216, SM_WR = 11264, SM_END = 44032;
constexpr size_t WS_BAR = 768 * 1024;
constexpr size_t WS_INRM = 1 * MiB;
constexpr size_t WS_AFF = 1 * MiB;
constexpr size_t WS_ROPE = 7 * MiB;
constexpr size_t WS_BTL1 = 2 * MiB;
constexpr size_t WS_BTL2 = 4 * MiB;
constexpr size_t WS_WAT = 8 * MiB, WS_WBT = 12 * MiB, WS_WOT = 16 * MiB;
constexpr size_t WS_HN = 24 * MiB;
constexpr size_t WS_RKV = 24 * MiB;
constexpr size_t WS_WINT = 88 * MiB;
constexpr size_t WS_PDA = 130 * MiB;
constexpr size_t WS_MERGED = 130 * MiB;
constexpr size_t WS_GATES = 226 * MiB;
constexpr size_t WS_LORA = 354 * MiB;
constexpr size_t WS_END1 = 546 * MiB;
constexpr size_t WS_W1T = 24 * MiB;
__host__ __device__ __forceinline__ size_t w1t_base(int e) { return e < 4 ? (514 + 8 * (size_t)e) * MiB : e < 6 ? (610 + 8 * (size_t)(e - 4)) * MiB : e == 6 ? 120 * MiB : WS_W1T + 8 * (size_t)(e - 7) * MiB; }
constexpr int N_EARLY_EXPERTS = 7, N_EARLY_S = 5, N_P7_END = 12;
constexpr size_t WS_WDT = 546 * MiB;
constexpr size_t WS_XE = 216 * MiB;
constexpr size_t WS_HN2 = 216 * MiB;
constexpr size_t WS_HID = 344 * MiB;
constexpr size_t WS_NEED = 626 * MiB;
constexpr size_t DO_PRW = 0, DO_LIN = 112 * MiB, DO_YSF = 0, DO_YSB = 32 * MiB, DO_YAB = 64 * MiB;

constexpr int MISC_OFF = 155648;
constexpr int LDS_BYTES = 159744;

#define LAS __attribute__((address_space(3)))
typedef unsigned short bf16_t;
typedef unsigned v4u __attribute__((ext_vector_type(4)));
typedef unsigned v2u __attribute__((ext_vector_type(2)));

__device__ __forceinline__ int fresh_tid() { int t = threadIdx.x; asm volatile("" : "+v"(t)); return t; }
__device__ __forceinline__ float bf2f(unsigned short b) { return __builtin_bit_cast(float, (unsigned)b << 16); }
__device__ __forceinline__ float bflo(unsigned w) { return __builtin_bit_cast(float, w << 16); }
__device__ __forceinline__ float bfhi(unsigned w) { return __builtin_bit_cast(float, w & 0xffff0000u); }
__device__ __forceinline__ unsigned f2bf(float f) { unsigned u = __builtin_bit_cast(unsigned, f); return (u + 0x7fffu + ((u >> 16) & 1u)) >> 16; }
typedef float f32x2_t __attribute__((ext_vector_type(2))); typedef __bf16 bf16x2_t __attribute__((ext_vector_type(2)));
__device__ __forceinline__ unsigned pk2(float lo, float hi) { f32x2_t v = {lo, hi}; bf16x2_t b = __builtin_convertvector(v, bf16x2_t); return __builtin_bit_cast(unsigned, b); }
__device__ __forceinline__ float sigmoidf_(float x) { return __builtin_amdgcn_rcpf(1.0f + __expf(-x)); }
__device__ __forceinline__ float wave_sum(float v) {
#pragma unroll
    for (int o = 1; o < 64; o <<= 1) v += __shfl_xor(v, o);
    return v;
}
__device__ __forceinline__ float sum8(float v) { v += __shfl_xor(v, 1); v += __shfl_xor(v, 2); v += __shfl_xor(v, 4); return v; }
__device__ __forceinline__ void unpack8(const v4u& w, float (&f)[8]) {
    f[0] = bflo(w.x); f[1] = bfhi(w.x); f[2] = bflo(w.y); f[3] = bfhi(w.y); f[4] = bflo(w.z); f[5] = bfhi(w.z); f[6] = bflo(w.w); f[7] = bfhi(w.w);
}
__device__ __forceinline__ v4u pack8(const float (&f)[8]) { v4u w; w.x = pk2(f[0], f[1]); w.y = pk2(f[2], f[3]); w.z = pk2(f[4], f[5]); w.w = pk2(f[6], f[7]); return w; }

#define XB_TMO      128
#define XB_XCNT(j)  (256  + 64 * (j))
#define XB_XSUB(j)  (1280 + 64 * (j))
#define XB_XGEN(j)  (2304 + 64 * (j))
#define XB_TOP      3328
#define XB_TOPGEN   3392
#define XCD_BAR_WORDS 3456
#define XB_SPIN_CAP (1u << 18)

__device__ __forceinline__ unsigned xb_ld(unsigned* p)              { return __hip_atomic_load(p, __ATOMIC_RELAXED, __HIP_MEMORY_SCOPE_AGENT); }
__device__ __forceinline__ unsigned xb_add(unsigned* p, unsigned v) { return __hip_atomic_fetch_add(p, v, __ATOMIC_RELAXED, __HIP_MEMORY_SCOPE_AGENT); }
__device__ __forceinline__ unsigned xb_xcc_id() { return (unsigned)__builtin_amdgcn_s_getreg((3 << 11) | 20) & 0xFu; }
#define XB_SPIN(cond, bar) do { unsigned _sp = 0; while (cond) { __builtin_amdgcn_s_sleep(1); \
    if ((++_sp & 255u) == 0u) { if (xb_ld(&(bar)[XB_TMO])) break; if (_sp > XB_SPIN_CAP) { atomicAdd(&(bar)[XB_TMO], 1u); break; } } } } while (0)

struct XcdBarrier {
    unsigned* bar; unsigned x;
    volatile LAS unsigned* st;
};

__device__ __forceinline__ XcdBarrier xcd_barrier_post(unsigned* bar, volatile LAS unsigned* st) {
    XcdBarrier b; b.bar = bar; b.x = xb_xcc_id(); b.st = st;
    if (threadIdx.x == 0) (void)xb_add(&bar[XB_XCNT(b.x)], 1u);
    return b;
}
__device__ __forceinline__ void xcd_barrier_complete(unsigned* bar, unsigned x, unsigned& nloc, unsigned& nx) {
    const unsigned G = gridDim.x * gridDim.y * gridDim.z;
    unsigned sum, cnt, mine, sp = 0u;
    for (;;) {
        sum = 0u; cnt = 0u; mine = 0u;
#pragma unroll
        for (unsigned j = 0; j < 16; ++j) { const unsigned c = xb_ld(&bar[XB_XCNT(j)]); sum += c; cnt += (c > 0u) ? 1u : 0u; mine = (j == x) ? c : mine; }
        if (sum == G) break;
        __builtin_amdgcn_s_sleep(1);
        if ((++sp & 255u) == 0u) { if (xb_ld(&bar[XB_TMO])) break; if (sp > XB_SPIN_CAP) { atomicAdd(&bar[XB_TMO], 1u); break; } }
    }
    nloc = mine > 0u ? mine : 1u; nx = cnt > 0u ? cnt : 1u;
}

__device__ __forceinline__ void xcd_barrier(const XcdBarrier& b) {
    asm volatile("s_waitcnt vmcnt(0)" ::: "memory");
    __syncthreads();
    if (threadIdx.x == 0) {
        unsigned* bar = b.bar;
        __builtin_amdgcn_s_waitcnt(0);
        unsigned nloc = b.st[0], nx = b.st[1];
        if (nloc == 0u) { xcd_barrier_complete(bar, b.x, nloc, nx); b.st[0] = nloc; b.st[1] = nx; }
        const unsigned old = xb_add(&bar[XB_XSUB(b.x)], 1u);
        const unsigned gen = old / nloc;
        if (old + 1u == (gen + 1u) * nloc) {
            __builtin_amdgcn_fence(__ATOMIC_RELEASE, "agent");
            asm volatile("s_waitcnt vmcnt(0)" ::: "memory");
            const unsigned og = xb_add(&bar[XB_TOP], 1u);
            const unsigned tg = og / nx;
            if (og + 1u == (tg + 1u) * nx) xb_add(&bar[XB_TOPGEN], 1u);
            else XB_SPIN(xb_ld(&bar[XB_TOPGEN]) == tg, bar);
            __builtin_amdgcn_fence(__ATOMIC_ACQUIRE, "agent");
            xb_add(&bar[XB_XGEN(b.x)], 1u);
            asm volatile("s_waitcnt vmcnt(0)" ::: "memory");
        } else {
            XB_SPIN(xb_ld(&bar[XB_XGEN(b.x)]) == gen, bar);
            __builtin_amdgcn_fence(__ATOMIC_ACQUIRE, "agent");
            asm volatile("s_waitcnt vmcnt(0)" ::: "memory");
        }
    }
    __syncthreads();
}
namespace pg8 {
#define PG8_LAS __attribute__((address_space(3)))
typedef unsigned short bf16_t;
typedef short bf16x8 __attribute__((ext_vector_type(8)));
typedef float f32x4 __attribute__((ext_vector_type(4)));
typedef unsigned u32x4 __attribute__((ext_vector_type(4)));
constexpr int BM = 256, BK = 64, HALF = 128, HTB = HALF * BK * 2  , STAGE_BYTES = 8 * HTB, NXCD = 8, WGM = 4;

__host__ __device__ __forceinline__ int lds_byte(int r, int c) { const int st = (r >> 4) * 2 + (c >> 5), rr = r & 15, cc = c & 31, ob = rr * 64 + cc * 2; return st * 1024 + (ob ^ (((ob >> 9) & 1) << 5)); }
__host__ __device__ __forceinline__ void stage_rc(int b, int& R, int& C) { const int st = b / 1024, sb = b % 1024, swz = sb ^ (((sb >> 9) & 1) << 5); R = (st >> 1) * 16 + swz / 64; C = (st & 1) * 32 + (swz % 64) / 2; }
__host__ __device__ __forceinline__ int perm32(int rho) { const int n = rho >> 4, i = rho & 15; return 8 * (i >> 2) + 4 * n + (i & 3); }

struct Unit { int pm, pn; };
struct Gemm { const bf16_t* A; const bf16_t* Bt; int lda, ldb, K; };

struct StaticOrder {
    int nM, nN, nwg, G, c;
    __host__ __device__ void init(int M, int N, int G_, int c_) { nM = M / BM; nN = N / BM; nwg = nM * nN; G = G_; c = c_; }
    __host__ __device__ bool next(int i, Unit& u) const {
        const long L = (long)i * G + c; if (L >= nwg) return false;
        int wgid = (int)L; { const int q = nwg / NXCD, r = nwg % NXCD, xcd = wgid % NXCD, off = wgid / NXCD; wgid = (xcd < r ? xcd * (q + 1) : r * (q + 1) + (xcd - r) * q) + off; }
        const int nig = WGM * nN, gid = wgid / nig, fm = gid * WGM, gsz = (nM - fm) < WGM ? (nM - fm) : WGM;
        u.pm = fm + ((wgid % nig) % gsz); u.pn = (wgid % nig) / gsz; return true;
    }
    __device__ __forceinline__ void a_ready(const Unit&) const {}
    __device__ __forceinline__ void done(const Unit&) const {}
};

__device__ __forceinline__ unsigned cvt_pk_bf16(float lo, float hi) { return pk2(lo, hi); }
__device__ __forceinline__ u32x4 pack_bf16x8(const f32x4& v0, const f32x4& v1) { u32x4 w; w.x = cvt_pk_bf16(v0[0], v0[1]); w.y = cvt_pk_bf16(v0[2], v0[3]); w.z = cvt_pk_bf16(v1[0], v1[1]); w.w = cvt_pk_bf16(v1[2], v1[3]); return w; }
__device__ __forceinline__ float sigm(float x) { return __builtin_amdgcn_rcpf(1.0f + __expf(-x)); }
__device__ __forceinline__ f32x4 sigm4(f32x4 v) { return (f32x4){sigm(v[0]), sigm(v[1]), sigm(v[2]), sigm(v[3])}; }
__device__ __forceinline__ void unpk8(const u32x4& w, f32x4& a, f32x4& b) {
    a = (f32x4){__builtin_bit_cast(float, w.x << 16), __builtin_bit_cast(float, w.x & 0xffff0000u), __builtin_bit_cast(float, w.y << 16), __builtin_bit_cast(float, w.y & 0xffff0000u)};
    b = (f32x4){__builtin_bit_cast(float, w.z << 16), __builtin_bit_cast(float, w.z & 0xffff0000u), __builtin_bit_cast(float, w.w << 16), __builtin_bit_cast(float, w.w & 0xffff0000u)};
}

struct EpiProj {
    static constexpr bool PERM = true, AFTER_DRAIN = false, HAS_MID = false, HAS_INIT = false;
    bf16_t* pda; bf16_t* prw; bf16_t* gates;
    __device__ __forceinline__ void operator()(const f32x4 (&acc)[2][2][4][2], const Unit& u, int wr, int wc, int fr, int fq) const {
        const int row0 = u.pm * BM + wr * 64 + fr;
        if (u.pn >= 26) {
            const int col0 = (u.pn - 26) * 128 + wc * 32 + 8 * fq;
#pragma unroll
            for (int ai = 0; ai < 2; ++ai)
#pragma unroll
                for (int m = 0; m < 4; ++m) { bf16_t* rowp = gates + (size_t)(row0 + ai * HALF + m * 16) * 4096 + col0;
                    f32x4 rt[2], gb[2];
#pragma unroll
                    for (int n = 0; n < 2; ++n)
#pragma unroll
                        for (int e = 0; e < 4; ++e) { const float ea = __expf(-acc[ai][0][m][n][e]), eb = __expf(-acc[ai][1][m][n][e]);
                            gb[n][e] = __builtin_amdgcn_rcpf(1.0f + eb); rt[n][e] = (1.0f + eb) * __builtin_amdgcn_rcpf(1.0f + ea); }
                    *(u32x4*)rowp = pack_bf16x8(rt[0], rt[1]); *(u32x4*)(rowp + 2048) = pack_bf16x8(gb[0], gb[1]); }
            return;
        }
        bf16_t* base; int ldc, colt;
        if (u.pn < 12) { base = pda; ldc = 3072; colt = u.pn * 256; }
        else { base = prw; ldc = 3584; colt = (u.pn - 12) * 256; }
        const int col0 = colt + wc * 32 + 8 * fq;
#pragma unroll
        for (int ai = 0; ai < 2; ++ai)
#pragma unroll
            for (int m = 0; m < 4; ++m) { bf16_t* rowp = base + (size_t)(row0 + ai * HALF + m * 16) * ldc + col0;
#pragma unroll
                for (int bj = 0; bj < 2; ++bj) *(u32x4*)(rowp + bj * HALF) = pack_bf16x8(acc[ai][bj][m][0], acc[ai][bj][m][1]); }
    }
};
template <int KIND> struct EpiLora {
    static constexpr bool PERM = true, AFTER_DRAIN = false, HAS_MID = false, HAS_INIT = false;
    bf16_t* out; const float* bias4;
    __device__ __forceinline__ void operator()(const f32x4 (&acc)[2][2][4][2], const Unit& u, int wr, int wc, int fr, int fq) const {
        const int seg = (KIND == 0) ? (u.pn >> 2) : 4, colt = (KIND == 0) ? (u.pn & 3) * 256 : u.pn * 256;
        bf16_t* base = out + (size_t)seg * ((size_t)M * 1024);
        const float* bias = bias4 + (seg & 3) * 1024;
        const int row0 = u.pm * BM + wr * 64 + fr, col0 = colt + wc * 32 + 8 * fq;
        const float sc = (seg < 2) ? -0.60653065971f : 1.0f;
#pragma unroll
        for (int bj = 0; bj < 2; ++bj) {
            f32x4 bv0 = (f32x4){0.f, 0.f, 0.f, 0.f}, bv1 = bv0;
            if (KIND == 0) { bv0 = *(const f32x4*)(bias + col0 + bj * HALF); bv1 = *(const f32x4*)(bias + col0 + bj * HALF + 4); }
#pragma unroll
            for (int ai = 0; ai < 2; ++ai)
#pragma unroll
                for (int m = 0; m < 4; ++m) { bf16_t* rowp = base + (size_t)(row0 + ai * HALF + m * 16) * 1024 + col0;
                    f32x4 v0 = acc[ai][bj][m][0] + bv0, v1 = acc[ai][bj][m][1] + bv1;
                    if (KIND == 0) { v0 = sigm4(v0) * sc; v1 = sigm4(v1) * sc; }
                    *(u32x4*)(rowp + bj * HALF) = pack_bf16x8(v0, v1); }
        }
    }
};
struct EpiMergeF {
    static constexpr bool PERM = true, AFTER_DRAIN = false, HAS_MID = true, HAS_INIT = false;
    bf16_t* merged; const bf16_t* gates;
    template <int HALFSEL> __device__ __forceinline__ void scale(f32x4 (&acc)[2][2][4][2], const Unit& u, int wr, int wc, int fr, int fq, bool store) const {
        int row0 = u.pm * BM + wr * 64 + fr, col0 = u.pn * 256 + wc * 32 + 8 * fq;
        asm volatile("" : "+v"(row0), "+v"(col0));
        u32x4 gw[2][2][2];
#define EMF_LOAD(g) do { _Pragma("unroll") for (int mm = 0; mm < 2; ++mm) _Pragma("unroll") for (int bj = 0; bj < 2; ++bj) \
            gw[(g) & 1][mm][bj] = *(const u32x4*)(gates + (size_t)(row0 + ((g) >> 1) * HALF + (2 * ((g) & 1) + mm) * 16) * 4096 + HALFSEL * 2048 + col0 + bj * HALF); } while (0)
        EMF_LOAD(0);
#pragma unroll
        for (int g = 0; g < 4; ++g) { const int ai = g >> 1, mh = g & 1;
            if (g < 3) EMF_LOAD(g + 1);
#pragma unroll
            for (int mm = 0; mm < 2; ++mm)
#pragma unroll
                for (int bj = 0; bj < 2; ++bj) { const int m = 2 * mh + mm; f32x4 g0, g1; unpk8(gw[g & 1][mm][bj], g0, g1);
                    acc[ai][bj][m][0] *= g0; acc[ai][bj][m][1] *= g1;
                    if (store) *(u32x4*)(merged + (size_t)(row0 + ai * HALF + m * 16) * 2048 + col0 + bj * HALF) = pack_bf16x8(acc[ai][bj][m][0], acc[ai][bj][m][1]); }
            asm volatile("" ::: "memory");
        }
#undef EMF_LOAD
    }
    __device__ __forceinline__ void mid(f32x4 (&acc)[2][2][4][2], const Unit& u, int wr, int wc, int fr, int fq) const { scale<0>(acc, u, wr, wc, fr, fq, false); }
    __device__ __forceinline__ void operator()(const f32x4 (&acc)[2][2][4][2], const Unit& u, int wr, int wc, int fr, int fq) const {
        f32x4 (&ac)[2][2][4][2] = const_cast<f32x4 (&)[2][2][4][2]>(acc); scale<1>(ac, u, wr, wc, fr, fq, true); }
};
struct EpiOut {
    static constexpr bool PERM = false, AFTER_DRAIN = false, HAS_MID = false, HAS_INIT = true;
    const float* x; float* out; float* ss;
    __device__ __forceinline__ void init(f32x4 (&acc)[2][2][4][2], const Unit& u, int wr, int wc, int fr, int fq) const {
        const int row0 = u.pm * BM + wr * 64 + fr, col0 = u.pn * 256 + wc * 32 + 4 * fq;
#pragma unroll
        for (int ai = 0; ai < 2; ++ai)
#pragma unroll
            for (int m = 0; m < 4; ++m)
#pragma unroll
                for (int bj = 0; bj < 2; ++bj)
#pragma unroll
                    for (int n = 0; n < 2; ++n) acc[ai][bj][m][n] = *(const f32x4*)(x + (size_t)(row0 + ai * HALF + m * 16) * 2048 + col0 + bj * HALF + n * 16);
    }
    __device__ __forceinline__ void operator()(const f32x4 (&acc)[2][2][4][2], const Unit& u, int wr, int wc, int fr, int fq) const {
        const int row0 = u.pm * BM + wr * 64 + fr, col0 = u.pn * 256 + wc * 32 + 4 * fq;
#pragma unroll
        for (int ai = 0; ai < 2; ++ai) {
#pragma unroll
            for (int m = 0; m < 4; ++m) { const size_t r = (size_t)(row0 + ai * HALF + m * 16); float s = 0.f;
#pragma unroll
                for (int bj = 0; bj < 2; ++bj)
#pragma unroll
                    for (int n = 0; n < 2; ++n) { const f32x4 h = acc[ai][bj][m][n]; *(f32x4*)(out + r * 2048 + col0 + bj * HALF + n * 16) = h;
                        s += (h[0] * h[0] + h[1] * h[1]) + (h[2] * h[2] + h[3] * h[3]); }
                s += __shfl_xor(s, 16); s += __shfl_xor(s, 32);
                if (fq == 0) ss[r * 32 + u.pn * 4 + wc] = s; }
        }
    }
};
struct EpiMoeUp {
    static constexpr bool PERM = true, AFTER_DRAIN = false, HAS_MID = false, HAS_INIT = false;
    bf16_t* hid;
    __device__ __forceinline__ void operator()(const f32x4 (&acc)[2][2][4][2], const Unit& u, int wr, int wc, int fr, int fq) const {
        const int row0 = u.pm * BM + wr * 64 + fr, col0 = (u.pn & 7) * 128 + wc * 32 + 8 * fq;
#pragma unroll
        for (int ai = 0; ai < 2; ++ai)
#pragma unroll
            for (int m = 0; m < 4; ++m) { bf16_t* rowp = hid + (size_t)(row0 + ai * HALF + m * 16) * 1024 + col0;
                const f32x4 g0 = acc[ai][0][m][0], g1 = acc[ai][0][m][1], u0 = acc[ai][1][m][0], u1 = acc[ai][1][m][1];
                const f32x4 v0 = g0 * sigm4(g0) * u0, v1 = g1 * sigm4(g1) * u1;
                *(u32x4*)rowp = pack_bf16x8(v0, v1); }
    }
};
struct EpiMoeDown {
    static constexpr bool PERM = true, AFTER_DRAIN = false, HAS_MID = false, HAS_INIT = false;
    bf16_t* ye; const float* selgate;
    __device__ __forceinline__ void operator()(const f32x4 (&acc)[2][2][4][2], const Unit& u, int wr, int wc, int fr, int fq) const {
        const int row0 = u.pm * BM + wr * 64 + fr, col0 = (u.pn & 7) * 256 + wc * 32 + 8 * fq;
#pragma unroll
        for (int ai = 0; ai < 2; ++ai)
#pragma unroll
            for (int m = 0; m < 4; ++m) { const int r = row0 + ai * HALF + m * 16; const int e = r >> 11, b = (r >> 9) & 3, c = r & 511;
                const float g = selgate[(b * 16 + e) * 512 + c];
                bf16_t* rowp = ye + (size_t)r * 2048 + col0;
#pragma unroll
                for (int bj = 0; bj < 2; ++bj) *(u32x4*)(rowp + bj * HALF) = pack_bf16x8(acc[ai][bj][m][0] * g, acc[ai][bj][m][1] * g); }
    }
};
struct ExpertOrder {
    int G, c;
    __device__ __forceinline__ bool next(int i, Unit& u) const {
        const int L = i * G + c; if (L >= 1024) return false;
        const int wgid = (L % NXCD) * (1024 / NXCD) + L / NXCD;
        const int e = wgid >> 6, r = wgid & 63; u.pm = e * 8 + (r & 3) + 4 * ((r >> 5) & 1); u.pn = e * 8 + ((r >> 2) & 7); return true;
    }
    __device__ __forceinline__ void a_ready(const Unit&) const {}
    __device__ __forceinline__ void done(const Unit&) const {}
};

struct ExpertGatherOrder {
    int G, c; const int* seltok;
    __device__ __forceinline__ bool next(int i, Unit& u) const {
        const int L = i * G + c; if (L >= 1024) return false;
        const int wgid = (L % NXCD) * (1024 / NXCD) + L / NXCD;
        const int e = wgid >> 6, r = wgid & 63; u.pm = e * 8 + (r & 3) + 4 * ((r >> 5) & 1); u.pn = e * 8 + ((r >> 2) & 7); return true;
    }
    __device__ __forceinline__ int arow(int r) const { const int e = r >> 11, b = (r >> 9) & 3, cc = r & 511; return b * 4096 + seltok[(b * 16 + e) * 512 + cc]; }
    __device__ __forceinline__ size_t boff(const Unit& u) const { return w1t_base(u.pn >> 3) + (size_t)(u.pn & 7) * (256 * 2048 * 2); }
    __device__ __forceinline__ void a_ready(const Unit&) const {}
    __device__ __forceinline__ void done(const Unit&) const {}
};
template <class Epi, class Sched, bool ALIGN_EPI = false, bool SP2 = false>
__device__ __forceinline__ void gemm_phase(PG8_LAS unsigned char* lds, const Gemm g, const Sched& S, const Epi& E) {
    const int tid = fresh_tid(), wid = __builtin_amdgcn_readfirstlane(tid >> 6), lane = tid & 63, wr = wid >> 2, wc = wid & 3, fr = lane & 15, fq = lane >> 4;
    const int K = g.K, nt = K / BK;
    unsigned voffA[2], voffB[2];
#pragma unroll
    for (int i = 0; i < 2; ++i) { int R, C; stage_rc(tid * 16 + i * 8192, R, C); const int Rb = Epi::PERM ? ((R & ~31) + perm32(R & 31)) : R;
        voffA[i] = (unsigned)(R * g.lda + C) * 2u; voffB[i] = (unsigned)(Rb * g.ldb + C) * 2u; }
    const size_t kstep = (size_t)(BK * 2);
    const size_t hsA = (size_t)HALF * g.lda * 2, hsB = (size_t)HALF * g.ldb * 2;
    const size_t tsA = 2 * hsA, tsB = 2 * hsB;
    const unsigned ldsw = (unsigned)wid * 1024u;
    const int aoff = lds_byte(wr * 64 + fr, fq * 8), boff = lds_byte(wc * 32 + fr, fq * 8);
#define PG8_SA(b, h) (((b) * 2 + (h)) * HTB)
#define PG8_SB(b, h) ((4 + (b) * 2 + (h)) * HTB)
#define PG8_STAGE(bufoff, gbase, voff) do { _Pragma("unroll") for (int _i = 0; _i < 2; ++_i) \
        __builtin_amdgcn_global_load_lds((const unsigned*)((const char*)(gbase) + (voff)[_i]), (PG8_LAS unsigned*)(lds + (bufoff) + ldsw + _i * 8192), 16, 0, 0); } while (0)
#define PG8_LDA(dst, b, h) do { _Pragma("unroll") for (int m = 0; m < 4; ++m) _Pragma("unroll") for (int k = 0; k < 2; ++k) dst[m][k] = *(const PG8_LAS bf16x8*)(lds + PG8_SA(b, h) + aoff + m * 2048 + k * 1024); } while (0)
#define PG8_LDB(dst, b, h) do { _Pragma("unroll") for (int n = 0; n < 2; ++n) _Pragma("unroll") for (int k = 0; k < 2; ++k) dst[n][k] = *(const PG8_LAS bf16x8*)(lds + PG8_SB(b, h) + boff + n * 2048 + k * 1024); } while (0)
#define PG8_MMA(ai, bj, At, Bt) do { __builtin_amdgcn_s_setprio(1); _Pragma("unroll") for (int m = 0; m < 4; ++m) _Pragma("unroll") for (int n = 0; n < 2; ++n) _Pragma("unroll") for (int k = 0; k < 2; ++k) \
        acc[ai][bj][m][n] = __builtin_amdgcn_mfma_f32_16x16x32_bf16(Bt[n][k], At[m][k], acc[ai][bj][m][n], 0, 0, 0); __builtin_amdgcn_s_setprio(0); } while (0)
#define PG8_WAIT_V(n) asm volatile("s_waitcnt vmcnt(" #n ")" ::: "memory")
#define PG8_WAIT_L(n) asm volatile("s_waitcnt lgkmcnt(" #n ")" ::: "memory")
#define PG8_BAR __builtin_amdgcn_s_barrier()
#define PG8_SCHED __builtin_amdgcn_sched_barrier(0)
    Unit cur, nxt; int ui = 0;
    if (!S.next(0, cur)) return;
    f32x4 acc[2][2][4][2];
    if constexpr (Epi::HAS_INIT) E.init(acc, cur, wr, wc, fr, fq); else {
#pragma unroll
    for (int a = 0; a < 2; ++a)
#pragma unroll
        for (int b = 0; b < 2; ++b)
#pragma unroll
            for (int m = 0; m < 4; ++m)
#pragma unroll
                for (int n = 0; n < 2; ++n) acc[a][b][m][n] = (f32x4){0.f, 0.f, 0.f, 0.f};
    }
    bf16x8 At[4][2], B0[2][2], B1[2][2];
    const char* cA = (const char*)g.A + (size_t)cur.pm * tsA; const char* cB = (const char*)g.Bt + (size_t)cur.pn * tsB;
    S.a_ready(cur);
    if constexpr (SP2) {
        PG8_STAGE(PG8_SB(0, 0), cB, voffB); PG8_STAGE(PG8_SB(0, 1), cB + hsB, voffB); PG8_STAGE(PG8_SA(0, 0), cA, voffA); PG8_STAGE(PG8_SA(0, 1), cA + hsA, voffA);
        if (wr == 1) PG8_BAR;
        PG8_WAIT_V(2); PG8_BAR;
        PG8_STAGE(PG8_SB(1, 0), cB + kstep, voffB); PG8_STAGE(PG8_SA(1, 0), cA + kstep, voffA); PG8_STAGE(PG8_SB(1, 1), cB + hsB + kstep, voffB);
        PG8_WAIT_V(6); PG8_BAR;
    } else {
        PG8_STAGE(PG8_SB(0, 0), cB, voffB); PG8_STAGE(PG8_SA(0, 0), cA, voffA); PG8_STAGE(PG8_SB(0, 1), cB + hsB, voffB); PG8_STAGE(PG8_SA(0, 1), cA + hsA, voffA);
        if (wr == 1) PG8_BAR;
        PG8_WAIT_V(4); PG8_BAR;
        PG8_STAGE(PG8_SB(1, 0), cB + kstep, voffB); PG8_STAGE(PG8_SA(1, 0), cA + kstep, voffA); PG8_STAGE(PG8_SB(1, 1), cB + hsB + kstep, voffB);
        PG8_WAIT_V(6); PG8_BAR;
    }
    for (;;) {
        const bool has_next = S.next(ui + 1, nxt);
        const char* nA = has_next ? (const char*)g.A + (size_t)nxt.pm * tsA : cA; const char* nB = has_next ? (const char*)g.Bt + (size_t)nxt.pn * tsB : cB;
#pragma unroll 1
        for (int t = 0; t < nt; t += 2) {
            const bool last = (t == nt - 2);
            const char* a1 = cA + (size_t)(t + 1) * kstep;
            const char* a2 = last ? nA : cA + (size_t)(t + 2) * kstep; const char* b2 = last ? nB : cB + (size_t)(t + 2) * kstep;
            const char* a3 = a2 + kstep; const char* b3 = b2 + kstep;
            if (last && has_next) S.a_ready(nxt);
            if constexpr (Epi::HAS_MID) { if (t == nt / 2) E.mid(acc, cur, wr, wc, fr, fq); }
            if constexpr (SP2) {
            PG8_LDB(B0, 0, 0); PG8_LDB(B1, 0, 1); PG8_SCHED; PG8_LDA(At, 0, 0); PG8_STAGE(PG8_SA(1, 1), a1 + hsA, voffA);
            PG8_WAIT_V(8); PG8_WAIT_L(0); PG8_BAR; PG8_MMA(0, 0, At, B0); PG8_MMA(0, 1, At, B1); PG8_BAR; PG8_SCHED;
            PG8_LDA(At, 0, 1); PG8_STAGE(PG8_SB(0, 0), b2, voffB); PG8_STAGE(PG8_SB(0, 1), b2 + hsB, voffB); PG8_STAGE(PG8_SA(0, 0), a2, voffA);
            PG8_WAIT_V(8); PG8_WAIT_L(0); PG8_BAR; PG8_MMA(1, 0, At, B0); PG8_MMA(1, 1, At, B1); PG8_BAR; PG8_SCHED;
            PG8_LDB(B0, 1, 0); PG8_LDB(B1, 1, 1); PG8_SCHED; PG8_LDA(At, 1, 0); PG8_STAGE(PG8_SA(0, 1), a2 + hsA, voffA);
            PG8_WAIT_V(8); PG8_WAIT_L(0); PG8_BAR; PG8_MMA(0, 0, At, B0); PG8_MMA(0, 1, At, B1); PG8_BAR; PG8_SCHED;
            PG8_LDA(At, 1, 1); PG8_STAGE(PG8_SB(1, 0), b3, voffB); PG8_STAGE(PG8_SB(1, 1), b3 + hsB, voffB); PG8_STAGE(PG8_SA(1, 0), a3, voffA);
            PG8_WAIT_V(8); PG8_WAIT_L(0); PG8_BAR; PG8_MMA(1, 0, At, B0); PG8_MMA(1, 1, At, B1); PG8_BAR; PG8_SCHED;
            } else {
            PG8_LDB(B0, 0, 0); PG8_SCHED; PG8_LDA(At, 0, 0); PG8_STAGE(PG8_SA(1, 1), a1 + hsA, voffA);
            PG8_WAIT_L(8); PG8_BAR; PG8_WAIT_L(0); PG8_MMA(0, 0, At, B0); PG8_BAR; PG8_SCHED;
            PG8_LDB(B1, 0, 1); PG8_STAGE(PG8_SB(0, 0), b2, voffB);
            PG8_BAR; PG8_WAIT_L(0); PG8_MMA(0, 1, At, B1); PG8_BAR;
            PG8_LDA(At, 0, 1); PG8_STAGE(PG8_SA(0, 0), a2, voffA);
            PG8_BAR; PG8_WAIT_L(0); PG8_MMA(1, 0, At, B0); PG8_BAR; PG8_SCHED;
            PG8_STAGE(PG8_SB(0, 1), b2 + hsB, voffB);
            PG8_WAIT_V(6); PG8_BAR; PG8_MMA(1, 1, At, B1); PG8_BAR;
            PG8_LDB(B0, 1, 0); PG8_SCHED; PG8_LDA(At, 1, 0); PG8_STAGE(PG8_SA(0, 1), a2 + hsA, voffA);
            PG8_WAIT_L(8); PG8_BAR; PG8_WAIT_L(0); PG8_MMA(0, 0, At, B0); PG8_BAR; PG8_SCHED;
            PG8_LDB(B1, 1, 1); PG8_STAGE(PG8_SB(1, 0), b3, voffB);
            PG8_BAR; PG8_WAIT_L(0); PG8_MMA(0, 1, At, B1); PG8_BAR;
            PG8_LDA(At, 1, 1); PG8_STAGE(PG8_SA(1, 0), a3, voffA);
            PG8_BAR; PG8_WAIT_L(0); PG8_MMA(1, 0, At, B0); PG8_BAR; PG8_SCHED;
            PG8_STAGE(PG8_SB(1, 1), b3 + hsB, voffB);
            PG8_WAIT_V(6); PG8_BAR; PG8_MMA(1, 1, At, B1); PG8_BAR;
            }
        }
        if constexpr (ALIGN_EPI) { if (wr == 0) PG8_BAR; }
        if constexpr (!Epi::AFTER_DRAIN) { E(acc, cur, wr, wc, fr, fq); S.done(cur); }
        if (!has_next) break;
        if constexpr (Epi::HAS_INIT) E.init(acc, nxt, wr, wc, fr, fq); else {
#pragma unroll
        for (int a = 0; a < 2; ++a)
#pragma unroll
            for (int b = 0; b < 2; ++b)
#pragma unroll
                for (int m = 0; m < 4; ++m)
#pragma unroll
                    for (int n = 0; n < 2; ++n) acc[a][b][m][n] = (f32x4){0.f, 0.f, 0.f, 0.f};
        }
        cur = nxt; cA = nA; cB = nB; ++ui;
        if constexpr (ALIGN_EPI) { if (wr == 1) PG8_BAR; }
    }
    PG8_WAIT_V(0);
    if constexpr (!ALIGN_EPI) { if (wr == 0) PG8_BAR; }
    PG8_BAR;
    if constexpr (Epi::AFTER_DRAIN) { E.fused(acc, cur, wr, wc, fr, fq, lds, wid, lane); S.done(cur); }
#undef PG8_SA
#undef PG8_SB
#undef PG8_STAGE
#undef PG8_LDA
#undef PG8_LDB
#undef PG8_MMA
#undef PG8_WAIT_V
#undef PG8_WAIT_L
#undef PG8_BAR
#undef PG8_SCHED
}

template <class Epi, class Sched, bool ALIGN_EPI = false, bool SP2 = false>
__device__ __forceinline__ void gemm_phase_g(PG8_LAS unsigned char* lds, const Gemm g, const Sched& S, const Epi& E) {
    const int tid = fresh_tid(), wid = __builtin_amdgcn_readfirstlane(tid >> 6), lane = tid & 63, wr = wid >> 2, wc = wid & 3, fr = lane & 15, fq = lane >> 4;
    const int K = g.K, nt = K / BK;
    unsigned voffB[2]; int RAr[2]; unsigned CAb[2];
#pragma unroll
    for (int i = 0; i < 2; ++i) { int R, C; stage_rc(tid * 16 + i * 8192, R, C); const int Rb = Epi::PERM ? ((R & ~31) + perm32(R & 31)) : R;
        RAr[i] = R; CAb[i] = (unsigned)C * 2u; voffB[i] = (unsigned)(Rb * g.ldb + C) * 2u; }
    const size_t kstep = (size_t)(BK * 2);
    const size_t hsA = (size_t)HALF * g.lda * 2, hsB = (size_t)HALF * g.ldb * 2;
    const size_t tsA = 2 * hsA, tsB = 2 * hsB;
    const unsigned ldsw = (unsigned)wid * 1024u;
    const int aoff = lds_byte(wr * 64 + fr, fq * 8), boff = lds_byte(wc * 32 + fr, fq * 8);
#define PG8_SA(b, h) (((b) * 2 + (h)) * HTB)
#define PG8_SB(b, h) ((4 + (b) * 2 + (h)) * HTB)
#define PG8_STAGE(bufoff, gbase, voff) do { _Pragma("unroll") for (int _i = 0; _i < 2; ++_i) \
        __builtin_amdgcn_global_load_lds((const unsigned*)((const char*)(gbase) + (voff)[_i]), (PG8_LAS unsigned*)(lds + (bufoff) + ldsw + _i * 8192), 16, 0, 0); } while (0)
#define PG8_LDA(dst, b, h) do { _Pragma("unroll") for (int m = 0; m < 4; ++m) _Pragma("unroll") for (int k = 0; k < 2; ++k) dst[m][k] = *(const PG8_LAS bf16x8*)(lds + PG8_SA(b, h) + aoff + m * 2048 + k * 1024); } while (0)
#define PG8_LDB(dst, b, h) do { _Pragma("unroll") for (int n = 0; n < 2; ++n) _Pragma("unroll") for (int k = 0; k < 2; ++k) dst[n][k] = *(const PG8_LAS bf16x8*)(lds + PG8_SB(b, h) + boff + n * 2048 + k * 1024); } while (0)
#define PG8_MMA(ai, bj, At, Bt) do { __builtin_amdgcn_s_setprio(1); _Pragma("unroll") for (int m = 0; m < 4; ++m) _Pragma("unroll") for (int n = 0; n < 2; ++n) _Pragma("unroll") for (int k = 0; k < 2; ++k) \
        acc[ai][bj][m][n] = __builtin_amdgcn_mfma_f32_16x16x32_bf16(Bt[n][k], At[m][k], acc[ai][bj][m][n], 0, 0, 0); __builtin_amdgcn_s_setprio(0); } while (0)
#define PG8_WAIT_V(n) asm volatile("s_waitcnt vmcnt(" #n ")" ::: "memory")
#define PG8_WAIT_L(n) asm volatile("s_waitcnt lgkmcnt(" #n ")" ::: "memory")
#define PG8_BAR __builtin_amdgcn_s_barrier()
#define PG8_SCHED __builtin_amdgcn_sched_barrier(0)
    Unit cur, nxt; int ui = 0;
    if (!S.next(0, cur)) return;
    f32x4 acc[2][2][4][2];
    if constexpr (Epi::HAS_INIT) E.init(acc, cur, wr, wc, fr, fq); else {
#pragma unroll
    for (int a = 0; a < 2; ++a)
#pragma unroll
        for (int b = 0; b < 2; ++b)
#pragma unroll
            for (int m = 0; m < 4; ++m)
#pragma unroll
                for (int n = 0; n < 2; ++n) acc[a][b][m][n] = (f32x4){0.f, 0.f, 0.f, 0.f};
    }
    bf16x8 At[4][2], B0[2][2], B1[2][2];
    unsigned vAll[4][2][2];
#pragma unroll
    for (int q = 0; q < 4; ++q) { Unit uq; const bool ok = S.next(q, uq);
#pragma unroll
        for (int h = 0; h < 2; ++h)
#pragma unroll
            for (int i = 0; i < 2; ++i) vAll[q][h][i] = ok ? (unsigned)S.arow(uq.pm * BM + h * HALF + RAr[i]) * (unsigned)(g.lda * 2) + CAb[i] : 0u; }
#define PG8_PICK(dst, idx) do { _Pragma("unroll") for (int h_ = 0; h_ < 2; ++h_) _Pragma("unroll") for (int i_ = 0; i_ < 2; ++i_) \
        dst[h_][i_] = (idx) == 0 ? vAll[0][h_][i_] : (idx) == 1 ? vAll[1][h_][i_] : (idx) == 2 ? vAll[2][h_][i_] : vAll[3][h_][i_]; } while (0)
    unsigned vA[2][2], vAn[2][2], vS[2][2];
    PG8_PICK(vA, 0);
    const char* A0 = (const char*)g.A; const char* cB = (const char*)g.Bt + S.boff(cur);
    S.a_ready(cur);
    if constexpr (SP2) {
        PG8_STAGE(PG8_SB(0, 0), cB, voffB); PG8_STAGE(PG8_SB(0, 1), cB + hsB, voffB); PG8_STAGE(PG8_SA(0, 0), A0, vA[0]); PG8_STAGE(PG8_SA(0, 1), A0, vA[1]);
        if (wr == 1) PG8_BAR;
        PG8_WAIT_V(2); PG8_BAR;
        PG8_STAGE(PG8_SB(1, 0), cB + kstep, voffB); PG8_STAGE(PG8_SA(1, 0), A0 + kstep, vA[0]); PG8_STAGE(PG8_SB(1, 1), cB + hsB + kstep, voffB);
        PG8_WAIT_V(6); PG8_BAR;
    } else {
        PG8_STAGE(PG8_SB(0, 0), cB, voffB); PG8_STAGE(PG8_SA(0, 0), A0, vA[0]); PG8_STAGE(PG8_SB(0, 1), cB + hsB, voffB); PG8_STAGE(PG8_SA(0, 1), A0, vA[1]);
        if (wr == 1) PG8_BAR;
        PG8_WAIT_V(4); PG8_BAR;
        PG8_STAGE(PG8_SB(1, 0), cB + kstep, voffB); PG8_STAGE(PG8_SA(1, 0), A0 + kstep, vA[0]); PG8_STAGE(PG8_SB(1, 1), cB + hsB + kstep, voffB);
        PG8_WAIT_V(6); PG8_BAR;
    }
    for (;;) {
        const bool has_next = S.next(ui + 1, nxt);
        const char* nB = has_next ? (const char*)g.Bt + S.boff(nxt) : cB;
        if (has_next) { PG8_PICK(vAn, ui + 1); } else { PG8_PICK(vAn, ui); }
#pragma unroll 1
        for (int t = 0; t < nt; t += 2) {
            const bool last = (t == nt - 2);
            const char* a1 = A0 + (size_t)(t + 1) * kstep;
            const char* a2 = last ? A0 : A0 + (size_t)(t + 2) * kstep; const char* b2 = last ? nB : cB + (size_t)(t + 2) * kstep;
#pragma unroll
            for (int h_ = 0; h_ < 2; ++h_)
#pragma unroll
                for (int i_ = 0; i_ < 2; ++i_) vS[h_][i_] = last ? vAn[h_][i_] : vA[h_][i_];
            const char* a3 = a2 + kstep; const char* b3 = b2 + kstep;
            if (last && has_next) S.a_ready(nxt);
            if constexpr (Epi::HAS_MID) { if (t == nt / 2) E.mid(acc, cur, wr, wc, fr, fq); }
            if constexpr (SP2) {
            PG8_LDB(B0, 0, 0); PG8_LDB(B1, 0, 1); PG8_SCHED; PG8_LDA(At, 0, 0); PG8_STAGE(PG8_SA(1, 1), a1, vA[1]);
            PG8_WAIT_V(8); PG8_WAIT_L(0); PG8_BAR; PG8_MMA(0, 0, At, B0); PG8_MMA(0, 1, At, B1); PG8_BAR; PG8_SCHED;
            PG8_LDA(At, 0, 1); PG8_STAGE(PG8_SB(0, 0), b2, voffB); PG8_STAGE(PG8_SB(0, 1), b2 + hsB, voffB); PG8_STAGE(PG8_SA(0, 0), a2, vS[0]);
            PG8_WAIT_V(8); PG8_WAIT_L(0); PG8_BAR; PG8_MMA(1, 0, At, B0); PG8_MMA(1, 1, At, B1); PG8_BAR; PG8_SCHED;
            PG8_LDB(B0, 1, 0); PG8_LDB(B1, 1, 1); PG8_SCHED; PG8_LDA(At, 1, 0); PG8_STAGE(PG8_SA(0, 1), a2, vS[1]);
            PG8_WAIT_V(8); PG8_WAIT_L(0); PG8_BAR; PG8_MMA(0, 0, At, B0); PG8_MMA(0, 1, At, B1); PG8_BAR; PG8_SCHED;
            PG8_LDA(At, 1, 1); PG8_STAGE(PG8_SB(1, 0), b3, voffB); PG8_STAGE(PG8_SB(1, 1), b3 + hsB, voffB); PG8_STAGE(PG8_SA(1, 0), a3, vS[0]);
            PG8_WAIT_V(8); PG8_WAIT_L(0); PG8_BAR; PG8_MMA(1, 0, At, B0); PG8_MMA(1, 1, At, B1); PG8_BAR; PG8_SCHED;
            } else {
            PG8_LDB(B0, 0, 0); PG8_SCHED; PG8_LDA(At, 0, 0); PG8_STAGE(PG8_SA(1, 1), a1, vA[1]);
            PG8_WAIT_L(8); PG8_BAR; PG8_WAIT_L(0); PG8_MMA(0, 0, At, B0); PG8_BAR; PG8_SCHED;
            PG8_LDB(B1, 0, 1); PG8_STAGE(PG8_SB(0, 0), b2, voffB);
            PG8_BAR; PG8_WAIT_L(0); PG8_MMA(0, 1, At, B1); PG8_BAR;
            PG8_LDA(At, 0, 1); PG8_STAGE(PG8_SA(0, 0), a2, vS[0]);
            PG8_BAR; PG8_WAIT_L(0); PG8_MMA(1, 0, At, B0); PG8_BAR; PG8_SCHED;
            PG8_STAGE(PG8_SB(0, 1), b2 + hsB, voffB);
            PG8_WAIT_V(6); PG8_BAR; PG8_MMA(1, 1, At, B1); PG8_BAR;
            PG8_LDB(B0, 1, 0); PG8_SCHED; PG8_LDA(At, 1, 0); PG8_STAGE(PG8_SA(0, 1), a2, vS[1]);
            PG8_WAIT_L(8); PG8_BAR; PG8_WAIT_L(0); PG8_MMA(0, 0, At, B0); PG8_BAR; PG8_SCHED;
            PG8_LDB(B1, 1, 1); PG8_STAGE(PG8_SB(1, 0), b3, voffB);
            PG8_BAR; PG8_WAIT_L(0); PG8_MMA(0, 1, At, B1); PG8_BAR;
            PG8_LDA(At, 1, 1); PG8_STAGE(PG8_SA(1, 0), a3, vS[0]);
            PG8_BAR; PG8_WAIT_L(0); PG8_MMA(1, 0, At, B0); PG8_BAR; PG8_SCHED;
            PG8_STAGE(PG8_SB(1, 1), b3 + hsB, voffB);
            PG8_WAIT_V(6); PG8_BAR; PG8_MMA(1, 1, At, B1); PG8_BAR;
            }
        }
        if constexpr (ALIGN_EPI) { if (wr == 0) PG8_BAR; }
        if constexpr (!Epi::AFTER_DRAIN) { E(acc, cur, wr, wc, fr, fq); S.done(cur); }
        if (!has_next) break;
        if constexpr (Epi::HAS_INIT) E.init(acc, nxt, wr, wc, fr, fq); else {
#pragma unroll
        for (int a = 0; a < 2; ++a)
#pragma unroll
            for (int b = 0; b < 2; ++b)
#pragma unroll
                for (int m = 0; m < 4; ++m)
#pragma unroll
                    for (int n = 0; n < 2; ++n) acc[a][b][m][n] = (f32x4){0.f, 0.f, 0.f, 0.f};
        }
        cur = nxt; cB = nB; ++ui;
#pragma unroll
        for (int h_ = 0; h_ < 2; ++h_)
#pragma unroll
            for (int i_ = 0; i_ < 2; ++i_) vA[h_][i_] = vAn[h_][i_];
        if constexpr (ALIGN_EPI) { if (wr == 1) PG8_BAR; }
    }
    PG8_WAIT_V(0);
    if constexpr (!ALIGN_EPI) { if (wr == 0) PG8_BAR; }
    PG8_BAR;
    if constexpr (Epi::AFTER_DRAIN) { E.fused(acc, cur, wr, wc, fr, fq, lds, wid, lane); S.done(cur); }
#undef PG8_SA
#undef PG8_SB
#undef PG8_STAGE
#undef PG8_LDA
#undef PG8_LDB
#undef PG8_MMA
#undef PG8_WAIT_V
#undef PG8_WAIT_L
#undef PG8_BAR
#undef PG8_SCHED
#undef PG8_PICK
}


}

namespace attn {
using bf16x8 = __attribute__((ext_vector_type(8))) short;
using s16x4  = __attribute__((ext_vector_type(4))) short;
using f32x16 = __attribute__((ext_vector_type(16))) float;
using u32x4  = __attribute__((ext_vector_type(4))) unsigned;
constexpr int QBLK = 32, KVBLK = 64, LDQ = 3072;
constexpr float SCALE = 0.125f, QSCALE = 0.125f * 1.4426950408889634f;
constexpr size_t SHM_V = KVBLK * 128 * 2, SHM_K = KVBLK * 128 * 2, SHM_ATTN = 2 * SHM_V + 2 * SHM_K + 8 * 64 * 4;
#define KSWZ(row, colB) ((row) * 256 + ((colB) ^ (((row) & 7) << 4)))
#define SBAR() __builtin_amdgcn_sched_barrier(0)
__device__ __forceinline__ int crow(int r, int hi) { return (r & 3) + 8 * (r >> 2) + 4 * hi; }
__device__ __forceinline__ unsigned cvtpk(float lo, float hi) { return pk2(lo, hi); }
__device__ __forceinline__ bf16x8 ld8(const bf16_t* p) { return *reinterpret_cast<const bf16x8*>(p); }

__device__ __forceinline__ void partialSM(f32x16& p0, f32x16& p1) {
  for (int r = 0; r < 16; ++r) p0[r] = __builtin_amdgcn_exp2f(p0[r]);
}
__device__ __forceinline__ void finishSM(f32x16& p0, f32x16& p1, float& l_reg, bf16x8& pa0, bf16x8& pa1, bf16x8& pa2, bf16x8& pa3) {
  for (int r = 0; r < 16; ++r) p1[r] = __builtin_amdgcn_exp2f(p1[r]);
  float ps = 0; for (int r = 0; r < 16; ++r) ps += p0[r]; for (int r = 0; r < 16; ++r) ps += p1[r];
  l_reg += ps;
#define PK4(P, BASE, OUT) do { unsigned a0 = cvtpk(P[BASE + 0], P[BASE + 1]), a1 = cvtpk(P[BASE + 2], P[BASE + 3]);   \
    unsigned b0 = cvtpk(P[BASE + 4], P[BASE + 5]), b1 = cvtpk(P[BASE + 6], P[BASE + 7]);                              \
    auto r0 = __builtin_amdgcn_permlane32_swap(a0, b0, false, false); auto r1 = __builtin_amdgcn_permlane32_swap(a1, b1, false, false); \
    u32x4 w = {r0[0], r1[0], r0[1], r1[1]}; OUT = *reinterpret_cast<bf16x8*>(&w); } while (0)
  PK4(p0, 0, pa0); PK4(p0, 8, pa1); PK4(p1, 0, pa2); PK4(p1, 8, pa3);
#undef PK4
}
__device__ __forceinline__ void qkt(f32x16& p0, f32x16& p1, const bf16_t* Ks, const bf16x8* qr, int r32, int hi, int sub) {
  p0 = f32x16{}; p1 = f32x16{};
#pragma unroll
  for (int d0 = 0; d0 < 4; ++d0) { int cb = (sub * 64 + d0 * 16 + hi * 8) * 2;
    bf16x8 b0 = *reinterpret_cast<const bf16x8*>((const char*)Ks + KSWZ(r32, cb));
    bf16x8 b1 = *reinterpret_cast<const bf16x8*>((const char*)Ks + KSWZ(32 + r32, cb));
    p0 = __builtin_amdgcn_mfma_f32_32x32x16_bf16(b0, qr[d0], p0, 0, 0, 0);
    p1 = __builtin_amdgcn_mfma_f32_32x32x16_bf16(b1, qr[d0], p1, 0, 0, 0); }
}
__device__ __forceinline__ int v_st(int k, int c) { const int kk = (k & ~0xC) | ((k & 4) << 1) | ((k & 8) >> 1); return ((kk >> 3) * 4 + (c >> 5)) * 512 + ((kk & 7) * 32 + (c & 31)) * 2; }
__device__ __forceinline__ int v_rd_base(int lane) { return ((lane & 3) << 3) | (((lane >> 2) & 3) << 6) | (((lane >> 4) & 1) << 5) | (((lane >> 5) & 1) << 8); }
constexpr int v_rd_off(int d0, int ks, int half) { return d0 * 512 + ks * 4096 + half * 2048; }
template <int OFF> __device__ __forceinline__ s16x4 tr_read(int vb) {
  s16x4 r; asm volatile("ds_read_b64_tr_b16 %0, %1 offset:%2" : "=&v"(r) : "v"(vb), "i"(OFF) : "memory"); return r;
}
template <int D0> __device__ __forceinline__ void pv_one(f32x16& od, int vb, bf16x8 pa0, bf16x8 pa1, bf16x8 pa2, bf16x8 pa3) {
  const s16x4 l0 = tr_read<v_rd_off(D0, 0, 0)>(vb), h0 = tr_read<v_rd_off(D0, 0, 1)>(vb), l1 = tr_read<v_rd_off(D0, 1, 0)>(vb), h1 = tr_read<v_rd_off(D0, 1, 1)>(vb);
  const s16x4 l2 = tr_read<v_rd_off(D0, 2, 0)>(vb), h2 = tr_read<v_rd_off(D0, 2, 1)>(vb), l3 = tr_read<v_rd_off(D0, 3, 0)>(vb), h3 = tr_read<v_rd_off(D0, 3, 1)>(vb);
  asm volatile("s_waitcnt lgkmcnt(0)" ::: "memory"); SBAR();
#define PK(L, H) (bf16x8){L[0], L[1], L[2], L[3], H[0], H[1], H[2], H[3]}
  od = __builtin_amdgcn_mfma_f32_32x32x16_bf16(pa0, PK(l0, h0), od, 0, 0, 0);
  od = __builtin_amdgcn_mfma_f32_32x32x16_bf16(pa1, PK(l1, h1), od, 0, 0, 0);
  od = __builtin_amdgcn_mfma_f32_32x32x16_bf16(pa2, PK(l2, h2), od, 0, 0, 0);
  od = __builtin_amdgcn_mfma_f32_32x32x16_bf16(pa3, PK(l3, h3), od, 0, 0, 0);
#undef PK
}
__device__ __forceinline__ void pv_d0(f32x16* o, int vb, bf16x8 pa0, bf16x8 pa1, bf16x8 pa2, bf16x8 pa3) {
  pv_one<0>(o[0], vb, pa0, pa1, pa2, pa3); pv_one<1>(o[1], vb, pa0, pa1, pa2, pa3); pv_one<2>(o[2], vb, pa0, pa1, pa2, pa3); pv_one<3>(o[3], vb, pa0, pa1, pa2, pa3);
}

struct Stage { bf16x8 vs0, vs1, ks0, ks1; };
__device__ __forceinline__ void attn_prime(const bf16_t* Kh, const bf16_t* Vh, Stage (&sr_)[2]) {
  const int tid = fresh_tid(), sr = tid >> 4, sc = (tid & 15) * 8;
  sr_[0].vs0 = ld8(&Vh[(long)sr * LDQ + sc]); sr_[0].vs1 = ld8(&Vh[(long)(32 + sr) * LDQ + sc]); sr_[0].ks0 = ld8(&Kh[(long)sr * LDQ + sc]); sr_[0].ks1 = ld8(&Kh[(long)(32 + sr) * LDQ + sc]);
}
__device__ __forceinline__ void attn_unit(const bf16_t* Qb, const bf16_t* Kh, const bf16_t* Vh, bf16_t* Ya, float lam, const float* subln_g, int seq, char* lds, const bf16_t* nKh, const bf16_t* nVh, Stage (&sr_)[2]) {
  const int tid = fresh_tid(), wid = __builtin_amdgcn_readfirstlane(tid >> 6), lane = tid & 63, r32 = lane & 31, hi = lane >> 5, sub = wid >> 2, wq = wid & 3;
  bf16_t* V_lds = (bf16_t*)lds; bf16_t* K_lds = (bf16_t*)(lds + 2 * SHM_V);
  float* ws = (float*)(lds + 2 * SHM_V + 2 * SHM_K) + wid * 64; float* li_l = ws;
  float l_reg = 0; f32x16 o[4] = {}; bf16x8 qr[4];
  const bf16_t* Qw = Qb + (long)(wq * QBLK + r32) * LDQ + sub * 64 + hi * 8;
#pragma unroll
  for (int d0 = 0; d0 < 4; ++d0) qr[d0] = ld8(Qw + d0 * 16);
  const int sr = tid >> 4, sc = (tid & 15) * 8, vst0 = v_st(sr, sc), vst1 = v_st(32 + sr, sc);
  const int vb0 = (int)(uintptr_t)V_lds + v_rd_base(lane);
#define SLOAD(i, k0) do { sr_[i].vs0 = ld8(&Vh[(long)((k0) + sr) * LDQ + sc]); sr_[i].vs1 = ld8(&Vh[(long)((k0) + 32 + sr) * LDQ + sc]); \
    sr_[i].ks0 = ld8(&Kh[(long)((k0) + sr) * LDQ + sc]); sr_[i].ks1 = ld8(&Kh[(long)((k0) + 32 + sr) * LDQ + sc]); } while (0)
#define SWRITE(b, i) do { *(bf16x8*)((char*)V_lds + (b) * SHM_V + vst0) = sr_[i].vs0;          \
    *(bf16x8*)((char*)V_lds + (b) * SHM_V + vst1) = sr_[i].vs1; int kc = sc * 2;               \
    *(bf16x8*)((char*)K_lds + (b) * SHM_K + KSWZ(sr, kc)) = sr_[i].ks0;                       \
    *(bf16x8*)((char*)K_lds + (b) * SHM_K + KSWZ(32 + sr, kc)) = sr_[i].ks1; } while (0)
#define SWAIT() asm volatile("s_waitcnt vmcnt(4)" ::: "memory")
  f32x16 pA0, pA1, pB0, pB1; bf16x8 pa0, pa1, pa2, pa3; const int NT = seq / KVBLK;
  constexpr int SE = 0, SO = 1;
  asm volatile("s_waitcnt vmcnt(0)" ::: "memory"); SWRITE(0, SE); __syncthreads();
  qkt(pA0, pA1, K_lds, qr, r32, hi, sub); partialSM(pA0, pA1);
  SLOAD(SO, KVBLK); if (2 < NT) SLOAD(SE, 2 * KVBLK);
  SWAIT(); SWRITE(1, SO); __syncthreads();
  for (int j = 1; j + 1 < NT; j += 2) {
    SBAR(); qkt(pB0, pB1, (bf16_t*)((char*)K_lds + SHM_K), qr, r32, hi, sub);
    finishSM(pA0, pA1, l_reg, pa0, pa1, pa2, pa3); SBAR();
    SLOAD(SO, (j + 2) * KVBLK); SBAR();
    pv_d0(o, vb0, pa0, pa1, pa2, pa3); partialSM(pB0, pB1);
    __syncthreads(); SWAIT(); SWRITE(0, SE); __syncthreads();
    SBAR(); qkt(pA0, pA1, K_lds, qr, r32, hi, sub);
    finishSM(pB0, pB1, l_reg, pa0, pa1, pa2, pa3); SBAR();
    if (j + 3 < NT) SLOAD(SE, (j + 3) * KVBLK); SBAR();
    pv_d0(o, vb0 + (int)SHM_V, pa0, pa1, pa2, pa3); partialSM(pA0, pA1);
    __syncthreads(); SWAIT(); SWRITE(1, SO); __syncthreads();
  }
  sr_[SE].vs0 = ld8(&nVh[(long)sr * LDQ + sc]); sr_[SE].vs1 = ld8(&nVh[(long)(32 + sr) * LDQ + sc]); sr_[SE].ks0 = ld8(&nKh[(long)sr * LDQ + sc]); sr_[SE].ks1 = ld8(&nKh[(long)(32 + sr) * LDQ + sc]);
  SBAR(); qkt(pB0, pB1, (bf16_t*)((char*)K_lds + SHM_K), qr, r32, hi, sub);
  finishSM(pA0, pA1, l_reg, pa0, pa1, pa2, pa3); SBAR();
  pv_d0(o, vb0, pa0, pa1, pa2, pa3); partialSM(pB0, pB1);
  __syncthreads();
  finishSM(pB0, pB1, l_reg, pa0, pa1, pa2, pa3); SBAR();
  pv_d0(o, vb0 + (int)SHM_V, pa0, pa1, pa2, pa3);
  { auto rr = __builtin_amdgcn_permlane32_swap(__float_as_uint(l_reg), __float_as_uint(l_reg), false, false); l_reg = __uint_as_float(rr[0]) + __uint_as_float(rr[1]); }
  if (hi == 0) li_l[r32] = l_reg; asm volatile("s_waitcnt lgkmcnt(0)" ::: "memory");
  float rli[16];
#pragma unroll
  for (int r = 0; r < 16; ++r) rli[r] = __builtin_amdgcn_rcpf(li_l[crow(r, hi)]);
  __syncthreads();
  float* xo = (float*)lds;
  if (sub == 1) {
#pragma unroll
    for (int r = 0; r < 16; ++r) { const int orow = wq * 32 + crow(r, hi);
#pragma unroll
      for (int d0 = 0; d0 < 4; ++d0) xo[orow * 128 + d0 * 32 + r32] = o[d0][r] * rli[r]; }
  }
  __syncthreads();
  if (sub == 0) {
    float gv[4];
#pragma unroll
    for (int d0 = 0; d0 < 4; ++d0) gv[d0] = subln_g[d0 * 32 + r32] * (1.0f - LAM_INIT);
#pragma unroll
    for (int r = 0; r < 16; ++r) { const int orow = wq * 32 + crow(r, hi); float v[4]; float ssq = 0.f;
#pragma unroll
      for (int d0 = 0; d0 < 4; ++d0) { v[d0] = o[d0][r] * rli[r] - lam * xo[orow * 128 + d0 * 32 + r32]; ssq += v[d0] * v[d0]; }
      ssq += __shfl_xor(ssq, 1); ssq += __shfl_xor(ssq, 2); ssq += __shfl_xor(ssq, 4); ssq += __shfl_xor(ssq, 8); ssq += __shfl_xor(ssq, 16);
      const float sc_ = 1.0f / sqrtf(ssq * (1.0f / 128.0f) + RMS_EPS);
#pragma unroll
      for (int d0 = 0; d0 < 4; ++d0) Ya[(long)orow * 2048 + d0 * 32 + r32] = (bf16_t)f2bf(v[d0] * sc_ * gv[d0]); }
  }
  __syncthreads();
#undef SLOAD
#undef SWRITE
#undef SWAIT
}
#undef KSWZ
#undef SBAR
}

struct Args {
    const float* in[33];
    float* out; unsigned char* ws;
    int ph_lo, ph_hi;
};
enum { I_X = 0, I_ANG, I_WIN, I_QNG, I_KNG, I_LQ1, I_LK1, I_LQ2, I_LK2, I_SUBLN, I_MU, I_W0F, I_W2F, I_W0B, I_W2B, I_A0F, I_A2F, I_A0B, I_A2B, I_G2, I_KK, I_KA, I_RK,
       I_LNW, I_LNB, I_WBA, I_WBB, I_WOUT, I_FNG, I_WR, I_WG, I_WU, I_WD };

__device__ __forceinline__ void tr_item(const float* W, int ldw, int k0, int n0, bf16_t* dst, int ldd, LAS float* scr, int lane) {
    float tv[32];
    const float* src = W + (size_t)(k0 + (lane >> 5)) * ldw + n0 + (lane & 31);
#pragma unroll
    for (int i = 0; i < 32; ++i) tv[i] = src[(size_t)(2 * i) * ldw];
#pragma unroll
    for (int i = 0; i < 32; ++i) scr[(2 * i + (lane >> 5)) * 33 + (lane & 31)] = tv[i];
    asm volatile("s_waitcnt lgkmcnt(0)" ::: "memory");
    const int c = lane & 7;
#pragma unroll
    for (int j = 0; j < 4; ++j) { const int n = (lane >> 3) + 8 * j; const LAS float* s = scr + (8 * c) * 33 + n;
        v4u o; o.x = pk2(s[0 * 33], s[1 * 33]); o.y = pk2(s[2 * 33], s[3 * 33]); o.z = pk2(s[4 * 33], s[5 * 33]); o.w = pk2(s[6 * 33], s[7 * 33]);
        *(v4u*)(dst + (size_t)n * ldd + 8 * c) = o; }
    asm volatile("s_waitcnt lgkmcnt(0)" ::: "memory");
}

__device__ __forceinline__ void p0_prologue(const Args& a, LAS unsigned char* lds, int gw, int NGW, int wave, int lane) {
    unsigned char* ws = a.ws;
    LAS float* scr = (LAS float*)(lds + wave * 16384);
    bf16_t* WinT = (bf16_t*)(ws + WS_WINT);
    bf16_t* WaT = (bf16_t*)(ws + WS_WAT); bf16_t* WoT = (bf16_t*)(ws + WS_WOT);
    constexpr int I_IN = 32 * 333, I_A = 16 * 64, I_B = 16 * 64, I_O = 32 * 64, NITEMS = I_IN + I_A + I_B + I_O;
    for (int it = gw; it < NITEMS; it += NGW) {
        int r = it;
        if (r < I_IN) { const int kb = r / 333, nb = r % 333, n0 = nb * 32; int drow = n0;
            if (n0 >= 6560) { const int c = n0 - 6560, which = c >> 11, cc = c & 2047; drow = 6656 + (cc >> 7) * 256 + which * 128 + (cc & 127); }
            tr_item(a.in[I_WIN], IN_COLS, kb * 64, n0, WinT + (size_t)drow * 2048 + kb * 64, 2048, scr, lane); continue; } r -= I_IN;
        if (r < I_A) { const int kb = r / 64, nb = r % 64; tr_item(a.in[I_WBA], 2048, kb * 64, nb * 32, WaT + (size_t)(nb * 32) * 2048 + kb * 64, 2048, scr, lane); continue; } r -= I_A;
        if (r < I_B) { const int kb = r / 64, nb = r % 64; tr_item(a.in[I_WBB], 2048, kb * 64, nb * 32, WaT + (size_t)(nb * 32) * 2048 + 1024 + kb * 64, 2048, scr, lane); continue; } r -= I_B;
        { const int kb = r / 64, nb = r % 64; tr_item(a.in[I_WOUT], 2048, kb * 64, nb * 32, WoT + (size_t)(nb * 32) * 2048 + kb * 64, 2048, scr, lane); }
    }
    { const int gt = gw * 64 + lane, NT_ = NGW * 64;
      v4u z = {0u, 0u, 0u, 0u};
      for (int i = gt; i < 24576; i += NT_) ((v4u*)(WinT + (size_t)6560 * 2048))[i] = z;
      { const float invf[8] = {1.000000000e+00f, 1.939227432e-01f, 3.760603070e-02f, 7.292664610e-03f, 1.414213562e-03f, 2.742481884e-04f, 5.318296098e-05f, 1.031338616e-05f};
        for (int i = gt; i < SEQ * 8; i += NT_) { float iv = invf[0];
#pragma unroll
            for (int j = 1; j < 8; ++j) iv = ((i & 7) == j) ? invf[j] : iv;
            float sv, cv; sincosf((float)(i >> 3) * iv, &sv, &cv); ((float2*)(ws + WS_ROPE))[i] = make_float2(cv, sv); } }
      { float* sm = (float*)(ws + WS_SMALL);
#define CPY(OFF, IDX, N) for (int i = gt; i < (N); i += NT_) sm[(OFF) + i] = a.in[IDX][i];
        CPY(SM_QNG, I_QNG, 64) CPY(SM_KNG, I_KNG, 64) CPY(SM_LQ1, I_LQ1, 64) CPY(SM_LK1, I_LK1, 64) CPY(SM_LQ2, I_LQ2, 64) CPY(SM_LK2, I_LK2, 64) CPY(SM_SUBLN, I_SUBLN, 128)
        CPY(SM_MU, I_MU, 3488) CPY(SM_KK, I_KK, 1024) CPY(SM_KA, I_KA, 1024) CPY(SM_RK, I_RK, 1024) CPY(SM_LNW, I_LNW, 1024) CPY(SM_LNB, I_LNB, 1024) CPY(SM_FNG, I_FNG, 2048) CPY(SM_WR, I_WR, 32768)
#undef CPY
      }
      for (int i = gt; i < 4096; i += NT_) { const int seg = i >> 10, c = i & 1023; ((float*)(ws + WS_BIAS4))[i] = (seg == 0) ? a.in[I_W0F][c] : (seg == 1) ? a.in[I_W0B][c] : (seg == 2) ? a.in[I_A0F][c] : a.in[I_A0B][c]; }
      bf16_t* B1 = (bf16_t*)(ws + WS_BTL1); bf16_t* B2 = (bf16_t*)(ws + WS_BTL2);
      for (int i = gt; i < 4096 * 32; i += NT_) { const int n = i >> 5, kc = (i & 31) * 8, seg = n >> 10, c = n & 1023;
          const float* w2 = (seg == 0) ? a.in[I_W2F] : (seg == 1) ? a.in[I_W2B] : (seg == 2) ? a.in[I_A2F] : a.in[I_A2B];
          float f[8];
#pragma unroll
          for (int j = 0; j < 8; ++j) { const int k = kc + j - 64 * seg; f[j] = (k >= 0 && k < 64) ? w2[(size_t)k * 1024 + c] : 0.f; }
          *(v4u*)(B1 + (size_t)n * 256 + kc) = pack8(f); }
      for (int i = gt; i < 1024 * 32; i += NT_) { const int n = i >> 5, kc = (i & 31) * 8; float f[8];
#pragma unroll
          for (int j = 0; j < 8; ++j) { const int k = kc + j; f[j] = (k < 160) ? a.in[I_G2][(size_t)k * 1024 + n] : 0.f; }
          *(v4u*)(B2 + (size_t)n * 256 + kc) = pack8(f); }
    }
    bf16_t* HN = (bf16_t*)(ws + WS_HN); const float* x = a.in[I_X]; const float* g = a.in[I_ANG];
    for (int m = gw; m < M; m += NGW) {
        const float4* xr = (const float4*)(x + (size_t)m * DM) + lane; float4 v[8]; float s = 0.f;
#pragma unroll
        for (int j = 0; j < 8; ++j) { v[j] = xr[64 * j]; s += (v[j].x * v[j].x + v[j].y * v[j].y) + (v[j].z * v[j].z + v[j].w * v[j].w); }
        const float rs = 1.0f / sqrtf(wave_sum(s) * (1.0f / DM) + RMS_EPS);
        v2u* o = (v2u*)(HN + (size_t)m * DM) + lane;
#pragma unroll
        for (int j = 0; j < 8; ++j) { const float4 gg = ((const float4*)g)[64 * j + lane]; v2u w; w.x = pk2(v[j].x * rs * gg.x, v[j].y * rs * gg.y); w.y = pk2(v[j].z * rs * gg.z, v[j].w * rs * gg.w); o[64 * j] = w; }
    }
}

__device__ __forceinline__ void p2_prep(const Args& a, int gw, int NGW, int lane, bool dummy = false) {
    unsigned char* ws = a.ws;
    bf16_t* PDA = (bf16_t*)(ws + WS_PDA); const bf16_t* PRW = (const bf16_t*)((unsigned char*)a.out + DO_PRW);
    bf16_t* RKV = (bf16_t*)(ws + WS_RKV); bf16_t* LIN = (bf16_t*)((unsigned char*)a.out + DO_LIN);
    const float* sm = (const float*)(ws + WS_SMALL); const float* mu = sm + SM_MU;
    const int sub8 = lane & 7;
    float gq[8], gk[8];
#pragma unroll
    for (int j = 0; j < 8; ++j) { gq[j] = sm[SM_QNG + sub8 * 8 + j]; gk[j] = sm[SM_KNG + sub8 * 8 + j]; }
    for (int m = gw; m < M; m += NGW) {
        const int t = m & (SEQ - 1);
        const float2 csv = ((const float2*)(ws + WS_ROPE))[t * 8 + sub8]; const float cv = csv.x, sv = csv.y;
        float cs[8], sn[8];
#pragma unroll
        for (int j = 0; j < 8; ++j) { cs[j] = __shfl(cv, j); sn[j] = __shfl(sv, j); }
#pragma unroll
        for (int it = 0; it < 4; ++it) {
            const int v = it * 8 + (lane >> 3);
            bf16_t* p = PDA + (size_t)m * 3072 + (v < 16 ? 0 : 1024) + (v & 15) * 64 + sub8 * 8;
            const v4u w = *(const v4u*)p; float f[8]; unpack8(w, f);
            float s = 0.f;
#pragma unroll
            for (int j = 0; j < 8; ++j) s += f[j] * f[j];
            s = sum8(s); const float rs = 1.0f / sqrtf(s * (1.0f / 64.0f) + RMS_EPS);
            float y[8], oth[8];
#pragma unroll
            for (int j = 0; j < 8; ++j) { y[j] = f[j] * rs * (v < 16 ? gq[j] : gk[j]); }
#pragma unroll
            for (int j = 0; j < 8; ++j) oth[j] = __shfl_xor(y[j], 1);
            float o[8];
#pragma unroll
            for (int j = 0; j < 8; ++j) o[j] = (sub8 == 0) ? (y[j] * cs[j] - oth[j] * sn[j]) : (sub8 == 1) ? (y[j] * cs[j] + oth[j] * sn[j]) : y[j];
            if (v < 16) {
#pragma unroll
                for (int j = 0; j < 8; ++j) o[j] *= 0.125f * 1.4426950408889634f; }
            *(v4u*)(dummy ? (bf16_t*)(ws + WS_LORA) + (p - PDA) : p) = pack8(o);
        }
        const bool hp = t > 0, hn_ = t < SEQ - 1;
        const bf16_t* pr = PRW + (size_t)m * RW_PAD;
#pragma unroll
        for (int it = 0; it < 7; ++it) {
            const int v = it * 64 + lane; if (it == 6 && v >= 436) continue;
            const v4u wc = *(const v4u*)(pr + v * 8);
            v4u wp = {0u, 0u, 0u, 0u}, wn = {0u, 0u, 0u, 0u};
            if (hp) wp = *(const v4u*)(pr - RW_PAD + v * 8);
            if (hn_) wn = *(const v4u*)(pr + RW_PAD + v * 8);
            float c[8], pv[8], nx[8]; unpack8(wc, c); unpack8(wp, pv); unpack8(wn, nx);
            const float4 m0 = *(const float4*)(mu + v * 8), m1 = *(const float4*)(mu + v * 8 + 4);
            const float mm[8] = {m0.x, m0.y, m0.z, m0.w, m1.x, m1.y, m1.z, m1.w};
            float xs[8];
#pragma unroll
            for (int j = 0; j < 8; ++j) xs[j] = c[j] + mm[j] * (0.5f * (pv[j] + nx[j]) - c[j]);
            if (v < 384) { const v4u pw = pack8(xs); *(v4u*)(RKV + (size_t)m * 3072 + v * 8) = pw;
                if (it == 2 || it == 3) {
                    float kr[8]; unpack8(pw, kr); float ssq = 0.f;
#pragma unroll
                    for (int j = 0; j < 8; ++j) { const float kkv = kr[j] * sm[SM_KK + (v - 128) * 8 + j]; ssq += kkv * kkv; }
                    ssq = sum8(ssq);
                    if ((lane & 7) == 0) ((float*)(ws + WS_INRM))[(size_t)m * 16 + ((v - 128) >> 3)] = 1.0f / fmaxf(sqrtf(ssq), 1e-12f); } }
            else if (v < 400) {
#pragma unroll
                for (int j = 0; j < 8; ++j) xs[j] = 1.0f - 2.0f * __builtin_amdgcn_rcpf(1.0f + __expf(2.0f * xs[j]));
                *(v4u*)(LIN + (size_t)m * 512 + (v - 384) * 8) = pack8(xs); }
            else if (v < 416) { *(v4u*)(LIN + (size_t)m * 512 + (v - 384) * 8) = pack8(xs); }
            else {
#pragma unroll
                for (int j = 0; j < 8; ++j) xs[j] = sigmoidf_(xs[j]);
                *(v4u*)(LIN + (size_t)m * 512 + 256 + (v - 416) * 8) = pack8(xs); }
        }
        if (lane < 12) { v4u z = {0u, 0u, 0u, 0u}; *(v4u*)(LIN + (size_t)m * 512 + 416 + lane * 8) = z; }
    }
}

__device__ __forceinline__ void p6_rwpost(const Args& a, int gw, int NGW, int lane) {
    unsigned char* ws = a.ws;
    const bf16_t* RKV = (const bf16_t*)(ws + WS_RKV); const bf16_t* LO = (const bf16_t*)(ws + WS_LORA);
    const bf16_t* YSF = (const bf16_t*)((unsigned char*)a.out + DO_YSF); const bf16_t* YSB = (const bf16_t*)((unsigned char*)a.out + DO_YSB);
    bf16_t* YB = (bf16_t*)((unsigned char*)a.out + DO_YAB) + 1024;
    const size_t SEG = (size_t)M * 1024; const float* sm = (const float*)(ws + WS_SMALL);
    for (int it = gw; it < 2 * M; it += NGW) {
        const int m = it >> 1, col = (it & 1) * 512 + lane * 8;
        float yf[8], ybk[8], r[8], k[8], v[8], af[8], ab[8], g[8];
        unpack8(*(const v4u*)(YSF + (size_t)m * 1024 + col), yf); unpack8(*(const v4u*)(YSB + (size_t)m * 1024 + col), ybk);
        unpack8(*(const v4u*)(RKV + (size_t)m * 3072 + col), r); unpack8(*(const v4u*)(RKV + (size_t)m * 3072 + 1024 + col), k); unpack8(*(const v4u*)(RKV + (size_t)m * 3072 + 2048 + col), v);
        unpack8(*(const v4u*)(LO + 2 * SEG + (size_t)m * 1024 + col), af); unpack8(*(const v4u*)(LO + 3 * SEG + (size_t)m * 1024 + col), ab); unpack8(*(const v4u*)(LO + 4 * SEG + (size_t)m * 1024 + col), g);
        float y[8]; float s = 0.f;
#pragma unroll
        for (int j = 0; j < 8; ++j) { y[j] = yf[j] + ybk[j]; s += y[j]; }
        const float mean = sum8(s) * (1.0f / 64.0f); float q = 0.f;
#pragma unroll
        for (int j = 0; j < 8; ++j) { y[j] -= mean; q += y[j] * y[j]; }
        const float rstd = 1.0f / sqrtf(sum8(q) * (1.0f / 64.0f) + GN_EPS);
        float bs = 0.f;
#pragma unroll
        for (int j = 0; j < 8; ++j) { const float kfb = k[j] * (2.0f + (af[j] + ab[j] - 2.0f) * sm[SM_KA + col + j]); bs += r[j] * kfb * sm[SM_RK + col + j]; }
        bs = sum8(bs);
        float o[8];
#pragma unroll
        for (int j = 0; j < 8; ++j) o[j] = (y[j] * rstd * sm[SM_LNW + col + j] + sm[SM_LNB + col + j] + bs * v[j]) * g[j];
        *(v4u*)(YB + (size_t)m * 2048 + col) = pack8(o);
    }
}

__device__ __forceinline__ void expert_convert_gu(const Args& a, LAS unsigned char* lds, int gw, int NGW, int wave, int lane, int e_lo, int e_hi, int it_end = 1 << 30) {
    unsigned char* ws = a.ws;
    LAS float* scr = (LAS float*)(lds + wave * 16384);
    const int per = (e_hi - e_lo) * 1024;
    for (int it = gw; it < 2 * per && it < it_end; it += NGW) {
        const int which = it >= per ? 1 : 0, r = it - which * per, e = e_lo + (r >> 10), q = r & 1023;
        const int kb = q >> 5, nb = q & 31, n0 = nb * 32;
        const float* W = (which == 0 ? a.in[I_WG] : a.in[I_WU]) + (size_t)e * 2048 * 1024;
        const int drow = (n0 >> 7) * 256 + which * 128 + (n0 & 127);
        tr_item(W, 1024, kb * 64, n0, (bf16_t*)(ws + w1t_base(e)) + (size_t)drow * 2048 + kb * 64, 2048, scr, lane); }
}
__device__ __forceinline__ void expert_convert_down(const Args& a, LAS unsigned char* lds, int gw, int NGW, int wave, int lane) {
    unsigned char* ws = a.ws;
    LAS float* scr = (LAS float*)(lds + wave * 16384);
    bf16_t* WDT = (bf16_t*)(ws + WS_WDT);
    for (int it = gw; it < 16384; it += NGW) { const int e = it >> 10, q = it & 1023, kb = q >> 6, nb = q & 63;
        const float* W = a.in[I_WD] + (size_t)e * 1024 * 2048;
        tr_item(W, 2048, kb * 64, nb * 32, WDT + ((size_t)e * 2048 + nb * 32) * 1024 + kb * 64, 1024, scr, lane); }
}
__device__ __forceinline__ void p9_router(const Args& a, LAS unsigned char* lds, int gw, int NGW, int wave, int lane) {
    unsigned char* ws = a.ws;
    expert_convert_gu(a, lds, gw, NGW, wave, lane, (gridDim.x == 256) ? NE : 0, NE);
    __syncthreads();
    LAS float* wrT = (LAS float*)lds;
    { const float4* wr4 = (const float4*)((const float*)(ws + WS_SMALL) + SM_WR);
      for (int idx = fresh_tid(); idx < 2048 * 4; idx += NTHREADS) { const int d = idx >> 2, q = idx & 3; const float4 w4 = wr4[idx];
          wrT[(4 * q + 0) * 2048 + d] = w4.x; wrT[(4 * q + 1) * 2048 + d] = w4.y; wrT[(4 * q + 2) * 2048 + d] = w4.z; wrT[(4 * q + 3) * 2048 + d] = w4.w; } }
    __syncthreads();
    const float* h = a.out; const float* ss = (const float*)(ws + WS_SSP); const float* g = (const float*)(ws + WS_SMALL) + SM_FNG;
    float* aff = (float*)(ws + WS_AFF); bf16_t* hn2 = (bf16_t*)(ws + WS_HN2);
    for (int mp = gw; mp < M / 2; mp += NGW) {
        const int m0 = 2 * mp;
        const float rs0 = 1.0f / sqrtf(wave_sum(lane < 32 ? ss[(size_t)m0 * 32 + lane] : 0.f) * (1.0f / DM) + RMS_EPS);
        const float rs1 = 1.0f / sqrtf(wave_sum(lane < 32 ? ss[(size_t)(m0 + 1) * 32 + lane] : 0.f) * (1.0f / DM) + RMS_EPS);
        float acc0[16], acc1[16];
#pragma unroll
        for (int e = 0; e < 16; ++e) { acc0[e] = 0.f; acc1[e] = 0.f; }
#pragma unroll 2
        for (int j = 0; j < 8; ++j) { const int d = j * 256 + lane * 4;
            const float4 gv = *(const float4*)(g + d), h0 = *(const float4*)(h + (size_t)m0 * DM + d), h1 = *(const float4*)(h + (size_t)(m0 + 1) * DM + d);
            const float x0[4] = {h0.x * rs0 * gv.x, h0.y * rs0 * gv.y, h0.z * rs0 * gv.z, h0.w * rs0 * gv.w};
            const float x1[4] = {h1.x * rs1 * gv.x, h1.y * rs1 * gv.y, h1.z * rs1 * gv.z, h1.w * rs1 * gv.w};
            { v2u w0, w1; w0.x = pk2(x0[0], x0[1]); w0.y = pk2(x0[2], x0[3]); w1.x = pk2(x1[0], x1[1]); w1.y = pk2(x1[2], x1[3]);
              *(v2u*)(hn2 + (size_t)m0 * DM + d) = w0; *(v2u*)(hn2 + (size_t)(m0 + 1) * DM + d) = w1; }
#pragma unroll
            for (int e = 0; e < 16; ++e) { const pg8::f32x4 w4 = *(const LAS pg8::f32x4*)(wrT + e * 2048 + d);
                acc0[e] += x0[0] * w4.x + x0[1] * w4.y + x0[2] * w4.z + x0[3] * w4.w;
                acc1[e] += x1[0] * w4.x + x1[1] * w4.y + x1[2] * w4.z + x1[3] * w4.w; } }
#pragma unroll
        for (int t2 = 0; t2 < 2; ++t2) {
            float mx = -1e30f, lg[16];
#pragma unroll
            for (int e = 0; e < 16; ++e) { lg[e] = wave_sum(t2 ? acc1[e] : acc0[e]); mx = fmaxf(mx, lg[e]); }
            float den = 0.f;
#pragma unroll
            for (int e = 0; e < 16; ++e) { lg[e] = __expf(lg[e] - mx); den += lg[e]; }
            float mine = lg[0];
#pragma unroll
            for (int e = 1; e < 16; ++e) mine = (lane == e) ? lg[e] : mine;
            const int m = m0 + t2;
            if (lane < 16) aff[((size_t)(m >> 12) * 16 + lane) * SEQ + (m & (SEQ - 1))] = mine / den;
        }
    }
}

__device__ __forceinline__ void p10_topk(const Args& a, unsigned char* ldsg) {
    const int bx = blockIdx.x; if (bx >= NB * NE) return;
    LAS unsigned char* L = (LAS unsigned char*)ldsg;
    const int tid = fresh_tid(), lane = tid & 63, w = tid >> 6;
    unsigned char* ws = a.ws;
    const float* aff = (const float*)(ws + WS_AFF) + (size_t)bx * SEQ;
    LAS unsigned* hist = (LAS unsigned*)L;
    LAS unsigned* ctl = hist + 256;
    LAS unsigned* wtot = hist + 272;
    unsigned v[8];
    { const v4u a0 = *(const v4u*)(aff + tid * 8), a1 = *(const v4u*)(aff + tid * 8 + 4); v[0] = a0.x; v[1] = a0.y; v[2] = a0.z; v[3] = a0.w; v[4] = a1.x; v[5] = a1.y; v[6] = a1.z; v[7] = a1.w; }
    unsigned prefix = 0u, mask = 0u, remaining = CAP;
#pragma unroll 1
    for (int pass = 0; pass < 4; ++pass) {
        const int shift = 24 - 8 * pass;
        if (tid < 256) hist[tid] = 0u;
        __syncthreads();
#pragma unroll
        for (int q = 0; q < 8; ++q) if ((v[q] & mask) == prefix) __hip_atomic_fetch_add((unsigned*)&hist[(v[q] >> shift) & 255u], 1u, __ATOMIC_RELAXED, __HIP_MEMORY_SCOPE_WORKGROUP);
        __syncthreads();
        if (w == 0) {
            const v4u hb = *(const LAS v4u*)(hist + 4 * lane);
            const unsigned own = hb.x + hb.y + hb.z + hb.w;
            unsigned suf = own;
#pragma unroll
            for (int o = 1; o < 64; o <<= 1) { const unsigned t = __shfl_down(suf, o); suf += (lane + o < 64) ? t : 0u; }
            const unsigned above = suf - own;
            if (above < remaining && remaining <= suf) {
                unsigned c3 = above, d, rem;
                if (remaining <= c3 + hb.w) { d = 3; rem = remaining - c3; }
                else { c3 += hb.w; if (remaining <= c3 + hb.z) { d = 2; rem = remaining - c3; }
                    else { c3 += hb.z; if (remaining <= c3 + hb.y) { d = 1; rem = remaining - c3; } else { c3 += hb.y; d = 0; rem = remaining - c3; } } }
                ctl[0] = 4u * lane + d; ctl[1] = rem;
            }
        }
        __syncthreads();
        prefix |= ctl[0] << shift; mask |= 255u << shift; remaining = ctl[1];
        __syncthreads();
    }
    const unsigned thr = prefix;
    unsigned ceq = 0u, cgt = 0u;
#pragma unroll
    for (int q = 0; q < 8; ++q) { ceq += (v[q] == thr) ? 1u : 0u; cgt += (v[q] > thr) ? 1u : 0u; }
    unsigned inc = ceq;
#pragma unroll
    for (int o = 1; o < 64; o <<= 1) { const unsigned t = __shfl_up(inc, o); inc += (lane >= o) ? t : 0u; }
    if (lane == 63) wtot[w] = inc;
    __syncthreads();
    unsigned eqbase = inc - ceq;
#pragma unroll
    for (int q = 0; q < 8; ++q) eqbase += (q < w) ? wtot[q] : 0u;
    __syncthreads();
    unsigned selmask = 0u, nsel = 0u, er = eqbase;
#pragma unroll
    for (int q = 0; q < 8; ++q) { bool s = v[q] > thr; if (v[q] == thr) { s = er < remaining; ++er; } selmask |= s ? (1u << q) : 0u; nsel += s ? 1u : 0u; }
    inc = nsel;
#pragma unroll
    for (int o = 1; o < 64; o <<= 1) { const unsigned t = __shfl_up(inc, o); inc += (lane >= o) ? t : 0u; }
    if (lane == 63) wtot[w] = inc;
    __syncthreads();
    unsigned pos = inc - nsel;
#pragma unroll
    for (int q = 0; q < 8; ++q) pos += (q < w) ? wtot[q] : 0u;
    int* seltok = (int*)(ws + WS_SELTOK) + bx * CAP; float* selgate = (float*)(ws + WS_SELGATE) + bx * CAP;
#pragma unroll
    for (int q = 0; q < 8; ++q) if (selmask & (1u << q)) { if (pos < (unsigned)CAP) { seltok[pos] = tid * 8 + q; selgate[pos] = __uint_as_float(v[q]); } ++pos; }
    (void)cgt;
}

__device__ __forceinline__ void p11_gather(const Args& a, int gw, int NGW, int lane) {
    unsigned char* ws = a.ws;
    const float* h = a.out; const float* ss = (const float*)(ws + WS_SSP); const float* g = (const float*)(ws + WS_SMALL) + SM_FNG;
    const int* seltok = (const int*)(ws + WS_SELTOK); bf16_t* XE = (bf16_t*)(ws + WS_XE);
    for (int r = gw; r < NSLOT; r += NGW) {
        const int e = r >> 11, b = (r >> 9) & 3, c = r & 511;
        const int tok = seltok[(b * 16 + e) * CAP + c]; const size_t m = (size_t)b * SEQ + tok;
        const float rs = 1.0f / sqrtf(wave_sum(lane < 32 ? ss[m * 32 + lane] : 0.f) * (1.0f / DM) + RMS_EPS);
        const float4* hr = (const float4*)(h + m * DM) + lane; v2u* o = (v2u*)(XE + (size_t)r * DM) + lane;
#pragma unroll
        for (int j = 0; j < 8; ++j) { const float4 hv = hr[64 * j], gg = ((const float4*)g)[64 * j + lane];
            v2u w; w.x = pk2(hv.x * rs * gg.x, hv.y * rs * gg.y); w.y = pk2(hv.z * rs * gg.z, hv.w * rs * gg.w); o[64 * j] = w; }
    }
}

__device__ __forceinline__ void p14_combine(const Args& a, unsigned char* lds, int wave, int lane) {
    unsigned char* ws = a.ws;
    const int G = gridDim.x, bx = blockIdx.x, tid = fresh_tid();
    const int per = M / G;
    const int m0 = bx * per, b = m0 >> 12, t0 = m0 & (SEQ - 1);
    int* inv = (int*)lds;
    for (int i = tid; i < per * 16; i += NTHREADS) inv[i] = -1;
    __syncthreads();
    const int* seltok = (const int*)(ws + WS_SELTOK) + b * 16 * CAP;
    for (int i = tid; i < 16 * CAP; i += NTHREADS) { const int e = i >> 9, c = i & 511; const int tok = seltok[i]; const int tl = tok - t0;
        if (tl >= 0 && tl < per) inv[tl * 16 + e] = e * 2048 + b * 512 + c; }
    __syncthreads();
    const bf16_t* YE = (const bf16_t*)(ws + WS_XE);
    float* out = a.out;
    for (int tl = wave; tl < per; tl += NWAVES) {
        const size_t m = (size_t)m0 + tl;
        float4* orow = (float4*)(out + m * DM) + lane;
        float4 acc[8];
#pragma unroll
        for (int j = 0; j < 8; ++j) acc[j] = orow[64 * j];
        int sl[16]; int ns = 0;
#pragma unroll
        for (int e = 0; e < 16; ++e) { const int s_ = inv[tl * 16 + e]; if (s_ >= 0) { _Pragma("unroll") for (int q = 0; q < 16; ++q) if (q == ns) sl[q] = s_; ++ns; } }
        for (int q = 0; q < ns; q += 2) { int s0 = sl[0], s1 = sl[0];
#pragma unroll
            for (int z = 0; z < 16; ++z) { if (z == q) s0 = sl[z]; if (z == q + 1) s1 = sl[z]; }
            const bool two = q + 1 < ns;
            const v2u* y0 = (const v2u*)(YE + (size_t)s0 * DM) + lane; const v2u* y1 = (const v2u*)(YE + (size_t)(two ? s1 : s0) * DM) + lane;
            v2u w0[8], w1[8];
#pragma unroll
            for (int j = 0; j < 8; ++j) { w0[j] = y0[64 * j]; w1[j] = y1[64 * j]; }
#pragma unroll
            for (int j = 0; j < 8; ++j) { acc[j].x += bflo(w0[j].x); acc[j].y += bfhi(w0[j].x); acc[j].z += bflo(w0[j].y); acc[j].w += bfhi(w0[j].y);
                if (two) { acc[j].x += bflo(w1[j].x); acc[j].y += bfhi(w1[j].x); acc[j].z += bflo(w1[j].y); acc[j].w += bfhi(w1[j].y); } } }
#pragma unroll
        for (int j = 0; j < 8; ++j) orow[64 * j] = acc[j];
    }
}


namespace scan {
typedef short bf16x8 __attribute__((ext_vector_type(8)));
typedef float f32x4 __attribute__((ext_vector_type(4)));
constexpr int TILE_B = 64 * 128;
enum { SL_ATC = 0, SL_BTC = 1, SL_KTC = 2, SL_RTC = 3, SL_BBT = 4, SL_KBT = 5, SL_VT = 6, SL_XCA = 7, SL_TTA = 8, SL_NKA = 9, SL_NBRT = 10, SL_G = 11, SL_SB = 12, SL_RP = 13, SL_BBT1 = 14, SL_VT1 = 15, SL_NKR = 16,
       SL_XCB = 1, SL_TTB = 2, SL_APT = 7, SL_HT = 9, SL_PSIT = 8, SL_WB = 10 };
constexpr int OFF_PL = 17 * TILE_B, OFF_TOT = OFF_PL + 512, OFF_CNT = OFF_TOT + 4096;
#define TILE(s) (L + (s) * TILE_B)
__device__ __forceinline__ int swz16(int r) { return (((r & 7) ^ (((r >> 3) & 1) * 5)) << 4); }
__device__ __forceinline__ int toff(int row, int colbyte) { return row * 128 + (colbyte ^ swz16(row)); }
__device__ __forceinline__ bf16x8 frag(const LAS unsigned char* tile, int row0, int k0, int lane) {
    const int l15 = lane & 15, g4 = lane >> 4;
    return *(const LAS bf16x8*)(tile + row0 * 128 + l15 * 128 + (((g4 << 4) ^ swz16(l15)) ^ (k0 * 2)));
}
__device__ __forceinline__ void st4(LAS unsigned char* tile, int brow, int acol0, const f32x4& v) {
    v2u w; w.x = pg8::cvt_pk_bf16(v[0], v[1]); w.y = pg8::cvt_pk_bf16(v[2], v[3]); *(LAS v2u*)(tile + toff(brow, acol0 * 2)) = w;
}
__device__ __forceinline__ f32x4 ld4(const LAS unsigned char* tile, int brow, int acol0) {
    const v2u w = *(const LAS v2u*)(tile + toff(brow, acol0 * 2)); return (f32x4){bflo(w.x), bfhi(w.x), bflo(w.y), bfhi(w.y)};
}
typedef short v4i16_t __attribute__((ext_vector_type(4)));
typedef short bf16x4 __attribute__((ext_vector_type(4)));
typedef float f32x2 __attribute__((ext_vector_type(2)));
__device__ __forceinline__ bf16x8 fragT(const LAS unsigned char* tileT, int row0, int k0, int lane) {
    const int g = lane >> 4, q = (lane >> 2) & 3, p = lane & 3;
    const int t0 = (8 * g + q) * 128 + ((8 * p) ^ ((q ^ ((g & 1) * 5)) << 4));
    const LAS unsigned char* a = tileT + k0 * 128;
    const v4i16_t lo = __builtin_amdgcn_ds_read_tr16_b64_v4i16((LAS v4i16_t*)(a + (t0 ^ (row0 * 2)))), hi = __builtin_amdgcn_ds_read_tr16_b64_v4i16((LAS v4i16_t*)(a + 512 + ((t0 ^ 64) ^ (row0 * 2))));
    return (bf16x8){lo[0], lo[1], lo[2], lo[3], hi[0], hi[1], hi[2], hi[3]};
}
struct Fr { bf16x8 k0, k1; };
__device__ __forceinline__ Fr ldf(const LAS unsigned char* tile, int row0, int lane) { Fr f; f.k0 = frag(tile, row0, 0, lane); f.k1 = frag(tile, row0, 32, lane); return f; }
__device__ __forceinline__ Fr ldfT(const LAS unsigned char* tileT, int row0, int lane) { Fr f; f.k0 = fragT(tileT, row0, 0, lane); f.k1 = fragT(tileT, row0, 32, lane); return f; }
__device__ __forceinline__ void mmf(f32x4& acc, const Fr& A, const Fr& B) {
    acc = __builtin_amdgcn_mfma_f32_16x16x32_bf16(A.k0, B.k0, acc, 0, 0, 0); acc = __builtin_amdgcn_mfma_f32_16x16x32_bf16(A.k1, B.k1, acc, 0, 0, 0);
}
#define ZERO4 ((f32x4){0.f, 0.f, 0.f, 0.f})
#ifndef TP_SEL
#define TP_SEL -1
#endif
#ifndef TP_WAVE
#define TP_WAVE 0
#endif
#if TP_SEL >= 0
#define TP_MARK(k) do { if (w == TP_WAVE) { const unsigned long long t_ = __builtin_amdgcn_s_memtime(); if (TP_SEL == (k) || TP_SEL == 7) tp_acc += t_ - tp_last; tp_last = t_; } } while (0)
#else
#define TP_MARK(k) do { } while (0)
#endif
__device__ __forceinline__ int opq(int x) { asm volatile("" : "+v"(x)); return x; }
#define LWAIT() asm volatile("s_waitcnt lgkmcnt(0)" ::: "memory")

__device__ __forceinline__ void scan_phase(const Args& a, unsigned char* ldsg) {
    const int bx = blockIdx.x; if (bx >= 128) return;
    LAS unsigned char* L = (LAS unsigned char*)ldsg;
    const int tid = fresh_tid(), lane0 = tid & 63, w = __builtin_amdgcn_readfirstlane(tid >> 6);
    const int dir = bx >> 6, b = (bx >> 4) & 3, hh = bx & 15;
    unsigned char* ws = a.ws;
    bf16_t* YS = (bf16_t*)((unsigned char*)a.out + (dir ? DO_YSB : DO_YSF));
    const int ta = w >> 1, tb0 = (w & 1) * 2;
#define STAGE_LANE() const int lane = opq(lane0), g4 = lane >> 4, l15 = lane & 15, a0 = ta * 16 + 4 * g4
    unsigned rw[8][5]; float inr[8];
    const int wk = w & 3, tg = lane0 >> 5, cp = lane0 & 31;
    const unsigned char* RKVh = ws + WS_RKV + hh * 128; const unsigned char* LWh = ws + WS_LORA + (size_t)dir * ((size_t)M * 2048) + hh * 128; const unsigned char* ALh = ws + WS_LORA + (size_t)(2 + dir) * ((size_t)M * 2048) + hh * 128;
    const int tlane = dir ? (1 - tg) * 8 : tg * 8;
    const unsigned vR = (unsigned)(tlane * 6144 + cp * 4), vL = (unsigned)(tlane * 2048 + cp * 4), vI = (unsigned)(tlane * 64);
    const float* INRM = (const float*)(ws + WS_INRM) + hh;
    const f32x2 kkc2 = *(const f32x2*)((const float*)(ws + WS_SMALL) + SM_KK + hh * 64 + 2 * cp), kac2 = *(const f32x2*)((const float*)(ws + WS_SMALL) + SM_KA + hh * 64 + 2 * cp);
#define RAW_LOAD(chunk, j0) do { _Pragma("unroll") for (int j = (j0); j < (j0) + 4; ++j) { const int s_ = (chunk) * 64 + wk * 16 + j; const int t_ = dir ? (SEQ - 1 - s_ - 8) : s_; const size_t m_ = (size_t)b * SEQ + t_; \
        const unsigned char* pr_ = RKVh + m_ * 6144; const unsigned char* pl_ = LWh + m_ * 2048; const unsigned char* pa_ = ALh + m_ * 2048; \
        rw[j][0] = *(const unsigned*)(pr_ + vR); rw[j][1] = *(const unsigned*)(pr_ + 2048 + vR); rw[j][2] = *(const unsigned*)(pr_ + 4096 + vR); rw[j][3] = *(const unsigned*)(pl_ + vL); rw[j][4] = *(const unsigned*)(pa_ + vL); \
        inr[j] = *(const float*)((const unsigned char*)(INRM + m_ * 16) + vI); } } while (0)
#define DSUM(n) do { const int l2_ = fresh_tid() & 63, tg_ = l2_ >> 5, cp_ = l2_ & 31; \
        f32x2 run_ = {0.f, 0.f}; _Pragma("unroll") for (int j = 0; j < 8; ++j) run_ += (f32x2){bflo(rw[j][3]), bfhi(rw[j][3])}; \
        *(LAS f32x2*)(L + OFF_TOT + ((((n) & 1) * 8 + 2 * wk + tg_) * 64 + 2 * cp_) * 4) = run_; \
        LWAIT(); \
        if (l2_ == 0) __hip_atomic_fetch_add((unsigned*)(L + OFF_CNT), 1u, __ATOMIC_RELAXED, __HIP_MEMORY_SCOPE_WORKGROUP); \
        while (*(volatile LAS unsigned*)(L + OFF_CNT) < 4u * (unsigned)((n) + 1)) __builtin_amdgcn_s_sleep(1); } while (0)
    f32x2 prun, ppv, ppl; unsigned pk[6][2][4], vt[2][4];
#define PTOK(jp) do { f32x2 o[2][6]; \
        _Pragma("unroll") for (int h = 0; h < 2; ++h) { const int j = 2 * (jp) + h; \
            prun += (f32x2){bflo(rw[j][3]), bfhi(rw[j][3])} * 1.44269504f; \
            const f32x2 p = {__builtin_amdgcn_exp2f(prun[0]), __builtin_amdgcn_exp2f(prun[1])}, em = {__builtin_amdgcn_rcpf(p[0]), __builtin_amdgcn_rcpf(p[1])}, eL = ppl * em; \
            const f32x2 r = {bflo(rw[j][0]), bfhi(rw[j][0])}, k = {bflo(rw[j][1]), bfhi(rw[j][1])}, al = {bflo(rw[j][4]), bfhi(rw[j][4])}; \
            const f32x2 kk = k * kkc2 * inr[j], kdv = k * (1.0f + (al - 1.0f) * kac2), bbj = kk * al; \
            o[h][0] = -kk * ppv; ppv = p; o[h][1] = bbj * em; o[h][2] = kdv * em; o[h][3] = r * p; o[h][4] = bbj * eL; o[h][5] = kdv * eL; } \
        _Pragma("unroll") for (int q = 0; q < 6; ++q) { pk[q][0][jp] = pk2(o[0][q][0], o[1][q][0]); pk[q][1][jp] = pk2(o[0][q][1], o[1][q][1]); } \
        vt[0][jp] = (rw[2 * (jp)][2] & 0xffffu) | (rw[2 * (jp) + 1][2] << 16); vt[1][jp] = (rw[2 * (jp)][2] >> 16) | (rw[2 * (jp) + 1][2] & 0xffff0000u); } while (0)
#define PREP1(n) do { const int l2_ = fresh_tid() & 63, tg_ = l2_ >> 5, cp_ = l2_ & 31; \
        f32x2 run = {0.f, 0.f}, tot = {0.f, 0.f}; \
        _Pragma("unroll") for (int q = 0; q < 8; ++q) { const f32x2 t_ = *(const LAS f32x2*)(L + OFF_TOT + ((((n) & 1) * 8 + q) * 64 + 2 * cp_) * 4); \
            const float m_ = (q < 2 * wk + tg_) ? 1.0f : 0.f; run += t_ * m_; tot += t_; } \
        run *= 1.44269504f; tot *= 1.44269504f;                                                                \
        ppl = (f32x2){__builtin_amdgcn_exp2f(tot[0]), __builtin_amdgcn_exp2f(tot[1])}; \
        if (wk == 0 && tg_ == 0) *(LAS f32x2*)(L + OFF_PL + (((n) & 1) * 64 + 2 * cp_) * 4) = ppl; \
        prun = run; ppv = (f32x2){__builtin_amdgcn_exp2f(run[0]), __builtin_amdgcn_exp2f(run[1])}; \
        PTOK(0); PTOK(1); } while (0)
#define PREP2(n) do { const int l2_ = fresh_tid() & 63, tg_ = l2_ >> 5, cp_ = l2_ & 31; \
        PTOK(2); PTOK(3); \
        LAS unsigned char* bbt_ = TILE(((n) & 1) ? SL_BBT1 : SL_BBT); LAS unsigned char* vt_ = TILE(((n) & 1) ? SL_VT1 : SL_VT); \
        _Pragma("unroll") for (int x = 0; x < 2; ++x) { const int o16 = toff(2 * cp_ + x, (wk * 16 + tg_ * 8) * 2); \
            *(LAS v4u*)(TILE(SL_ATC) + o16) = (v4u){pk[0][x][0], pk[0][x][1], pk[0][x][2], pk[0][x][3]}; *(LAS v4u*)(TILE(SL_BTC) + o16) = (v4u){pk[1][x][0], pk[1][x][1], pk[1][x][2], pk[1][x][3]}; \
            *(LAS v4u*)(TILE(SL_KTC) + o16) = (v4u){pk[2][x][0], pk[2][x][1], pk[2][x][2], pk[2][x][3]}; *(LAS v4u*)(TILE(SL_RTC) + o16) = (v4u){pk[3][x][0], pk[3][x][1], pk[3][x][2], pk[3][x][3]}; \
            *(LAS v4u*)(bbt_ + o16) = (v4u){pk[4][x][0], pk[4][x][1], pk[4][x][2], pk[4][x][3]}; *(LAS v4u*)(TILE(SL_KBT) + o16) = (v4u){pk[5][x][0], pk[5][x][1], pk[5][x][2], pk[5][x][3]}; \
            *(LAS v4u*)(vt_ + o16) = (v4u){vt[x][0], vt[x][1], vt[x][2], vt[x][3]}; } \
    } while (0)
#if TP_SEL >= 0
    unsigned long long tp_acc = 0, tp_last = __builtin_amdgcn_s_memtime();
#endif
    f32x4 accS[4];
#pragma unroll
    for (int q = 0; q < 4; ++q) accS[q] = (f32x4){0.f, 0.f, 0.f, 0.f};
    for (int u = tid; u < TILE_B / 16; u += NTHREADS) ((LAS v4u*)TILE(SL_SB))[u] = (v4u){0u, 0u, 0u, 0u};
    if (tid == 0) *(LAS unsigned*)(L + OFF_CNT) = 0u;
    if (w >= 4) { RAW_LOAD(0, 0); RAW_LOAD(0, 4); }
    __syncthreads();
    if (w >= 4) { DSUM(0); PREP1(0); PREP2(0); }
#pragma unroll 1
    for (int c = 0; c < SEQ / 64; ++c) {
        LAS unsigned char* BBTc = TILE((c & 1) ? SL_BBT1 : SL_BBT); LAS unsigned char* VTc = TILE((c & 1) ? SL_VT1 : SL_VT);
        TP_MARK(5);
        __syncthreads();
        TP_MARK(0);
        if (w >= 4 && c + 1 < SEQ / 64) { RAW_LOAD(c + 1, 0); RAW_LOAD(c + 1, 4); }
        {   STAGE_LANE();
            const int p = w & 3;
            LAS unsigned char* As = TILE((p == 0 || p == 2) ? SL_BTC : SL_KTC); LAS unsigned char* Bs = TILE(p < 2 ? SL_ATC : SL_RTC);
            LAS unsigned char* Ds = TILE(p == 0 ? SL_XCA : p == 1 ? SL_NKA : p == 2 ? SL_NBRT : SL_NKR);
            const int lim = l15 + (p < 2 ? 0 : 1) - 4 * g4;
#define S1_MASK(dv) do { _Pragma("unroll") for (int e = 0; e < 4; ++e) (dv)[e] = (e < lim) ? (dv)[e] : 0.f; } while (0)
#define S1_EYE(dv) do { _Pragma("unroll") for (int e = 0; e < 4; ++e) (dv)[e] += (e == l15 - 4 * g4) ? 1.0f : 0.f; } while (0)
            if (w < 4) {
                const Fr a0f = ldfT(As, 0, lane), a1f = ldfT(As, 16, lane); Fr bf[4];
#pragma unroll
                for (int j = 0; j < 4; ++j) bf[j] = ldfT(Bs, j * 16, lane);
                f32x4 d0[4], d1[3];
#pragma unroll
                for (int j = 0; j < 4; ++j) { d0[j] = ZERO4; mmf(d0[j], a0f, bf[j]); }
#pragma unroll
                for (int j = 0; j < 3; ++j) { d1[j] = ZERO4; mmf(d1[j], a1f, bf[j + 1]); }
                S1_MASK(d0[0]); S1_MASK(d1[0]);
#pragma unroll
                for (int j = 0; j < 4; ++j) st4(Ds, j * 16 + l15, 4 * g4, d0[j]);
#pragma unroll
                for (int j = 0; j < 3; ++j) st4(Ds, (j + 1) * 16 + l15, 16 + 4 * g4, d1[j]);
                if (p == 0) { S1_EYE(d0[0]); S1_EYE(d1[0]);
#pragma unroll
                    for (int j = 0; j < 4; ++j) st4(TILE(SL_TTA), j * 16 + l15, 4 * g4, d0[j]);
#pragma unroll
                    for (int j = 0; j < 3; ++j) st4(TILE(SL_TTA), (j + 1) * 16 + l15, 16 + 4 * g4, d1[j]); }
            } else {
                const Fr a2f = ldfT(As, 32, lane), a3f = ldfT(As, 48, lane), b2f = ldfT(Bs, 32, lane), b3f = ldfT(Bs, 48, lane);
                f32x4 d22 = ZERO4, d23 = ZERO4, d33 = ZERO4;
                mmf(d22, a2f, b2f); mmf(d23, a2f, b3f); mmf(d33, a3f, b3f);
                S1_MASK(d22); S1_MASK(d33);
                st4(Ds, 32 + l15, 32 + 4 * g4, d22); st4(Ds, 48 + l15, 32 + 4 * g4, d23); st4(Ds, 48 + l15, 48 + 4 * g4, d33);
                if (p < 3) { LAS unsigned char* Zs = p == 0 ? TILE(SL_TTA) : Ds; const f32x4 z = ZERO4;
                    st4(Zs, l15, 16 + 4 * g4, z); st4(Zs, l15, 32 + 4 * g4, z); st4(Zs, l15, 48 + 4 * g4, z); st4(Zs, 16 + l15, 32 + 4 * g4, z); st4(Zs, 16 + l15, 48 + 4 * g4, z); st4(Zs, 32 + l15, 48 + 4 * g4, z); }
                if (p == 0) { const f32x4 z = ZERO4; st4(Ds, l15, 16 + 4 * g4, z); st4(Ds, 32 + l15, 48 + 4 * g4, z);
                    S1_EYE(d22); S1_EYE(d33); st4(TILE(SL_TTA), 32 + l15, 32 + 4 * g4, d22); st4(TILE(SL_TTA), 48 + l15, 32 + 4 * g4, d23); st4(TILE(SL_TTA), 48 + l15, 48 + 4 * g4, d33); }
            }
#undef S1_MASK
#undef S1_EYE
        }
        __syncthreads();
        TP_MARK(1);
        if (w < 2) {
            STAGE_LANE();
            const int d = w, s0 = 2 * d, s1 = 2 * d + 1, kd = 32 * d;
#define CAT(lo, hi) ((bf16x8)__builtin_shufflevector(lo, hi, 0, 1, 2, 3, 4, 5, 6, 7))
#define CV4(v) __builtin_bit_cast(bf16x4, (v2u){pk2((v)[0], (v)[1]), pk2((v)[2], (v)[3])})
#define MM(A, B, C) __builtin_amdgcn_mfma_f32_16x16x32_bf16(A, B, C, 0, 0, 0)
            const bf16x4 z4 = {0, 0, 0, 0};
            bf16x8 AF0 = fragT(TILE(SL_XCA), s0 * 16, kd, lane), AF1 = fragT(TILE(SL_XCA), s1 * 16, kd, lane);
            bf16x8 BF0 = frag(TILE(SL_XCA), s0 * 16, kd, lane), BF1 = frag(TILE(SL_XCA), s1 * 16, kd, lane);
            f32x4 t00 = ld4(TILE(SL_TTA), s0 * 16 + l15, s0 * 16 + 4 * g4), t01 = ld4(TILE(SL_TTA), s1 * 16 + l15, s0 * 16 + 4 * g4), t11 = ld4(TILE(SL_TTA), s1 * 16 + l15, s1 * 16 + 4 * g4);
            f32x4 l02, l03, l12, l13;
            if (w == 0) {
                l02 = ld4(TILE(SL_TTA), 32 + l15, 4 * g4); l03 = ld4(TILE(SL_TTA), 48 + l15, 4 * g4); l12 = ld4(TILE(SL_TTA), 32 + l15, 16 + 4 * g4); l13 = ld4(TILE(SL_TTA), 48 + l15, 16 + 4 * g4);
                const bf16x8 C2 = frag(TILE(SL_TTA), 32, 0, lane), C3 = frag(TILE(SL_TTA), 48, 0, lane);
                l02 = MM(AF0, C2, l02); l03 = MM(AF0, C3, l03); l12 = MM(AF1, C2, l12); l13 = MM(AF1, C3, l13);
            }
#pragma unroll
            for (int r = 0; r <= 4; ++r) {
                if (r >= 1) {
                    const bf16x8 BT0 = CAT(CV4(t00), z4), BT1 = CAT(CV4(t01), CV4(t11));
                    if (w == 0) { const bf16x8 BL2 = CAT(CV4(l02), CV4(l12)), BL3 = CAT(CV4(l03), CV4(l13));
                        l02 = MM(AF0, BL2, l02); l03 = MM(AF0, BL3, l03); l12 = MM(AF1, BL2, l12); l13 = MM(AF1, BL3, l13); }
                    t00 = MM(AF0, BT0, t00); t01 = MM(AF0, BT1, t01); t11 = MM(AF1, BT1, t11);
                }
                if (r < 4) {
                    const f32x4 x00 = MM(AF0, BF0, ZERO4), x01 = MM(AF0, BF1, ZERO4), x11 = MM(AF1, BF1, ZERO4);
                    const f32x4 y00 = MM(BF0, AF0, ZERO4), y10 = MM(BF1, AF0, ZERO4), y11 = MM(BF1, AF1, ZERO4);
                    BF0 = CAT(CV4(x00), z4); BF1 = CAT(CV4(x01), CV4(x11));
                    AF0 = CAT(CV4(y00), CV4(y10)); AF1 = CAT(z4, CV4(y11));
                }
            }
            st4(TILE(SL_TTA), s0 * 16 + l15, s0 * 16 + 4 * g4, t00); st4(TILE(SL_TTA), s1 * 16 + l15, s0 * 16 + 4 * g4, t01); st4(TILE(SL_TTA), s1 * 16 + l15, s1 * 16 + 4 * g4, t11);
            if (w == 0) { st4(TILE(SL_TTA), 32 + l15, 4 * g4, l02); st4(TILE(SL_TTA), 48 + l15, 4 * g4, l03); st4(TILE(SL_TTA), 32 + l15, 16 + 4 * g4, l12); st4(TILE(SL_TTA), 48 + l15, 16 + 4 * g4, l13); }
#undef CAT
#undef CV4
#undef MM
        }
        else if (w >= 4 && c + 1 < SEQ / 64) { DSUM(c + 1); PREP1(c + 1); }
        __syncthreads();
        if (w < 2) {
            STAGE_LANE();
            const bf16x8 A = fragT(TILE(SL_TTA), w * 16, 32, lane), B2 = frag(TILE(SL_TTA), 32, 32, lane), B3 = frag(TILE(SL_TTA), 48, 32, lane);
            const f32x4 u2 = __builtin_amdgcn_mfma_f32_16x16x32_bf16(A, B2, ZERO4, 0, 0, 0), u3 = __builtin_amdgcn_mfma_f32_16x16x32_bf16(A, B3, ZERO4, 0, 0, 0);
            st4(TILE(SL_TTA), 32 + l15, w * 16 + 4 * g4, u2); st4(TILE(SL_TTA), 48 + l15, w * 16 + 4 * g4, u3);
        }
        __syncthreads();
        TP_MARK(2);
        {   STAGE_LANE();
            const Fr aATC = ldf(TILE(SL_ATC), ta * 16, lane), aTT = ldf(TILE(SL_TTA), ta * 16, lane); Fr bTT[2], bNKA[2];
#pragma unroll
            for (int q = 0; q < 2; ++q) { bTT[q] = ldf(TILE(SL_TTA), (tb0 + q) * 16, lane); bNKA[q] = ldfT(TILE(SL_NKA), (tb0 + q) * 16, lane); }
            f32x4 e1[2], e3[2];
#pragma unroll
            for (int q = 0; q < 2; ++q) { e1[q] = ZERO4; e3[q] = ZERO4;
                mmf(e1[q], aATC, bTT[q]);
                mmf(e3[q], aTT, bNKA[q]); }
#pragma unroll
            for (int q = 0; q < 2; ++q) { const int bcol = (tb0 + q) * 16 + l15; st4(TILE(SL_APT), bcol, a0, e1[q]); st4(TILE(SL_G), bcol, a0, e3[q]); }
        }
        __syncthreads();
        TP_MARK(3);
        {   STAGE_LANE();
            const Fr aNB = ldf(TILE(SL_NBRT), ta * 16, lane), aG = ldf(TILE(SL_G), ta * 16, lane); Fr bAP[2], bNB[2], bBB[2]; f32x4 rp[2], ps[2], accH[2];
#pragma unroll
            for (int q = 0; q < 2; ++q) { const int bcol = (tb0 + q) * 16 + l15; bAP[q] = ldfT(TILE(SL_APT), (tb0 + q) * 16, lane); bNB[q] = ldf(TILE(SL_NBRT), (tb0 + q) * 16, lane); bBB[q] = ldf(BBTc, (tb0 + q) * 16, lane);
                rp[q] = ld4(TILE(SL_RTC), bcol, a0); ps[q] = ld4(TILE(SL_KBT), bcol, a0); accH[q] = ld4(TILE(SL_NKR), bcol, a0); if (ta > tb0 + q) accH[q] = ZERO4; }
#pragma unroll
            for (int q = 0; q < 2; ++q) { mmf(rp[q], aNB, bAP[q]);
                mmf(accH[q], aG, bNB[q]);
                mmf(ps[q], aG, bBB[q]); }
#pragma unroll
            for (int q = 0; q < 2; ++q) { const int bcol = (tb0 + q) * 16 + l15;
                st4(TILE(SL_RP), bcol, a0, rp[q]); st4(TILE(SL_HT), bcol, a0, accH[q]); st4(TILE(SL_PSIT), bcol, a0, ps[q]); }
        }
        __syncthreads();
        TP_MARK(4);
        if (w < 4) {
            STAGE_LANE();
            const int vrow = w * 16 + l15;
            const Fr fS = ldf(TILE(SL_SB), w * 16, lane), fV = ldf(VTc, w * 16, lane);
            f32x4 wv[4], yv[4];
            {
                Fr fAPT[4];
#pragma unroll
                for (int q = 0; q < 4; ++q) fAPT[q] = ldf(TILE(SL_APT), q * 16, lane);
#pragma unroll
                for (int q = 0; q < 4; ++q) { wv[q] = ZERO4; mmf(wv[q], fAPT[q], fS); }
#pragma unroll
                for (int q = 0; q < 4; ++q) st4(TILE(SL_WB), vrow, q * 16 + 4 * g4, wv[q]);
            }
            {
                Fr fRPT[4], fHT[4];
#pragma unroll
                for (int q = 0; q < 4; ++q) { fRPT[q] = ldfT(TILE(SL_RP), q * 16, lane); fHT[q] = ldf(TILE(SL_HT), q * 16, lane); }
#pragma unroll
                for (int q = 0; q < 4; ++q) { yv[q] = ZERO4; mmf(yv[q], fS, fRPT[q]); mmf(yv[q], fV, fHT[q]); }
#pragma unroll
                for (int q = 0; q < 4; ++q) { const int s_ = c * 64 + q * 16 + l15; const int t_ = dir ? (SEQ - 1 - s_) : s_;
                    v2u o; o.x = pg8::cvt_pk_bf16(yv[q][0], yv[q][1]); o.y = pg8::cvt_pk_bf16(yv[q][2], yv[q][3]);
                    *(v2u*)(YS + ((size_t)b * SEQ + t_) * 1024 + hh * 64 + w * 16 + 4 * g4) = o; }
            }
            {
                Fr fPS[4];
#pragma unroll
                for (int q = 0; q < 4; ++q) fPS[q] = ldf(TILE(SL_PSIT), q * 16, lane);
#pragma unroll
                for (int q = 0; q < 4; ++q) { const f32x4 pl = *(const LAS f32x4*)(L + OFF_PL + ((c & 1) * 64 + q * 16 + 4 * g4) * 4); accS[q] = accS[q] * pl; mmf(accS[q], fPS[q], fV); }
                LWAIT();
                const Fr fW = ldf(TILE(SL_WB), w * 16, lane); Fr fBB[4];
#pragma unroll
                for (int q = 0; q < 4; ++q) fBB[q] = ldf(BBTc, q * 16, lane);
#pragma unroll
                for (int q = 0; q < 4; ++q) { mmf(accS[q], fBB[q], fW); st4(TILE(SL_SB), vrow, q * 16 + 4 * g4, accS[q]); }
            }
        } else if (c + 1 < SEQ / 64) { PREP2(c + 1); }
    }
#if TP_SEL >= 0
    if (bx == 0 && w == TP_WAVE && lane0 == 0) *(unsigned long long*)(ws + 760 * 1024) = tp_acc;
#endif
#undef RAW_LOAD
#undef STAGE_LANE
#undef PREP1
#undef PREP2
#undef PTOK
#undef DSUM
}
#undef TILE
#undef LWAIT
}
__global__ void __launch_bounds__(NTHREADS, 2) mega_fwd(Args a) {
    extern __shared__ __attribute__((aligned(16))) unsigned char lds[];
    cg::grid_group grid = cg::this_grid();
    const int G = gridDim.x, bx = blockIdx.x;
    const int vcu = (G % 8 == 0) ? (bx % 8) * (G / 8) + bx / 8 : bx;
    const int NGW = G * NWAVES;
#define WIDS() const int tid = fresh_tid(), lane = tid & 63, wave = __builtin_amdgcn_readfirstlane(tid >> 6), gw = vcu * NWAVES + wave; (void)lane; (void)gw
    unsigned char* ws = a.ws;
    LAS unsigned char* lds3 = (LAS unsigned char*)lds;
    const int lo = a.ph_lo, hi = a.ph_hi;
#ifndef ONLY
#define ONLY -1
#endif
#define IN(k) (lo <= (k) && (k) < hi && (ONLY < 0 || ONLY == (k)))
#ifndef PROBE_S
#define PROBE_S 0
#endif
#ifndef PROBE_A
#define PROBE_A 0
#endif
#ifndef DUPMASK
#define DUPMASK 0
#endif
#ifndef USE_CG
#define USE_CG 0
#endif
#define GRIDBAR(k) do { if (USE_CG || a.ph_hi > 1000) grid.sync(); else xcd_barrier(bar); } while (0)
#define SEAM(k) do { if (IN(k) && IN((k) + 1)) GRIDBAR(k); } while (0)
#define PH_BEGIN(k) if (IN(k)) for (int rep_ = 0; rep_ <= ((DUPMASK >> (k)) & 1); ++rep_) { if (rep_) GRIDBAR(1);
#define PH_END(k) } SEAM(k);
    for (int u = fresh_tid(); u < 64; u += NTHREADS) ((LAS unsigned*)(lds3 + MISC_OFF))[u] = 0u;
    __syncthreads();
    XcdBarrier bar = xcd_barrier_post((unsigned*)(ws + WS_BAR), (volatile LAS unsigned*)(lds3 + MISC_OFF) + 8);

    PH_BEGIN(0) { WIDS(); p0_prologue(a, lds3, gw, NGW, wave, lane); } PH_END(0)
    PH_BEGIN(1) {
        pg8::Gemm g{(const bf16_t*)(ws + WS_HN), (const bf16_t*)(ws + WS_WINT), DM, DM, DM}; pg8::StaticOrder S; S.init(M, IN_PAD, G, bx);
        pg8::EpiProj E{(bf16_t*)(ws + WS_PDA), (bf16_t*)((unsigned char*)a.out + DO_PRW), (bf16_t*)(ws + WS_GATES)};
        pg8::gemm_phase<pg8::EpiProj, pg8::StaticOrder, true, true>(lds3, g, S, E);
        if (G == 256 && bx >= 128) { WIDS(); expert_convert_down(a, lds3, (bx - 128) * NWAVES + wave, 128 * NWAVES, wave, lane); }
        else if (G != 256) { WIDS(); expert_convert_down(a, lds3, gw, NGW, wave, lane); }
    } PH_END(1)
    PH_BEGIN(2) { WIDS(); p2_prep(a, gw, NGW, lane); } PH_END(2)
    PH_BEGIN(3) {
        const bf16_t* LIN = (const bf16_t*)((unsigned char*)a.out + DO_LIN);
        { pg8::Gemm g{LIN, (const bf16_t*)(ws + WS_BTL1), 512, 256, 256}; pg8::StaticOrder S; S.init(M, 4096, G, bx);
          pg8::EpiLora<0> E{(bf16_t*)(ws + WS_LORA), (const float*)(ws + WS_BIAS4)};
          pg8::gemm_phase<pg8::EpiLora<0>, pg8::StaticOrder, true, true>(lds3, g, S, E); }
        { pg8::Gemm g{LIN + 256, (const bf16_t*)(ws + WS_BTL2), 512, 256, 256}; pg8::StaticOrder S; S.init(M, 1024, G, bx);
          pg8::EpiLora<1> E{(bf16_t*)(ws + WS_LORA), nullptr};
          pg8::gemm_phase<pg8::EpiLora<1>, pg8::StaticOrder, true, true>(lds3, g, S, E); }
    } PH_END(3)
    PH_BEGIN(4) { WIDS();
        const float* sm = (const float*)(ws + WS_SMALL); const float d1 = wave_sum(sm[SM_LQ1 + lane] * sm[SM_LK1 + lane]), d2 = wave_sum(sm[SM_LQ2 + lane] * sm[SM_LK2 + lane]);
        const float lam = __int_as_float(__builtin_amdgcn_readfirstlane(__float_as_int(__expf(d1) - __expf(d2) + LAM_INIT)));
        const bf16_t* PDA = (const bf16_t*)(ws + WS_PDA); bf16_t* YA = (bf16_t*)((unsigned char*)a.out + DO_YAB);
        if (G == 256) {
            int u0, nu;
            if (bx < 128) {
#if PROBE_S
                scan::scan_phase(a, lds); __syncthreads();
#endif
                scan::scan_phase(a, lds); __syncthreads(); const int i = (bx & 7) * 16 + (bx >> 3); u0 = 768 + 2 * i; nu = 2; }
            else { const int k = bx - 128, i = (k & 7) * 16 + (k >> 3); u0 = 6 * i; nu = 6; }
            attn::Stage stg[2];
            { const int bh = u0 >> 5, b = bh >> 3, h = bh & 7; const size_t row0 = (size_t)b * SEQ; attn::attn_prime(PDA + row0 * 3072 + 1024 + h * 128, PDA + row0 * 3072 + 2048 + h * 128, stg); }
            for (int q = (PROBE_A && bx >= 128) ? -1 : 0; q < nu; ++q) { const int u = u0 + (q < 0 ? 0 : q); const int bh = u >> 5, qb = u & 31, b = bh >> 3, h = bh & 7;
                const size_t row0 = (size_t)b * SEQ;
                const int un = (q + 1 < nu) ? u0 + q + 1 : u; const int bhn = un >> 5, bn = bhn >> 3, hn_ = bhn & 7; const size_t rown = (size_t)bn * SEQ;
                attn::attn_unit(PDA + (row0 + qb * 128) * 3072 + h * 128, PDA + row0 * 3072 + 1024 + h * 128, PDA + row0 * 3072 + 2048 + h * 128,
                                YA + (row0 + qb * 128) * 2048 + h * 128, lam, sm + SM_SUBLN, SEQ, (char*)lds, PDA + rown * 3072 + 1024 + hn_ * 128, PDA + rown * 3072 + 2048 + hn_ * 128, stg); }
            { __syncthreads(); const int t2 = fresh_tid(); const bool sb = bx < 128;
              expert_convert_gu(a, lds3, (sb ? bx : bx - 128) * NWAVES + (t2 >> 6), 128 * NWAVES, t2 >> 6, t2 & 63, sb ? 0 : N_EARLY_S, sb ? N_EARLY_S : N_EARLY_EXPERTS); }
        } else {
        const int upb = 1024 / G;
        for (int i = 0; i < upb; ++i) { const int u = vcu * upb + i; const int bh = u >> 5, qb = u & 31, b = bh >> 3, h = bh & 7;
            const size_t row0 = (size_t)b * SEQ;
            attn::Stage stg[2]; attn::attn_prime(PDA + row0 * 3072 + 1024 + h * 128, PDA + row0 * 3072 + 2048 + h * 128, stg);
            attn::attn_unit(PDA + (row0 + qb * 128) * 3072 + h * 128, PDA + row0 * 3072 + 1024 + h * 128, PDA + row0 * 3072 + 2048 + h * 128,
                            YA + (row0 + qb * 128) * 2048 + h * 128, lam, sm + SM_SUBLN, SEQ, (char*)lds, PDA + row0 * 3072 + 1024 + h * 128, PDA + row0 * 3072 + 2048 + h * 128, stg); }
        }
    } PH_END(4)
    if (G != 256) { PH_BEGIN(5) { scan::scan_phase(a, lds); } PH_END(5) }
    PH_BEGIN(6) { WIDS(); p6_rwpost(a, gw, NGW, lane); } PH_END(6)
    PH_BEGIN(7) {
        if (G == 256 && (bx & 1)) { WIDS(); expert_convert_gu(a, lds3, gw, NGW, wave, lane, N_EARLY_EXPERTS, N_P7_END); __syncthreads(); }
        bf16_t* MG = (bf16_t*)(ws + WS_MERGED); const bf16_t* GT = (const bf16_t*)(ws + WS_GATES);
        { pg8::Gemm g{(const bf16_t*)((unsigned char*)a.out + DO_YAB), (const bf16_t*)(ws + WS_WAT), DM, DM, DM}; pg8::StaticOrder S; S.init(M, DM, G, bx);
          pg8::EpiMergeF E{MG, GT}; pg8::gemm_phase<pg8::EpiMergeF, pg8::StaticOrder, true, true>(lds3, g, S, E); }
        if (G == 256 && !(bx & 1)) { WIDS(); __syncthreads(); expert_convert_gu(a, lds3, gw, NGW, wave, lane, N_EARLY_EXPERTS, N_P7_END); }
    } PH_END(7)
    PH_BEGIN(8) {
        if (G == 256 && !(bx & 1)) { WIDS(); expert_convert_gu(a, lds3, gw, NGW, wave, lane, N_P7_END, NE); __syncthreads(); }
        pg8::Gemm g{(const bf16_t*)(ws + WS_MERGED), (const bf16_t*)(ws + WS_WOT), DM, DM, DM}; pg8::StaticOrder S; S.init(M, DM, G, bx);
        pg8::EpiOut E{a.in[I_X], a.out, (float*)(ws + WS_SSP)};
        pg8::gemm_phase<pg8::EpiOut, pg8::StaticOrder, true, true>(lds3, g, S, E);
        if (G == 256 && (bx & 1)) { WIDS(); __syncthreads(); expert_convert_gu(a, lds3, gw, NGW, wave, lane, N_P7_END, NE); }
    } PH_END(8)
    PH_BEGIN(9) { WIDS(); p9_router(a, lds3, gw, NGW, wave, lane); } PH_END(9)
    PH_BEGIN(10) { p10_topk(a, lds); } PH_END(10)
    if (G != 256) { PH_BEGIN(11) { WIDS(); p11_gather(a, gw, NGW, lane); } PH_END(11) }
    PH_BEGIN(12) {
        pg8::EpiMoeUp E{(bf16_t*)(ws + WS_HID)};
        if (G == 256) {
            pg8::Gemm g{(const bf16_t*)(ws + WS_HN2), (const bf16_t*)ws, DM, DM, DM}; pg8::ExpertGatherOrder S{G, bx, (const int*)(ws + WS_SELTOK)};
            pg8::gemm_phase_g<pg8::EpiMoeUp, pg8::ExpertGatherOrder, true, true>(lds3, g, S, E);
        } else {
            pg8::Gemm g{(const bf16_t*)(ws + WS_XE), (const bf16_t*)(ws + WS_W1T), DM, DM, DM}; pg8::ExpertOrder S{G, bx};
            pg8::gemm_phase<pg8::EpiMoeUp, pg8::ExpertOrder, true, true>(lds3, g, S, E);
        }
    } PH_END(12)
    PH_BEGIN(13) {
        pg8::Gemm g{(const bf16_t*)(ws + WS_HID), (const bf16_t*)(ws + WS_WDT), FF, FF, FF}; pg8::ExpertOrder S{G, bx};
        pg8::EpiMoeDown E{(bf16_t*)(ws + WS_XE), (const float*)(ws + WS_SELGATE)};
        pg8::gemm_phase<pg8::EpiMoeDown, pg8::ExpertOrder, true, true>(lds3, g, S, E);
    } PH_END(13)
    PH_BEGIN(14) { WIDS(); p14_combine(a, lds, wave, lane); } }
#if TP_SEL >= 0
    if (a.ph_hi >= 15 && blockIdx.x == 0 && fresh_tid() == 0) { const unsigned long long d_ = 16ull * *(volatile unsigned long long*)(ws + 760 * 1024), t0_ = __builtin_amdgcn_s_memtime(); while (__builtin_amdgcn_s_memtime() - t0_ < d_) __builtin_amdgcn_s_sleep(8); }
#endif
#undef IN
#undef SEAM
}

constexpr int NPHASES = 15;
#ifndef MK_SPLIT
#define MK_SPLIT 0
#endif
extern "C" void kernel_launch(void* const* d_in, const int* in_sizes, int n_in, void* d_out, int out_size, void* d_ws, size_t ws_size, hipStream_t stream) {
    static int grid = 0;
    if (grid == 0) {
        if (n_in != 33 || in_sizes[0] != M * DM || out_size != M * DM || ws_size < WS_NEED) {
            fprintf(stderr, "kernel_launch: unexpected shapes: n_in %d in0 %d out %d ws %zu (need %zu)\n", n_in, n_in > 0 ? in_sizes[0] : -1, out_size, ws_size, (size_t)WS_NEED); grid = -1; return; }
        int dev = 0, cus = 0, per_cu = 0;
        if (hipGetDevice(&dev) != hipSuccess || hipDeviceGetAttribute(&cus, hipDeviceAttributeMultiprocessorCount, dev) != hipSuccess) { grid = -1; return; }
        if (hipFuncSetAttribute((const void*)mega_fwd, hipFuncAttributeMaxDynamicSharedMemorySize, LDS_BYTES) != hipSuccess) { fprintf(stderr, "kernel_launch: hipFuncSetAttribute failed\n"); grid = -1; return; }
        if (hipOccupancyMaxActiveBlocksPerMultiprocessor(&per_cu, (const void*)mega_fwd, NTHREADS, LDS_BYTES) != hipSuccess || per_cu < 1) { fprintf(stderr, "kernel_launch: occupancy query says %d\n", per_cu); (void)hipGetLastError(); per_cu = 1; }
        grid = cus;
        if (grid != 256) { fprintf(stderr, "kernel_launch: this kernel is built for a 256-CU MI355X (got %d CUs); nothing launched\n", grid); grid = -1; return; }
    }
    if (grid < 0) return;
    if (hipMemsetAsync((char*)d_ws + WS_BAR, 0, 16384, stream) != hipSuccess) { fprintf(stderr, "kernel_launch: memset failed\n"); return; }
    Args a{};
    for (int i = 0; i < 33; ++i) a.in[i] = (const float*)d_in[i];
    a.out = (float*)d_out; a.ws = (unsigned char*)d_ws;
#if MK_SPLIT
    for (int p = 0; p < NPHASES; ++p) { a.ph_lo = p; a.ph_hi = p + 1; void* args[] = {&a};
        hipError_t e = hipLaunchCooperativeKernel((const void*)mega_fwd, dim3(grid), dim3(NTHREADS), args, LDS_BYTES, stream);
        if (e != hipSuccess) { fprintf(stderr, "kernel_launch: launch of phase %d failed: %s\n", p, hipGetErrorString(e)); return; } }
#else
    a.ph_lo = 0; a.ph_hi = NPHASES; void* args[] = {&a};
    hipError_t e = hipLaunchCooperativeKernel((const void*)mega_fwd, dim3(grid), dim3(NTHREADS), args, LDS_BYTES, stream);
    if (e != hipSuccess) fprintf(stderr, "kernel_launch: cooperative launch failed: %s (grid %d)\n", hipGetErrorString(e), grid);
#endif
}
```

```cpp
#include <hip/hip_runtime.h>
#include <hip/hip_cooperative_groups.h>
#include <cstdio>
#include <cstdint>
namespace cg = cooperative_groups;

constexpr int NB = 4, SEQ = 4096, M = NB * SEQ, DM = 2048;
constexpr int DA_COLS = 3072, RW_COLS = 3488, RW_PAD = 3584, GATE_COLS = 4096, IN_COLS = 10656, IN_PAD = 10752;
constexpr int NE = 16, FF = 1024, CAP = 512, NSLOT = NB * NE * CAP;
constexpr float RMS_EPS = 1e-6f, GN_EPS = 64e-5f, LAM_INIT = 0.2f;
constexpr int NWAVES = 8, NTHREADS = 512;

constexpr size_t MiB = 1u << 20;
constexpr size_t WS_SSP = 5 * MiB;
constexpr size_t WS_SELTOK = 128 * 1024;
constexpr size_t WS_SELGATE = 256 * 1024;
constexpr size_t WS_BIAS4 = 512 * 1024;
constexpr size_t WS_SMALL = 576 * 1024;
constexpr int SM_QNG = 0, SM_KNG = 64, SM_LQ1 = 128, SM_LK1 = 192, SM_LQ2 = 256, SM_LK2 = 320, SM_SUBLN = 384, SM_MU = 512, SM_KK = 4096, SM_KA = 5120, SM_RK = 6144,
              SM_LNW = 7168, SM_LNB = 8192, SM_FNG = 9216, SM_WR = 11264, SM_END = 44032;
constexpr size_t WS_BAR = 768 * 1024;
constexpr size_t WS_INRM = 1 * MiB;
constexpr size_t WS_AFF = 1 * MiB;
constexpr size_t WS_ROPE = 7 * MiB;
constexpr size_t WS_BTL1 = 2 * MiB;
constexpr size_t WS_BTL2 = 4 * MiB;
constexpr size_t WS_WAT = 8 * MiB, WS_WBT = 12 * MiB, WS_WOT = 16 * MiB;
constexpr size_t WS_HN = 24 * MiB;
constexpr size_t WS_RKV = 24 * MiB;
constexpr size_t WS_WINT = 88 * MiB;
constexpr size_t WS_PDA = 130 * MiB;
constexpr size_t WS_MERGED = 130 * MiB;
constexpr size_t WS_GATES = 226 * MiB;
constexpr size_t WS_LORA = 354 * MiB;
constexpr size_t WS_END1 = 546 * MiB;
constexpr size_t WS_W1T = 24 * MiB;
__host__ __device__ __forceinline__ size_t w1t_base(int e) { return e < 4 ? (514 + 8 * (size_t)e) * MiB : e < 6 ? (610 + 8 * (size_t)(e - 4)) * MiB : e == 6 ? 120 * MiB : WS_W1T + 8 * (size_t)(e - 7) * MiB; }
constexpr int N_EARLY_EXPERTS = 7, N_EARLY_S = 5;
constexpr size_t WS_WDT = 546 * MiB;
constexpr size_t WS_XE = 216 * MiB;
constexpr size_t WS_HN2 = 216 * MiB;
constexpr size_t WS_HID = 344 * MiB;
constexpr size_t WS_NEED = 626 * MiB;
constexpr size_t DO_PRW = 0, DO_LIN = 112 * MiB, DO_YSF = 0, DO_YSB = 32 * MiB, DO_YAB = 64 * MiB;

constexpr int MISC_OFF = 155648;
constexpr int LDS_BYTES = 159744;

#define LAS __attribute__((address_space(3)))
typedef unsigned short bf16_t;
typedef unsigned v4u __attribute__((ext_vector_type(4)));
typedef unsigned v2u __attribute__((ext_vector_type(2)));

__device__ __forceinline__ int fresh_tid() { int t = threadIdx.x; asm volatile("" : "+v"(t)); return t; }
__device__ __forceinline__ float bf2f(unsigned short b) { return __builtin_bit_cast(float, (unsigned)b << 16); }
__device__ __forceinline__ float bflo(unsigned w) { return __builtin_bit_cast(float, w << 16); }
__device__ __forceinline__ float bfhi(unsigned w) { return __builtin_bit_cast(float, w & 0xffff0000u); }
__device__ __forceinline__ unsigned f2bf(float f) { unsigned u = __builtin_bit_cast(unsigned, f); return (u + 0x7fffu + ((u >> 16) & 1u)) >> 16; }
typedef float f32x2_t __attribute__((ext_vector_type(2))); typedef __bf16 bf16x2_t __attribute__((ext_vector_type(2)));
__device__ __forceinline__ unsigned pk2(float lo, float hi) { f32x2_t v = {lo, hi}; bf16x2_t b = __builtin_convertvector(v, bf16x2_t); return __builtin_bit_cast(unsigned, b); }
__device__ __forceinline__ float sigmoidf_(float x) { return __builtin_amdgcn_rcpf(1.0f + __expf(-x)); }
__device__ __forceinline__ float wave_sum(float v) {
#pragma unroll
    for (int o = 1; o < 64; o <<= 1) v += __shfl_xor(v, o);
    return v;
}
__device__ __forceinline__ float sum8(float v) { v += __shfl_xor(v, 1); v += __shfl_xor(v, 2); v += __shfl_xor(v, 4); return v; }
__device__ __forceinline__ void unpack8(const v4u& w, float (&f)[8]) {
    f[0] = bflo(w.x); f[1] = bfhi(w.x); f[2] = bflo(w.y); f[3] = bfhi(w.y); f[4] = bflo(w.z); f[5] = bfhi(w.z); f[6] = bflo(w.w); f[7] = bfhi(w.w);
}
__device__ __forceinline__ v4u pack8(const float (&f)[8]) { v4u w; w.x = pk2(f[0], f[1]); w.y = pk2(f[2], f[3]); w.z = pk2(f[4], f[5]); w.w = pk2(f[6], f[7]); return w; }

#define XB_TMO      128
#define XB_XCNT(j)  (256  + 64 * (j))
#define XB_XSUB(j)  (1280 + 64 * (j))
#define XB_XGEN(j)  (2304 + 64 * (j))
#define XB_TOP      3328
#define XB_TOPGEN   3392
#define XCD_BAR_WORDS 3456
#define XB_SPIN_CAP (1u << 18)

__device__ __forceinline__ unsigned xb_ld(unsigned* p)              { return __hip_atomic_load(p, __ATOMIC_RELAXED, __HIP_MEMORY_SCOPE_AGENT); }
__device__ __forceinline__ unsigned xb_add(unsigned* p, unsigned v) { return __hip_atomic_fetch_add(p, v, __ATOMIC_RELAXED, __HIP_MEMORY_SCOPE_AGENT); }
__device__ __forceinline__ unsigned xb_xcc_id() { return (unsigned)__builtin_amdgcn_s_getreg((3 << 11) | 20) & 0xFu; }
#define XB_SPIN(cond, bar) do { unsigned _sp = 0; while (cond) { __builtin_amdgcn_s_sleep(1); \
    if ((++_sp & 255u) == 0u) { if (xb_ld(&(bar)[XB_TMO])) break; if (_sp > XB_SPIN_CAP) { atomicAdd(&(bar)[XB_TMO], 1u); break; } } } } while (0)

struct XcdBarrier {
    unsigned* bar; unsigned x;
    volatile LAS unsigned* st;
};

__device__ __forceinline__ XcdBarrier xcd_barrier_post(unsigned* bar, volatile LAS unsigned* st) {
    XcdBarrier b; b.bar = bar; b.x = xb_xcc_id(); b.st = st;
    if (threadIdx.x == 0) (void)xb_add(&bar[XB_XCNT(b.x)], 1u);
    return b;
}
__device__ __forceinline__ void xcd_barrier_complete(unsigned* bar, unsigned x, unsigned& nloc, unsigned& nx) {
    const unsigned G = gridDim.x * gridDim.y * gridDim.z;
    unsigned sum, cnt, mine, sp = 0u;
    for (;;) {
        sum = 0u; cnt = 0u; mine = 0u;
#pragma unroll
        for (unsigned j = 0; j < 16; ++j) { const unsigned c = xb_ld(&bar[XB_XCNT(j)]); sum += c; cnt += (c > 0u) ? 1u : 0u; mine = (j == x) ? c : mine; }
        if (sum == G) break;
        __builtin_amdgcn_s_sleep(1);
        if ((++sp & 255u) == 0u) { if (xb_ld(&bar[XB_TMO])) break; if (sp > XB_SPIN_CAP) { atomicAdd(&bar[XB_TMO], 1u); break; } }
    }
    nloc = mine > 0u ? mine : 1u; nx = cnt > 0u ? cnt : 1u;
}

__device__ __forceinline__ void xcd_barrier(const XcdBarrier& b) {
    asm volatile("s_waitcnt vmcnt(0)" ::: "memory");
    __syncthreads();
    if (threadIdx.x == 0) {
        unsigned* bar = b.bar;
        __builtin_amdgcn_s_waitcnt(0);
        unsigned nloc = b.st[0], nx = b.st[1];
        if (nloc == 0u) { xcd_barrier_complete(bar, b.x, nloc, nx); b.st[0] = nloc; b.st[1] = nx; }
        const unsigned old = xb_add(&bar[XB_XSUB(b.x)], 1u);
        const unsigned gen = old / nloc;
        if (old + 1u == (gen + 1u) * nloc) {
            __builtin_amdgcn_fence(__ATOMIC_RELEASE, "agent");
            asm volatile("s_waitcnt vmcnt(0)" ::: "memory");
            const unsigned og = xb_add(&bar[XB_TOP], 1u);
            const unsigned tg = og / nx;
            if (og + 1u == (tg + 1u) * nx) xb_add(&bar[XB_TOPGEN], 1u);
            else XB_SPIN(xb_ld(&bar[XB_TOPGEN]) == tg, bar);
            __builtin_amdgcn_fence(__ATOMIC_ACQUIRE, "agent");
            xb_add(&bar[XB_XGEN(b.x)], 1u);
            asm volatile("s_waitcnt vmcnt(0)" ::: "memory");
        } else {
            XB_SPIN(xb_ld(&bar[XB_XGEN(b.x)]) == gen, bar);
            __builtin_amdgcn_fence(__ATOMIC_ACQUIRE, "agent");
            asm volatile("s_waitcnt vmcnt(0)" ::: "memory");
        }
    }
    __syncthreads();
}
namespace pg8 {
#define PG8_LAS __attribute__((address_space(3)))
typedef unsigned short bf16_t;
typedef short bf16x8 __attribute__((ext_vector_type(8)));
typedef float f32x4 __attribute__((ext_vector_type(4)));
typedef unsigned u32x4 __attribute__((ext_vector_type(4)));
constexpr int BM = 256, BK = 64, HALF = 128, HTB = HALF * BK * 2  , STAGE_BYTES = 8 * HTB, NXCD = 8, WGM = 4;

__host__ __device__ __forceinline__ int lds_byte(int r, int c) { const int st = (r >> 4) * 2 + (c >> 5), rr = r & 15, cc = c & 31, ob = rr * 64 + cc * 2; return st * 1024 + (ob ^ (((ob >> 9) & 1) << 5)); }
__host__ __device__ __forceinline__ void stage_rc(int b, int& R, int& C) { const int st = b / 1024, sb = b % 1024, swz = sb ^ (((sb >> 9) & 1) << 5); R = (st >> 1) * 16 + swz / 64; C = (st & 1) * 32 + (swz % 64) / 2; }
__host__ __device__ __forceinline__ int perm32(int rho) { const int n = rho >> 4, i = rho & 15; return 8 * (i >> 2) + 4 * n + (i & 3); }

struct Unit { int pm, pn; };
struct Gemm { const bf16_t* A; const bf16_t* Bt; int lda, ldb, K; };

struct StaticOrder {
    int nM, nN, nwg, G, c;
    __host__ __device__ void init(int M, int N, int G_, int c_) { nM = M / BM; nN = N / BM; nwg = nM * nN; G = G_; c = c_; }
    __host__ __device__ bool next(int i, Unit& u) const {
        const long L = (long)i * G + c; if (L >= nwg) return false;
        int wgid = (int)L; { const int q = nwg / NXCD, r = nwg % NXCD, xcd = wgid % NXCD, off = wgid / NXCD; wgid = (xcd < r ? xcd * (q + 1) : r * (q + 1) + (xcd - r) * q) + off; }
        const int nig = WGM * nN, gid = wgid / nig, fm = gid * WGM, gsz = (nM - fm) < WGM ? (nM - fm) : WGM;
        u.pm = fm + ((wgid % nig) % gsz); u.pn = (wgid % nig) / gsz; return true;
    }
    __device__ __forceinline__ void a_ready(const Unit&) const {}
    __device__ __forceinline__ void done(const Unit&) const {}
};

__device__ __forceinline__ unsigned cvt_pk_bf16(float lo, float hi) { return pk2(lo, hi); }
__device__ __forceinline__ u32x4 pack_bf16x8(const f32x4& v0, const f32x4& v1) { u32x4 w; w.x = cvt_pk_bf16(v0[0], v0[1]); w.y = cvt_pk_bf16(v0[2], v0[3]); w.z = cvt_pk_bf16(v1[0], v1[1]); w.w = cvt_pk_bf16(v1[2], v1[3]); return w; }
__device__ __forceinline__ float sigm(float x) { return __builtin_amdgcn_rcpf(1.0f + __expf(-x)); }
__device__ __forceinline__ f32x4 sigm4(f32x4 v) { return (f32x4){sigm(v[0]), sigm(v[1]), sigm(v[2]), sigm(v[3])}; }
__device__ __forceinline__ void unpk8(const u32x4& w, f32x4& a, f32x4& b) {
    a = (f32x4){__builtin_bit_cast(float, w.x << 16), __builtin_bit_cast(float, w.x & 0xffff0000u), __builtin_bit_cast(float, w.y << 16), __builtin_bit_cast(float, w.y & 0xffff0000u)};
    b = (f32x4){__builtin_bit_cast(float, w.z << 16), __builtin_bit_cast(float, w.z & 0xffff0000u), __builtin_bit_cast(float, w.w << 16), __builtin_bit_cast(float, w.w & 0xffff0000u)};
}

struct EpiProj {
    static constexpr bool PERM = true, AFTER_DRAIN = false, HAS_MID = false, HAS_INIT = false;
    bf16_t* pda; bf16_t* prw; bf16_t* gates;
    __device__ __forceinline__ void operator()(const f32x4 (&acc)[2][2][4][2], const Unit& u, int wr, int wc, int fr, int fq) const {
        const int row0 = u.pm * BM + wr * 64 + fr;
        if (u.pn >= 26) {
            const int col0 = (u.pn - 26) * 128 + wc * 32 + 8 * fq;
#pragma unroll
            for (int ai = 0; ai < 2; ++ai)
#pragma unroll
                for (int m = 0; m < 4; ++m) { bf16_t* rowp = gates + (size_t)(row0 + ai * HALF + m * 16) * 4096 + col0;
                    f32x4 rt[2], gb[2];
#pragma unroll
                    for (int n = 0; n < 2; ++n)
#pragma unroll
                        for (int e = 0; e < 4; ++e) { const float ea = __expf(-acc[ai][0][m][n][e]), eb = __expf(-acc[ai][1][m][n][e]);
                            gb[n][e] = __builtin_amdgcn_rcpf(1.0f + eb); rt[n][e] = (1.0f + eb) * __builtin_amdgcn_rcpf(1.0f + ea); }
                    *(u32x4*)rowp = pack_bf16x8(rt[0], rt[1]); *(u32x4*)(rowp + 2048) = pack_bf16x8(gb[0], gb[1]); }
            return;
        }
        bf16_t* base; int ldc, colt;
        if (u.pn < 12) { base = pda; ldc = 3072; colt = u.pn * 256; }
        else { base = prw; ldc = 3584; colt = (u.pn - 12) * 256; }
        const int col0 = colt + wc * 32 + 8 * fq;
#pragma unroll
        for (int ai = 0; ai < 2; ++ai)
#pragma unroll
            for (int m = 0; m < 4; ++m) { bf16_t* rowp = base + (size_t)(row0 + ai * HALF + m * 16) * ldc + col0;
#pragma unroll
                for (int bj = 0; bj < 2; ++bj) *(u32x4*)(rowp + bj * HALF) = pack_bf16x8(acc[ai][bj][m][0], acc[ai][bj][m][1]); }
    }
};
template <int KIND> struct EpiLora {
    static constexpr bool PERM = true, AFTER_DRAIN = false, HAS_MID = false, HAS_INIT = false;
    bf16_t* out; const float* bias4;
    __device__ __forceinline__ void operator()(const f32x4 (&acc)[2][2][4][2], const Unit& u, int wr, int wc, int fr, int fq) const {
        const int seg = (KIND == 0) ? (u.pn >> 2) : 4, colt = (KIND == 0) ? (u.pn & 3) * 256 : u.pn * 256;
        bf16_t* base = out + (size_t)seg * ((size_t)M * 1024);
        const float* bias = bias4 + (seg & 3) * 1024;
        const int row0 = u.pm * BM + wr * 64 + fr, col0 = colt + wc * 32 + 8 * fq;
        const float sc = (seg < 2) ? -0.60653065971f : 1.0f;
#pragma unroll
        for (int bj = 0; bj < 2; ++bj) {
            f32x4 bv0 = (f32x4){0.f, 0.f, 0.f, 0.f}, bv1 = bv0;
            if (KIND == 0) { bv0 = *(const f32x4*)(bias + col0 + bj * HALF); bv1 = *(const f32x4*)(bias + col0 + bj * HALF + 4); }
#pragma unroll
            for (int ai = 0; ai < 2; ++ai)
#pragma unroll
                for (int m = 0; m < 4; ++m) { bf16_t* rowp = base + (size_t)(row0 + ai * HALF + m * 16) * 1024 + col0;
                    f32x4 v0 = acc[ai][bj][m][0] + bv0, v1 = acc[ai][bj][m][1] + bv1;
                    if (KIND == 0) { v0 = sigm4(v0) * sc; v1 = sigm4(v1) * sc; }
                    *(u32x4*)(rowp + bj * HALF) = pack_bf16x8(v0, v1); }
        }
    }
};
struct EpiMergeF {
    static constexpr bool PERM = true, AFTER_DRAIN = false, HAS_MID = true, HAS_INIT = false;
    bf16_t* merged; const bf16_t* gates;
    template <int HALFSEL> __device__ __forceinline__ void scale(f32x4 (&acc)[2][2][4][2], const Unit& u, int wr, int wc, int fr, int fq, bool store) const {
        int row0 = u.pm * BM + wr * 64 + fr, col0 = u.pn * 256 + wc * 32 + 8 * fq;
        asm volatile("" : "+v"(row0), "+v"(col0));
        u32x4 gw[2][2][2];
#define EMF_LOAD(g) do { _Pragma("unroll") for (int mm = 0; mm < 2; ++mm) _Pragma("unroll") for (int bj = 0; bj < 2; ++bj) \
            gw[(g) & 1][mm][bj] = *(const u32x4*)(gates + (size_t)(row0 + ((g) >> 1) * HALF + (2 * ((g) & 1) + mm) * 16) * 4096 + HALFSEL * 2048 + col0 + bj * HALF); } while (0)
        EMF_LOAD(0);
#pragma unroll
        for (int g = 0; g < 4; ++g) { const int ai = g >> 1, mh = g & 1;
            if (g < 3) EMF_LOAD(g + 1);
#pragma unroll
            for (int mm = 0; mm < 2; ++mm)
#pragma unroll
                for (int bj = 0; bj < 2; ++bj) { const int m = 2 * mh + mm; f32x4 g0, g1; unpk8(gw[g & 1][mm][bj], g0, g1);
                    acc[ai][bj][m][0] *= g0; acc[ai][bj][m][1] *= g1;
                    if (store) *(u32x4*)(merged + (size_t)(row0 + ai * HALF + m * 16) * 2048 + col0 + bj * HALF) = pack_bf16x8(acc[ai][bj][m][0], acc[ai][bj][m][1]); }
            asm volatile("" ::: "memory");
        }
#undef EMF_LOAD
    }
    __device__ __forceinline__ void mid(f32x4 (&acc)[2][2][4][2], const Unit& u, int wr, int wc, int fr, int fq) const { scale<0>(acc, u, wr, wc, fr, fq, false); }
    __device__ __forceinline__ void operator()(const f32x4 (&acc)[2][2][4][2], const Unit& u, int wr, int wc, int fr, int fq) const {
        f32x4 (&ac)[2][2][4][2] = const_cast<f32x4 (&)[2][2][4][2]>(acc); scale<1>(ac, u, wr, wc, fr, fq, true); }
};
struct EpiOut {
    static constexpr bool PERM = false, AFTER_DRAIN = false, HAS_MID = false, HAS_INIT = true;
    const float* x; float* out; float* ss;
    __device__ __forceinline__ void init(f32x4 (&acc)[2][2][4][2], const Unit& u, int wr, int wc, int fr, int fq) const {
        const int row0 = u.pm * BM + wr * 64 + fr, col0 = u.pn * 256 + wc * 32 + 4 * fq;
#pragma unroll
        for (int ai = 0; ai < 2; ++ai)
#pragma unroll
            for (int m = 0; m < 4; ++m)
#pragma unroll
                for (int bj = 0; bj < 2; ++bj)
#pragma unroll
                    for (int n = 0; n < 2; ++n) acc[ai][bj][m][n] = *(const f32x4*)(x + (size_t)(row0 + ai * HALF + m * 16) * 2048 + col0 + bj * HALF + n * 16);
    }
    __device__ __forceinline__ void operator()(const f32x4 (&acc)[2][2][4][2], const Unit& u, int wr, int wc, int fr, int fq) const {
        const int row0 = u.pm * BM + wr * 64 + fr, col0 = u.pn * 256 + wc * 32 + 4 * fq;
#pragma unroll
        for (int ai = 0; ai < 2; ++ai) {
#pragma unroll
            for (int m = 0; m < 4; ++m) { const size_t r = (size_t)(row0 + ai * HALF + m * 16); float s = 0.f;
#pragma unroll
                for (int bj = 0; bj < 2; ++bj)
#pragma unroll
                    for (int n = 0; n < 2; ++n) { const f32x4 h = acc[ai][bj][m][n]; *(f32x4*)(out + r * 2048 + col0 + bj * HALF + n * 16) = h;
                        s += (h[0] * h[0] + h[1] * h[1]) + (h[2] * h[2] + h[3] * h[3]); }
                s += __shfl_xor(s, 16); s += __shfl_xor(s, 32);
                if (fq == 0) ss[r * 32 + u.pn * 4 + wc] = s; }
        }
    }
};
struct EpiMoeUp {
    static constexpr bool PERM = true, AFTER_DRAIN = false, HAS_MID = false, HAS_INIT = false;
    bf16_t* hid;
    __device__ __forceinline__ void operator()(const f32x4 (&acc)[2][2][4][2], const Unit& u, int wr, int wc, int fr, int fq) const {
        const int row0 = u.pm * BM + wr * 64 + fr, col0 = (u.pn & 7) * 128 + wc * 32 + 8 * fq;
#pragma unroll
        for (int ai = 0; ai < 2; ++ai)
#pragma unroll
            for (int m = 0; m < 4; ++m) { bf16_t* rowp = hid + (size_t)(row0 + ai * HALF + m * 16) * 1024 + col0;
                const f32x4 g0 = acc[ai][0][m][0], g1 = acc[ai][0][m][1], u0 = acc[ai][1][m][0], u1 = acc[ai][1][m][1];
                const f32x4 v0 = g0 * sigm4(g0) * u0, v1 = g1 * sigm4(g1) * u1;
                *(u32x4*)rowp = pack_bf16x8(v0, v1); }
    }
};
struct EpiMoeDown {
    static constexpr bool PERM = true, AFTER_DRAIN = false, HAS_MID = false, HAS_INIT = false;
    bf16_t* ye; const float* selgate;
    __device__ __forceinline__ void operator()(const f32x4 (&acc)[2][2][4][2], const Unit& u, int wr, int wc, int fr, int fq) const {
        const int row0 = u.pm * BM + wr * 64 + fr, col0 = (u.pn & 7) * 256 + wc * 32 + 8 * fq;
#pragma unroll
        for (int ai = 0; ai < 2; ++ai)
#pragma unroll
            for (int m = 0; m < 4; ++m) { const int r = row0 + ai * HALF + m * 16; const int e = r >> 11, b = (r >> 9) & 3, c = r & 511;
                const float g = selgate[(b * 16 + e) * 512 + c];
                bf16_t* rowp = ye + (size_t)r * 2048 + col0;
#pragma unroll
                for (int bj = 0; bj < 2; ++bj) *(u32x4*)(rowp + bj * HALF) = pack_bf16x8(acc[ai][bj][m][0] * g, acc[ai][bj][m][1] * g); }
    }
};
struct ExpertOrder {
    int G, c;
    __device__ __forceinline__ bool next(int i, Unit& u) const {
        const int L = i * G + c; if (L >= 1024) return false;
        const int wgid = (L % NXCD) * (1024 / NXCD) + L / NXCD;
        const int e = wgid >> 6, r = wgid & 63; u.pm = e * 8 + (r & 3) + 4 * ((r >> 5) & 1); u.pn = e * 8 + ((r >> 2) & 7); return true;
    }
    __device__ __forceinline__ void a_ready(const Unit&) const {}
    __device__ __forceinline__ void done(const Unit&) const {}
};

struct ExpertGatherOrder {
    int G, c; const int* seltok;
    __device__ __forceinline__ bool next(int i, Unit& u) const {
        const int L = i * G + c; if (L >= 1024) return false;
        const int wgid = (L % NXCD) * (1024 / NXCD) + L / NXCD;
        const int e = wgid >> 6, r = wgid & 63; u.pm = e * 8 + (r & 3) + 4 * ((r >> 5) & 1); u.pn = e * 8 + ((r >> 2) & 7); return true;
    }
    __device__ __forceinline__ int arow(int r) const { const int e = r >> 11, b = (r >> 9) & 3, cc = r & 511; return b * 4096 + seltok[(b * 16 + e) * 512 + cc]; }
    __device__ __forceinline__ size_t boff(const Unit& u) const { return w1t_base(u.pn >> 3) + (size_t)(u.pn & 7) * (256 * 2048 * 2); }
    __device__ __forceinline__ void a_ready(const Unit&) const {}
    __device__ __forceinline__ void done(const Unit&) const {}
};
template <class Epi, class Sched, bool ALIGN_EPI = false, bool SP2 = false>
__device__ __forceinline__ void gemm_phase(PG8_LAS unsigned char* lds, const Gemm g, const Sched& S, const Epi& E) {
    const int tid = fresh_tid(), wid = __builtin_amdgcn_readfirstlane(tid >> 6), lane = tid & 63, wr = wid >> 2, wc = wid & 3, fr = lane & 15, fq = lane >> 4;
    const int K = g.K, nt = K / BK;
    unsigned voffA[2], voffB[2];
#pragma unroll
    for (int i = 0; i < 2; ++i) { int R, C; stage_rc(tid * 16 + i * 8192, R, C); const int Rb = Epi::PERM ? ((R & ~31) + perm32(R & 31)) : R;
        voffA[i] = (unsigned)(R * g.lda + C) * 2u; voffB[i] = (unsigned)(Rb * g.ldb + C) * 2u; }
    const size_t kstep = (size_t)(BK * 2);
    const size_t hsA = (size_t)HALF * g.lda * 2, hsB = (size_t)HALF * g.ldb * 2;
    const size_t tsA = 2 * hsA, tsB = 2 * hsB;
    const unsigned ldsw = (unsigned)wid * 1024u;
    const int aoff = lds_byte(wr * 64 + fr, fq * 8), boff = lds_byte(wc * 32 + fr, fq * 8);
#define PG8_SA(b, h) (((b) * 2 + (h)) * HTB)
#define PG8_SB(b, h) ((4 + (b) * 2 + (h)) * HTB)
#define PG8_STAGE(bufoff, gbase, voff) do { _Pragma("unroll") for (int _i = 0; _i < 2; ++_i) \
        __builtin_amdgcn_global_load_lds((const unsigned*)((const char*)(gbase) + (voff)[_i]), (PG8_LAS unsigned*)(lds + (bufoff) + ldsw + _i * 8192), 16, 0, 0); } while (0)
#define PG8_LDA(dst, b, h) do { _Pragma("unroll") for (int m = 0; m < 4; ++m) _Pragma("unroll") for (int k = 0; k < 2; ++k) dst[m][k] = *(const PG8_LAS bf16x8*)(lds + PG8_SA(b, h) + aoff + m * 2048 + k * 1024); } while (0)
#define PG8_LDB(dst, b, h) do { _Pragma("unroll") for (int n = 0; n < 2; ++n) _Pragma("unroll") for (int k = 0; k < 2; ++k) dst[n][k] = *(const PG8_LAS bf16x8*)(lds + PG8_SB(b, h) + boff + n * 2048 + k * 1024); } while (0)
#define PG8_MMA(ai, bj, At, Bt) do { __builtin_amdgcn_s_setprio(1); _Pragma("unroll") for (int m = 0; m < 4; ++m) _Pragma("unroll") for (int n = 0; n < 2; ++n) _Pragma("unroll") for (int k = 0; k < 2; ++k) \
        acc[ai][bj][m][n] = __builtin_amdgcn_mfma_f32_16x16x32_bf16(Bt[n][k], At[m][k], acc[ai][bj][m][n], 0, 0, 0); __builtin_amdgcn_s_setprio(0); } while (0)
#define PG8_WAIT_V(n) asm volatile("s_waitcnt vmcnt(" #n ")" ::: "memory")
#define PG8_WAIT_L(n) asm volatile("s_waitcnt lgkmcnt(" #n ")" ::: "memory")
#define PG8_BAR __builtin_amdgcn_s_barrier()
#define PG8_SCHED __builtin_amdgcn_sched_barrier(0)
    Unit cur, nxt; int ui = 0;
    if (!S.next(0, cur)) return;
    f32x4 acc[2][2][4][2];
    if constexpr (Epi::HAS_INIT) E.init(acc, cur, wr, wc, fr, fq); else {
#pragma unroll
    for (int a = 0; a < 2; ++a)
#pragma unroll
        for (int b = 0; b < 2; ++b)
#pragma unroll
            for (int m = 0; m < 4; ++m)
#pragma unroll
                for (int n = 0; n < 2; ++n) acc[a][b][m][n] = (f32x4){0.f, 0.f, 0.f, 0.f};
    }
    bf16x8 At[4][2], B0[2][2], B1[2][2];
    const char* cA = (const char*)g.A + (size_t)cur.pm * tsA; const char* cB = (const char*)g.Bt + (size_t)cur.pn * tsB;
    S.a_ready(cur);
    if constexpr (SP2) {
        PG8_STAGE(PG8_SB(0, 0), cB, voffB); PG8_STAGE(PG8_SB(0, 1), cB + hsB, voffB); PG8_STAGE(PG8_SA(0, 0), cA, voffA); PG8_STAGE(PG8_SA(0, 1), cA + hsA, voffA);
        if (wr == 1) PG8_BAR;
        PG8_WAIT_V(2); PG8_BAR;
        PG8_STAGE(PG8_SB(1, 0), cB + kstep, voffB); PG8_STAGE(PG8_SA(1, 0), cA + kstep, voffA); PG8_STAGE(PG8_SB(1, 1), cB + hsB + kstep, voffB);
        PG8_WAIT_V(6); PG8_BAR;
    } else {
        PG8_STAGE(PG8_SB(0, 0), cB, voffB); PG8_STAGE(PG8_SA(0, 0), cA, voffA); PG8_STAGE(PG8_SB(0, 1), cB + hsB, voffB); PG8_STAGE(PG8_SA(0, 1), cA + hsA, voffA);
        if (wr == 1) PG8_BAR;
        PG8_WAIT_V(4); PG8_BAR;
        PG8_STAGE(PG8_SB(1, 0), cB + kstep, voffB); PG8_STAGE(PG8_SA(1, 0), cA + kstep, voffA); PG8_STAGE(PG8_SB(1, 1), cB + hsB + kstep, voffB);
        PG8_WAIT_V(6); PG8_BAR;
    }
    for (;;) {
        const bool has_next = S.next(ui + 1, nxt);
        const char* nA = has_next ? (const char*)g.A + (size_t)nxt.pm * tsA : cA; const char* nB = has_next ? (const char*)g.Bt + (size_t)nxt.pn * tsB : cB;
#pragma unroll 1
        for (int t = 0; t < nt; t += 2) {
            const bool last = (t == nt - 2);
            const char* a1 = cA + (size_t)(t + 1) * kstep;
            const char* a2 = last ? nA : cA + (size_t)(t + 2) * kstep; const char* b2 = last ? nB : cB + (size_t)(t + 2) * kstep;
            const char* a3 = a2 + kstep; const char* b3 = b2 + kstep;
            if (last && has_next) S.a_ready(nxt);
            if constexpr (Epi::HAS_MID) { if (t == nt / 2) E.mid(acc, cur, wr, wc, fr, fq); }
            if constexpr (SP2) {
            PG8_LDB(B0, 0, 0); PG8_LDB(B1, 0, 1); PG8_SCHED; PG8_LDA(At, 0, 0); PG8_STAGE(PG8_SA(1, 1), a1 + hsA, voffA);
            PG8_WAIT_V(8); PG8_WAIT_L(0); PG8_BAR; PG8_MMA(0, 0, At, B0); PG8_MMA(0, 1, At, B1); PG8_BAR; PG8_SCHED;
            PG8_LDA(At, 0, 1); PG8_STAGE(PG8_SB(0, 0), b2, voffB); PG8_STAGE(PG8_SB(0, 1), b2 + hsB, voffB); PG8_STAGE(PG8_SA(0, 0), a2, voffA);
            PG8_WAIT_V(8); PG8_WAIT_L(0); PG8_BAR; PG8_MMA(1, 0, At, B0); PG8_MMA(1, 1, At, B1); PG8_BAR; PG8_SCHED;
            PG8_LDB(B0, 1, 0); PG8_LDB(B1, 1, 1); PG8_SCHED; PG8_LDA(At, 1, 0); PG8_STAGE(PG8_SA(0, 1), a2 + hsA, voffA);
            PG8_WAIT_V(8); PG8_WAIT_L(0); PG8_BAR; PG8_MMA(0, 0, At, B0); PG8_MMA(0, 1, At, B1); PG8_BAR; PG8_SCHED;
            PG8_LDA(At, 1, 1); PG8_STAGE(PG8_SB(1, 0), b3, voffB); PG8_STAGE(PG8_SB(1, 1), b3 + hsB, voffB); PG8_STAGE(PG8_SA(1, 0), a3, voffA);
            PG8_WAIT_V(8); PG8_WAIT_L(0); PG8_BAR; PG8_MMA(1, 0, At, B0); PG8_MMA(1, 1, At, B1); PG8_BAR; PG8_SCHED;
            } else {
            PG8_LDB(B0, 0, 0); PG8_SCHED; PG8_LDA(At, 0, 0); PG8_STAGE(PG8_SA(1, 1), a1 + hsA, voffA);
            PG8_WAIT_L(8); PG8_BAR; PG8_WAIT_L(0); PG8_MMA(0, 0, At, B0); PG8_BAR; PG8_SCHED;
            PG8_LDB(B1, 0, 1); PG8_STAGE(PG8_SB(0, 0), b2, voffB);
            PG8_BAR; PG8_WAIT_L(0); PG8_MMA(0, 1, At, B1); PG8_BAR;
            PG8_LDA(At, 0, 1); PG8_STAGE(PG8_SA(0, 0), a2, voffA);
            PG8_BAR; PG8_WAIT_L(0); PG8_MMA(1, 0, At, B0); PG8_BAR; PG8_SCHED;
            PG8_STAGE(PG8_SB(0, 1), b2 + hsB, voffB);
            PG8_WAIT_V(6); PG8_BAR; PG8_MMA(1, 1, At, B1); PG8_BAR;
            PG8_LDB(B0, 1, 0); PG8_SCHED; PG8_LDA(At, 1, 0); PG8_STAGE(PG8_SA(0, 1), a2 + hsA, voffA);
            PG8_WAIT_L(8); PG8_BAR; PG8_WAIT_L(0); PG8_MMA(0, 0, At, B0); PG8_BAR; PG8_SCHED;
            PG8_LDB(B1, 1, 1); PG8_STAGE(PG8_SB(1, 0), b3, voffB);
            PG8_BAR; PG8_WAIT_L(0); PG8_MMA(0, 1, At, B1); PG8_BAR;
            PG8_LDA(At, 1, 1); PG8_STAGE(PG8_SA(1, 0), a3, voffA);
            PG8_BAR; PG8_WAIT_L(0); PG8_MMA(1, 0, At, B0); PG8_BAR; PG8_SCHED;
            PG8_STAGE(PG8_SB(1, 1), b3 + hsB, voffB);
            PG8_WAIT_V(6); PG8_BAR; PG8_MMA(1, 1, At, B1); PG8_BAR;
            }
        }
        if constexpr (ALIGN_EPI) { if (wr == 0) PG8_BAR; }
        if constexpr (!Epi::AFTER_DRAIN) { E(acc, cur, wr, wc, fr, fq); S.done(cur); }
        if (!has_next) break;
        if constexpr (Epi::HAS_INIT) E.init(acc, nxt, wr, wc, fr, fq); else {
#pragma unroll
        for (int a = 0; a < 2; ++a)
#pragma unroll
            for (int b = 0; b < 2; ++b)
#pragma unroll
                for (int m = 0; m < 4; ++m)
#pragma unroll
                    for (int n = 0; n < 2; ++n) acc[a][b][m][n] = (f32x4){0.f, 0.f, 0.f, 0.f};
        }
        cur = nxt; cA = nA; cB = nB; ++ui;
        if constexpr (ALIGN_EPI) { if (wr == 1) PG8_BAR; }
    }
    PG8_WAIT_V(0);
    if constexpr (!ALIGN_EPI) { if (wr == 0) PG8_BAR; }
    PG8_BAR;
    if constexpr (Epi::AFTER_DRAIN) { E.fused(acc, cur, wr, wc, fr, fq, lds, wid, lane); S.done(cur); }
#undef PG8_SA
#undef PG8_SB
#undef PG8_STAGE
#undef PG8_LDA
#undef PG8_LDB
#undef PG8_MMA
#undef PG8_WAIT_V
#undef PG8_WAIT_L
#undef PG8_BAR
#undef PG8_SCHED
}

template <class Epi, class Sched, bool ALIGN_EPI = false, bool SP2 = false>
__device__ __forceinline__ void gemm_phase_g(PG8_LAS unsigned char* lds, const Gemm g, const Sched& S, const Epi& E) {
    const int tid = fresh_tid(), wid = __builtin_amdgcn_readfirstlane(tid >> 6), lane = tid & 63, wr = wid >> 2, wc = wid & 3, fr = lane & 15, fq = lane >> 4;
    const int K = g.K, nt = K / BK;
    unsigned voffB[2]; int RAr[2]; unsigned CAb[2];
#pragma unroll
    for (int i = 0; i < 2; ++i) { int R, C; stage_rc(tid * 16 + i * 8192, R, C); const int Rb = Epi::PERM ? ((R & ~31) + perm32(R & 31)) : R;
        RAr[i] = R; CAb[i] = (unsigned)C * 2u; voffB[i] = (unsigned)(Rb * g.ldb + C) * 2u; }
    const size_t kstep = (size_t)(BK * 2);
    const size_t hsA = (size_t)HALF * g.lda * 2, hsB = (size_t)HALF * g.ldb * 2;
    const size_t tsA = 2 * hsA, tsB = 2 * hsB;
    const unsigned ldsw = (unsigned)wid * 1024u;
    const int aoff = lds_byte(wr * 64 + fr, fq * 8), boff = lds_byte(wc * 32 + fr, fq * 8);
#define PG8_SA(b, h) (((b) * 2 + (h)) * HTB)
#define PG8_SB(b, h) ((4 + (b) * 2 + (h)) * HTB)
#define PG8_STAGE(bufoff, gbase, voff) do { _Pragma("unroll") for (int _i = 0; _i < 2; ++_i) \
        __builtin_amdgcn_global_load_lds((const unsigned*)((const char*)(gbase) + (voff)[_i]), (PG8_LAS unsigned*)(lds + (bufoff) + ldsw + _i * 8192), 16, 0, 0); } while (0)
#define PG8_LDA(dst, b, h) do { _Pragma("unroll") for (int m = 0; m < 4; ++m) _Pragma("unroll") for (int k = 0; k < 2; ++k) dst[m][k] = *(const PG8_LAS bf16x8*)(lds + PG8_SA(b, h) + aoff + m * 2048 + k * 1024); } while (0)
#define PG8_LDB(dst, b, h) do { _Pragma("unroll") for (int n = 0; n < 2; ++n) _Pragma("unroll") for (int k = 0; k < 2; ++k) dst[n][k] = *(const PG8_LAS bf16x8*)(lds + PG8_SB(b, h) + boff + n * 2048 + k * 1024); } while (0)
#define PG8_MMA(ai, bj, At, Bt) do { __builtin_amdgcn_s_setprio(1); _Pragma("unroll") for (int m = 0; m < 4; ++m) _Pragma("unroll") for (int n = 0; n < 2; ++n) _Pragma("unroll") for (int k = 0; k < 2; ++k) \
        acc[ai][bj][m][n] = __builtin_amdgcn_mfma_f32_16x16x32_bf16(Bt[n][k], At[m][k], acc[ai][bj][m][n], 0, 0, 0); __builtin_amdgcn_s_setprio(0); } while (0)
#define PG8_WAIT_V(n) asm volatile("s_waitcnt vmcnt(" #n ")" ::: "memory")
#define PG8_WAIT_L(n) asm volatile("s_waitcnt lgkmcnt(" #n ")" ::: "memory")
#define PG8_BAR __builtin_amdgcn_s_barrier()
#define PG8_SCHED __builtin_amdgcn_sched_barrier(0)
    Unit cur, nxt; int ui = 0;
    if (!S.next(0, cur)) return;
    f32x4 acc[2][2][4][2];
    if constexpr (Epi::HAS_INIT) E.init(acc, cur, wr, wc, fr, fq); else {
#pragma unroll
    for (int a = 0; a < 2; ++a)
#pragma unroll
        for (int b = 0; b < 2; ++b)
#pragma unroll
            for (int m = 0; m < 4; ++m)
#pragma unroll
                for (int n = 0; n < 2; ++n) acc[a][b][m][n] = (f32x4){0.f, 0.f, 0.f, 0.f};
    }
    bf16x8 At[4][2], B0[2][2], B1[2][2];
    unsigned vAll[4][2][2];
#pragma unroll
    for (int q = 0; q < 4; ++q) { Unit uq; const bool ok = S.next(q, uq);
#pragma unroll
        for (int h = 0; h < 2; ++h)
#pragma unroll
            for (int i = 0; i < 2; ++i) vAll[q][h][i] = ok ? (unsigned)S.arow(uq.pm * BM + h * HALF + RAr[i]) * (unsigned)(g.lda * 2) + CAb[i] : 0u; }
#define PG8_PICK(dst, idx) do { _Pragma("unroll") for (int h_ = 0; h_ < 2; ++h_) _Pragma("unroll") for (int i_ = 0; i_ < 2; ++i_) \
        dst[h_][i_] = (idx) == 0 ? vAll[0][h_][i_] : (idx) == 1 ? vAll[1][h_][i_] : (idx) == 2 ? vAll[2][h_][i_] : vAll[3][h_][i_]; } while (0)
    unsigned vA[2][2], vAn[2][2], vS[2][2];
    PG8_PICK(vA, 0);
    const char* A0 = (const char*)g.A; const char* cB = (const char*)g.Bt + S.boff(cur);
    S.a_ready(cur);
    if constexpr (SP2) {
        PG8_STAGE(PG8_SB(0, 0), cB, voffB); PG8_STAGE(PG8_SB(0, 1), cB + hsB, voffB); PG8_STAGE(PG8_SA(0, 0), A0, vA[0]); PG8_STAGE(PG8_SA(0, 1), A0, vA[1]);
        if (wr == 1) PG8_BAR;
        PG8_WAIT_V(2); PG8_BAR;
        PG8_STAGE(PG8_SB(1, 0), cB + kstep, voffB); PG8_STAGE(PG8_SA(1, 0), A0 + kstep, vA[0]); PG8_STAGE(PG8_SB(1, 1), cB + hsB + kstep, voffB);
        PG8_WAIT_V(6); PG8_BAR;
    } else {
        PG8_STAGE(PG8_SB(0, 0), cB, voffB); PG8_STAGE(PG8_SA(0, 0), A0, vA[0]); PG8_STAGE(PG8_SB(0, 1), cB + hsB, voffB); PG8_STAGE(PG8_SA(0, 1), A0, vA[1]);
        if (wr == 1) PG8_BAR;
        PG8_WAIT_V(4); PG8_BAR;
        PG8_STAGE(PG8_SB(1, 0), cB + kstep, voffB); PG8_STAGE(PG8_SA(1, 0), A0 + kstep, vA[0]); PG8_STAGE(PG8_SB(1, 1), cB + hsB + kstep, voffB);
        PG8_WAIT_V(6); PG8_BAR;
    }
    for (;;) {
        const bool has_next = S.next(ui + 1, nxt);
        const char* nB = has_next ? (const char*)g.Bt + S.boff(nxt) : cB;
        if (has_next) { PG8_PICK(vAn, ui + 1); } else { PG8_PICK(vAn, ui); }
#pragma unroll 1
        for (int t = 0; t < nt; t += 2) {
            const bool last = (t == nt - 2);
            const char* a1 = A0 + (size_t)(t + 1) * kstep;
            const char* a2 = last ? A0 : A0 + (size_t)(t + 2) * kstep; const char* b2 = last ? nB : cB + (size_t)(t + 2) * kstep;
#pragma unroll
            for (int h_ = 0; h_ < 2; ++h_)
#pragma unroll
                for (int i_ = 0; i_ < 2; ++i_) vS[h_][i_] = last ? vAn[h_][i_] : vA[h_][i_];
            const char* a3 = a2 + kstep; const char* b3 = b2 + kstep;
            if (last && has_next) S.a_ready(nxt);
            if constexpr (Epi::HAS_MID) { if (t == nt / 2) E.mid(acc, cur, wr, wc, fr, fq); }
            if constexpr (SP2) {
            PG8_LDB(B0, 0, 0); PG8_LDB(B1, 0, 1); PG8_SCHED; PG8_LDA(At, 0, 0); PG8_STAGE(PG8_SA(1, 1), a1, vA[1]);
            PG8_WAIT_V(8); PG8_WAIT_L(0); PG8_BAR; PG8_MMA(0, 0, At, B0); PG8_MMA(0, 1, At, B1); PG8_BAR; PG8_SCHED;
            PG8_LDA(At, 0, 1); PG8_STAGE(PG8_SB(0, 0), b2, voffB); PG8_STAGE(PG8_SB(0, 1), b2 + hsB, voffB); PG8_STAGE(PG8_SA(0, 0), a2, vS[0]);
            PG8_WAIT_V(8); PG8_WAIT_L(0); PG8_BAR; PG8_MMA(1, 0, At, B0); PG8_MMA(1, 1, At, B1); PG8_BAR; PG8_SCHED;
            PG8_LDB(B0, 1, 0); PG8_LDB(B1, 1, 1); PG8_SCHED; PG8_LDA(At, 1, 0); PG8_STAGE(PG8_SA(0, 1), a2, vS[1]);
            PG8_WAIT_V(8); PG8_WAIT_L(0); PG8_BAR; PG8_MMA(0, 0, At, B0); PG8_MMA(0, 1, At, B1); PG8_BAR; PG8_SCHED;
            PG8_LDA(At, 1, 1); PG8_STAGE(PG8_SB(1, 0), b3, voffB); PG8_STAGE(PG8_SB(1, 1), b3 + hsB, voffB); PG8_STAGE(PG8_SA(1, 0), a3, vS[0]);
            PG8_WAIT_V(8); PG8_WAIT_L(0); PG8_BAR; PG8_MMA(1, 0, At, B0); PG8_MMA(1, 1, At, B1); PG8_BAR; PG8_SCHED;
            } else {
            PG8_LDB(B0, 0, 0); PG8_SCHED; PG8_LDA(At, 0, 0); PG8_STAGE(PG8_SA(1, 1), a1, vA[1]);
            PG8_WAIT_L(8); PG8_BAR; PG8_WAIT_L(0); PG8_MMA(0, 0, At, B0); PG8_BAR; PG8_SCHED;
            PG8_LDB(B1, 0, 1); PG8_STAGE(PG8_SB(0, 0), b2, voffB);
            PG8_BAR; PG8_WAIT_L(0); PG8_MMA(0, 1, At, B1); PG8_BAR;
            PG8_LDA(At, 0, 1); PG8_STAGE(PG8_SA(0, 0), a2, vS[0]);
            PG8_BAR; PG8_WAIT_L(0); PG8_MMA(1, 0, At, B0); PG8_BAR; PG8_SCHED;
            PG8_STAGE(PG8_SB(0, 1), b2 + hsB, voffB);
            PG8_WAIT_V(6); PG8_BAR; PG8_MMA(1, 1, At, B1); PG8_BAR;
            PG8_LDB(B0, 1, 0); PG8_SCHED; PG8_LDA(At, 1, 0); PG8_STAGE(PG8_SA(0, 1), a2, vS[1]);
            PG8_WAIT_L(8); PG8_BAR; PG8_WAIT_L(0); PG8_MMA(0, 0, At, B0); PG8_BAR; PG8_SCHED;
            PG8_LDB(B1, 1, 1); PG8_STAGE(PG8_SB(1, 0), b3, voffB);
            PG8_BAR; PG8_WAIT_L(0); PG8_MMA(0, 1, At, B1); PG8_BAR;
            PG8_LDA(At, 1, 1); PG8_STAGE(PG8_SA(1, 0), a3, vS[0]);
            PG8_BAR; PG8_WAIT_L(0); PG8_MMA(1, 0, At, B0); PG8_BAR; PG8_SCHED;
            PG8_STAGE(PG8_SB(1, 1), b3 + hsB, voffB);
            PG8_WAIT_V(6); PG8_BAR; PG8_MMA(1, 1, At, B1); PG8_BAR;
            }
        }
        if constexpr (ALIGN_EPI) { if (wr == 0) PG8_BAR; }
        if constexpr (!Epi::AFTER_DRAIN) { E(acc, cur, wr, wc, fr, fq); S.done(cur); }
        if (!has_next) break;
        if constexpr (Epi::HAS_INIT) E.init(acc, nxt, wr, wc, fr, fq); else {
#pragma unroll
        for (int a = 0; a < 2; ++a)
#pragma unroll
            for (int b = 0; b < 2; ++b)
#pragma unroll
                for (int m = 0; m < 4; ++m)
#pragma unroll
                    for (int n = 0; n < 2; ++n) acc[a][b][m][n] = (f32x4){0.f, 0.f, 0.f, 0.f};
        }
        cur = nxt; cB = nB; ++ui;
#pragma unroll
        for (int h_ = 0; h_ < 2; ++h_)
#pragma unroll
            for (int i_ = 0; i_ < 2; ++i_) vA[h_][i_] = vAn[h_][i_];
        if constexpr (ALIGN_EPI) { if (wr == 1) PG8_BAR; }
    }
    PG8_WAIT_V(0);
    if constexpr (!ALIGN_EPI) { if (wr == 0) PG8_BAR; }
    PG8_BAR;
    if constexpr (Epi::AFTER_DRAIN) { E.fused(acc, cur, wr, wc, fr, fq, lds, wid, lane); S.done(cur); }
#undef PG8_SA
#undef PG8_SB
#undef PG8_STAGE
#undef PG8_LDA
#undef PG8_LDB
#undef PG8_MMA
#undef PG8_WAIT_V
#undef PG8_WAIT_L
#undef PG8_BAR
#undef PG8_SCHED
#undef PG8_PICK
}


}

namespace attn {
using bf16x8 = __attribute__((ext_vector_type(8))) short;
using s16x4  = __attribute__((ext_vector_type(4))) short;
using f32x16 = __attribute__((ext_vector_type(16))) float;
using u32x4  = __attribute__((ext_vector_type(4))) unsigned;
constexpr int QBLK = 32, KVBLK = 64, LDQ = 3072;
constexpr float SCALE = 0.125f, QSCALE = 0.125f * 1.4426950408889634f;
constexpr size_t SHM_V = KVBLK * 128 * 2, SHM_K = KVBLK * 128 * 2, SHM_ATTN = 2 * SHM_V + 2 * SHM_K + 8 * 64 * 4;
#define KSWZ(row, colB) ((row) * 256 + ((colB) ^ (((row) & 7) << 4)))
#define SBAR() __builtin_amdgcn_sched_barrier(0)
__device__ __forceinline__ int crow(int r, int hi) { return (r & 3) + 8 * (r >> 2) + 4 * hi; }
__device__ __forceinline__ unsigned cvtpk(float lo, float hi) { return pk2(lo, hi); }
__device__ __forceinline__ bf16x8 ld8(const bf16_t* p) { return *reinterpret_cast<const bf16x8*>(p); }

__device__ __forceinline__ void partialSM(f32x16& p0, f32x16& p1) {
  for (int r = 0; r < 16; ++r) p0[r] = __builtin_amdgcn_exp2f(p0[r]);
}
__device__ __forceinline__ void finishSM(f32x16& p0, f32x16& p1, float& l_reg, bf16x8& pa0, bf16x8& pa1, bf16x8& pa2, bf16x8& pa3) {
  for (int r = 0; r < 16; ++r) p1[r] = __builtin_amdgcn_exp2f(p1[r]);
  float ps = 0; for (int r = 0; r < 16; ++r) ps += p0[r]; for (int r = 0; r < 16; ++r) ps += p1[r];
  l_reg += ps;
#define PK4(P, BASE, OUT) do { unsigned a0 = cvtpk(P[BASE + 0], P[BASE + 1]), a1 = cvtpk(P[BASE + 2], P[BASE + 3]);   \
    unsigned b0 = cvtpk(P[BASE + 4], P[BASE + 5]), b1 = cvtpk(P[BASE + 6], P[BASE + 7]);                              \
    auto r0 = __builtin_amdgcn_permlane32_swap(a0, b0, false, false); auto r1 = __builtin_amdgcn_permlane32_swap(a1, b1, false, false); \
    u32x4 w = {r0[0], r1[0], r0[1], r1[1]}; OUT = *reinterpret_cast<bf16x8*>(&w); } while (0)
  PK4(p0, 0, pa0); PK4(p0, 8, pa1); PK4(p1, 0, pa2); PK4(p1, 8, pa3);
#undef PK4
}
__device__ __forceinline__ void qkt(f32x16& p0, f32x16& p1, const bf16_t* Ks, const bf16x8* qr, int r32, int hi, int sub) {
  p0 = f32x16{}; p1 = f32x16{};
#pragma unroll
  for (int d0 = 0; d0 < 4; ++d0) { int cb = (sub * 64 + d0 * 16 + hi * 8) * 2;
    bf16x8 b0 = *reinterpret_cast<const bf16x8*>((const char*)Ks + KSWZ(r32, cb));
    bf16x8 b1 = *reinterpret_cast<const bf16x8*>((const char*)Ks + KSWZ(32 + r32, cb));
    p0 = __builtin_amdgcn_mfma_f32_32x32x16_bf16(b0, qr[d0], p0, 0, 0, 0);
    p1 = __builtin_amdgcn_mfma_f32_32x32x16_bf16(b1, qr[d0], p1, 0, 0, 0); }
}
__device__ __forceinline__ int v_st(int k, int c) { const int kk = (k & ~0xC) | ((k & 4) << 1) | ((k & 8) >> 1); return ((kk >> 3) * 4 + (c >> 5)) * 512 + ((kk & 7) * 32 + (c & 31)) * 2; }
__device__ __forceinline__ int v_rd_base(int lane) { return ((lane & 3) << 3) | (((lane >> 2) & 3) << 6) | (((lane >> 4) & 1) << 5) | (((lane >> 5) & 1) << 8); }
constexpr int v_rd_off(int d0, int ks, int half) { return d0 * 512 + ks * 4096 + half * 2048; }
template <int OFF> __device__ __forceinline__ s16x4 tr_read(int vb) {
  s16x4 r; asm volatile("ds_read_b64_tr_b16 %0, %1 offset:%2" : "=&v"(r) : "v"(vb), "i"(OFF) : "memory"); return r;
}
template <int D0> __device__ __forceinline__ void pv_one(f32x16& od, int vb, bf16x8 pa0, bf16x8 pa1, bf16x8 pa2, bf16x8 pa3) {
  const s16x4 l0 = tr_read<v_rd_off(D0, 0, 0)>(vb), h0 = tr_read<v_rd_off(D0, 0, 1)>(vb), l1 = tr_read<v_rd_off(D0, 1, 0)>(vb), h1 = tr_read<v_rd_off(D0, 1, 1)>(vb);
  const s16x4 l2 = tr_read<v_rd_off(D0, 2, 0)>(vb), h2 = tr_read<v_rd_off(D0, 2, 1)>(vb), l3 = tr_read<v_rd_off(D0, 3, 0)>(vb), h3 = tr_read<v_rd_off(D0, 3, 1)>(vb);
  asm volatile("s_waitcnt lgkmcnt(0)" ::: "memory"); SBAR();
#define PK(L, H) (bf16x8){L[0], L[1], L[2], L[3], H[0], H[1], H[2], H[3]}
  od = __builtin_amdgcn_mfma_f32_32x32x16_bf16(pa0, PK(l0, h0), od, 0, 0, 0);
  od = __builtin_amdgcn_mfma_f32_32x32x16_bf16(pa1, PK(l1, h1), od, 0, 0, 0);
  od = __builtin_amdgcn_mfma_f32_32x32x16_bf16(pa2, PK(l2, h2), od, 0, 0, 0);
  od = __builtin_amdgcn_mfma_f32_32x32x16_bf16(pa3, PK(l3, h3), od, 0, 0, 0);
#undef PK
}
__device__ __forceinline__ void pv_d0(f32x16* o, int vb, bf16x8 pa0, bf16x8 pa1, bf16x8 pa2, bf16x8 pa3) {
  pv_one<0>(o[0], vb, pa0, pa1, pa2, pa3); pv_one<1>(o[1], vb, pa0, pa1, pa2, pa3); pv_one<2>(o[2], vb, pa0, pa1, pa2, pa3); pv_one<3>(o[3], vb, pa0, pa1, pa2, pa3);
}

struct Stage { bf16x8 vs0, vs1, ks0, ks1; };
__device__ __forceinline__ void attn_prime(const bf16_t* Kh, const bf16_t* Vh, Stage (&sr_)[2]) {
  const int tid = fresh_tid(), sr = tid >> 4, sc = (tid & 15) * 8;
  sr_[0].vs0 = ld8(&Vh[(long)sr * LDQ + sc]); sr_[0].vs1 = ld8(&Vh[(long)(32 + sr) * LDQ + sc]); sr_[0].ks0 = ld8(&Kh[(long)sr * LDQ + sc]); sr_[0].ks1 = ld8(&Kh[(long)(32 + sr) * LDQ + sc]);
}
__device__ __forceinline__ void attn_unit(const bf16_t* Qb, const bf16_t* Kh, const bf16_t* Vh, bf16_t* Ya, float lam, const float* subln_g, int seq, char* lds, const bf16_t* nKh, const bf16_t* nVh, Stage (&sr_)[2]) {
  const int tid = fresh_tid(), wid = __builtin_amdgcn_readfirstlane(tid >> 6), lane = tid & 63, r32 = lane & 31, hi = lane >> 5, sub = wid >> 2, wq = wid & 3;
  bf16_t* V_lds = (bf16_t*)lds; bf16_t* K_lds = (bf16_t*)(lds + 2 * SHM_V);
  float* ws = (float*)(lds + 2 * SHM_V + 2 * SHM_K) + wid * 64; float* li_l = ws;
  float l_reg = 0; f32x16 o[4] = {}; bf16x8 qr[4];
  const bf16_t* Qw = Qb + (long)(wq * QBLK + r32) * LDQ + sub * 64 + hi * 8;
#pragma unroll
  for (int d0 = 0; d0 < 4; ++d0) qr[d0] = ld8(Qw + d0 * 16);
  const int sr = tid >> 4, sc = (tid & 15) * 8, vst0 = v_st(sr, sc), vst1 = v_st(32 + sr, sc);
  const int vb0 = (int)(uintptr_t)V_lds + v_rd_base(lane);
#define SLOAD(i, k0) do { sr_[i].vs0 = ld8(&Vh[(long)((k0) + sr) * LDQ + sc]); sr_[i].vs1 = ld8(&Vh[(long)((k0) + 32 + sr) * LDQ + sc]); \
    sr_[i].ks0 = ld8(&Kh[(long)((k0) + sr) * LDQ + sc]); sr_[i].ks1 = ld8(&Kh[(long)((k0) + 32 + sr) * LDQ + sc]); } while (0)
#define SWRITE(b, i) do { *(bf16x8*)((char*)V_lds + (b) * SHM_V + vst0) = sr_[i].vs0;          \
    *(bf16x8*)((char*)V_lds + (b) * SHM_V + vst1) = sr_[i].vs1; int kc = sc * 2;               \
    *(bf16x8*)((char*)K_lds + (b) * SHM_K + KSWZ(sr, kc)) = sr_[i].ks0;                       \
    *(bf16x8*)((char*)K_lds + (b) * SHM_K + KSWZ(32 + sr, kc)) = sr_[i].ks1; } while (0)
#define SWAIT() asm volatile("s_waitcnt vmcnt(4)" ::: "memory")
  f32x16 pA0, pA1, pB0, pB1; bf16x8 pa0, pa1, pa2, pa3; const int NT = seq / KVBLK;
  constexpr int SE = 0, SO = 1;
  asm volatile("s_waitcnt vmcnt(0)" ::: "memory"); SWRITE(0, SE); __syncthreads();
  qkt(pA0, pA1, K_lds, qr, r32, hi, sub); partialSM(pA0, pA1);
  SLOAD(SO, KVBLK); if (2 < NT) SLOAD(SE, 2 * KVBLK);
  SWAIT(); SWRITE(1, SO); __syncthreads();
  for (int j = 1; j + 1 < NT; j += 2) {
    SBAR(); qkt(pB0, pB1, (bf16_t*)((char*)K_lds + SHM_K), qr, r32, hi, sub);
    finishSM(pA0, pA1, l_reg, pa0, pa1, pa2, pa3); SBAR();
    SLOAD(SO, (j + 2) * KVBLK); SBAR();
    pv_d0(o, vb0, pa0, pa1, pa2, pa3); partialSM(pB0, pB1);
    __syncthreads(); SWAIT(); SWRITE(0, SE); __syncthreads();
    SBAR(); qkt(pA0, pA1, K_lds, qr, r32, hi, sub);
    finishSM(pB0, pB1, l_reg, pa0, pa1, pa2, pa3); SBAR();
    if (j + 3 < NT) SLOAD(SE, (j + 3) * KVBLK); SBAR();
    pv_d0(o, vb0 + (int)SHM_V, pa0, pa1, pa2, pa3); partialSM(pA0, pA1);
    __syncthreads(); SWAIT(); SWRITE(1, SO); __syncthreads();
  }
  sr_[SE].vs0 = ld8(&nVh[(long)sr * LDQ + sc]); sr_[SE].vs1 = ld8(&nVh[(long)(32 + sr) * LDQ + sc]); sr_[SE].ks0 = ld8(&nKh[(long)sr * LDQ + sc]); sr_[SE].ks1 = ld8(&nKh[(long)(32 + sr) * LDQ + sc]);
  SBAR(); qkt(pB0, pB1, (bf16_t*)((char*)K_lds + SHM_K), qr, r32, hi, sub);
  finishSM(pA0, pA1, l_reg, pa0, pa1, pa2, pa3); SBAR();
  pv_d0(o, vb0, pa0, pa1, pa2, pa3); partialSM(pB0, pB1);
  __syncthreads();
  finishSM(pB0, pB1, l_reg, pa0, pa1, pa2, pa3); SBAR();
  pv_d0(o, vb0 + (int)SHM_V, pa0, pa1, pa2, pa3);
  { auto rr = __builtin_amdgcn_permlane32_swap(__float_as_uint(l_reg), __float_as_uint(l_reg), false, false); l_reg = __uint_as_float(rr[0]) + __uint_as_float(rr[1]); }
  if (hi == 0) li_l[r32] = l_reg; asm volatile("s_waitcnt lgkmcnt(0)" ::: "memory");
  float rli[16];
#pragma unroll
  for (int r = 0; r < 16; ++r) rli[r] = __builtin_amdgcn_rcpf(li_l[crow(r, hi)]);
  __syncthreads();
  float* xo = (float*)lds;
  if (sub == 1) {
#pragma unroll
    for (int r = 0; r < 16; ++r) { const int orow = wq * 32 + crow(r, hi);
#pragma unroll
      for (int d0 = 0; d0 < 4; ++d0) xo[orow * 128 + d0 * 32 + r32] = o[d0][r] * rli[r]; }
  }
  __syncthreads();
  if (sub == 0) {
    float gv[4];
#pragma unroll
    for (int d0 = 0; d0 < 4; ++d0) gv[d0] = subln_g[d0 * 32 + r32] * (1.0f - LAM_INIT);
#pragma unroll
    for (int r = 0; r < 16; ++r) { const int orow = wq * 32 + crow(r, hi); float v[4]; float ssq = 0.f;
#pragma unroll
      for (int d0 = 0; d0 < 4; ++d0) { v[d0] = o[d0][r] * rli[r] - lam * xo[orow * 128 + d0 * 32 + r32]; ssq += v[d0] * v[d0]; }
      ssq += __shfl_xor(ssq, 1); ssq += __shfl_xor(ssq, 2); ssq += __shfl_xor(ssq, 4); ssq += __shfl_xor(ssq, 8); ssq += __shfl_xor(ssq, 16);
      const float sc_ = 1.0f / sqrtf(ssq * (1.0f / 128.0f) + RMS_EPS);
#pragma unroll
      for (int d0 = 0; d0 < 4; ++d0) Ya[(long)orow * 2048 + d0 * 32 + r32] = (bf16_t)f2bf(v[d0] * sc_ * gv[d0]); }
  }
  __syncthreads();
#undef SLOAD
#undef SWRITE
#undef SWAIT
}
#undef KSWZ
#undef SBAR
}

struct Args {
    const float* in[33];
    float* out; unsigned char* ws;
    int ph_lo, ph_hi;
};
enum { I_X = 0, I_ANG, I_WIN, I_QNG, I_KNG, I_LQ1, I_LK1, I_LQ2, I_LK2, I_SUBLN, I_MU, I_W0F, I_W2F, I_W0B, I_W2B, I_A0F, I_A2F, I_A0B, I_A2B, I_G2, I_KK, I_KA, I_RK,
       I_LNW, I_LNB, I_WBA, I_WBB, I_WOUT, I_FNG, I_WR, I_WG, I_WU, I_WD };

__device__ __forceinline__ void tr_item(const float* W, int ldw, int k0, int n0, bf16_t* dst, int ldd, LAS float* scr, int lane) {
    float tv[32];
    const float* src = W + (size_t)(k0 + (lane >> 5)) * ldw + n0 + (lane & 31);
#pragma unroll
    for (int i = 0; i < 32; ++i) tv[i] = src[(size_t)(2 * i) * ldw];
#pragma unroll
    for (int i = 0; i < 32; ++i) scr[(2 * i + (lane >> 5)) * 33 + (lane & 31)] = tv[i];
    asm volatile("s_waitcnt lgkmcnt(0)" ::: "memory");
    const int c = lane & 7;
#pragma unroll
    for (int j = 0; j < 4; ++j) { const int n = (lane >> 3) + 8 * j; const LAS float* s = scr + (8 * c) * 33 + n;
        v4u o; o.x = pk2(s[0 * 33], s[1 * 33]); o.y = pk2(s[2 * 33], s[3 * 33]); o.z = pk2(s[4 * 33], s[5 * 33]); o.w = pk2(s[6 * 33], s[7 * 33]);
        *(v4u*)(dst + (size_t)n * ldd + 8 * c) = o; }
    asm volatile("s_waitcnt lgkmcnt(0)" ::: "memory");
}

__device__ __forceinline__ void p0_prologue(const Args& a, LAS unsigned char* lds, int gw, int NGW, int wave, int lane) {
    unsigned char* ws = a.ws;
    LAS float* scr = (LAS float*)(lds + wave * 16384);
    bf16_t* WinT = (bf16_t*)(ws + WS_WINT);
    bf16_t* WaT = (bf16_t*)(ws + WS_WAT); bf16_t* WoT = (bf16_t*)(ws + WS_WOT);
    constexpr int I_IN = 32 * 333, I_A = 16 * 64, I_B = 16 * 64, I_O = 32 * 64, NITEMS = I_IN + I_A + I_B + I_O;
    for (int it = gw; it < NITEMS; it += NGW) {
        int r = it;
        if (r < I_IN) { const int kb = r / 333, nb = r % 333, n0 = nb * 32; int drow = n0;
            if (n0 >= 6560) { const int c = n0 - 6560, which = c >> 11, cc = c & 2047; drow = 6656 + (cc >> 7) * 256 + which * 128 + (cc & 127); }
            tr_item(a.in[I_WIN], IN_COLS, kb * 64, n0, WinT + (size_t)drow * 2048 + kb * 64, 2048, scr, lane); continue; } r -= I_IN;
        if (r < I_A) { const int kb = r / 64, nb = r % 64; tr_item(a.in[I_WBA], 2048, kb * 64, nb * 32, WaT + (size_t)(nb * 32) * 2048 + kb * 64, 2048, scr, lane); continue; } r -= I_A;
        if (r < I_B) { const int kb = r / 64, nb = r % 64; tr_item(a.in[I_WBB], 2048, kb * 64, nb * 32, WaT + (size_t)(nb * 32) * 2048 + 1024 + kb * 64, 2048, scr, lane); continue; } r -= I_B;
        { const int kb = r / 64, nb = r % 64; tr_item(a.in[I_WOUT], 2048, kb * 64, nb * 32, WoT + (size_t)(nb * 32) * 2048 + kb * 64, 2048, scr, lane); }
    }
    { const int gt = gw * 64 + lane, NT_ = NGW * 64;
      v4u z = {0u, 0u, 0u, 0u};
      for (int i = gt; i < 24576; i += NT_) ((v4u*)(WinT + (size_t)6560 * 2048))[i] = z;
      { const float invf[8] = {1.000000000e+00f, 1.939227432e-01f, 3.760603070e-02f, 7.292664610e-03f, 1.414213562e-03f, 2.742481884e-04f, 5.318296098e-05f, 1.031338616e-05f};
        for (int i = gt; i < SEQ * 8; i += NT_) { float iv = invf[0];
#pragma unroll
            for (int j = 1; j < 8; ++j) iv = ((i & 7) == j) ? invf[j] : iv;
            float sv, cv; sincosf((float)(i >> 3) * iv, &sv, &cv); ((float2*)(ws + WS_ROPE))[i] = make_float2(cv, sv); } }
      { float* sm = (float*)(ws + WS_SMALL);
#define CPY(OFF, IDX, N) for (int i = gt; i < (N); i += NT_) sm[(OFF) + i] = a.in[IDX][i];
        CPY(SM_QNG, I_QNG, 64) CPY(SM_KNG, I_KNG, 64) CPY(SM_LQ1, I_LQ1, 64) CPY(SM_LK1, I_LK1, 64) CPY(SM_LQ2, I_LQ2, 64) CPY(SM_LK2, I_LK2, 64) CPY(SM_SUBLN, I_SUBLN, 128)
        CPY(SM_MU, I_MU, 3488) CPY(SM_KK, I_KK, 1024) CPY(SM_KA, I_KA, 1024) CPY(SM_RK, I_RK, 1024) CPY(SM_LNW, I_LNW, 1024) CPY(SM_LNB, I_LNB, 1024) CPY(SM_FNG, I_FNG, 2048) CPY(SM_WR, I_WR, 32768)
#undef CPY
      }
      for (int i = gt; i < 4096; i += NT_) { const int seg = i >> 10, c = i & 1023; ((float*)(ws + WS_BIAS4))[i] = (seg == 0) ? a.in[I_W0F][c] : (seg == 1) ? a.in[I_W0B][c] : (seg == 2) ? a.in[I_A0F][c] : a.in[I_A0B][c]; }
      bf16_t* B1 = (bf16_t*)(ws + WS_BTL1); bf16_t* B2 = (bf16_t*)(ws + WS_BTL2);
      for (int i = gt; i < 4096 * 32; i += NT_) { const int n = i >> 5, kc = (i & 31) * 8, seg = n >> 10, c = n & 1023;
          const float* w2 = (seg == 0) ? a.in[I_W2F] : (seg == 1) ? a.in[I_W2B] : (seg == 2) ? a.in[I_A2F] : a.in[I_A2B];
          float f[8];
#pragma unroll
          for (int j = 0; j < 8; ++j) { const int k = kc + j - 64 * seg; f[j] = (k >= 0 && k < 64) ? w2[(size_t)k * 1024 + c] : 0.f; }
          *(v4u*)(B1 + (size_t)n * 256 + kc) = pack8(f); }
      for (int i = gt; i < 1024 * 32; i += NT_) { const int n = i >> 5, kc = (i & 31) * 8; float f[8];
#pragma unroll
          for (int j = 0; j < 8; ++j) { const int k = kc + j; f[j] = (k < 160) ? a.in[I_G2][(size_t)k * 1024 + n] : 0.f; }
          *(v4u*)(B2 + (size_t)n * 256 + kc) = pack8(f); }
    }
    bf16_t* HN = (bf16_t*)(ws + WS_HN); const float* x = a.in[I_X]; const float* g = a.in[I_ANG];
    float4 gg8[8];
#pragma unroll
    for (int j = 0; j < 8; ++j) gg8[j] = ((const float4*)g)[64 * j + lane];
    for (int m = gw; m < M; m += NGW) {
        const float4* xr = (const float4*)(x + (size_t)m * DM) + lane; float4 v[8]; float s = 0.f;
#pragma unroll
        for (int j = 0; j < 8; ++j) { v[j] = xr[64 * j]; s += (v[j].x * v[j].x + v[j].y * v[j].y) + (v[j].z * v[j].z + v[j].w * v[j].w); }
        const float rs = 1.0f / sqrtf(wave_sum(s) * (1.0f / DM) + RMS_EPS);
        v2u* o = (v2u*)(HN + (size_t)m * DM) + lane;
#pragma unroll
        for (int j = 0; j < 8; ++j) { const float4 gg = gg8[j]; v2u w; w.x = pk2(v[j].x * rs * gg.x, v[j].y * rs * gg.y); w.y = pk2(v[j].z * rs * gg.z, v[j].w * rs * gg.w); o[64 * j] = w; }
    }
}

__device__ __forceinline__ void p2_prep(const Args& a, int gw, int NGW, int lane, bool dummy = false) {
    unsigned char* ws = a.ws;
    bf16_t* PDA = (bf16_t*)(ws + WS_PDA); const bf16_t* PRW = (const bf16_t*)((unsigned char*)a.out + DO_PRW);
    bf16_t* RKV = (bf16_t*)(ws + WS_RKV); bf16_t* LIN = (bf16_t*)((unsigned char*)a.out + DO_LIN);
    const float* sm = (const float*)(ws + WS_SMALL); const float* mu = sm + SM_MU;
    const int sub8 = lane & 7;
    float gq[8], gk[8];
#pragma unroll
    for (int j = 0; j < 8; ++j) { gq[j] = sm[SM_QNG + sub8 * 8 + j]; gk[j] = sm[SM_KNG + sub8 * 8 + j]; }
    for (int m = gw; m < M; m += NGW) {
        const int t = m & (SEQ - 1);
        const float2 csv = ((const float2*)(ws + WS_ROPE))[t * 8 + sub8]; const float cv = csv.x, sv = csv.y;
        float cs[8], sn[8];
#pragma unroll
        for (int j = 0; j < 8; ++j) { cs[j] = __shfl(cv, j); sn[j] = __shfl(sv, j); }
        const bool hp = t > 0, hn_ = t < SEQ - 1;
        const bf16_t* pr = PRW + (size_t)m * RW_PAD;
        v4u rc[7], rp[7], rn[7];
#pragma unroll
        for (int it = 0; it < 7; ++it) { const int v = it * 64 + lane; const bool ok = !(it == 6 && v >= 436);
            rc[it] = (v4u){0u, 0u, 0u, 0u}; rp[it] = (v4u){0u, 0u, 0u, 0u}; rn[it] = (v4u){0u, 0u, 0u, 0u};
            if (ok) { rc[it] = *(const v4u*)(pr + v * 8); if (hp) rp[it] = *(const v4u*)(pr - RW_PAD + v * 8); if (hn_) rn[it] = *(const v4u*)(pr + RW_PAD + v * 8); } }
        v4u wq[4];
#pragma unroll
        for (int it = 0; it < 4; ++it) { const int v = it * 8 + (lane >> 3); wq[it] = *(const v4u*)(PDA + (size_t)m * 3072 + (v < 16 ? 0 : 1024) + (v & 15) * 64 + sub8 * 8); }
#pragma unroll
        for (int it = 0; it < 4; ++it) {
            const int v = it * 8 + (lane >> 3);
            bf16_t* p = PDA + (size_t)m * 3072 + (v < 16 ? 0 : 1024) + (v & 15) * 64 + sub8 * 8;
            const v4u w = wq[it]; float f[8]; unpack8(w, f);
            float s = 0.f;
#pragma unroll
            for (int j = 0; j < 8; ++j) s += f[j] * f[j];
            s = sum8(s); const float rs = 1.0f / sqrtf(s * (1.0f / 64.0f) + RMS_EPS);
            float y[8], oth[8];
#pragma unroll
            for (int j = 0; j < 8; ++j) { y[j] = f[j] * rs * (v < 16 ? gq[j] : gk[j]); }
#pragma unroll
            for (int j = 0; j < 8; ++j) oth[j] = __shfl_xor(y[j], 1);
            float o[8];
#pragma unroll
            for (int j = 0; j < 8; ++j) o[j] = (sub8 == 0) ? (y[j] * cs[j] - oth[j] * sn[j]) : (sub8 == 1) ? (y[j] * cs[j] + oth[j] * sn[j]) : y[j];
            if (v < 16) {
#pragma unroll
                for (int j = 0; j < 8; ++j) o[j] *= 0.125f * 1.4426950408889634f; }
            *(v4u*)(dummy ? (bf16_t*)(ws + WS_LORA) + (p - PDA) : p) = pack8(o);
        }
#pragma unroll
        for (int it = 0; it < 7; ++it) {
            const int v = it * 64 + lane; if (it == 6 && v >= 436) continue;
            const v4u wc = rc[it], wp = rp[it], wn = rn[it];
            float c[8], pv[8], nx[8]; unpack8(wc, c); unpack8(wp, pv); unpack8(wn, nx);
            const float4 m0 = *(const float4*)(mu + v * 8), m1 = *(const float4*)(mu + v * 8 + 4);
            const float mm[8] = {m0.x, m0.y, m0.z, m0.w, m1.x, m1.y, m1.z, m1.w};
            float xs[8];
#pragma unroll
            for (int j = 0; j < 8; ++j) xs[j] = c[j] + mm[j] * (0.5f * (pv[j] + nx[j]) - c[j]);
            if (v < 384) { const v4u pw = pack8(xs); *(v4u*)(RKV + (size_t)m * 3072 + v * 8) = pw;
                if (it == 2 || it == 3) {
                    float kr[8]; unpack8(pw, kr); float ssq = 0.f;
#pragma unroll
                    for (int j = 0; j < 8; ++j) { const float kkv = kr[j] * sm[SM_KK + (v - 128) * 8 + j]; ssq += kkv * kkv; }
                    ssq = sum8(ssq);
                    if ((lane & 7) == 0) ((float*)(ws + WS_INRM))[(size_t)m * 16 + ((v - 128) >> 3)] = 1.0f / fmaxf(sqrtf(ssq), 1e-12f); } }
            else if (v < 400) {
#pragma unroll
                for (int j = 0; j < 8; ++j) xs[j] = 1.0f - 2.0f * __builtin_amdgcn_rcpf(1.0f + __expf(2.0f * xs[j]));
                *(v4u*)(LIN + (size_t)m * 512 + (v - 384) * 8) = pack8(xs); }
            else if (v < 416) { *(v4u*)(LIN + (size_t)m * 512 + (v - 384) * 8) = pack8(xs); }
            else {
#pragma unroll
                for (int j = 0; j < 8; ++j) xs[j] = sigmoidf_(xs[j]);
                *(v4u*)(LIN + (size_t)m * 512 + 256 + (v - 416) * 8) = pack8(xs); }
        }
        if (lane < 12) { v4u z = {0u, 0u, 0u, 0u}; *(v4u*)(LIN + (size_t)m * 512 + 416 + lane * 8) = z; }
    }
}

__device__ __forceinline__ void p6_rwpost(const Args& a, int gw, int NGW, int lane) {
    unsigned char* ws = a.ws;
    const bf16_t* RKV = (const bf16_t*)(ws + WS_RKV); const bf16_t* LO = (const bf16_t*)(ws + WS_LORA);
    const bf16_t* YSF = (const bf16_t*)((unsigned char*)a.out + DO_YSF); const bf16_t* YSB = (const bf16_t*)((unsigned char*)a.out + DO_YSB);
    bf16_t* YB = (bf16_t*)((unsigned char*)a.out + DO_YAB) + 1024;
    const size_t SEG = (size_t)M * 1024; const float* sm = (const float*)(ws + WS_SMALL);
    for (int it = gw; it < 2 * M; it += NGW) {
        const int m = it >> 1, col = (it & 1) * 512 + lane * 8;
        float yf[8], ybk[8], r[8], k[8], v[8], af[8], ab[8], g[8];
        unpack8(*(const v4u*)(YSF + (size_t)m * 1024 + col), yf); unpack8(*(const v4u*)(YSB + (size_t)m * 1024 + col), ybk);
        unpack8(*(const v4u*)(RKV + (size_t)m * 3072 + col), r); unpack8(*(const v4u*)(RKV + (size_t)m * 3072 + 1024 + col), k); unpack8(*(const v4u*)(RKV + (size_t)m * 3072 + 2048 + col), v);
        unpack8(*(const v4u*)(LO + 2 * SEG + (size_t)m * 1024 + col), af); unpack8(*(const v4u*)(LO + 3 * SEG + (size_t)m * 1024 + col), ab); unpack8(*(const v4u*)(LO + 4 * SEG + (size_t)m * 1024 + col), g);
        float y[8]; float s = 0.f;
#pragma unroll
        for (int j = 0; j < 8; ++j) { y[j] = yf[j] + ybk[j]; s += y[j]; }
        const float mean = sum8(s) * (1.0f / 64.0f); float q = 0.f;
#pragma unroll
        for (int j = 0; j < 8; ++j) { y[j] -= mean; q += y[j] * y[j]; }
        const float rstd = 1.0f / sqrtf(sum8(q) * (1.0f / 64.0f) + GN_EPS);
        float bs = 0.f;
#pragma unroll
        for (int j = 0; j < 8; ++j) { const float kfb = k[j] * (2.0f + (af[j] + ab[j] - 2.0f) * sm[SM_KA + col + j]); bs += r[j] * kfb * sm[SM_RK + col + j]; }
        bs = sum8(bs);
        float o[8];
#pragma unroll
        for (int j = 0; j < 8; ++j) o[j] = (y[j] * rstd * sm[SM_LNW + col + j] + sm[SM_LNB + col + j] + bs * v[j]) * g[j];
        *(v4u*)(YB + (size_t)m * 2048 + col) = pack8(o);
    }
}

__device__ __forceinline__ void expert_convert_gu(const Args& a, LAS unsigned char* lds, int gw, int NGW, int wave, int lane, int e_lo, int e_hi, int it_end = 1 << 30) {
    unsigned char* ws = a.ws;
    LAS float* scr = (LAS float*)(lds + wave * 16384);
    const int per = (e_hi - e_lo) * 1024;
    for (int it = gw; it < 2 * per && it < it_end; it += NGW) {
        const int which = it >= per ? 1 : 0, r = it - which * per, e = e_lo + (r >> 10), q = r & 1023;
        const int kb = q >> 5, nb = q & 31, n0 = nb * 32;
        const float* W = (which == 0 ? a.in[I_WG] : a.in[I_WU]) + (size_t)e * 2048 * 1024;
        const int drow = (n0 >> 7) * 256 + which * 128 + (n0 & 127);
        tr_item(W, 1024, kb * 64, n0, (bf16_t*)(ws + w1t_base(e)) + (size_t)drow * 2048 + kb * 64, 2048, scr, lane); }
}
__device__ __forceinline__ void expert_convert_down(const Args& a, LAS unsigned char* lds, int gw, int NGW, int wave, int lane) {
    unsigned char* ws = a.ws;
    LAS float* scr = (LAS float*)(lds + wave * 16384);
    bf16_t* WDT = (bf16_t*)(ws + WS_WDT);
    for (int it = gw; it < 16384; it += NGW) { const int e = it >> 10, q = it & 1023, kb = q >> 6, nb = q & 63;
        const float* W = a.in[I_WD] + (size_t)e * 1024 * 2048;
        tr_item(W, 2048, kb * 64, nb * 32, WDT + ((size_t)e * 2048 + nb * 32) * 1024 + kb * 64, 1024, scr, lane); }
}
__device__ __forceinline__ void p9_router(const Args& a, LAS unsigned char* lds, int gw, int NGW, int wave, int lane) {
    unsigned char* ws = a.ws;
    expert_convert_gu(a, lds, gw, NGW, wave, lane, (gridDim.x == 256) ? N_EARLY_EXPERTS : 0, NE);
    __syncthreads();
    LAS float* wrT = (LAS float*)lds;
    { const float4* wr4 = (const float4*)((const float*)(ws + WS_SMALL) + SM_WR);
      for (int idx = fresh_tid(); idx < 2048 * 4; idx += NTHREADS) { const int d = idx >> 2, q = idx & 3; const float4 w4 = wr4[idx];
          wrT[(4 * q + 0) * 2048 + d] = w4.x; wrT[(4 * q + 1) * 2048 + d] = w4.y; wrT[(4 * q + 2) * 2048 + d] = w4.z; wrT[(4 * q + 3) * 2048 + d] = w4.w; } }
    __syncthreads();
    const float* h = a.out; const float* ss = (const float*)(ws + WS_SSP); const float* g = (const float*)(ws + WS_SMALL) + SM_FNG;
    float* aff = (float*)(ws + WS_AFF); bf16_t* hn2 = (bf16_t*)(ws + WS_HN2);
    for (int mp = gw; mp < M / 2; mp += NGW) {
        const int m0 = 2 * mp;
        const float rs0 = 1.0f / sqrtf(wave_sum(lane < 32 ? ss[(size_t)m0 * 32 + lane] : 0.f) * (1.0f / DM) + RMS_EPS);
        const float rs1 = 1.0f / sqrtf(wave_sum(lane < 32 ? ss[(size_t)(m0 + 1) * 32 + lane] : 0.f) * (1.0f / DM) + RMS_EPS);
        float acc0[16], acc1[16];
#pragma unroll
        for (int e = 0; e < 16; ++e) { acc0[e] = 0.f; acc1[e] = 0.f; }
#pragma unroll 2
        for (int j = 0; j < 8; ++j) { const int d = j * 256 + lane * 4;
            const float4 gv = *(const float4*)(g + d), h0 = *(const float4*)(h + (size_t)m0 * DM + d), h1 = *(const float4*)(h + (size_t)(m0 + 1) * DM + d);
            const float x0[4] = {h0.x * rs0 * gv.x, h0.y * rs0 * gv.y, h0.z * rs0 * gv.z, h0.w * rs0 * gv.w};
            const float x1[4] = {h1.x * rs1 * gv.x, h1.y * rs1 * gv.y, h1.z * rs1 * gv.z, h1.w * rs1 * gv.w};
            { v2u w0, w1; w0.x = pk2(x0[0], x0[1]); w0.y = pk2(x0[2], x0[3]); w1.x = pk2(x1[0], x1[1]); w1.y = pk2(x1[2], x1[3]);
              *(v2u*)(hn2 + (size_t)m0 * DM + d) = w0; *(v2u*)(hn2 + (size_t)(m0 + 1) * DM + d) = w1; }
#pragma unroll
            for (int e = 0; e < 16; ++e) { const pg8::f32x4 w4 = *(const LAS pg8::f32x4*)(wrT + e * 2048 + d);
                acc0[e] += x0[0] * w4.x + x0[1] * w4.y + x0[2] * w4.z + x0[3] * w4.w;
                acc1[e] += x1[0] * w4.x + x1[1] * w4.y + x1[2] * w4.z + x1[3] * w4.w; } }
#pragma unroll
        for (int t2 = 0; t2 < 2; ++t2) {
            float mx = -1e30f, lg[16];
#pragma unroll
            for (int e = 0; e < 16; ++e) { lg[e] = wave_sum(t2 ? acc1[e] : acc0[e]); mx = fmaxf(mx, lg[e]); }
            float den = 0.f;
#pragma unroll
            for (int e = 0; e < 16; ++e) { lg[e] = __expf(lg[e] - mx); den += lg[e]; }
            float mine = lg[0];
#pragma unroll
            for (int e = 1; e < 16; ++e) mine = (lane == e) ? lg[e] : mine;
            const int m = m0 + t2;
            if (lane < 16) aff[((size_t)(m >> 12) * 16 + lane) * SEQ + (m & (SEQ - 1))] = mine / den;
        }
    }
}

__device__ __forceinline__ void p10_topk(const Args& a, unsigned char* ldsg) {
    const int bx = blockIdx.x; if (bx >= NB * NE) return;
    LAS unsigned char* L = (LAS unsigned char*)ldsg;
    const int tid = fresh_tid(), lane = tid & 63, w = tid >> 6;
    unsigned char* ws = a.ws;
    const float* aff = (const float*)(ws + WS_AFF) + (size_t)bx * SEQ;
    LAS unsigned* hist = (LAS unsigned*)L;
    LAS unsigned* ctl = hist + 256;
    LAS unsigned* wtot = hist + 272;
    unsigned v[8];
    { const v4u a0 = *(const v4u*)(aff + tid * 8), a1 = *(const v4u*)(aff + tid * 8 + 4); v[0] = a0.x; v[1] = a0.y; v[2] = a0.z; v[3] = a0.w; v[4] = a1.x; v[5] = a1.y; v[6] = a1.z; v[7] = a1.w; }
    unsigned prefix = 0u, mask = 0u, remaining = CAP;
#pragma unroll 1
    for (int pass = 0; pass < 4; ++pass) {
        const int shift = 24 - 8 * pass;
        if (tid < 256) hist[tid] = 0u;
        __syncthreads();
#pragma unroll
        for (int q = 0; q < 8; ++q) if ((v[q] & mask) == prefix) __hip_atomic_fetch_add((unsigned*)&hist[(v[q] >> shift) & 255u], 1u, __ATOMIC_RELAXED, __HIP_MEMORY_SCOPE_WORKGROUP);
        __syncthreads();
        if (w == 0) {
            const v4u hb = *(const LAS v4u*)(hist + 4 * lane);
            const unsigned own = hb.x + hb.y + hb.z + hb.w;
            unsigned suf = own;
#pragma unroll
            for (int o = 1; o < 64; o <<= 1) { const unsigned t = __shfl_down(suf, o); suf += (lane + o < 64) ? t : 0u; }
            const unsigned above = suf - own;
            if (above < remaining && remaining <= suf) {
                unsigned c3 = above, d, rem;
                if (remaining <= c3 + hb.w) { d = 3; rem = remaining - c3; }
                else { c3 += hb.w; if (remaining <= c3 + hb.z) { d = 2; rem = remaining - c3; }
                    else { c3 += hb.z; if (remaining <= c3 + hb.y) { d = 1; rem = remaining - c3; } else { c3 += hb.y; d = 0; rem = remaining - c3; } } }
                ctl[0] = 4u * lane + d; ctl[1] = rem;
            }
        }
        __syncthreads();
        prefix |= ctl[0] << shift; mask |= 255u << shift; remaining = ctl[1];
        __syncthreads();
    }
    const unsigned thr = prefix;
    unsigned ceq = 0u, cgt = 0u;
#pragma unroll
    for (int q = 0; q < 8; ++q) { ceq += (v[q] == thr) ? 1u : 0u; cgt += (v[q] > thr) ? 1u : 0u; }
    unsigned inc = ceq;
#pragma unroll
    for (int o = 1; o < 64; o <<= 1) { const unsigned t = __shfl_up(inc, o); inc += (lane >= o) ? t : 0u; }
    if (lane == 63) wtot[w] = inc;
    __syncthreads();
    unsigned eqbase = inc - ceq;
#pragma unroll
    for (int q = 0; q < 8; ++q) eqbase += (q < w) ? wtot[q] : 0u;
    __syncthreads();
    unsigned selmask = 0u, nsel = 0u, er = eqbase;
#pragma unroll
    for (int q = 0; q < 8; ++q) { bool s = v[q] > thr; if (v[q] == thr) { s = er < remaining; ++er; } selmask |= s ? (1u << q) : 0u; nsel += s ? 1u : 0u; }
    inc = nsel;
#pragma unroll
    for (int o = 1; o < 64; o <<= 1) { const unsigned t = __shfl_up(inc, o); inc += (lane >= o) ? t : 0u; }
    if (lane == 63) wtot[w] = inc;
    __syncthreads();
    unsigned pos = inc - nsel;
#pragma unroll
    for (int q = 0; q < 8; ++q) pos += (q < w) ? wtot[q] : 0u;
    int* seltok = (int*)(ws + WS_SELTOK) + bx * CAP; float* selgate = (float*)(ws + WS_SELGATE) + bx * CAP;
#pragma unroll
    for (int q = 0; q < 8; ++q) if (selmask & (1u << q)) { if (pos < (unsigned)CAP) { seltok[pos] = tid * 8 + q; selgate[pos] = __uint_as_float(v[q]); } ++pos; }
    (void)cgt;
}

__device__ __forceinline__ void p11_gather(const Args& a, int gw, int NGW, int lane) {
    unsigned char* ws = a.ws;
    const float* h = a.out; const float* ss = (const float*)(ws + WS_SSP); const float* g = (const float*)(ws + WS_SMALL) + SM_FNG;
    const int* seltok = (const int*)(ws + WS_SELTOK); bf16_t* XE = (bf16_t*)(ws + WS_XE);
    for (int r = gw; r < NSLOT; r += NGW) {
        const int e = r >> 11, b = (r >> 9) & 3, c = r & 511;
        const int tok = seltok[(b * 16 + e) * CAP + c]; const size_t m = (size_t)b * SEQ + tok;
        const float rs = 1.0f / sqrtf(wave_sum(lane < 32 ? ss[m * 32 + lane] : 0.f) * (1.0f / DM) + RMS_EPS);
        const float4* hr = (const float4*)(h + m * DM) + lane; v2u* o = (v2u*)(XE + (size_t)r * DM) + lane;
#pragma unroll
        for (int j = 0; j < 8; ++j) { const float4 hv = hr[64 * j], gg = ((const float4*)g)[64 * j + lane];
            v2u w; w.x = pk2(hv.x * rs * gg.x, hv.y * rs * gg.y); w.y = pk2(hv.z * rs * gg.z, hv.w * rs * gg.w); o[64 * j] = w; }
    }
}

__device__ __forceinline__ void p14_combine(const Args& a, unsigned char* lds, int wave, int lane) {
    unsigned char* ws = a.ws;
    const int G = gridDim.x, bx = blockIdx.x, tid = fresh_tid();
    const int per = M / G;
    const int m0 = bx * per, b = m0 >> 12, t0 = m0 & (SEQ - 1);
    int* inv = (int*)lds;
    for (int i = tid; i < per * 16; i += NTHREADS) inv[i] = -1;
    __syncthreads();
    const int* seltok = (const int*)(ws + WS_SELTOK) + b * 16 * CAP;
    for (int i = tid; i < 16 * CAP; i += NTHREADS) { const int e = i >> 9, c = i & 511; const int tok = seltok[i]; const int tl = tok - t0;
        if (tl >= 0 && tl < per) inv[tl * 16 + e] = e * 2048 + b * 512 + c; }
    __syncthreads();
    const bf16_t* YE = (const bf16_t*)(ws + WS_XE);
    float* out = a.out;
    for (int tl = wave; tl < per; tl += NWAVES) {
        const size_t m = (size_t)m0 + tl;
        float4* orow = (float4*)(out + m * DM) + lane;
        float4 acc[8];
#pragma unroll
        for (int j = 0; j < 8; ++j) acc[j] = orow[64 * j];
        int sl[16]; int ns = 0;
#pragma unroll
        for (int e = 0; e < 16; ++e) { const int s_ = inv[tl * 16 + e]; if (s_ >= 0) { _Pragma("unroll") for (int q = 0; q < 16; ++q) if (q == ns) sl[q] = s_; ++ns; } }
        for (int q = 0; q < ns; q += 2) { int s0 = sl[0], s1 = sl[0];
#pragma unroll
            for (int z = 0; z < 16; ++z) { if (z == q) s0 = sl[z]; if (z == q + 1) s1 = sl[z]; }
            const bool two = q + 1 < ns;
            const v2u* y0 = (const v2u*)(YE + (size_t)s0 * DM) + lane; const v2u* y1 = (const v2u*)(YE + (size_t)(two ? s1 : s0) * DM) + lane;
            v2u w0[8], w1[8];
#pragma unroll
            for (int j = 0; j < 8; ++j) { w0[j] = y0[64 * j]; w1[j] = y1[64 * j]; }
#pragma unroll
            for (int j = 0; j < 8; ++j) { acc[j].x += bflo(w0[j].x); acc[j].y += bfhi(w0[j].x); acc[j].z += bflo(w0[j].y); acc[j].w += bfhi(w0[j].y);
                if (two) { acc[j].x += bflo(w1[j].x); acc[j].y += bfhi(w1[j].x); acc[j].z += bflo(w1[j].y); acc[j].w += bfhi(w1[j].y); } } }
#pragma unroll
        for (int j = 0; j < 8; ++j) orow[64 * j] = acc[j];
    }
}


namespace scan {
typedef short bf16x8 __attribute__((ext_vector_type(8)));
typedef float f32x4 __attribute__((ext_vector_type(4)));
constexpr int TILE_B = 64 * 128;
enum { SL_ATC = 0, SL_BTC = 1, SL_KTC = 2, SL_RTC = 3, SL_BBT = 4, SL_KBT = 5, SL_VT = 6, SL_XCA = 7, SL_TTA = 8, SL_NKA = 9, SL_NBRT = 10, SL_G = 11, SL_SB = 12, SL_RP = 13, SL_BBT1 = 14, SL_VT1 = 15, SL_NKR = 16,
       SL_XCB = 1, SL_TTB = 2, SL_APT = 7, SL_HT = 9, SL_PSIT = 8, SL_WB = 10 };
constexpr int OFF_PL = 17 * TILE_B, OFF_TOT = OFF_PL + 512, OFF_CNT = OFF_TOT + 4096;
#define TILE(s) (L + (s) * TILE_B)
__device__ __forceinline__ int swz16(int r) { return (((r & 7) ^ (((r >> 3) & 1) * 5)) << 4); }
__device__ __forceinline__ int toff(int row, int colbyte) { return row * 128 + (colbyte ^ swz16(row)); }
__device__ __forceinline__ bf16x8 frag(const LAS unsigned char* tile, int row0, int k0, int lane) {
    const int l15 = lane & 15, g4 = lane >> 4;
    return *(const LAS bf16x8*)(tile + row0 * 128 + l15 * 128 + (((g4 << 4) ^ swz16(l15)) ^ (k0 * 2)));
}
__device__ __forceinline__ void st4(LAS unsigned char* tile, int brow, int acol0, const f32x4& v) {
    v2u w; w.x = pg8::cvt_pk_bf16(v[0], v[1]); w.y = pg8::cvt_pk_bf16(v[2], v[3]); *(LAS v2u*)(tile + toff(brow, acol0 * 2)) = w;
}
__device__ __forceinline__ f32x4 ld4(const LAS unsigned char* tile, int brow, int acol0) {
    const v2u w = *(const LAS v2u*)(tile + toff(brow, acol0 * 2)); return (f32x4){bflo(w.x), bfhi(w.x), bflo(w.y), bfhi(w.y)};
}
typedef short v4i16_t __attribute__((ext_vector_type(4)));
typedef short bf16x4 __attribute__((ext_vector_type(4)));
typedef float f32x2 __attribute__((ext_vector_type(2)));
__device__ __forceinline__ bf16x8 fragT(const LAS unsigned char* tileT, int row0, int k0, int lane) {
    const int g = lane >> 4, q = (lane >> 2) & 3, p = lane & 3;
    const int t0 = (8 * g + q) * 128 + ((8 * p) ^ ((q ^ ((g & 1) * 5)) << 4));
    const LAS unsigned char* a = tileT + k0 * 128;
    const v4i16_t lo = __builtin_amdgcn_ds_read_tr16_b64_v4i16((LAS v4i16_t*)(a + (t0 ^ (row0 * 2)))), hi = __builtin_amdgcn_ds_read_tr16_b64_v4i16((LAS v4i16_t*)(a + 512 + ((t0 ^ 64) ^ (row0 * 2))));
    return (bf16x8){lo[0], lo[1], lo[2], lo[3], hi[0], hi[1], hi[2], hi[3]};
}
struct Fr { bf16x8 k0, k1; };
__device__ __forceinline__ Fr ldf(const LAS unsigned char* tile, int row0, int lane) { Fr f; f.k0 = frag(tile, row0, 0, lane); f.k1 = frag(tile, row0, 32, lane); return f; }
__device__ __forceinline__ Fr ldfT(const LAS unsigned char* tileT, int row0, int lane) { Fr f; f.k0 = fragT(tileT, row0, 0, lane); f.k1 = fragT(tileT, row0, 32, lane); return f; }
__device__ __forceinline__ void mmf(f32x4& acc, const Fr& A, const Fr& B) {
    acc = __builtin_amdgcn_mfma_f32_16x16x32_bf16(A.k0, B.k0, acc, 0, 0, 0); acc = __builtin_amdgcn_mfma_f32_16x16x32_bf16(A.k1, B.k1, acc, 0, 0, 0);
}
#define ZERO4 ((f32x4){0.f, 0.f, 0.f, 0.f})
#ifndef TP_SEL
#define TP_SEL -1
#endif
#ifndef TP_WAVE
#define TP_WAVE 0
#endif
#if TP_SEL >= 0
#define TP_MARK(k) do { if (w == TP_WAVE) { const unsigned long long t_ = __builtin_amdgcn_s_memtime(); if (TP_SEL == (k) || TP_SEL == 7) tp_acc += t_ - tp_last; tp_last = t_; } } while (0)
#else
#define TP_MARK(k) do { } while (0)
#endif
__device__ __forceinline__ int opq(int x) { asm volatile("" : "+v"(x)); return x; }
#define LWAIT() asm volatile("s_waitcnt lgkmcnt(0)" ::: "memory")

__device__ __forceinline__ void scan_phase(const Args& a, unsigned char* ldsg) {
    const int bx = blockIdx.x; if (bx >= 128) return;
    LAS unsigned char* L = (LAS unsigned char*)ldsg;
    const int tid = fresh_tid(), lane0 = tid & 63, w = __builtin_amdgcn_readfirstlane(tid >> 6);
    const int dir = bx >> 6, b = (bx >> 4) & 3, hh = bx & 15;
    unsigned char* ws = a.ws;
    bf16_t* YS = (bf16_t*)((unsigned char*)a.out + (dir ? DO_YSB : DO_YSF));
    const int ta = w >> 1, tb0 = (w & 1) * 2;
#define STAGE_LANE() const int lane = opq(lane0), g4 = lane >> 4, l15 = lane & 15, a0 = ta * 16 + 4 * g4
    unsigned rw[8][5]; float inr[8];
    const int wk = w & 3, tg = lane0 >> 5, cp = lane0 & 31;
    const unsigned char* RKVh = ws + WS_RKV + hh * 128; const unsigned char* LWh = ws + WS_LORA + (size_t)dir * ((size_t)M * 2048) + hh * 128; const unsigned char* ALh = ws + WS_LORA + (size_t)(2 + dir) * ((size_t)M * 2048) + hh * 128;
    const int tlane = dir ? (1 - tg) * 8 : tg * 8;
    const unsigned vR = (unsigned)(tlane * 6144 + cp * 4), vL = (unsigned)(tlane * 2048 + cp * 4), vI = (unsigned)(tlane * 64);
    const float* INRM = (const float*)(ws + WS_INRM) + hh;
    const f32x2 kkc2 = *(const f32x2*)((const float*)(ws + WS_SMALL) + SM_KK + hh * 64 + 2 * cp), kac2 = *(const f32x2*)((const float*)(ws + WS_SMALL) + SM_KA + hh * 64 + 2 * cp);
#define RAW_LOAD(chunk, j0) do { _Pragma("unroll") for (int j = (j0); j < (j0) + 4; ++j) { const int s_ = (chunk) * 64 + wk * 16 + j; const int t_ = dir ? (SEQ - 1 - s_ - 8) : s_; const size_t m_ = (size_t)b * SEQ + t_; \
        const unsigned char* pr_ = RKVh + m_ * 6144; const unsigned char* pl_ = LWh + m_ * 2048; const unsigned char* pa_ = ALh + m_ * 2048; \
        rw[j][0] = *(const unsigned*)(pr_ + vR); rw[j][1] = *(const unsigned*)(pr_ + 2048 + vR); rw[j][2] = *(const unsigned*)(pr_ + 4096 + vR); rw[j][3] = *(const unsigned*)(pl_ + vL); rw[j][4] = *(const unsigned*)(pa_ + vL); \
        inr[j] = *(const float*)((const unsigned char*)(INRM + m_ * 16) + vI); } } while (0)
#define DSUM(n) do { const int l2_ = fresh_tid() & 63, tg_ = l2_ >> 5, cp_ = l2_ & 31; \
        f32x2 run_ = {0.f, 0.f}; _Pragma("unroll") for (int j = 0; j < 8; ++j) run_ += (f32x2){bflo(rw[j][3]), bfhi(rw[j][3])}; \
        *(LAS f32x2*)(L + OFF_TOT + ((((n) & 1) * 8 + 2 * wk + tg_) * 64 + 2 * cp_) * 4) = run_; \
        LWAIT(); \
        if (l2_ == 0) __hip_atomic_fetch_add((unsigned*)(L + OFF_CNT), 1u, __ATOMIC_RELAXED, __HIP_MEMORY_SCOPE_WORKGROUP); \
        while (*(volatile LAS unsigned*)(L + OFF_CNT) < 4u * (unsigned)((n) + 1)) __builtin_amdgcn_s_sleep(1); } while (0)
    f32x2 prun, ppv, ppl; unsigned pk[6][2][4], vt[2][4];
#define PTOK(jp) do { f32x2 o[2][6]; \
        _Pragma("unroll") for (int h = 0; h < 2; ++h) { const int j = 2 * (jp) + h; \
            prun += (f32x2){bflo(rw[j][3]), bfhi(rw[j][3])} * 1.44269504f; \
            const f32x2 p = {__builtin_amdgcn_exp2f(prun[0]), __builtin_amdgcn_exp2f(prun[1])}, em = {__builtin_amdgcn_rcpf(p[0]), __builtin_amdgcn_rcpf(p[1])}, eL = ppl * em; \
            const f32x2 r = {bflo(rw[j][0]), bfhi(rw[j][0])}, k = {bflo(rw[j][1]), bfhi(rw[j][1])}, al = {bflo(rw[j][4]), bfhi(rw[j][4])}; \
            const f32x2 kk = k * kkc2 * inr[j], kdv = k * (1.0f + (al - 1.0f) * kac2), bbj = kk * al; \
            o[h][0] = -kk * ppv; ppv = p; o[h][1] = bbj * em; o[h][2] = kdv * em; o[h][3] = r * p; o[h][4] = bbj * eL; o[h][5] = kdv * eL; } \
        _Pragma("unroll") for (int q = 0; q < 6; ++q) { pk[q][0][jp] = pk2(o[0][q][0], o[1][q][0]); pk[q][1][jp] = pk2(o[0][q][1], o[1][q][1]); } \
        vt[0][jp] = (rw[2 * (jp)][2] & 0xffffu) | (rw[2 * (jp) + 1][2] << 16); vt[1][jp] = (rw[2 * (jp)][2] >> 16) | (rw[2 * (jp) + 1][2] & 0xffff0000u); } while (0)
#define PREP1(n) do { const int l2_ = fresh_tid() & 63, tg_ = l2_ >> 5, cp_ = l2_ & 31; \
        f32x2 run = {0.f, 0.f}, tot = {0.f, 0.f}; \
        _Pragma("unroll") for (int q = 0; q < 8; ++q) { const f32x2 t_ = *(const LAS f32x2*)(L + OFF_TOT + ((((n) & 1) * 8 + q) * 64 + 2 * cp_) * 4); \
            const float m_ = (q < 2 * wk + tg_) ? 1.0f : 0.f; run += t_ * m_; tot += t_; } \
        run *= 1.44269504f; tot *= 1.44269504f;                                                                \
        ppl = (f32x2){__builtin_amdgcn_exp2f(tot[0]), __builtin_amdgcn_exp2f(tot[1])}; \
        if (wk == 0 && tg_ == 0) *(LAS f32x2*)(L + OFF_PL + (((n) & 1) * 64 + 2 * cp_) * 4) = ppl; \
        prun = run; ppv = (f32x2){__builtin_amdgcn_exp2f(run[0]), __builtin_amdgcn_exp2f(run[1])}; \
        PTOK(0); PTOK(1); } while (0)
#define PREP2(n) do { const int l2_ = fresh_tid() & 63, tg_ = l2_ >> 5, cp_ = l2_ & 31; \
        PTOK(2); PTOK(3); \
        LAS unsigned char* bbt_ = TILE(((n) & 1) ? SL_BBT1 : SL_BBT); LAS unsigned char* vt_ = TILE(((n) & 1) ? SL_VT1 : SL_VT); \
        _Pragma("unroll") for (int x = 0; x < 2; ++x) { const int o16 = toff(2 * cp_ + x, (wk * 16 + tg_ * 8) * 2); \
            *(LAS v4u*)(TILE(SL_ATC) + o16) = (v4u){pk[0][x][0], pk[0][x][1], pk[0][x][2], pk[0][x][3]}; *(LAS v4u*)(TILE(SL_BTC) + o16) = (v4u){pk[1][x][0], pk[1][x][1], pk[1][x][2], pk[1][x][3]}; \
            *(LAS v4u*)(TILE(SL_KTC) + o16) = (v4u){pk[2][x][0], pk[2][x][1], pk[2][x][2], pk[2][x][3]}; *(LAS v4u*)(TILE(SL_RTC) + o16) = (v4u){pk[3][x][0], pk[3][x][1], pk[3][x][2], pk[3][x][3]}; \
            *(LAS v4u*)(bbt_ + o16) = (v4u){pk[4][x][0], pk[4][x][1], pk[4][x][2], pk[4][x][3]}; *(LAS v4u*)(TILE(SL_KBT) + o16) = (v4u){pk[5][x][0], pk[5][x][1], pk[5][x][2], pk[5][x][3]}; \
            *(LAS v4u*)(vt_ + o16) = (v4u){vt[x][0], vt[x][1], vt[x][2], vt[x][3]}; } \
    } while (0)
#if TP_SEL >= 0
    unsigned long long tp_acc = 0, tp_last = __builtin_amdgcn_s_memtime();
#endif
    f32x4 accS[4];
#pragma unroll
    for (int q = 0; q < 4; ++q) accS[q] = (f32x4){0.f, 0.f, 0.f, 0.f};
    for (int u = tid; u < TILE_B / 16; u += NTHREADS) ((LAS v4u*)TILE(SL_SB))[u] = (v4u){0u, 0u, 0u, 0u};
    if (tid == 0) *(LAS unsigned*)(L + OFF_CNT) = 0u;
    if (w >= 4) { RAW_LOAD(0, 0); RAW_LOAD(0, 4); }
    __syncthreads();
    if (w >= 4) { DSUM(0); PREP1(0); PREP2(0); }
#pragma unroll 1
    for (int c = 0; c < SEQ / 64; ++c) {
        LAS unsigned char* BBTc = TILE((c & 1) ? SL_BBT1 : SL_BBT); LAS unsigned char* VTc = TILE((c & 1) ? SL_VT1 : SL_VT);
        TP_MARK(5);
        __syncthreads();
        TP_MARK(0);
        if (w >= 4 && c + 1 < SEQ / 64) { RAW_LOAD(c + 1, 0); RAW_LOAD(c + 1, 4); }
        {   STAGE_LANE();
            const int p = w & 3;
            LAS unsigned char* As = TILE((p == 0 || p == 2) ? SL_BTC : SL_KTC); LAS unsigned char* Bs = TILE(p < 2 ? SL_ATC : SL_RTC);
            LAS unsigned char* Ds = TILE(p == 0 ? SL_XCA : p == 1 ? SL_NKA : p == 2 ? SL_NBRT : SL_NKR);
            const int lim = l15 + (p < 2 ? 0 : 1) - 4 * g4;
#define S1_MASK(dv) do { _Pragma("unroll") for (int e = 0; e < 4; ++e) (dv)[e] = (e < lim) ? (dv)[e] : 0.f; } while (0)
#define S1_EYE(dv) do { _Pragma("unroll") for (int e = 0; e < 4; ++e) (dv)[e] += (e == l15 - 4 * g4) ? 1.0f : 0.f; } while (0)
            if (w < 4) {
                const Fr a0f = ldfT(As, 0, lane), a1f = ldfT(As, 16, lane); Fr bf[4];
#pragma unroll
                for (int j = 0; j < 4; ++j) bf[j] = ldfT(Bs, j * 16, lane);
                f32x4 d0[4], d1[3];
#pragma unroll
                for (int j = 0; j < 4; ++j) { d0[j] = ZERO4; mmf(d0[j], a0f, bf[j]); }
#pragma unroll
                for (int j = 0; j < 3; ++j) { d1[j] = ZERO4; mmf(d1[j], a1f, bf[j + 1]); }
                S1_MASK(d0[0]); S1_MASK(d1[0]);
#pragma unroll
                for (int j = 0; j < 4; ++j) st4(Ds, j * 16 + l15, 4 * g4, d0[j]);
#pragma unroll
                for (int j = 0; j < 3; ++j) st4(Ds, (j + 1) * 16 + l15, 16 + 4 * g4, d1[j]);
                if (p == 0) { S1_EYE(d0[0]); S1_EYE(d1[0]);
#pragma unroll
                    for (int j = 0; j < 4; ++j) st4(TILE(SL_TTA), j * 16 + l15, 4 * g4, d0[j]);
#pragma unroll
                    for (int j = 0; j < 3; ++j) st4(TILE(SL_TTA), (j + 1) * 16 + l15, 16 + 4 * g4, d1[j]); }
            } else {
                const Fr a2f = ldfT(As, 32, lane), a3f = ldfT(As, 48, lane), b2f = ldfT(Bs, 32, lane), b3f = ldfT(Bs, 48, lane);
                f32x4 d22 = ZERO4, d23 = ZERO4, d33 = ZERO4;
                mmf(d22, a2f, b2f); mmf(d23, a2f, b3f); mmf(d33, a3f, b3f);
                S1_MASK(d22); S1_MASK(d33);
                st4(Ds, 32 + l15, 32 + 4 * g4, d22); st4(Ds, 48 + l15, 32 + 4 * g4, d23); st4(Ds, 48 + l15, 48 + 4 * g4, d33);
                if (p < 3) { LAS unsigned char* Zs = p == 0 ? TILE(SL_TTA) : Ds; const f32x4 z = ZERO4;
                    st4(Zs, l15, 16 + 4 * g4, z); st4(Zs, l15, 32 + 4 * g4, z); st4(Zs, l15, 48 + 4 * g4, z); st4(Zs, 16 + l15, 32 + 4 * g4, z); st4(Zs, 16 + l15, 48 + 4 * g4, z); st4(Zs, 32 + l15, 48 + 4 * g4, z); }
                if (p == 0) { const f32x4 z = ZERO4; st4(Ds, l15, 16 + 4 * g4, z); st4(Ds, 32 + l15, 48 + 4 * g4, z);
                    S1_EYE(d22); S1_EYE(d33); st4(TILE(SL_TTA), 32 + l15, 32 + 4 * g4, d22); st4(TILE(SL_TTA), 48 + l15, 32 + 4 * g4, d23); st4(TILE(SL_TTA), 48 + l15, 48 + 4 * g4, d33); }
            }
#undef S1_MASK
#undef S1_EYE
        }
        __syncthreads();
        TP_MARK(1);
        if (w < 2) {
            STAGE_LANE();
            const int d = w, s0 = 2 * d, s1 = 2 * d + 1, kd = 32 * d;
#define CAT(lo, hi) ((bf16x8)__builtin_shufflevector(lo, hi, 0, 1, 2, 3, 4, 5, 6, 7))
#define CV4(v) __builtin_bit_cast(bf16x4, (v2u){pk2((v)[0], (v)[1]), pk2((v)[2], (v)[3])})
#define MM(A, B, C) __builtin_amdgcn_mfma_f32_16x16x32_bf16(A, B, C, 0, 0, 0)
            const bf16x4 z4 = {0, 0, 0, 0};
            bf16x8 AF0 = fragT(TILE(SL_XCA), s0 * 16, kd, lane), AF1 = fragT(TILE(SL_XCA), s1 * 16, kd, lane);
            bf16x8 BF0 = frag(TILE(SL_XCA), s0 * 16, kd, lane), BF1 = frag(TILE(SL_XCA), s1 * 16, kd, lane);
            f32x4 t00 = ld4(TILE(SL_TTA), s0 * 16 + l15, s0 * 16 + 4 * g4), t01 = ld4(TILE(SL_TTA), s1 * 16 + l15, s0 * 16 + 4 * g4), t11 = ld4(TILE(SL_TTA), s1 * 16 + l15, s1 * 16 + 4 * g4);
            f32x4 l02, l03, l12, l13;
            if (w == 0) {
                l02 = ld4(TILE(SL_TTA), 32 + l15, 4 * g4); l03 = ld4(TILE(SL_TTA), 48 + l15, 4 * g4); l12 = ld4(TILE(SL_TTA), 32 + l15, 16 + 4 * g4); l13 = ld4(TILE(SL_TTA), 48 + l15, 16 + 4 * g4);
                const bf16x8 C2 = frag(TILE(SL_TTA), 32, 0, lane), C3 = frag(TILE(SL_TTA), 48, 0, lane);
                l02 = MM(AF0, C2, l02); l03 = MM(AF0, C3, l03); l12 = MM(AF1, C2, l12); l13 = MM(AF1, C3, l13);
            }
#pragma unroll
            for (int r = 0; r <= 4; ++r) {
                if (r >= 1) {
                    const bf16x8 BT0 = CAT(CV4(t00), z4), BT1 = CAT(CV4(t01), CV4(t11));
                    if (w == 0) { const bf16x8 BL2 = CAT(CV4(l02), CV4(l12)), BL3 = CAT(CV4(l03), CV4(l13));
                        l02 = MM(AF0, BL2, l02); l03 = MM(AF0, BL3, l03); l12 = MM(AF1, BL2, l12); l13 = MM(AF1, BL3, l13); }
                    t00 = MM(AF0, BT0, t00); t01 = MM(AF0, BT1, t01); t11 = MM(AF1, BT1, t11);
                }
                if (r < 4) {
                    const f32x4 x00 = MM(AF0, BF0, ZERO4), x01 = MM(AF0, BF1, ZERO4), x11 = MM(AF1, BF1, ZERO4);
                    const f32x4 y00 = MM(BF0, AF0, ZERO4), y10 = MM(BF1, AF0, ZERO4), y11 = MM(BF1, AF1, ZERO4);
                    BF0 = CAT(CV4(x00), z4); BF1 = CAT(CV4(x01), CV4(x11));
                    AF0 = CAT(CV4(y00), CV4(y10)); AF1 = CAT(z4, CV4(y11));
                }
            }
            st4(TILE(SL_TTA), s0 * 16 + l15, s0 * 16 + 4 * g4, t00); st4(TILE(SL_TTA), s1 * 16 + l15, s0 * 16 + 4 * g4, t01); st4(TILE(SL_TTA), s1 * 16 + l15, s1 * 16 + 4 * g4, t11);
            if (w == 0) { st4(TILE(SL_TTA), 32 + l15, 4 * g4, l02); st4(TILE(SL_TTA), 48 + l15, 4 * g4, l03); st4(TILE(SL_TTA), 32 + l15, 16 + 4 * g4, l12); st4(TILE(SL_TTA), 48 + l15, 16 + 4 * g4, l13); }
#undef CAT
#undef CV4
#undef MM
        }
        else if (w >= 4 && c + 1 < SEQ / 64) { DSUM(c + 1); PREP1(c + 1); }
        __syncthreads();
        if (w < 2) {
            STAGE_LANE();
            const bf16x8 A = fragT(TILE(SL_TTA), w * 16, 32, lane), B2 = frag(TILE(SL_TTA), 32, 32, lane), B3 = frag(TILE(SL_TTA), 48, 32, lane);
            const f32x4 u2 = __builtin_amdgcn_mfma_f32_16x16x32_bf16(A, B2, ZERO4, 0, 0, 0), u3 = __builtin_amdgcn_mfma_f32_16x16x32_bf16(A, B3, ZERO4, 0, 0, 0);
            st4(TILE(SL_TTA), 32 + l15, w * 16 + 4 * g4, u2); st4(TILE(SL_TTA), 48 + l15, w * 16 + 4 * g4, u3);
        }
        __syncthreads();
        TP_MARK(2);
        {   STAGE_LANE();
            const Fr aATC = ldf(TILE(SL_ATC), ta * 16, lane), aTT = ldf(TILE(SL_TTA), ta * 16, lane); Fr bTT[2], bNKA[2];
#pragma unroll
            for (int q = 0; q < 2; ++q) { bTT[q] = ldf(TILE(SL_TTA), (tb0 + q) * 16, lane); bNKA[q] = ldfT(TILE(SL_NKA), (tb0 + q) * 16, lane); }
            f32x4 e1[2], e3[2];
#pragma unroll
            for (int q = 0; q < 2; ++q) { e1[q] = ZERO4; e3[q] = ZERO4;
                mmf(e1[q], aATC, bTT[q]);
                mmf(e3[q], aTT, bNKA[q]); }
#pragma unroll
            for (int q = 0; q < 2; ++q) { const int bcol = (tb0 + q) * 16 + l15; st4(TILE(SL_APT), bcol, a0, e1[q]); st4(TILE(SL_G), bcol, a0, e3[q]); }
        }
        __syncthreads();
        TP_MARK(3);
        {   STAGE_LANE();
            const Fr aNB = ldf(TILE(SL_NBRT), ta * 16, lane), aG = ldf(TILE(SL_G), ta * 16, lane); Fr bAP[2], bNB[2], bBB[2]; f32x4 rp[2], ps[2], accH[2];
#pragma unroll
            for (int q = 0; q < 2; ++q) { const int bcol = (tb0 + q) * 16 + l15; bAP[q] = ldfT(TILE(SL_APT), (tb0 + q) * 16, lane); bNB[q] = ldf(TILE(SL_NBRT), (tb0 + q) * 16, lane); bBB[q] = ldf(BBTc, (tb0 + q) * 16, lane);
                rp[q] = ld4(TILE(SL_RTC), bcol, a0); ps[q] = ld4(TILE(SL_KBT), bcol, a0); accH[q] = ld4(TILE(SL_NKR), bcol, a0); if (ta > tb0 + q) accH[q] = ZERO4; }
#pragma unroll
            for (int q = 0; q < 2; ++q) { mmf(rp[q], aNB, bAP[q]);
                mmf(accH[q], aG, bNB[q]);
                mmf(ps[q], aG, bBB[q]); }
#pragma unroll
            for (int q = 0; q < 2; ++q) { const int bcol = (tb0 + q) * 16 + l15;
                st4(TILE(SL_RP), bcol, a0, rp[q]); st4(TILE(SL_HT), bcol, a0, accH[q]); st4(TILE(SL_PSIT), bcol, a0, ps[q]); }
        }
        __syncthreads();
        TP_MARK(4);
        if (w < 4) {
            STAGE_LANE();
            const int vrow = w * 16 + l15;
            const Fr fS = ldf(TILE(SL_SB), w * 16, lane), fV = ldf(VTc, w * 16, lane);
            f32x4 wv[4], yv[4];
            {
                Fr fAPT[4];
#pragma unroll
                for (int q = 0; q < 4; ++q) fAPT[q] = ldf(TILE(SL_APT), q * 16, lane);
#pragma unroll
                for (int q = 0; q < 4; ++q) { wv[q] = ZERO4; mmf(wv[q], fAPT[q], fS); }
#pragma unroll
                for (int q = 0; q < 4; ++q) st4(TILE(SL_WB), vrow, q * 16 + 4 * g4, wv[q]);
            }
            {
                Fr fRPT[4], fHT[4];
#pragma unroll
                for (int q = 0; q < 4; ++q) { fRPT[q] = ldfT(TILE(SL_RP), q * 16, lane); fHT[q] = ldf(TILE(SL_HT), q * 16, lane); }
#pragma unroll
                for (int q = 0; q < 4; ++q) { yv[q] = ZERO4; mmf(yv[q], fS, fRPT[q]); mmf(yv[q], fV, fHT[q]); }
#pragma unroll
                for (int q = 0; q < 4; ++q) { const int s_ = c * 64 + q * 16 + l15; const int t_ = dir ? (SEQ - 1 - s_) : s_;
                    v2u o; o.x = pg8::cvt_pk_bf16(yv[q][0], yv[q][1]); o.y = pg8::cvt_pk_bf16(yv[q][2], yv[q][3]);
                    *(v2u*)(YS + ((size_t)b * SEQ + t_) * 1024 + hh * 64 + w * 16 + 4 * g4) = o; }
            }
            {
                Fr fPS[4];
#pragma unroll
                for (int q = 0; q < 4; ++q) fPS[q] = ldf(TILE(SL_PSIT), q * 16, lane);
#pragma unroll
                for (int q = 0; q < 4; ++q) { const f32x4 pl = *(const LAS f32x4*)(L + OFF_PL + ((c & 1) * 64 + q * 16 + 4 * g4) * 4); accS[q] = accS[q] * pl; mmf(accS[q], fPS[q], fV); }
                LWAIT();
                const Fr fW = ldf(TILE(SL_WB), w * 16, lane); Fr fBB[4];
#pragma unroll
                for (int q = 0; q < 4; ++q) fBB[q] = ldf(BBTc, q * 16, lane);
#pragma unroll
                for (int q = 0; q < 4; ++q) { mmf(accS[q], fBB[q], fW); st4(TILE(SL_SB), vrow, q * 16 + 4 * g4, accS[q]); }
            }
        } else if (c + 1 < SEQ / 64) { PREP2(c + 1); }
    }
#if TP_SEL >= 0
    if (bx == 0 && w == TP_WAVE && lane0 == 0) *(unsigned long long*)(ws + 760 * 1024) = tp_acc;
#endif
#undef RAW_LOAD
#undef STAGE_LANE
#undef PREP1
#undef PREP2
#undef PTOK
#undef DSUM
}
#undef TILE
#undef LWAIT
}
__global__ void __launch_bounds__(NTHREADS, 2) mega_fwd(Args a) {
    extern __shared__ __attribute__((aligned(16))) unsigned char lds[];
    cg::grid_group grid = cg::this_grid();
    const int G = gridDim.x, bx = blockIdx.x;
    const int vcu = (G % 8 == 0) ? (bx % 8) * (G / 8) + bx / 8 : bx;
    const int NGW = G * NWAVES;
#define WIDS() const int tid = fresh_tid(), lane = tid & 63, wave = __builtin_amdgcn_readfirstlane(tid >> 6), gw = vcu * NWAVES + wave; (void)lane; (void)gw
    unsigned char* ws = a.ws;
    LAS unsigned char* lds3 = (LAS unsigned char*)lds;
    const int lo = a.ph_lo, hi = a.ph_hi;
#ifndef ONLY
#define ONLY -1
#endif
#define IN(k) (lo <= (k) && (k) < hi && (ONLY < 0 || ONLY == (k)))
#ifndef PROBE_S
#define PROBE_S 0
#endif
#ifndef PROBE_A
#define PROBE_A 0
#endif
#ifndef DUPMASK
#define DUPMASK 0
#endif
#ifndef USE_CG
#define USE_CG 0
#endif
#define GRIDBAR(k) do { if (USE_CG || a.ph_hi > 1000) grid.sync(); else xcd_barrier(bar); } while (0)
#define SEAM(k) do { if (IN(k) && IN((k) + 1)) GRIDBAR(k); } while (0)
#define PH_BEGIN(k) if (IN(k)) for (int rep_ = 0; rep_ <= ((DUPMASK >> (k)) & 1); ++rep_) { if (rep_) GRIDBAR(1);
#define PH_END(k) } SEAM(k);
    for (int u = fresh_tid(); u < 64; u += NTHREADS) ((LAS unsigned*)(lds3 + MISC_OFF))[u] = 0u;
    __syncthreads();
    XcdBarrier bar = xcd_barrier_post((unsigned*)(ws + WS_BAR), (volatile LAS unsigned*)(lds3 + MISC_OFF) + 8);

    PH_BEGIN(0) { WIDS(); p0_prologue(a, lds3, gw, NGW, wave, lane); } PH_END(0)
    PH_BEGIN(1) {
        pg8::Gemm g{(const bf16_t*)(ws + WS_HN), (const bf16_t*)(ws + WS_WINT), DM, DM, DM}; pg8::StaticOrder S; S.init(M, IN_PAD, G, bx);
        pg8::EpiProj E{(bf16_t*)(ws + WS_PDA), (bf16_t*)((unsigned char*)a.out + DO_PRW), (bf16_t*)(ws + WS_GATES)};
        pg8::gemm_phase<pg8::EpiProj, pg8::StaticOrder, true, true>(lds3, g, S, E);
        if (G == 256 && bx >= 128) { WIDS(); expert_convert_down(a, lds3, (bx - 128) * NWAVES + wave, 128 * NWAVES, wave, lane); }
        else if (G != 256) { WIDS(); expert_convert_down(a, lds3, gw, NGW, wave, lane); }
    } PH_END(1)
    PH_BEGIN(2) { WIDS(); p2_prep(a, gw, NGW, lane); } PH_END(2)
    PH_BEGIN(3) {
        const bf16_t* LIN = (const bf16_t*)((unsigned char*)a.out + DO_LIN);
        { pg8::Gemm g{LIN, (const bf16_t*)(ws + WS_BTL1), 512, 256, 256}; pg8::StaticOrder S; S.init(M, 4096, G, bx);
          pg8::EpiLora<0> E{(bf16_t*)(ws + WS_LORA), (const float*)(ws + WS_BIAS4)};
          pg8::gemm_phase<pg8::EpiLora<0>, pg8::StaticOrder, true, true>(lds3, g, S, E); }
        { pg8::Gemm g{LIN + 256, (const bf16_t*)(ws + WS_BTL2), 512, 256, 256}; pg8::StaticOrder S; S.init(M, 1024, G, bx);
          pg8::EpiLora<1> E{(bf16_t*)(ws + WS_LORA), nullptr};
          pg8::gemm_phase<pg8::EpiLora<1>, pg8::StaticOrder, true, true>(lds3, g, S, E); }
    } PH_END(3)
    PH_BEGIN(4) { WIDS();
        const float* sm = (const float*)(ws + WS_SMALL); const float d1 = wave_sum(sm[SM_LQ1 + lane] * sm[SM_LK1 + lane]), d2 = wave_sum(sm[SM_LQ2 + lane] * sm[SM_LK2 + lane]);
        const float lam = __int_as_float(__builtin_amdgcn_readfirstlane(__float_as_int(__expf(d1) - __expf(d2) + LAM_INIT)));
        const bf16_t* PDA = (const bf16_t*)(ws + WS_PDA); bf16_t* YA = (bf16_t*)((unsigned char*)a.out + DO_YAB);
        if (G == 256) {
            int u0, nu;
            if (bx < 128) {
#if PROBE_S
                scan::scan_phase(a, lds); __syncthreads();
#endif
                scan::scan_phase(a, lds); __syncthreads(); const int i = (bx & 7) * 16 + (bx >> 3); u0 = 768 + 2 * i; nu = 2; }
            else { const int k = bx - 128, i = (k & 7) * 16 + (k >> 3); u0 = 6 * i; nu = 6; }
            attn::Stage stg[2];
            { const int bh = u0 >> 5, b = bh >> 3, h = bh & 7; const size_t row0 = (size_t)b * SEQ; attn::attn_prime(PDA + row0 * 3072 + 1024 + h * 128, PDA + row0 * 3072 + 2048 + h * 128, stg); }
            for (int q = (PROBE_A && bx >= 128) ? -1 : 0; q < nu; ++q) { const int u = u0 + (q < 0 ? 0 : q); const int bh = u >> 5, qb = u & 31, b = bh >> 3, h = bh & 7;
                const size_t row0 = (size_t)b * SEQ;
                const int un = (q + 1 < nu) ? u0 + q + 1 : u; const int bhn = un >> 5, bn = bhn >> 3, hn_ = bhn & 7; const size_t rown = (size_t)bn * SEQ;
                attn::attn_unit(PDA + (row0 + qb * 128) * 3072 + h * 128, PDA + row0 * 3072 + 1024 + h * 128, PDA + row0 * 3072 + 2048 + h * 128,
                                YA + (row0 + qb * 128) * 2048 + h * 128, lam, sm + SM_SUBLN, SEQ, (char*)lds, PDA + rown * 3072 + 1024 + hn_ * 128, PDA + rown * 3072 + 2048 + hn_ * 128, stg); }
            { __syncthreads(); const int t2 = fresh_tid(); const bool sb = bx < 128;
              expert_convert_gu(a, lds3, (sb ? bx : bx - 128) * NWAVES + (t2 >> 6), 128 * NWAVES, t2 >> 6, t2 & 63, sb ? 0 : N_EARLY_S, sb ? N_EARLY_S : N_EARLY_EXPERTS); }
        } else {
        const int upb = 1024 / G;
        for (int i = 0; i < upb; ++i) { const int u = vcu * upb + i; const int bh = u >> 5, qb = u & 31, b = bh >> 3, h = bh & 7;
            const size_t row0 = (size_t)b * SEQ;
            attn::Stage stg[2]; attn::attn_prime(PDA + row0 * 3072 + 1024 + h * 128, PDA + row0 * 3072 + 2048 + h * 128, stg);
            attn::attn_unit(PDA + (row0 + qb * 128) * 3072 + h * 128, PDA + row0 * 3072 + 1024 + h * 128, PDA + row0 * 3072 + 2048 + h * 128,
                            YA + (row0 + qb * 128) * 2048 + h * 128, lam, sm + SM_SUBLN, SEQ, (char*)lds, PDA + row0 * 3072 + 1024 + h * 128, PDA + row0 * 3072 + 2048 + h * 128, stg); }
        }
    } PH_END(4)
    if (G != 256) { PH_BEGIN(5) { scan::scan_phase(a, lds); } PH_END(5) }
    PH_BEGIN(6) { WIDS(); p6_rwpost(a, gw, NGW, lane); } PH_END(6)
    PH_BEGIN(7) {
        bf16_t* MG = (bf16_t*)(ws + WS_MERGED); const bf16_t* GT = (const bf16_t*)(ws + WS_GATES);
        { pg8::Gemm g{(const bf16_t*)((unsigned char*)a.out + DO_YAB), (const bf16_t*)(ws + WS_WAT), DM, DM, DM}; pg8::StaticOrder S; S.init(M, DM, G, bx);
          pg8::EpiMergeF E{MG, GT}; pg8::gemm_phase<pg8::EpiMergeF, pg8::StaticOrder, true, true>(lds3, g, S, E); }
    } PH_END(7)
    PH_BEGIN(8) {
        pg8::Gemm g{(const bf16_t*)(ws + WS_MERGED), (const bf16_t*)(ws + WS_WOT), DM, DM, DM}; pg8::StaticOrder S; S.init(M, DM, G, bx);
        pg8::EpiOut E{a.in[I_X], a.out, (float*)(ws + WS_SSP)};
        pg8::gemm_phase<pg8::EpiOut, pg8::StaticOrder, true, true>(lds3, g, S, E);
    } PH_END(8)
    PH_BEGIN(9) { WIDS(); p9_router(a, lds3, gw, NGW, wave, lane); } PH_END(9)
    PH_BEGIN(10) { p10_topk(a, lds); } PH_END(10)
    if (G != 256) { PH_BEGIN(11) { WIDS(); p11_gather(a, gw, NGW, lane); } PH_END(11) }
    PH_BEGIN(12) {
        pg8::EpiMoeUp E{(bf16_t*)(ws + WS_HID)};
        if (G == 256) {
            pg8::Gemm g{(const bf16_t*)(ws + WS_HN2), (const bf16_t*)ws, DM, DM, DM}; pg8::ExpertGatherOrder S{G, bx, (const int*)(ws + WS_SELTOK)};
            pg8::gemm_phase_g<pg8::EpiMoeUp, pg8::ExpertGatherOrder, true, true>(lds3, g, S, E);
        } else {
            pg8::Gemm g{(const bf16_t*)(ws + WS_XE), (const bf16_t*)(ws + WS_W1T), DM, DM, DM}; pg8::ExpertOrder S{G, bx};
            pg8::gemm_phase<pg8::EpiMoeUp, pg8::ExpertOrder, true, true>(lds3, g, S, E);
        }
    } PH_END(12)
    PH_BEGIN(13) {
        pg8::Gemm g{(const bf16_t*)(ws + WS_HID), (const bf16_t*)(ws + WS_WDT), FF, FF, FF}; pg8::ExpertOrder S{G, bx};
        pg8::EpiMoeDown E{(bf16_t*)(ws + WS_XE), (const float*)(ws + WS_SELGATE)};
        pg8::gemm_phase<pg8::EpiMoeDown, pg8::ExpertOrder, true, true>(lds3, g, S, E);
    } PH_END(13)
    PH_BEGIN(14) { WIDS(); p14_combine(a, lds, wave, lane); } }
#if TP_SEL >= 0
    if (a.ph_hi >= 15 && blockIdx.x == 0 && fresh_tid() == 0) { const unsigned long long d_ = 16ull * *(volatile unsigned long long*)(ws + 760 * 1024), t0_ = __builtin_amdgcn_s_memtime(); while (__builtin_amdgcn_s_memtime() - t0_ < d_) __builtin_amdgcn_s_sleep(8); }
#endif
#undef IN
#undef SEAM
}

constexpr int NPHASES = 15;
#ifndef MK_SPLIT
#define MK_SPLIT 0
#endif
extern "C" void kernel_launch(void* const* d_in, const int* in_sizes, int n_in, void* d_out, int out_size, void* d_ws, size_t ws_size, hipStream_t stream) {
    static int grid = 0;
    if (grid == 0) {
        if (n_in != 33 || in_sizes[0] != M * DM || out_size != M * DM || ws_size < WS_NEED) {
            fprintf(stderr, "kernel_launch: unexpected shapes: n_in %d in0 %d out %d ws %zu (need %zu)\n", n_in, n_in > 0 ? in_sizes[0] : -1, out_size, ws_size, (size_t)WS_NEED); grid = -1; return; }
        int dev = 0, cus = 0, per_cu = 0;
        if (hipGetDevice(&dev) != hipSuccess || hipDeviceGetAttribute(&cus, hipDeviceAttributeMultiprocessorCount, dev) != hipSuccess) { grid = -1; return; }
        if (hipFuncSetAttribute((const void*)mega_fwd, hipFuncAttributeMaxDynamicSharedMemorySize, LDS_BYTES) != hipSuccess) { fprintf(stderr, "kernel_launch: hipFuncSetAttribute failed\n"); grid = -1; return; }
        if (hipOccupancyMaxActiveBlocksPerMultiprocessor(&per_cu, (const void*)mega_fwd, NTHREADS, LDS_BYTES) != hipSuccess || per_cu < 1) { fprintf(stderr, "kernel_launch: occupancy query says %d\n", per_cu); (void)hipGetLastError(); per_cu = 1; }
        grid = cus;
        if (grid != 256) { fprintf(stderr, "kernel_launch: this kernel is built for a 256-CU MI355X (got %d CUs); nothing launched\n", grid); grid = -1; return; }
    }
    if (grid < 0) return;
    if (hipMemsetAsync((char*)d_ws + WS_BAR, 0, 16384, stream) != hipSuccess) { fprintf(stderr, "kernel_launch: memset failed\n"); return; }
    Args a{};
    for (int i = 0; i < 33; ++i) a.in[i] = (const float*)d_in[i];
    a.out = (float*)d_out; a.ws = (unsigned char*)d_ws;
#if MK_SPLIT
    for (int p = 0; p < NPHASES; ++p) { a.ph_lo = p; a.ph_hi = p + 1; void* args[] = {&a};
        hipError_t e = hipLaunchCooperativeKernel((const void*)mega_fwd, dim3(grid), dim3(NTHREADS), args, LDS_BYTES, stream);
        if (e != hipSuccess) { fprintf(stderr, "kernel_launch: launch of phase %d failed: %s\n", p, hipGetErrorString(e)); return; } }
#else
    a.ph_lo = 0; a.ph_hi = NPHASES; void* args[] = {&a};
    hipError_t e = hipLaunchCooperativeKernel((const void*)mega_fwd, dim3(grid), dim3(NTHREADS), args, LDS_BYTES, stream);
    if (e != hipSuccess) fprintf(stderr, "kernel_launch: cooperative launch failed: %s (grid %d)\n", hipGetErrorString(e), grid);
#endif
}
```
